# Optimizing an MI355X kernel written in HIP

```python
import math
import jax
import jax.numpy as jnp
from jax import lax
import numpy as np

D_MODEL = 4096
BATCH = 2
SEQ = 4096
DEPTH = 2

GRID_W = 64
CTX_LEN = 256
HEAD_DIM = 128
MIX_WIDTH = D_MODEL
N_HEADS_TOTAL = MIX_WIDTH // HEAD_DIM
H_A = N_HEADS_TOTAL // 4
KV_A = H_A // 4
H_B = N_HEADS_TOTAL // 4
DH_B = HEAD_DIM // 2
H_C = N_HEADS_TOTAL // 4
KV_C = H_C // 4
H_D = N_HEADS_TOTAL // 4
WIN_C = 128
NA_KH = 8
NA_KW = 16
Q_BLOCK = 128
D_FF = ((8 * D_MODEL // 3 + 255) // 256) * 256
CONV_W = 3
ROPE_THETA = 10000.0
EPS = 1e-6
NEG_INF = -1e30

Q_SHAPES = ((H_A, HEAD_DIM), (H_B, 2, DH_B), (H_C, HEAD_DIM), (H_D, HEAD_DIM))
KV_SHAPES = ((KV_A, HEAD_DIM), (KV_A, HEAD_DIM), (H_B, 2, DH_B), (H_B, HEAD_DIM),
             (KV_C, HEAD_DIM), (KV_C, HEAD_DIM), (H_D, HEAD_DIM), (H_D, HEAD_DIM))
N_Q = sum(int(np.prod(s)) for s in Q_SHAPES)
N_KV = sum(int(np.prod(s)) for s in KV_SHAPES)
N_IN = N_Q + N_KV

kernel_name = 'hymba_style_four_group_flow_backbone'


def rmsnorm(x, g):
    xf = x.astype(jnp.float32)
    y = xf * lax.rsqrt(jnp.mean(xf * xf, axis=-1, keepdims=True) + EPS)
    return (y * g.astype(jnp.float32)).astype(x.dtype)


def axial_rope(head_dim, rows, cols):
    quarter = head_dim // 4
    inv = ROPE_THETA ** (-jnp.arange(quarter, dtype=jnp.float32) / quarter)
    ang = jnp.concatenate([rows[:, None] * inv, cols[:, None] * inv], axis=-1)
    return jnp.cos(ang), jnp.sin(ang)


def apply_rope(x, rope):
    cos = rope[0][None, :, None, :].astype(x.dtype)
    sin = rope[1][None, :, None, :].astype(x.dtype)
    x1, x2 = x[..., 0::2], x[..., 1::2]
    return jnp.stack([x1 * cos - x2 * sin, x1 * sin + x2 * cos], axis=-1).reshape(x.shape)


def project_heads(p, with_q):
    shapes = (Q_SHAPES if with_q else ()) + KV_SHAPES
    sizes = [int(np.prod(s)) for s in shapes]
    parts = jnp.split(p, np.cumsum(sizes)[:-1].tolist(), axis=-1)
    out = [t.reshape(t.shape[:2] + s) for t, s in zip(parts, shapes)]
    if not with_q:
        out = [None, None, None, None] + out
    return out


def gqa_attend(q, k, v, mask=None, sink=None):
    s = jnp.einsum('bqkgd,bskd->bkgqs', q, k).astype(jnp.float32) * (q.shape[-1] ** -0.5)
    if mask is not None:
        s = jnp.where(mask, s, NEG_INF)
    if sink is not None:
        sk = jnp.broadcast_to(sink.astype(jnp.float32)[None, :, :, None, None], s.shape[:-1] + (1,))
        p = jax.nn.softmax(jnp.concatenate([s, sk], axis=-1), axis=-1)[..., :-1]
    else:
        p = jax.nn.softmax(s, axis=-1)
    return jnp.einsum('bkgqs,bskd->bqkgd', p.astype(v.dtype), v)


def mixer_a(q, k, v, qc, kc, vc, g_q, g_k, rope):
    B, S, H, d = q.shape
    G = H // KV_A
    q = apply_rope(rmsnorm(q, g_q), rope).reshape(B, S, KV_A, G, d)
    k = apply_rope(rmsnorm(k, g_k), rope)
    kc = rmsnorm(kc, g_k)
    k_all = jnp.concatenate([k, kc], axis=1)
    v_all = jnp.concatenate([v, vc], axis=1)

    def block(i):
        qi = lax.dynamic_slice_in_dim(q, i * Q_BLOCK, Q_BLOCK, axis=1)
        return gqa_attend(qi, k_all, v_all)

    o = lax.map(block, jnp.arange(S // Q_BLOCK))
    o = jnp.moveaxis(o, 0, 1).reshape(B, S, H * d)
    oc = None
    if qc is not None:
        C = qc.shape[1]
        qcn = rmsnorm(qc, g_q).reshape(B, C, KV_A, G, d)
        oc = gqa_attend(qcn, kc, vc).reshape(B, C, H * d)
    return o, oc


def diff_attend(q, k, v, lam):
    s = jnp.einsum('bqhcd,bkhcd->bhcqk', q, k).astype(jnp.float32) * (q.shape[-1] ** -0.5)
    p = jax.nn.softmax(s, axis=-1)
    w = p[:, :, 0] - lam * p[:, :, 1]
    return jnp.einsum('bhqk,bkhe->bqhe', w.astype(v.dtype), v)


def mixer_b(q, k, v, qc, kc, vc, lam_q1, lam_k1, lam_q2, lam_k2, g_sub, lam_init, rope):
    B, S, H, _, dh = q.shape
    q = apply_rope(q.reshape(B, S, H * 2, dh), rope).reshape(B, S, H, 2, dh)
    k = apply_rope(k.reshape(B, S, H * 2, dh), rope).reshape(B, S, H, 2, dh)
    f32 = jnp.float32
    lam = (jnp.exp(jnp.sum(lam_q1.astype(f32) * lam_k1.astype(f32)))
           - jnp.exp(jnp.sum(lam_q2.astype(f32) * lam_k2.astype(f32))) + lam_init)
    k_all = jnp.concatenate([k, kc], axis=1)
    v_all = jnp.concatenate([v, vc], axis=1)

    def block(i):
        qi = lax.dynamic_slice_in_dim(q, i * Q_BLOCK, Q_BLOCK, axis=1)
        return diff_attend(qi, k_all, v_all, lam)

    o = lax.map(block, jnp.arange(S // Q_BLOCK))
    o = jnp.moveaxis(o, 0, 1).reshape(B, S, H, v.shape[-1])
    o = (rmsnorm(o, g_sub) * (1.0 - lam_init)).reshape(B, S, -1)
    oc = None
    if qc is not None:
        C = qc.shape[1]
        oc = (rmsnorm(diff_attend(qc, kc, vc, lam), g_sub) * (1.0 - lam_init)).reshape(B, C, -1)
    return o, oc


def mixer_c(q, k, v, qc, kc, vc, sink, rope):
    B, S, H, d = q.shape
    G = H // KV_C
    q = apply_rope(q, rope).reshape(B, S, KV_C, G, d)
    k = apply_rope(k, rope)
    pad = ((0, 0), (WIN_C, WIN_C), (0, 0), (0, 0))
    kp = jnp.pad(k, pad)
    vp = jnp.pad(v, pad)
    band = Q_BLOCK + 2 * WIN_C
    sink_g = sink.reshape(KV_C, G)
    ctx_ok = jnp.ones((Q_BLOCK, kc.shape[1]), dtype=bool)

    def block(i):
        s0 = i * Q_BLOCK
        qi = lax.dynamic_slice_in_dim(q, s0, Q_BLOCK, axis=1)
        kb = lax.dynamic_slice_in_dim(kp, s0, band, axis=1)
        vb = lax.dynamic_slice_in_dim(vp, s0, band, axis=1)
        qpos = s0 + jnp.arange(Q_BLOCK)
        kpos = s0 - WIN_C + jnp.arange(band)
        local = ((kpos >= 0) & (kpos < S))[None, :] & (jnp.abs(qpos[:, None] - kpos[None, :]) <= WIN_C)
        mask = jnp.concatenate([local, ctx_ok], axis=1)
        return gqa_attend(qi, jnp.concatenate([kb, kc], axis=1), jnp.concatenate([vb, vc], axis=1), mask, sink_g)

    o = lax.map(block, jnp.arange(S // Q_BLOCK))
    o = jnp.moveaxis(o, 0, 1).reshape(B, S, H * d)
    oc = None
    if qc is not None:
        C = qc.shape[1]
        oc = gqa_attend(qc.reshape(B, C, KV_C, G, d), kc, vc, sink=sink_g).reshape(B, C, H * d)
    return o, oc


def mixer_d(q, k, v, qc, kc, vc, bias_table, n_rows):
    B, S, H, d = q.shape
    kh = min(NA_KH, n_rows)
    kw = NA_KW
    scale = d ** -0.5
    qg = q.reshape(B, n_rows, GRID_W, H, d)
    kg = k.reshape(B, n_rows, GRID_W, H, d)
    vg = v.reshape(B, n_rows, GRID_W, H, d)
    cols = np.arange(GRID_W)
    col_idx = np.clip(cols - kw // 2, 0, GRID_W - kw)[:, None] + np.arange(kw)[None, :]
    col_off = col_idx - cols[:, None] + NA_KW - 1
    bias_cols = bias_table[:, :, col_off]

    def row(r):
        rs = jnp.clip(r - kh // 2, 0, n_rows - kh)
        kn = lax.dynamic_slice_in_dim(kg, rs, kh, axis=1)[:, :, col_idx]
        vn = lax.dynamic_slice_in_dim(vg, rs, kh, axis=1)[:, :, col_idx]
        qr = lax.dynamic_index_in_dim(qg, r, axis=1, keepdims=False)
        s_loc = jnp.einsum('bwhd,brwkhd->bhwrk', qr, kn).astype(jnp.float32) * scale
        roff = rs + jnp.arange(kh) - r + NA_KH - 1
        bias = jnp.take(bias_cols, roff, axis=1).transpose(0, 2, 1, 3)
        s_loc = (s_loc + bias[None].astype(jnp.float32)).reshape(B, H, GRID_W, kh * kw)
        s_ctx = jnp.einsum('bwhd,bchd->bhwc', qr, kc).astype(jnp.float32) * scale
        p = jax.nn.softmax(jnp.concatenate([s_loc, s_ctx], axis=-1), axis=-1).astype(v.dtype)
        p_loc = p[..., :kh * kw].reshape(B, H, GRID_W, kh, kw)
        p_ctx = p[..., kh * kw:]
        return (jnp.einsum('bhwrk,brwkhd->bwhd', p_loc, vn)
                + jnp.einsum('bhwc,bchd->bwhd', p_ctx, vc))

    o = lax.map(row, jnp.arange(n_rows))
    o = jnp.moveaxis(o, 0, 1).reshape(B, S, H * d)
    oc = None
    if qc is not None:
        C = qc.shape[1]
        oc = gqa_attend(qc[:, :, :, None, :], kc, vc).reshape(B, C, H * d)
    return o, oc


def conv_ffn(x, w_up, conv_w, w_down):
    L = x.shape[1]
    u = x @ w_up
    up = jnp.pad(u, ((0, 0), (CONV_W // 2, CONV_W // 2), (0, 0)))
    u = sum(up[:, j:j + L] * conv_w[j] for j in range(CONV_W))
    gate, val = jnp.split(u, 2, axis=-1)
    return (jax.nn.silu(gate) * val) @ w_down


def trunk_layer(x, h, silu_c, silu_cc, rope_hd, rope_dh, n_rows, layer_idx, last,
                w_ada, b_ada, g_attn_pre, g_attn_post, g_mlp_pre, g_mlp_post,
                w_in, w_out, g_q_a, g_k_a, lam_q1, lam_k1, lam_q2, lam_k2, g_sub_b,
                sink_c, na_bias, w_up, conv_w, w_down):
    D = x.shape[-1]
    mod = (silu_c @ w_ada + b_ada)[:, None, :]
    sh_a, sc_a, gt_a, sh_m, sc_m, gt_m = jnp.split(mod, 6, axis=-1)
    n_c = 2 if last else 6
    mod_c = jnp.split(silu_cc @ w_ada[:, :n_c * D] + b_ada[:n_c * D], n_c)
    hx = rmsnorm(x, g_attn_pre) * (1 + sc_a) + sh_a
    hc = rmsnorm(h, g_attn_pre) * (1 + mod_c[1]) + mod_c[0]
    lat = project_heads(hx @ w_in, True)
    cx = project_heads(hc @ (w_in[:, N_Q:] if last else w_in), not last)
    lam_init = 0.8 - 0.6 * math.exp(-0.3 * layer_idx)
    o_a, co_a = mixer_a(lat[0], lat[4], lat[5], cx[0], cx[4], cx[5], g_q_a, g_k_a, rope_hd)
    o_b, co_b = mixer_b(lat[1], lat[6], lat[7], cx[1], cx[6], cx[7],
                        lam_q1, lam_k1, lam_q2, lam_k2, g_sub_b, lam_init, rope_dh)
    o_c, co_c = mixer_c(lat[2], lat[8], lat[9], cx[2], cx[8], cx[9], sink_c, rope_hd)
    o_d, co_d = mixer_d(lat[3], lat[10], lat[11], cx[3], cx[10], cx[11], na_bias, n_rows)
    o = jnp.concatenate([o_a, o_b, o_c, o_d], axis=-1) @ w_out
    x = x + gt_a * rmsnorm(o, g_attn_post)
    hx = rmsnorm(x, g_mlp_pre) * (1 + sc_m) + sh_m
    x = x + gt_m * rmsnorm(conv_ffn(hx, w_up, conv_w, w_down), g_mlp_post)
    if not last:
        co = jnp.concatenate([co_a, co_b, co_c, co_d], axis=-1) @ w_out
        h = h + mod_c[2] * rmsnorm(co, g_attn_post)
        hc = rmsnorm(h, g_mlp_pre) * (1 + mod_c[4]) + mod_c[3]
        h = h + mod_c[5] * rmsnorm(conv_ffn(hc, w_up, conv_w, w_down), g_mlp_post)
    return x, h


def setup_inputs(seed: int = 0) -> dict:
    key = jax.random.key(seed)
    ks = jax.random.split(key, 24)
    f32 = jnp.float32
    L, D = DEPTH, D_MODEL

    def nrm(k, shape, scale):
        return jax.random.normal(k, shape, f32) * scale

    return {
        'x': nrm(ks[0], (BATCH, SEQ, D), 1.0),
        'c': nrm(ks[1], (BATCH, D), 1.0),
        'ctx': nrm(ks[2], (BATCH, CTX_LEN, D), 1.0),
        'c_ctx': nrm(ks[3], (D,), 1.0),
        'w_ada': nrm(ks[4], (L, D, 6 * D), 0.5 * D ** -0.5),
        'b_ada': nrm(ks[5], (L, 6 * D), 0.01),
        'g_attn_pre': 1.0 + nrm(ks[6], (L, D), 0.02),
        'g_attn_post': 1.0 + nrm(ks[7], (L, D), 0.02),
        'g_mlp_pre': 1.0 + nrm(ks[8], (L, D), 0.02),
        'g_mlp_post': 1.0 + nrm(ks[9], (L, D), 0.02),
        'w_in': nrm(ks[10], (L, D, N_IN), D ** -0.5),
        'w_out': nrm(ks[11], (L, MIX_WIDTH, D), MIX_WIDTH ** -0.5),
        'g_q_a': 1.0 + nrm(ks[12], (L, HEAD_DIM), 0.02),
        'g_k_a': 1.0 + nrm(ks[13], (L, HEAD_DIM), 0.02),
        'lam_q1': nrm(ks[14], (L, DH_B), 0.1),
        'lam_k1': nrm(ks[15], (L, DH_B), 0.1),
        'lam_q2': nrm(ks[16], (L, DH_B), 0.1),
        'lam_k2': nrm(ks[17], (L, DH_B), 0.1),
        'g_sub_b': 1.0 + nrm(ks[18], (L, HEAD_DIM), 0.02),
        'sink_c': nrm(ks[19], (L, H_C), 0.5),
        'na_bias': nrm(ks[20], (L, H_D, 2 * NA_KH - 1, 2 * NA_KW - 1), 0.1),
        'w_up': nrm(ks[21], (L, D, 2 * D_FF), D ** -0.5),
        'conv_ffn_w': nrm(ks[22], (L, CONV_W, 2 * D_FF), CONV_W ** -0.5),
        'w_down': nrm(ks[23], (L, D_FF, D), D_FF ** -0.5),
    }


def reference(x, c, ctx, c_ctx, w_ada, b_ada, g_attn_pre, g_attn_post, g_mlp_pre, g_mlp_post,
              w_in, w_out, g_q_a, g_k_a, lam_q1, lam_k1, lam_q2, lam_k2, g_sub_b, sink_c, na_bias,
              w_up, conv_ffn_w, w_down):
    S = x.shape[1]
    n_rows = S // GRID_W
    t = jnp.arange(S)
    rows = (t // GRID_W).astype(jnp.float32)
    cols = (t % GRID_W).astype(jnp.float32)
    rope_hd = axial_rope(HEAD_DIM, rows, cols)
    rope_dh = axial_rope(DH_B, rows, cols)
    silu_c = jax.nn.silu(c)
    silu_cc = jax.nn.silu(c_ctx)
    h = ctx
    for l in range(DEPTH):
        x, h = trunk_layer(x, h, silu_c, silu_cc, rope_hd, rope_dh, n_rows, l, l == DEPTH - 1,
                           w_ada[l], b_ada[l], g_attn_pre[l], g_attn_post[l], g_mlp_pre[l], g_mlp_post[l],
                           w_in[l], w_out[l], g_q_a[l], g_k_a[l], lam_q1[l], lam_k1[l], lam_q2[l], lam_k2[l],
                           g_sub_b[l], sink_c[l], na_bias[l], w_up[l], conv_ffn_w[l], w_down[l])
    return x
```

```cpp
#include <hip/hip_runtime.h>
#include <cstdio>
#include <cstdint>

#ifndef MK_SINGLE
#define MK_SINGLE 0
#endif

namespace pg8 {
#define PG8_LAS __attribute__((address_space(3)))
typedef unsigned short bf16_t;
typedef short bf16x8 __attribute__((ext_vector_type(8)));
typedef float f32x4 __attribute__((ext_vector_type(4)));
typedef unsigned u32x4 __attribute__((ext_vector_type(4)));
constexpr int BM = 256, BK = 64, HALF = 128, HTB = HALF * BK * 2, STAGE_BYTES = 8 * HTB, NXCD = 8, WGM = 8;

__host__ __device__ __forceinline__ int lds_byte(int r, int c) { const int st = (r >> 4) * 2 + (c >> 5), rr = r & 15, cc = c & 31, ob = rr * 64 + cc * 2; return st * 1024 + (ob ^ (((ob >> 9) & 1) << 5)); }
__host__ __device__ __forceinline__ void stage_rc(int b, int& R, int& C) { const int st = b / 1024, sb = b % 1024, swz = sb ^ (((sb >> 9) & 1) << 5); R = (st >> 1) * 16 + swz / 64; C = (st & 1) * 32 + (swz % 64) / 2; }
__host__ __device__ __forceinline__ int perm32(int rho) { const int n = rho >> 4, i = rho & 15; return 8 * (i >> 2) + 4 * n + (i & 3); }

struct Unit { int pm, pn; };
struct Gemm { const bf16_t* A; const bf16_t* Bt; int M, N, K; };

struct StaticOrder {
    int nM, nN, nwg, G, c, skip;
    __host__ __device__ void init(int nM_, int N, int G_, int c_, int skip_) { nM = nM_; nN = N / BM; nwg = nM * nN; G = G_; c = c_; skip = skip_; }
    __host__ __device__ bool next(int i, Unit& u) const {
        const long L = (long)i * G + c; if (L >= nwg) return false;
        int wgid = (int)L; { const int q = nwg / NXCD, r = nwg % NXCD, xcd = wgid % NXCD, off = wgid / NXCD; wgid = (xcd < r ? xcd * (q + 1) : r * (q + 1) + (xcd - r) * q) + off; }
        const int nig = WGM * nN, gid = wgid / nig, fm = gid * WGM, gsz = (nM - fm) < WGM ? (nM - fm) : WGM;
        u.pm = fm + ((wgid % nig) % gsz); u.pn = (wgid % nig) / gsz;
        if (skip && u.pm >= 16) u.pm += 1;
        return true;
    }
    __device__ __forceinline__ void a_ready(const Unit&) const {}
    __device__ __forceinline__ void done(const Unit&) const {}
};

__device__ __forceinline__ unsigned cvt_pk_bf16(float lo, float hi) { unsigned r; asm volatile("v_cvt_pk_bf16_f32 %0, %1, %2" : "=v"(r) : "v"(lo), "v"(hi)); return r; }

struct EpiBf16 {
    static constexpr bool PERM = true, AFTER_DRAIN = false;
    bf16_t* O; int ldc;
    __device__ __forceinline__ void operator()(const f32x4 (&acc)[2][2][4][2], const Unit& u, int wr, int wc, int fr, int fq) const {
        const int row0 = u.pm * BM + wr * 64 + fr; const int col0 = u.pn * BM + wc * 32 + 8 * fq;
#pragma unroll
        for (int ai = 0; ai < 2; ++ai)
#pragma unroll
            for (int m = 0; m < 4; ++m) { bf16_t* rowp = O + (size_t)(row0 + ai * HALF + m * 16) * ldc + col0;
#pragma unroll
                for (int bj = 0; bj < 2; ++bj) { const f32x4 v0 = acc[ai][bj][m][0], v1 = acc[ai][bj][m][1];
                    u32x4 w; w.x = cvt_pk_bf16(v0[0], v0[1]); w.y = cvt_pk_bf16(v0[2], v0[3]); w.z = cvt_pk_bf16(v1[0], v1[1]); w.w = cvt_pk_bf16(v1[2], v1[3]);
                    *(u32x4*)(rowp + bj * HALF) = w; } }
    }
};

template <class Epi, class Sched, bool ALIGN_EPI = false>
__device__ __forceinline__ void gemm_phase(PG8_LAS unsigned char* lds, const Gemm g, const Sched& S, const Epi& E) {
    int tid_ = threadIdx.x; asm volatile("" : "+v"(tid_));
    const int tid = tid_, wid = __builtin_amdgcn_readfirstlane(tid >> 6), lane = tid & 63, wr = wid >> 2, wc = wid & 3, fr = lane & 15, fq = lane >> 4;
    const int K = g.K, nt = K / BK;
    unsigned voffA[2], voffB[2];
#pragma unroll
    for (int i = 0; i < 2; ++i) { int R, C; stage_rc(tid * 16 + i * 8192, R, C); const int Rb = Epi::PERM ? ((R & ~31) + perm32(R & 31)) : R;
        voffA[i] = (unsigned)(R * K + C) * 2u; voffB[i] = (unsigned)(Rb * K + C) * 2u; }
    const size_t kstep = (size_t)(BK * 2);
    const size_t hstep = (size_t)HALF * K * 2;
    const size_t tstep = 2 * hstep;
    const unsigned ldsw = (unsigned)wid * 1024u;
    const int aoff = lds_byte(wr * 64 + fr, fq * 8), boff = lds_byte(wc * 32 + fr, fq * 8);
#define PG8_SA(b, h) (((b) * 2 + (h)) * HTB)
#define PG8_SB(b, h) ((4 + (b) * 2 + (h)) * HTB)
#define PG8_STAGE(bufoff, gbase, voff) do { _Pragma("unroll") for (int _i = 0; _i < 2; ++_i) \
        __builtin_amdgcn_global_load_lds((const unsigned*)((const char*)(gbase) + (voff)[_i]), (PG8_LAS unsigned*)(lds + (bufoff) + ldsw + _i * 8192), 16, 0, 0); } while (0)
#define PG8_LDA(dst, b, h) do { _Pragma("unroll") for (int m = 0; m < 4; ++m) _Pragma("unroll") for (int k = 0; k < 2; ++k) dst[m][k] = *(const PG8_LAS bf16x8*)(lds + PG8_SA(b, h) + aoff + m * 2048 + k * 1024); } while (0)
#define PG8_LDB(dst, b, h) do { _Pragma("unroll") for (int n = 0; n < 2; ++n) _Pragma("unroll") for (int k = 0; k < 2; ++k) dst[n][k] = *(const PG8_LAS bf16x8*)(lds + PG8_SB(b, h) + boff + n * 2048 + k * 1024); } while (0)
#define PG8_MMA(ai, bj, At, Bt) do { __builtin_amdgcn_s_setprio(1); _Pragma("unroll") for (int m = 0; m < 4; ++m) _Pragma("unroll") for (int n = 0; n < 2; ++n) _Pragma("unroll") for (int k = 0; k < 2; ++k) \
        acc[ai][bj][m][n] = __builtin_amdgcn_mfma_f32_16x16x32_bf16(Bt[n][k], At[m][k], acc[ai][bj][m][n], 0, 0, 0); __builtin_amdgcn_s_setprio(0); } while (0)
#define PG8_WAIT_V(n) asm volatile("s_waitcnt vmcnt(" #n ")" ::: "memory")
#define PG8_WAIT_L(n) asm volatile("s_waitcnt lgkmcnt(" #n ")" ::: "memory")
#define PG8_BAR __builtin_amdgcn_s_barrier()
#define PG8_SCHED __builtin_amdgcn_sched_barrier(0)
    Unit cur, nxt; int ui = 0;
    if (!S.next(0, cur)) return;
    f32x4 acc[2][2][4][2];
#pragma unroll
    for (int a = 0; a < 2; ++a)
#pragma unroll
        for (int b = 0; b < 2; ++b)
#pragma unroll
            for (int m = 0; m < 4; ++m)
#pragma unroll
                for (int n = 0; n < 2; ++n) acc[a][b][m][n] = (f32x4){0.f, 0.f, 0.f, 0.f};
    bf16x8 At[4][2], B0[2][2], B1[2][2];
    const char* cA = (const char*)g.A + (size_t)cur.pm * tstep; const char* cB = (const char*)g.Bt + (size_t)cur.pn * tstep;
    S.a_ready(cur);
    PG8_STAGE(PG8_SB(0, 0), cB, voffB); PG8_STAGE(PG8_SB(0, 1), cB + hstep, voffB); PG8_STAGE(PG8_SA(0, 0), cA, voffA); PG8_STAGE(PG8_SA(0, 1), cA + hstep, voffA);
    if (wr == 1) PG8_BAR;
    PG8_WAIT_V(2); PG8_BAR;
    PG8_STAGE(PG8_SB(1, 0), cB + kstep, voffB); PG8_STAGE(PG8_SA(1, 0), cA + kstep, voffA); PG8_STAGE(PG8_SB(1, 1), cB + hstep + kstep, voffB);
    PG8_WAIT_V(6); PG8_BAR;
    for (;;) {
        const bool has_next = S.next(ui + 1, nxt);
        const char* nA = has_next ? (const char*)g.A + (size_t)nxt.pm * tstep : cA; const char* nB = has_next ? (const char*)g.Bt + (size_t)nxt.pn * tstep : cB;
        for (int t = 0; t < nt; t += 2) {
            const bool last = (t == nt - 2);
            const char* a1 = cA + (size_t)(t + 1) * kstep;
            const char* a2 = last ? nA : cA + (size_t)(t + 2) * kstep; const char* b2 = last ? nB : cB + (size_t)(t + 2) * kstep;
            const char* a3 = a2 + kstep; const char* b3 = b2 + kstep;
            if (last && has_next) S.a_ready(nxt);
            PG8_LDB(B0, 0, 0); PG8_LDB(B1, 0, 1); PG8_SCHED; PG8_LDA(At, 0, 0); PG8_STAGE(PG8_SA(1, 1), a1 + hstep, voffA);
            PG8_WAIT_V(8); PG8_WAIT_L(0); PG8_BAR; PG8_MMA(0, 0, At, B0); PG8_MMA(0, 1, At, B1); PG8_BAR; PG8_SCHED;
            PG8_LDA(At, 0, 1); PG8_STAGE(PG8_SB(0, 0), b2, voffB); PG8_STAGE(PG8_SB(0, 1), b2 + hstep, voffB); PG8_STAGE(PG8_SA(0, 0), a2, voffA);
            PG8_WAIT_V(8); PG8_WAIT_L(0); PG8_BAR; PG8_MMA(1, 0, At, B0); PG8_MMA(1, 1, At, B1); PG8_BAR; PG8_SCHED;
            PG8_LDB(B0, 1, 0); PG8_LDB(B1, 1, 1); PG8_SCHED; PG8_LDA(At, 1, 0); PG8_STAGE(PG8_SA(0, 1), a2 + hstep, voffA);
            PG8_WAIT_V(8); PG8_WAIT_L(0); PG8_BAR; PG8_MMA(0, 0, At, B0); PG8_MMA(0, 1, At, B1); PG8_BAR; PG8_SCHED;
            PG8_LDA(At, 1, 1); PG8_STAGE(PG8_SB(1, 0), b3, voffB); PG8_STAGE(PG8_SB(1, 1), b3 + hstep, voffB); PG8_STAGE(PG8_SA(1, 0), a3, voffA);
            PG8_WAIT_V(8); PG8_WAIT_L(0); PG8_BAR; PG8_MMA(1, 0, At, B0); PG8_MMA(1, 1, At, B1); PG8_BAR; PG8_SCHED;
        }
        if constexpr (ALIGN_EPI) { if (wr == 0) PG8_BAR; }
        if constexpr (!Epi::AFTER_DRAIN) { E(acc, cur, wr, wc, fr, fq); S.done(cur); }
        if (!has_next) break;
#pragma unroll
        for (int a = 0; a < 2; ++a)
#pragma unroll
            for (int b = 0; b < 2; ++b)
#pragma unroll
                for (int m = 0; m < 4; ++m)
#pragma unroll
                    for (int n = 0; n < 2; ++n) acc[a][b][m][n] = (f32x4){0.f, 0.f, 0.f, 0.f};
        cur = nxt; cA = nA; cB = nB; ++ui;
        if constexpr (ALIGN_EPI) { if (wr == 1) PG8_BAR; }
    }
    PG8_WAIT_V(0);
    if constexpr (!ALIGN_EPI) { if (wr == 0) PG8_BAR; }
    PG8_BAR;
#undef PG8_SA
#undef PG8_SB
#undef PG8_STAGE
#undef PG8_LDA
#undef PG8_LDB
#undef PG8_MMA
#undef PG8_WAIT_V
#undef PG8_WAIT_L
#undef PG8_BAR
#undef PG8_SCHED
}
}

namespace att {
#define ALAS __attribute__((address_space(3)))
typedef unsigned short bf16;
typedef short bf16x8 __attribute__((ext_vector_type(8)));
typedef short s16x4 __attribute__((ext_vector_type(4)));
typedef float f32x16 __attribute__((ext_vector_type(16)));
typedef unsigned u32x4 __attribute__((ext_vector_type(4)));
constexpr int LDP = 9216, LDO = 4096;
constexpr int SLOT = 32768;
constexpr int WSCR_OFF = 131072 + 1024, BIAS_OFF = WSCR_OFF + 2048, SHM_END = BIAS_OFF + 2048;
constexpr int NCTX_T = 4;
#define KSWZ(row, colB) ((row) * 256 + ((colB) ^ (((row) & 7) << 4)))
#define SBAR() __builtin_amdgcn_sched_barrier(0)
__device__ __forceinline__ int crow(int r, int hi) { return (r & 3) + 8 * (r >> 2) + 4 * hi; }
__device__ __forceinline__ unsigned cvtpk(float lo, float hi) { unsigned r; asm volatile("v_cvt_pk_bf16_f32 %0, %1, %2" : "=v"(r) : "v"(lo), "v"(hi)); return r; }

__device__ __forceinline__ void partialSM(f32x16& p0, f32x16& p1, float& m_reg, float& mn, float& alpha, const float C, const float thr_raw) {
    float pmax = p0[0];
#pragma unroll
    for (int r = 1; r < 16; ++r) pmax = fmaxf(pmax, p0[r]);
#pragma unroll
    for (int r = 0; r < 16; ++r) pmax = fmaxf(pmax, p1[r]);
    { auto rr = __builtin_amdgcn_permlane32_swap(__float_as_uint(pmax), __float_as_uint(pmax), false, false);
      pmax = fmaxf(__uint_as_float(rr[0]), __uint_as_float(rr[1])); }
    if (__builtin_expect(__all(pmax - m_reg <= thr_raw), 1)) { mn = m_reg; alpha = 1.f; }
    else { mn = fmaxf(m_reg, pmax); alpha = __builtin_amdgcn_exp2f((m_reg - mn) * C); m_reg = mn; }
    const float mnC = -mn * C;
#pragma unroll
    for (int r = 0; r < 16; ++r) p0[r] = fmaf(p0[r], C, mnC);
#pragma unroll
    for (int r = 0; r < 16; ++r) p1[r] = fmaf(p1[r], C, mnC);
#pragma unroll
    for (int r = 0; r < 16; ++r) p0[r] = __builtin_amdgcn_exp2f(p0[r]);
}
__device__ __forceinline__ void finishSM(f32x16& p0, f32x16& p1, float alpha, float& l_reg, bf16x8& pa0, bf16x8& pa1, bf16x8& pa2, bf16x8& pa3) {
#pragma unroll
    for (int r = 0; r < 16; ++r) p1[r] = __builtin_amdgcn_exp2f(p1[r]);
    float ps = 0;
#pragma unroll
    for (int r = 0; r < 16; ++r) ps += p0[r];
#pragma unroll
    for (int r = 0; r < 16; ++r) ps += p1[r];
    { auto rr = __builtin_amdgcn_permlane32_swap(__float_as_uint(ps), __float_as_uint(ps), false, false);
      ps = __uint_as_float(rr[0]) + __uint_as_float(rr[1]); }
    l_reg = l_reg * alpha + ps;
#define PK4(P, BASE, OUT) do { unsigned a0 = cvtpk(P[BASE + 0], P[BASE + 1]), a1 = cvtpk(P[BASE + 2], P[BASE + 3]);   \
    unsigned b0 = cvtpk(P[BASE + 4], P[BASE + 5]), b1 = cvtpk(P[BASE + 6], P[BASE + 7]);                              \
    auto r0 = __builtin_amdgcn_permlane32_swap(a0, b0, false, false); auto r1 = __builtin_amdgcn_permlane32_swap(a1, b1, false, false); \
    u32x4 w = {r0[0], r1[0], r0[1], r1[1]}; OUT = __builtin_bit_cast(bf16x8, w); } while (0)
    PK4(p0, 0, pa0); PK4(p0, 8, pa1); PK4(p1, 0, pa2); PK4(p1, 8, pa3);
#undef PK4
}
template <int D0LO, int D0N>
__device__ __forceinline__ void qkt(f32x16& p0, f32x16& p1, const ALAS char* Ks, const bf16x8* qr, int r32, int hi) {
    p0 = f32x16{}; p1 = f32x16{};
#pragma unroll
    for (int d0 = D0LO; d0 < D0LO + D0N; ++d0) { const int cb = (d0 * 16 + hi * 8) * 2;
        const bf16x8 b0 = *(const ALAS bf16x8*)(Ks + KSWZ(r32, cb));
        const bf16x8 b1 = *(const ALAS bf16x8*)(Ks + KSWZ(32 + r32, cb));
        p0 = __builtin_amdgcn_mfma_f32_32x32x16_bf16(b0, qr[d0], p0, 0, 0, 0);
        p1 = __builtin_amdgcn_mfma_f32_32x32x16_bf16(b1, qr[d0], p1, 0, 0, 0); }
}
__device__ __forceinline__ int v_st(int k, int c) { const int kk = (k & ~0xC) | ((k & 4) << 1) | ((k & 8) >> 1); return ((kk >> 3) * 4 + (c >> 5)) * 512 + ((kk & 7) * 32 + (c & 31)) * 2; }
__device__ __forceinline__ int v_rd_base(int lane) { return ((lane & 3) << 3) | (((lane >> 2) & 3) << 6) | (((lane >> 4) & 1) << 5) | (((lane >> 5) & 1) << 8); }
constexpr int v_rd_off(int d0, int ks, int half) { return d0 * 512 + ks * 4096 + half * 2048; }
template <int OFF> __device__ __forceinline__ s16x4 tr_read(int vb) {
    s16x4 r; asm volatile("ds_read_b64_tr_b16 %0, %1 offset:%2" : "=&v"(r) : "v"(vb), "i"(OFF) : "memory"); return r;
}
template <int D0> __device__ __forceinline__ void pv_one(f32x16& od, int vb, bf16x8 pa0, bf16x8 pa1, bf16x8 pa2, bf16x8 pa3) {
    const s16x4 l0 = tr_read<v_rd_off(D0, 0, 0)>(vb), h0 = tr_read<v_rd_off(D0, 0, 1)>(vb), l1 = tr_read<v_rd_off(D0, 1, 0)>(vb), h1 = tr_read<v_rd_off(D0, 1, 1)>(vb);
    const s16x4 l2 = tr_read<v_rd_off(D0, 2, 0)>(vb), h2 = tr_read<v_rd_off(D0, 2, 1)>(vb), l3 = tr_read<v_rd_off(D0, 3, 0)>(vb), h3 = tr_read<v_rd_off(D0, 3, 1)>(vb);
    asm volatile("s_waitcnt lgkmcnt(0)" ::: "memory"); SBAR();
#define PK(L, H) (bf16x8){L[0], L[1], L[2], L[3], H[0], H[1], H[2], H[3]}
    od = __builtin_amdgcn_mfma_f32_32x32x16_bf16(pa0, PK(l0, h0), od, 0, 0, 0);
    od = __builtin_amdgcn_mfma_f32_32x32x16_bf16(pa1, PK(l1, h1), od, 0, 0, 0);
    od = __builtin_amdgcn_mfma_f32_32x32x16_bf16(pa2, PK(l2, h2), od, 0, 0, 0);
    od = __builtin_amdgcn_mfma_f32_32x32x16_bf16(pa3, PK(l3, h3), od, 0, 0, 0);
#undef PK
}
__device__ __forceinline__ void pv_d0(f32x16* o, int vb, bf16x8 pa0, bf16x8 pa1, bf16x8 pa2, bf16x8 pa3) {
    pv_one<0>(o[0], vb, pa0, pa1, pa2, pa3); pv_one<1>(o[1], vb, pa0, pa1, pa2, pa3); pv_one<2>(o[2], vb, pa0, pa1, pa2, pa3); pv_one<3>(o[3], vb, pa0, pa1, pa2, pa3);
}

template <int MASK>
__device__ __forceinline__ void apply_mask(f32x16& p0, f32x16& p1, int j, int loc0, int qp, int hi, const ALAS float* bias) {
    if constexpr (MASK == 2) {
        if (j >= NCTX_T) { const int kbase = loc0 + 64 * (j - NCTX_T);
#pragma unroll
            for (int r = 0; r < 16; ++r) { const int d0 = qp - (kbase + crow(r, hi)); const int d1 = d0 - 32;
                if (d0 > 128 || d0 < -128) p0[r] = -1e30f;
                if (d1 > 128 || d1 < -128) p1[r] = -1e30f; } }
    } else if constexpr (MASK == 3) {
        if (j >= NCTX_T) { const int kbase = loc0 + 64 * (j - NCTX_T);
            const int qrow = qp >> 6, qcol = qp & 63; const int rs = min(max(qrow - 4, 0), 56), cs = min(max(qcol - 8, 0), 48);
            const int kr = kbase >> 6; const int dr = kr - rs;
            if (dr < 0 || dr >= 8) {
#pragma unroll
                for (int r = 0; r < 16; ++r) { p0[r] = -1e30f; p1[r] = -1e30f; }
            } else {
                const ALAS float* brow = bias + (kr - qrow + 7) * 31 + 15 - qcol;
#pragma unroll
                for (int r = 0; r < 16; ++r) { const int kc0 = crow(r, hi), kc1 = kc0 + 32;
                    const bool ok0 = (unsigned)(kc0 - cs) < 16u, ok1 = (unsigned)(kc1 - cs) < 16u;
                    const float b0 = brow[ok0 ? kc0 : qcol], b1 = brow[ok1 ? kc1 : qcol];
                    p0[r] = ok0 ? p0[r] + b0 : -1e30f; p1[r] = ok1 ? p1[r] + b1 : -1e30f; }
            }
        }
    }
}

template <int MASK, int D0LO, int D0N>
__device__ __forceinline__ void attn_core(f32x16 (&o)[4], float& m_reg, float& l_reg, const bf16* __restrict__ Qw, const bf16* __restrict__ Kb, const bf16* __restrict__ Vb,
                                          const int nloc, const int loc0, const int qp, const float C, const float thr_raw, ALAS char* lds) {
    int tid_ = threadIdx.x; asm volatile("" : "+v"(tid_));
    const int tid = tid_, wid = __builtin_amdgcn_readfirstlane(tid >> 6), lane = tid & 63, r32 = lane & 31, hi = lane >> 5;
    ALAS float* ws = (ALAS float*)(lds + WSCR_OFF) + wid * 64; ALAS float* al_l = ws + 32;
    const ALAS float* bias = (const ALAS float*)(lds + BIAS_OFF);
    unsigned voffK[2], voffV[2];
#pragma unroll
    for (int i = 0; i < 2; ++i) { const int q = (wid + 8 * i) * 64 + lane;
        { const int row = q >> 4, cc = (q & 15) ^ (row & 7); voffK[i] = (unsigned)(row * (LDP * 2) + cc * 16); }
        { const int kk = (q >> 7) * 8 + ((q & 31) >> 2), c = ((q >> 5) & 3) * 32 + (q & 3) * 8; const int k = (kk & ~0xC) | ((kk & 4) << 1) | ((kk & 8) >> 1); voffV[i] = (unsigned)(k * (LDP * 2) + c * 2); } }
    const int NT = NCTX_T + nloc;
#define KOFF(j) ((j) < NCTX_T ? 4096 + 64 * (j) : loc0 + 64 * ((j) - NCTX_T))
#define ISSUE(j) do { const size_t _ro = (size_t)KOFF(j) * (LDP * 2); const char* _gk = (const char*)Kb + _ro; const char* _gv = (const char*)Vb + _ro; ALAS char* _sl = lds + ((j) & 3) * SLOT + wid * 1024; \
    _Pragma("unroll") for (int _i = 0; _i < 2; ++_i) __builtin_amdgcn_global_load_lds((const unsigned*)(_gk + voffK[_i]), (ALAS unsigned*)(_sl + _i * 8192), 16, 0, 0); \
    _Pragma("unroll") for (int _i = 0; _i < 2; ++_i) __builtin_amdgcn_global_load_lds((const unsigned*)(_gv + voffV[_i]), (ALAS unsigned*)(_sl + 16384 + _i * 8192), 16, 0, 0); } while (0)
#define WAITBAR(n) do { asm volatile("s_waitcnt vmcnt(" #n ") lgkmcnt(0)" ::: "memory"); __builtin_amdgcn_s_barrier(); asm volatile("" ::: "memory"); } while (0)
#define RESC(a) do { if (__any((a) < 1.f)) { if (hi == 0) al_l[r32] = (a); asm volatile("s_waitcnt lgkmcnt(0)" ::: "memory"); \
    _Pragma("unroll") for (int d = 0; d < 4; ++d) _Pragma("unroll") for (int r = 0; r < 16; ++r) o[d][r] *= al_l[crow(r, hi)]; } } while (0)
    asm volatile("s_waitcnt vmcnt(0)" ::: "memory");
    m_reg = -1e30f; l_reg = 0.f;
#pragma unroll
    for (int d = 0; d < 4; ++d) o[d] = f32x16{};
    bf16x8 qr[8];
#pragma unroll
    for (int d0 = 0; d0 < 8; ++d0) qr[d0] = *(const bf16x8*)(Qw + d0 * 16);
    ISSUE(0); ISSUE(1); ISSUE(2);
    const int vb0 = (int)(uintptr_t)lds + 16384 + v_rd_base(lane);
    f32x16 pA0, pA1, pB0, pB1; float mnA, mnB, alA, alB; bf16x8 pa0, pa1, pa2, pa3;
    WAITBAR(8);
    qkt<D0LO, D0N>(pA0, pA1, lds, qr, r32, hi); apply_mask<MASK>(pA0, pA1, 0, loc0, qp, hi, bias); partialSM(pA0, pA1, m_reg, mnA, alA, C, thr_raw);
    WAITBAR(4);
    ISSUE(3);
    for (int j = 1; j + 1 < NT; j += 2) {
        SBAR(); qkt<D0LO, D0N>(pB0, pB1, lds + (j & 3) * SLOT, qr, r32, hi);
        finishSM(pA0, pA1, alA, l_reg, pa0, pa1, pa2, pa3); SBAR();
        pv_d0(o, vb0 + ((j - 1) & 3) * SLOT, pa0, pa1, pa2, pa3); apply_mask<MASK>(pB0, pB1, j, loc0, qp, hi, bias); partialSM(pB0, pB1, m_reg, mnB, alB, C, thr_raw);
        if (j + 2 < NT) { WAITBAR(4); } else { WAITBAR(0); }
        if (j + 3 < NT) ISSUE(j + 3);
        RESC(alB);
        SBAR(); qkt<D0LO, D0N>(pA0, pA1, lds + ((j + 1) & 3) * SLOT, qr, r32, hi);
        finishSM(pB0, pB1, alB, l_reg, pa0, pa1, pa2, pa3); SBAR();
        pv_d0(o, vb0 + (j & 3) * SLOT, pa0, pa1, pa2, pa3); apply_mask<MASK>(pA0, pA1, j + 1, loc0, qp, hi, bias); partialSM(pA0, pA1, m_reg, mnA, alA, C, thr_raw);
        if (j + 3 < NT) { WAITBAR(4); } else { WAITBAR(0); }
        if (j + 4 < NT) ISSUE(j + 4);
        RESC(alA);
    }
    SBAR(); qkt<D0LO, D0N>(pB0, pB1, lds + ((NT - 1) & 3) * SLOT, qr, r32, hi);
    finishSM(pA0, pA1, alA, l_reg, pa0, pa1, pa2, pa3); SBAR();
    pv_d0(o, vb0 + ((NT - 2) & 3) * SLOT, pa0, pa1, pa2, pa3); apply_mask<MASK>(pB0, pB1, NT - 1, loc0, qp, hi, bias); partialSM(pB0, pB1, m_reg, mnB, alB, C, thr_raw);
    RESC(alB);
    finishSM(pB0, pB1, alB, l_reg, pa0, pa1, pa2, pa3); SBAR();
    pv_d0(o, vb0 + ((NT - 1) & 3) * SLOT, pa0, pa1, pa2, pa3);
#undef KOFF
#undef ISSUE
#undef WAITBAR
#undef RESC
}
}

constexpr int NWAVES = 8;
constexpr int DM = 4096, NB = 2, SEQ = 4096, CTXL = 256, TPB = SEQ + CTXL  , MROWS = NB * TPB  ;
constexpr int NIN = 9216, DFF = 11008, NUP = 2 * DFF, NADA = 6 * DM;
constexpr int QA = 0, QB_ = 1024, QC = 2048, QD = 3072, KA = 4096, VA = 4352, KB_ = 4608, VB_ = 5632, KC = 6656, VC = 6912, KD = 7168, VD = 8192;
constexpr float EPS = 1e-6f;
constexpr int NPHASE = 20;

constexpr size_t MiB = 1u << 20;
constexpr size_t WS_CTL = 0, CTL_ZERO_BYTES = 1 * MiB;
constexpr size_t WS_MOD = 1 * MiB;
constexpr size_t WS_TAB = 2 * MiB;
constexpr size_t WS_WIN = 4 * MiB;
constexpr size_t WS_WOUT = WS_WIN + 2 * 72 * MiB;
constexpr size_t WS_WUP = WS_WOUT + 2 * 32 * MiB;
constexpr size_t WS_WDN = WS_WUP + 2 * 172 * MiB;
constexpr size_t WS_XS = WS_WDN + 2 * 86 * MiB;
constexpr size_t WS_HX = WS_XS + 136 * MiB;
constexpr size_t WS_P = WS_HX + 68 * MiB;
constexpr size_t WS_O = WS_P + 153 * MiB;
constexpr size_t WS_Y = WS_O + 68 * MiB;
constexpr size_t WS_U = WS_Y + 68 * MiB;
constexpr size_t WS_ACT = WS_U + 366 * MiB;
constexpr size_t WS_STASH = WS_ACT + 183 * MiB;
constexpr size_t WS_END = WS_STASH + 32 * MiB;
static_assert((size_t)MROWS * NUP * 2 <= 366 * MiB && (size_t)MROWS * DFF * 2 <= 183 * MiB && (size_t)MROWS * NIN * 2 <= 153 * MiB, "ws map");
constexpr int CW_BAR = 4096;

constexpr int RING_OFF = 0, RING_BYTES = 131072;
constexpr int LDSCTL_OFF = RING_BYTES, MISC_OFF = LDSCTL_OFF + 320;
constexpr int LDS_BYTES = 147456;
static_assert(att::SHM_END <= LDS_BYTES && att::WSCR_OFF >= MISC_OFF + 128, "attention LDS map");

#define GAS __attribute__((address_space(1)))
#define LAS __attribute__((address_space(3)))
typedef unsigned short bf16;
typedef unsigned v4u __attribute__((ext_vector_type(4)));
typedef unsigned v2u __attribute__((ext_vector_type(2)));
typedef float f32x4 __attribute__((ext_vector_type(4)));
typedef float f32x2 __attribute__((ext_vector_type(2)));
typedef GAS unsigned gu32;
#define RLX_AGENT __ATOMIC_RELAXED, __HIP_MEMORY_SCOPE_AGENT
#define LDS_WAIT() asm volatile("s_waitcnt lgkmcnt(0)" ::: "memory")
#define VM_WAIT() asm volatile("s_waitcnt vmcnt(0)" ::: "memory")
__device__ __forceinline__ unsigned f2bf(float f) { unsigned u = __builtin_bit_cast(unsigned, f); return (u + 0x7fffu + ((u >> 16) & 1u)) >> 16; }
__device__ __forceinline__ unsigned pk2(float lo, float hi) { return f2bf(lo) | (f2bf(hi) << 16); }
__device__ __forceinline__ float bf_lo(unsigned w) { return __uint_as_float(w << 16); }
__device__ __forceinline__ float bf_hi(unsigned w) { return __uint_as_float(w & 0xffff0000u); }

#define XB_TMO      128
#define XB_XCNT(j)  (256  + 64 * (j))
#define XB_XSUB(j)  (1280 + 64 * (j))
#define XB_XGEN(j)  (2304 + 64 * (j))
#define XB_TOP      3328
#define XB_TOPGEN   3392
#define XCD_BAR_WORDS 3456
#define XB_SPIN_CAP (1u << 24)

__device__ __forceinline__ unsigned xb_ld(unsigned* p)              { return __hip_atomic_load(p, __ATOMIC_RELAXED, __HIP_MEMORY_SCOPE_AGENT); }
__device__ __forceinline__ unsigned xb_add(unsigned* p, unsigned v) { return __hip_atomic_fetch_add(p, v, __ATOMIC_RELAXED, __HIP_MEMORY_SCOPE_AGENT); }
__device__ __forceinline__ unsigned xb_xcc_id() { return (unsigned)__builtin_amdgcn_s_getreg((3 << 11) | 20) & 0xFu; }
#define XB_SPIN(cond, bar) do { unsigned _sp = 0; while (cond) { __builtin_amdgcn_s_sleep(1); \
    if ((++_sp & 255u) == 0u) { if (xb_ld(&(bar)[XB_TMO])) break; if (_sp > XB_SPIN_CAP) { atomicAdd(&(bar)[XB_TMO], 1u); break; } } } } while (0)

struct XcdBarrier { unsigned* bar; unsigned x; volatile LAS unsigned* st; };

__device__ __forceinline__ XcdBarrier xcd_barrier_post(unsigned* bar, volatile LAS unsigned* st) {
    XcdBarrier b; b.bar = bar; b.x = xb_xcc_id(); b.st = st;
    if (threadIdx.x == 0) (void)xb_add(&bar[XB_XCNT(b.x)], 1u);
    return b;
}
__device__ __forceinline__ void xcd_barrier_complete(unsigned* bar, unsigned x, unsigned& nloc, unsigned& nx) {
    const unsigned G = gridDim.x * gridDim.y * gridDim.z;
    unsigned sum, cnt, mine, sp = 0u;
    for (;;) {
        sum = 0u; cnt = 0u; mine = 0u;
#pragma unroll
        for (unsigned j = 0; j < 16; ++j) { const unsigned c = xb_ld(&bar[XB_XCNT(j)]); sum += c; cnt += (c > 0u) ? 1u : 0u; mine = (j == x) ? c : mine; }
        if (sum == G) break;
        __builtin_amdgcn_s_sleep(1);
        if ((++sp & 255u) == 0u) { if (xb_ld(&bar[XB_TMO])) break; if (sp > XB_SPIN_CAP) { atomicAdd(&bar[XB_TMO], 1u); break; } }
    }
    nloc = mine > 0u ? mine : 1u; nx = cnt > 0u ? cnt : 1u;
}
__device__ __forceinline__ void xcd_barrier(const XcdBarrier& b) {
    asm volatile("s_waitcnt vmcnt(0)" ::: "memory");
    __syncthreads();
    if (threadIdx.x == 0) {
        unsigned* bar = b.bar;
        __builtin_amdgcn_s_waitcnt(0);
        unsigned nloc = b.st[0], nx = b.st[1];
        if (nloc == 0u) { xcd_barrier_complete(bar, b.x, nloc, nx); b.st[0] = nloc; b.st[1] = nx; }
        const unsigned old = xb_add(&bar[XB_XSUB(b.x)], 1u);
        const unsigned gen = old / nloc;
        if (old + 1u == (gen + 1u) * nloc) {
            __builtin_amdgcn_fence(__ATOMIC_RELEASE, "agent");
            asm volatile("s_waitcnt vmcnt(0)" ::: "memory");
            const unsigned og = xb_add(&bar[XB_TOP], 1u);
            const unsigned tg = og / nx;
            if (og + 1u == (tg + 1u) * nx) xb_add(&bar[XB_TOPGEN], 1u);
            else XB_SPIN(xb_ld(&bar[XB_TOPGEN]) == tg, bar);
            __builtin_amdgcn_fence(__ATOMIC_ACQUIRE, "agent");
            xb_add(&bar[XB_XGEN(b.x)], 1u);
            asm volatile("s_waitcnt vmcnt(0)" ::: "memory");
        } else {
            XB_SPIN(xb_ld(&bar[XB_XGEN(b.x)]) == gen, bar);
            __builtin_amdgcn_fence(__ATOMIC_ACQUIRE, "agent");
            asm volatile("s_waitcnt vmcnt(0)" ::: "memory");
        }
    }
    __syncthreads();
}

struct Args {
    const float* in[24]; float* out; unsigned char* ws; int ph_lo, ph_hi;
};
struct Frame {
    LAS unsigned char* lds;
    int tid, lane, wave, vcu, G;
    unsigned char* ws;
};

__device__ __forceinline__ float wave_sum(float v) {
#pragma unroll
    for (int o = 1; o < 64; o <<= 1) v += __shfl_xor(v, o);
    return v;
}

__device__ const float INV32[32] = {
    1.0f, 0.74989420933f, 0.56234132519f, 0.42169650343f, 0.31622776602f, 0.23713737057f, 0.17782794100f, 0.13335214322f,
    0.1f, 0.074989420933f, 0.056234132519f, 0.042169650343f, 0.031622776602f, 0.023713737057f, 0.017782794100f, 0.013335214322f,
    0.01f, 0.0074989420933f, 0.0056234132519f, 0.0042169650343f, 0.0031622776602f, 0.0023713737057f, 0.0017782794100f, 0.0013335214322f,
    0.001f, 0.00074989420933f, 0.00056234132519f, 0.00042169650343f, 0.00031622776602f, 0.00023713737057f, 0.00017782794100f, 0.00013335214322f };
__device__ const float INV16[16] = {
    1.0f, 0.56234132519f, 0.31622776602f, 0.17782794100f, 0.1f, 0.056234132519f, 0.031622776602f, 0.017782794100f,
    0.01f, 0.0056234132519f, 0.0031622776602f, 0.0017782794100f, 0.001f, 0.00056234132519f, 0.00031622776602f, 0.00017782794100f };

__device__ __forceinline__ void sincos_acc(float af, float& c, float& s) {
    const double a = (double)af; const double kd = __builtin_rint(a * 0.63661977236758134308); const int k = (int)kd;
    const double r = (a - kd * 1.57079632679489655800) - kd * 6.12323399573676603587e-17; const double r2 = r * r;
    const double sn = r * (1.0 + r2 * (-1.0 / 6 + r2 * (1.0 / 120 + r2 * (-1.0 / 5040 + r2 * (1.0 / 362880 + r2 * (-1.0 / 39916800 + r2 * (1.0 / 6227020800.0)))))));
    const double cs = 1.0 + r2 * (-0.5 + r2 * (1.0 / 24 + r2 * (-1.0 / 720 + r2 * (1.0 / 40320 + r2 * (-1.0 / 3628800 + r2 * (1.0 / 479001600.0 + r2 * (-1.0 / 87178291200.0)))))));
    double cc, ss;
    switch (k & 3) { case 0: cc = cs; ss = sn; break; case 1: cc = -sn; ss = cs; break; case 2: cc = -cs; ss = -sn; break; default: cc = sn; ss = -cs; break; }
    c = (float)cc; s = (float)ss;
}

__device__ __forceinline__ void p0_transpose_item(const float* W, int K, int N, bf16* WT, LAS float* scr, int item, int lane) {
    const int nblk = N / 32, kb = item / nblk, nb = item % nblk, k0 = 64 * kb, n0 = 32 * nb;
#pragma unroll 8
    for (int i = 0; i < 32; ++i) { const int kk = 2 * i + (lane >> 5); scr[kk * 33 + (lane & 31)] = W[(size_t)(k0 + kk) * N + n0 + (lane & 31)]; }
    LDS_WAIT(); asm volatile("" ::: "memory");
    const int c = lane & 7;
#pragma unroll
    for (int j = 0; j < 4; ++j) { const int n = (lane >> 3) + 8 * j; const LAS float* s = scr + (8 * c) * 33 + n;
        v4u o; o.x = pk2(s[0 * 33], s[1 * 33]); o.y = pk2(s[2 * 33], s[3 * 33]); o.z = pk2(s[4 * 33], s[5 * 33]); o.w = pk2(s[6 * 33], s[7 * 33]);
        *(GAS v4u*)(WT + (size_t)(n0 + n) * K + k0 + 8 * c) = o; }
    LDS_WAIT(); asm volatile("" ::: "memory");
}

__device__ __forceinline__ float silu_f(float x) { return x / (1.f + __expf(-x)); }

__device__ __forceinline__ void phase_prologue(Frame& F, const Args& a) {
    const float* c_in = a.in[1]; const float* cctx = a.in[3]; const float* w_ada = a.in[4]; const float* b_ada = a.in[5];
    float* mod = (float*)(F.ws + WS_MOD);
    if (F.vcu == 0) {
        f32x2* thd = (f32x2*)(F.ws + WS_TAB);
        for (int e = F.tid; e < 64 * 32; e += NWAVES * 64) { const int pos = e >> 5, i = e & 31; float c, s; sincos_acc((float)pos * INV32[i], c, s); thd[e] = (f32x2){c, s}; }
        f32x2* tdh = (f32x2*)(F.ws + WS_TAB + 16384);
        for (int e = F.tid; e < 64 * 16; e += NWAVES * 64) { const int pos = e >> 4, i = e & 15; float c, s; sincos_acc((float)pos * INV16[i], c, s); tdh[e] = (f32x2){c, s}; }
        if (F.tid < 2) { const int l = F.tid; float s1 = 0.f, s2 = 0.f;
            for (int i = 0; i < 64; ++i) { s1 += a.in[14][l * 64 + i] * a.in[15][l * 64 + i]; s2 += a.in[16][l * 64 + i] * a.in[17][l * 64 + i]; }
            const float lam_init = 0.8f - 0.6f * expf(-0.3f * (float)l);
            float* lam = (float*)(F.ws + WS_TAB + 32768); lam[l * 2 + 0] = expf(s1) - expf(s2) + lam_init; lam[l * 2 + 1] = 1.f - lam_init; }
    }
    {
        LAS float* sv = (LAS float*)(F.lds + RING_OFF);
        LAS float* red = (LAS float*)(F.lds + RING_OFF + 49152);
        for (int e = F.tid; e < 3 * DM; e += NWAVES * 64) { const int v = e / DM, k = e % DM; const float x = v < 2 ? c_in[v * DM + k] : cctx[k]; sv[e] = silu_f(x); }
        __syncthreads();
        const int cg = F.lane & 15, kq = F.lane >> 4;
        for (int it = F.vcu; it < 2 * (NADA / 64); it += F.G) {
            const int l = it / (NADA / 64), ch = it % (NADA / 64);
            const float* W = w_ada + (size_t)l * DM * NADA + ch * 64 + cg * 4;
            f32x4 a0 = {0.f, 0.f, 0.f, 0.f}, a1 = a0, a2 = a0;
#pragma unroll 8
            for (int s = 0; s < DM / 32; ++s) { const int k = s * 32 + F.wave * 4 + kq; const f32x4 w = *(const GAS f32x4*)(W + (size_t)k * NADA);
                a0 += w * sv[k]; a1 += w * sv[DM + k]; a2 += w * sv[2 * DM + k]; }
#pragma unroll
            for (int e = 0; e < 4; ++e) { a0[e] += __shfl_xor(a0[e], 16); a0[e] += __shfl_xor(a0[e], 32); a1[e] += __shfl_xor(a1[e], 16); a1[e] += __shfl_xor(a1[e], 32); a2[e] += __shfl_xor(a2[e], 16); a2[e] += __shfl_xor(a2[e], 32); }
            if (kq == 0) {
#pragma unroll
                for (int e = 0; e < 4; ++e) { red[(F.wave * 3 + 0) * 64 + cg * 4 + e] = a0[e]; red[(F.wave * 3 + 1) * 64 + cg * 4 + e] = a1[e]; red[(F.wave * 3 + 2) * 64 + cg * 4 + e] = a2[e]; } }
            __syncthreads();
            if (F.tid < 192) { const int v = F.tid / 64, cidx = F.tid % 64; float s = 0.f;
#pragma unroll
                for (int w = 0; w < 8; ++w) s += red[(w * 3 + v) * 64 + cidx];
                const int col = ch * 64 + cidx; mod[((size_t)l * 3 + v) * NADA + col] = s + b_ada[(size_t)l * NADA + col]; }
            __syncthreads();
        }
    }
    {
        __syncthreads();
        LAS float* scr = (LAS float*)(F.lds + RING_OFF + F.wave * 16384);
        const int gw = F.vcu * NWAVES + F.wave, NGW = F.G * NWAVES;
        constexpr int I_IN = (DM / 64) * (NIN / 32), I_OUT = (DM / 64) * (DM / 32), I_UP = (DM / 64) * (NUP / 32), I_DN = (DFF / 64) * (DM / 32);
        constexpr int PER_L = I_IN + I_OUT + I_UP + I_DN;
        for (int it = gw; it < 2 * PER_L; it += NGW) {
            const int l = it / PER_L; int r = it % PER_L;
            if (r < I_IN) { p0_transpose_item(a.in[10] + (size_t)l * DM * NIN, DM, NIN, (bf16*)(F.ws + WS_WIN + (size_t)l * 72 * MiB), scr, r, F.lane); continue; } r -= I_IN;
            if (r < I_OUT) { p0_transpose_item(a.in[11] + (size_t)l * DM * DM, DM, DM, (bf16*)(F.ws + WS_WOUT + (size_t)l * 32 * MiB), scr, r, F.lane); continue; } r -= I_OUT;
            if (r < I_UP) { p0_transpose_item(a.in[21] + (size_t)l * DM * NUP, DM, NUP, (bf16*)(F.ws + WS_WUP + (size_t)l * 172 * MiB), scr, r, F.lane); continue; } r -= I_UP;
            p0_transpose_item(a.in[23] + (size_t)l * DFF * DM, DFF, DM, (bf16*)(F.ws + WS_WDN + (size_t)l * 86 * MiB), scr, r, F.lane);
        }
    }
}

struct RowRegs { f32x4 v[16]; };
__device__ __forceinline__ float row_sumsq(const RowRegs& r) {
    float s = 0.f;
#pragma unroll
    for (int j = 0; j < 16; ++j) s += (r.v[j].x * r.v[j].x + r.v[j].y * r.v[j].y) + (r.v[j].z * r.v[j].z + r.v[j].w * r.v[j].w);
    return wave_sum(s);
}
__device__ __forceinline__ void row_load_f32(RowRegs& r, const float* p, int lane) {
    const GAS f32x4* q = (const GAS f32x4*)p + lane;
#pragma unroll
    for (int j = 0; j < 16; ++j) r.v[j] = q[64 * j];
}
__device__ __forceinline__ void row_load_bf16(RowRegs& r, const bf16* p, int lane) {
    const GAS v2u* q = (const GAS v2u*)p + lane;
#pragma unroll
    for (int j = 0; j < 16; ++j) { const v2u w = q[64 * j]; r.v[j] = (f32x4){bf_lo(w.x), bf_hi(w.x), bf_lo(w.y), bf_hi(w.y)}; }
}
__device__ __forceinline__ void row_store_f32(const RowRegs& r, float* p, int lane) {
    GAS f32x4* q = (GAS f32x4*)p + lane;
#pragma unroll
    for (int j = 0; j < 16; ++j) q[64 * j] = r.v[j];
}
__device__ __forceinline__ void row_modnorm_store(const RowRegs& x, float rstd, const float* g, const float* sc, const float* sh, bf16* out, int lane) {
    GAS v2u* q = (GAS v2u*)out + lane;
#pragma unroll
    for (int j = 0; j < 16; ++j) { const int c = 4 * lane + 256 * j;
        const f32x4 gv = *(const GAS f32x4*)(g + c), sv = *(const GAS f32x4*)(sc + c), hv = *(const GAS f32x4*)(sh + c);
        const f32x4 y = (x.v[j] * rstd) * gv * (sv + 1.f) + hv;
        v2u w; w.x = pk2(y.x, y.y); w.y = pk2(y.z, y.w); q[64 * j] = w; }
}
__device__ __forceinline__ void row_residual(RowRegs& x, const RowRegs& y, float rstd, const float* g, const float* gate, int lane) {
#pragma unroll
    for (int j = 0; j < 16; ++j) { const int c = 4 * lane + 256 * j;
        const f32x4 gv = *(const GAS f32x4*)(g + c), tv = *(const GAS f32x4*)(gate + c);
        x.v[j] = x.v[j] + tv * ((y.v[j] * rstd) * gv); }
}

__device__ __forceinline__ void phase_r0(Frame& F, const Args& a) {
    const float* mod = (const float*)(F.ws + WS_MOD); float* xs = (float*)(F.ws + WS_XS); bf16* hx = (bf16*)(F.ws + WS_HX);
    const int gw = F.vcu * NWAVES + F.wave, NGW = F.G * NWAVES;
    for (int m = gw; m < MROWS; m += NGW) {
        const int b = m / TPB, t = m % TPB; const bool lat = t < SEQ;
        const float* src = lat ? a.in[0] + ((size_t)b * SEQ + t) * DM : a.in[2] + ((size_t)b * CTXL + (t - SEQ)) * DM;
        RowRegs x; row_load_f32(x, src, F.lane);
        row_store_f32(x, xs + (size_t)m * DM, F.lane);
        const float rstd = 1.f / sqrtf(row_sumsq(x) * (1.f / DM) + EPS);
        const float* mv = mod + (size_t)(0 * 3 + (lat ? b : 2)) * NADA;
        row_modnorm_store(x, rstd, a.in[6]  , mv + DM, mv, hx + (size_t)m * DM, F.lane);
    }
}
__device__ __forceinline__ void phase_r1(Frame& F, const Args& a, int l, bool last) {
    const float* mod = (const float*)(F.ws + WS_MOD); float* xs = (float*)(F.ws + WS_XS); bf16* hx = (bf16*)(F.ws + WS_HX); const bf16* yb = (const bf16*)(F.ws + WS_Y);
    const int gw = F.vcu * NWAVES + F.wave, NGW = F.G * NWAVES;
    for (int m = gw; m < MROWS; m += NGW) {
        const int b = m / TPB, t = m % TPB; const bool lat = t < SEQ;
        if (last && !lat) continue;
        const float* mv = mod + (size_t)(l * 3 + (lat ? b : 2)) * NADA;
        RowRegs x, y; row_load_f32(x, xs + (size_t)m * DM, F.lane); row_load_bf16(y, yb + (size_t)m * DM, F.lane);
        const float rstd_y = 1.f / sqrtf(row_sumsq(y) * (1.f / DM) + EPS);
        row_residual(x, y, rstd_y, a.in[7] + (size_t)l * DM, mv + 2 * DM, F.lane);
        row_store_f32(x, xs + (size_t)m * DM, F.lane);
        const float rstd = 1.f / sqrtf(row_sumsq(x) * (1.f / DM) + EPS);
        row_modnorm_store(x, rstd, a.in[8] + (size_t)l * DM, mv + 4 * DM, mv + 3 * DM, hx + (size_t)m * DM, F.lane);
    }
}
__device__ __forceinline__ void phase_r2(Frame& F, const Args& a, int l, bool last) {
    const float* mod = (const float*)(F.ws + WS_MOD); float* xs = (float*)(F.ws + WS_XS); bf16* hx = (bf16*)(F.ws + WS_HX); const bf16* yb = (const bf16*)(F.ws + WS_Y);
    const int gw = F.vcu * NWAVES + F.wave, NGW = F.G * NWAVES;
    for (int m = gw; m < MROWS; m += NGW) {
        const int b = m / TPB, t = m % TPB; const bool lat = t < SEQ;
        if (last && !lat) continue;
        const float* mv = mod + (size_t)(l * 3 + (lat ? b : 2)) * NADA;
        RowRegs x, y; row_load_f32(x, xs + (size_t)m * DM, F.lane); row_load_bf16(y, yb + (size_t)m * DM, F.lane);
        const float rstd_y = 1.f / sqrtf(row_sumsq(y) * (1.f / DM) + EPS);
        row_residual(x, y, rstd_y, a.in[9] + (size_t)l * DM, mv + 5 * DM, F.lane);
        if (last) { row_store_f32(x, a.out + ((size_t)b * SEQ + t) * DM, F.lane); continue; }
        row_store_f32(x, xs + (size_t)m * DM, F.lane);
        const float rstd = 1.f / sqrtf(row_sumsq(x) * (1.f / DM) + EPS);
        const float* mn = mod + (size_t)((l + 1) * 3 + (lat ? b : 2)) * NADA;
        row_modnorm_store(x, rstd, a.in[6] + (size_t)(l + 1) * DM, mn + DM, mn, hx + (size_t)m * DM, F.lane);
    }
}

__device__ __forceinline__ void phase_qkpost(Frame& F, const Args& a, int l) {
    bf16* P = (bf16*)(F.ws + WS_P);
    const f32x2* thd = (const f32x2*)(F.ws + WS_TAB); const f32x2* tdh = (const f32x2*)(F.ws + WS_TAB + 16384);
    const float* gq = a.in[12] + l * 128; const float* gk = a.in[13] + l * 128;
    const int gw = F.vcu * NWAVES + F.wave, NGW = F.G * NWAVES; const int lane = F.lane;
    const float gq0 = gq[2 * lane], gq1 = gq[2 * lane + 1], gk0 = gk[2 * lane], gk1 = gk[2 * lane + 1];
    for (int m = gw; m < MROWS; m += NGW) {
        const int t = m % TPB; const bool lat = t < SEQ;
        unsigned* row = (unsigned*)(P + (size_t)m * NIN);
        const int grow = (t >> 6) & 63, gcol = t & 63;
        f32x2 cs_hd = {1.f, 0.f}, cs_dh = {1.f, 0.f};
        if (lat) { cs_hd = thd[(lane < 32 ? grow : gcol) * 32 + (lane & 31)]; const int pp = lane & 31; cs_dh = tdh[(pp < 16 ? grow : gcol) * 16 + (pp & 15)]; }
#define QK_CHUNK(colbase, kind) do { unsigned* p = row + ((colbase) >> 1) + lane; const unsigned w = *p; float x0 = bf_lo(w), x1 = bf_hi(w); \
        if ((kind) == 0 || (kind) == 3) { const float ss = wave_sum(x0 * x0 + x1 * x1); const float rstd = 1.f / sqrtf(ss * (1.f / 128.f) + EPS); \
            x0 = x0 * rstd * ((kind) == 0 ? gq0 : gk0); x1 = x1 * rstd * ((kind) == 0 ? gq1 : gk1); } \
        const f32x2 cs = ((kind) == 1) ? cs_dh : cs_hd; const float y0 = x0 * cs.x - x1 * cs.y, y1 = x0 * cs.y + x1 * cs.x; *p = pk2(y0, y1); } while (0)
        if (lat) {
#pragma unroll 4
            for (int h = 0; h < 8; ++h) QK_CHUNK(QA + h * 128, 0);
#pragma unroll 4
            for (int h = 0; h < 8; ++h) QK_CHUNK(QB_ + h * 128, 1);
#pragma unroll 4
            for (int h = 0; h < 8; ++h) QK_CHUNK(QC + h * 128, 2);
#pragma unroll
            for (int h = 0; h < 2; ++h) QK_CHUNK(KA + h * 128, 3);
#pragma unroll 4
            for (int h = 0; h < 8; ++h) QK_CHUNK(KB_ + h * 128, 1);
#pragma unroll
            for (int h = 0; h < 2; ++h) QK_CHUNK(KC + h * 128, 2);
        } else {
#pragma unroll 4
            for (int h = 0; h < 8; ++h) QK_CHUNK(QA + h * 128, 0);
#pragma unroll
            for (int h = 0; h < 2; ++h) QK_CHUNK(KA + h * 128, 3);
        }
#undef QK_CHUNK
    }
}

__device__ __forceinline__ void phase_conv(Frame& F, const Args& a, int l, bool last) {
    const bf16* U = (const bf16*)(F.ws + WS_U); bf16* ACT = (bf16*)(F.ws + WS_ACT);
    const float* cw = a.in[22] + (size_t)l * 3 * NUP;
    const int gw = F.vcu * NWAVES + F.wave, NGW = F.G * NWAVES;
    constexpr int NCS = DFF / 256  , NBAND = MROWS / 32  ;
    for (int it = gw; it < NBAND * NCS; it += NGW) {
        const int band = it / NCS, cs = it % NCS; const int m0 = band * 32; const int t0 = m0 % TPB;
        if (last && t0 >= SEQ) continue;
        const int seq_lo = (t0 < SEQ) ? (m0 - t0) : (m0 - t0 + SEQ), seq_hi = (t0 < SEQ) ? (m0 - t0 + SEQ) : (m0 - t0 + TPB);
        const int col = cs * 256 + 4 * F.lane;
        f32x4 wg[3], wv[3];
#pragma unroll
        for (int j = 0; j < 3; ++j) { wg[j] = *(const GAS f32x4*)(cw + (size_t)j * NUP + col); wv[j] = *(const GAS f32x4*)(cw + (size_t)j * NUP + DFF + col); }
        f32x4 g0, g1, g2, v0, v1, v2;
#define LD_ROW(gm, G_, V_) do { if ((gm) >= seq_lo && (gm) < seq_hi) { const v2u wg_ = *(const GAS v2u*)(U + (size_t)(gm) * NUP + col); const v2u wv_ = *(const GAS v2u*)(U + (size_t)(gm) * NUP + DFF + col); \
            G_ = (f32x4){bf_lo(wg_.x), bf_hi(wg_.x), bf_lo(wg_.y), bf_hi(wg_.y)}; V_ = (f32x4){bf_lo(wv_.x), bf_hi(wv_.x), bf_lo(wv_.y), bf_hi(wv_.y)}; } \
            else { G_ = (f32x4){0.f, 0.f, 0.f, 0.f}; V_ = G_; } } while (0)
        LD_ROW(m0 - 1, g0, v0); LD_ROW(m0, g1, v1);
#pragma unroll 4
        for (int r = 0; r < 32; ++r) { const int m = m0 + r;
            LD_ROW(m + 1, g2, v2);
            const f32x4 gg = g0 * wg[0] + g1 * wg[1] + g2 * wg[2]; const f32x4 vv = v0 * wv[0] + v1 * wv[1] + v2 * wv[2];
            f32x4 o;
#pragma unroll
            for (int e = 0; e < 4; ++e) o[e] = gg[e] / (1.f + __expf(-gg[e])) * vv[e];
            v2u w; w.x = pk2(o.x, o.y); w.y = pk2(o.z, o.w);
            *(GAS v2u*)(ACT + (size_t)m * DFF + col) = w;
            g0 = g1; g1 = g2; v0 = v1; v1 = v2; }
#undef LD_ROW
    }
}

template <int MASK>
__device__ __forceinline__ void attn_std_unit(Frame& F, const bf16* P, bf16* O, int b, int qrow0  , int qcol, int kcol, int vcol, int ocol,
                                              int nloc, int loc0, float sink, bool has_sink) {
    using namespace att;
    int lane_ = F.lane; asm volatile("" : "+v"(lane_));
    int lane = lane_, wid = F.wave, r32 = lane & 31, hi = lane >> 5;
    constexpr float SCALE = 0.088388347648318440f; constexpr float C = SCALE * 1.4426950408889634f;
    const size_t base = (size_t)b * TPB;
    const bf16* Qw = P + (base + qrow0 + wid * 32 + r32) * LDP + qcol + hi * 8;
    f32x16 o[4]; float m_reg, l_reg;
    attn_core<MASK, 0, 8>(o, m_reg, l_reg, Qw, P + base * LDP + kcol, P + base * LDP + vcol, nloc, loc0, qrow0 + wid * 32 + r32, C, 8.f / SCALE, (ALAS char*)F.lds);
    if (has_sink) l_reg += __builtin_amdgcn_exp2f(sink * 1.4426950408889634f - m_reg * C);
    asm volatile("" : "+v"(lane_)); lane = lane_; r32 = lane & 31; hi = lane >> 5;
    ALAS float* li_l = (ALAS float*)((ALAS char*)F.lds + WSCR_OFF) + wid * 64;
    if (hi == 0) li_l[r32] = l_reg; asm volatile("s_waitcnt lgkmcnt(0)" ::: "memory");
    bf16* Ow = O + (base + qrow0 + wid * 32) * LDO + ocol;
#pragma unroll
    for (int r = 0; r < 16; ++r) { const int orow = crow(r, hi); const float rl = __builtin_amdgcn_rcpf(li_l[orow]);
#pragma unroll
        for (int d0 = 0; d0 < 4; ++d0) Ow[(size_t)orow * LDO + d0 * 32 + r32] = (bf16)f2bf(o[d0][r] * rl); }
}
__device__ __forceinline__ void attn_diff_unit(Frame& F, const bf16* P, bf16* O, int b, int qrow0, int h, int nloc, int loc0, float lam, float omli, const float* gsub) {
    using namespace att;
    int lane_ = F.lane; asm volatile("" : "+v"(lane_));
    int lane = lane_, wid = F.wave, r32 = lane & 31, hi = lane >> 5;
    constexpr float SCALE = 0.125f; constexpr float C = SCALE * 1.4426950408889634f;
    const size_t base = (size_t)b * TPB;
    const bf16* Qw = P + (base + qrow0 + wid * 32 + r32) * LDP + QB_ + h * 128 + hi * 8;
    const bf16* Kb = P + base * LDP + KB_ + h * 128; const bf16* Vb = P + base * LDP + VB_ + h * 128;
    ALAS float* li_l = (ALAS float*)((ALAS char*)F.lds + WSCR_OFF) + wid * 64;
    f32x16 o[4]; float m_reg, l_reg;
    attn_core<0, 4, 4>(o, m_reg, l_reg, Qw, Kb, Vb, nloc, loc0, 0, C, 8.f / SCALE, (ALAS char*)F.lds);
    asm volatile("" : "+v"(lane_)); lane = lane_; r32 = lane & 31; hi = lane >> 5;
    if (hi == 0) li_l[r32] = l_reg; asm volatile("s_waitcnt lgkmcnt(0)" ::: "memory");
    { float* stash = (float*)(F.ws + WS_STASH) + ((size_t)blockIdx.x * 8 + wid) * 4096 + lane;
#pragma unroll
    for (int d0 = 0; d0 < 4; ++d0) { float* sp = stash + d0 * 1024; asm volatile("" : "+v"(sp));
#pragma unroll
        for (int r = 0; r < 16; ++r) sp[r * 64] = o[d0][r] * __builtin_amdgcn_rcpf(li_l[crow(r, hi)]); } }
    __syncthreads();
    attn_core<0, 0, 4>(o, m_reg, l_reg, Qw, Kb, Vb, nloc, loc0, 0, C, 8.f / SCALE, (ALAS char*)F.lds);
    asm volatile("" : "+v"(lane_)); lane = lane_; r32 = lane & 31; hi = lane >> 5;
    if (hi == 0) li_l[r32] = l_reg; asm volatile("s_waitcnt lgkmcnt(0)" ::: "memory");
    float* stash = (float*)(F.ws + WS_STASH) + ((size_t)blockIdx.x * 8 + wid) * 4096 + lane;
    float g4[4];
#pragma unroll
    for (int d0 = 0; d0 < 4; ++d0) g4[d0] = gsub[d0 * 32 + r32] * omli;
    bf16* Ow = O + (base + qrow0 + wid * 32) * LDO + QB_ + h * 128;
#pragma unroll
    for (int r = 0; r < 16; ++r) { const int orow = crow(r, hi); const float rl = __builtin_amdgcn_rcpf(li_l[orow]);
        float v[4]; float ss = 0.f;
#pragma unroll
        for (int d0 = 0; d0 < 4; ++d0) { v[d0] = o[d0][r] * rl - lam * stash[(d0 * 16 + r) * 64]; ss += v[d0] * v[d0]; }
        ss += __shfl_xor(ss, 1); ss += __shfl_xor(ss, 2); ss += __shfl_xor(ss, 4); ss += __shfl_xor(ss, 8); ss += __shfl_xor(ss, 16);
        const float rstd = 1.f / sqrtf(ss * (1.f / 128.f) + EPS);
#pragma unroll
        for (int d0 = 0; d0 < 4; ++d0) Ow[(size_t)orow * LDO + d0 * 32 + r32] = (bf16)f2bf(v[d0] * rstd * g4[d0]); }
}

__device__ __forceinline__ void phase_attention(Frame& F, const Args& a, int l, bool last) {
    const bf16* P = (const bf16*)(F.ws + WS_P); bf16* O = (bf16*)(F.ws + WS_O);
    const float* lamv = (const float*)(F.ws + WS_TAB + 32768); const float lam = lamv[l * 2], omli = lamv[l * 2 + 1];
    const float* sinkv = a.in[19] + l * 8; const float* gsub = a.in[18] + l * 128; const float* nab = a.in[20] + (size_t)l * 8 * 15 * 31;
#ifndef ATT_MASK
#define ATT_MASK 15
#endif
    if (ATT_MASK & 1) for (int u = F.vcu; u < (last ? 256 : 272); u += F.G) {
        int b, h, qrow0, nloc;
        if (u < 256) { b = u >> 7; h = (u >> 4) & 7; qrow0 = (u & 15) * 256; nloc = 64; } else { const int e = u - 256; b = e >> 3; h = e & 7; qrow0 = SEQ; nloc = 0; }
        __syncthreads(); attn_diff_unit(F, P, O, b, qrow0, h, nloc, 0, lam, omli, gsub);
    }
    if (ATT_MASK & 2) for (int u = F.vcu; u < (last ? 256 : 304); u += F.G) {
        int b, qrow0, qcol, kcol, vcol, nloc; float sink = 0.f; bool has_sink = false;
        if (u < 256) { const int h = (u >> 4) & 7, qb = u & 15; b = u >> 7; qrow0 = qb * 256; qcol = QA + h * 128; kcol = KA + (h >> 2) * 128; vcol = VA + (h >> 2) * 128; nloc = 64; }
        else { const int e = u - 256, g = e >> 4, h = e & 7; b = (e >> 3) & 1; qrow0 = SEQ; nloc = 0;
            if (g == 0) { qcol = QA + h * 128; kcol = KA + (h >> 2) * 128; vcol = VA + (h >> 2) * 128; }
            else if (g == 1) { qcol = QC + h * 128; kcol = KC + (h >> 2) * 128; vcol = VC + (h >> 2) * 128; sink = sinkv[h]; has_sink = true; }
            else { qcol = QD + h * 128; kcol = KD + h * 128; vcol = VD + h * 128; } }
        __syncthreads(); attn_std_unit<0>(F, P, O, b, qrow0, qcol, kcol, vcol, qcol, nloc, 0, sink, has_sink);
    }
    if (ATT_MASK & 4) for (int u = F.vcu; u < 256; u += F.G) { const int b = u >> 7, h = (u >> 4) & 7, qb = u & 15;
        const int lo = max(qb * 256 - 128, 0), hiK = min(qb * 256 + 384, SEQ);
        __syncthreads(); attn_std_unit<2>(F, P, O, b, qb * 256, QC + h * 128, KC + (h >> 2) * 128, VC + (h >> 2) * 128, QC + h * 128, (hiK - lo) / 64, lo, sinkv[h], true); }
    if (ATT_MASK & 8) for (int u = F.vcu; u < 256; u += F.G) { const int b = u >> 7, h = (u >> 4) & 7, qb = u & 15;
        const int r0 = qb * 4; int rlo, nrow;
        if (r0 == 0) { rlo = 0; nrow = 8; } else if (r0 == 60) { rlo = 56; nrow = 8; } else { rlo = min(r0 - 4, 52); nrow = 12; }
        __syncthreads();
        { LAS float* bl = (LAS float*)(F.lds + att::BIAS_OFF); for (int e = F.tid; e < 15 * 31; e += NWAVES * 64) bl[e] = nab[h * 465 + e] * 11.313708498984761f; }
        attn_std_unit<3>(F, P, O, b, qb * 256, QD + h * 128, KD + h * 128, VD + h * 128, QD + h * 128, nrow, rlo * 64, 0.f, false); }
    __syncthreads();
}

__global__ void __launch_bounds__(NWAVES * 64, 2) fwd_kernel(Args args) {
    extern __shared__ __attribute__((aligned(16))) unsigned char lds[];
    Frame F;
    F.lds = (LAS unsigned char*)lds;
    volatile LAS unsigned* MISC = (volatile LAS unsigned*)(F.lds + MISC_OFF);
    F.tid = threadIdx.x; F.lane = F.tid & 63; F.wave = __builtin_amdgcn_readfirstlane(F.tid >> 6);
    F.G = gridDim.x; { const int bx = blockIdx.x; F.vcu = (F.G % 8 == 0) ? (bx % 8) * (F.G / 8) + bx / 8 : bx; }
    F.ws = args.ws;
    gu32* ctl = (gu32*)(F.ws + WS_CTL);
    for (int u = F.tid; u < (LDS_BYTES - LDSCTL_OFF) / 4; u += NWAVES * 64) ((LAS unsigned*)(F.lds + LDSCTL_OFF))[u] = 0u;
    __syncthreads();
    const int lo = args.ph_lo, hi = args.ph_hi;
    XcdBarrier bar; bar.bar = (unsigned*)(ctl + CW_BAR); bar.x = 0; bar.st = nullptr;
    if (hi - lo > 1) bar = xcd_barrier_post((unsigned*)(ctl + CW_BAR), MISC + 8);
#ifndef PH_MASK
#define PH_MASK 0x7ff
#endif
#define IN(k) (lo <= (k) && (k) < hi)
#define FRESH() asm volatile("" : "+v"(F.tid), "+v"(F.lane))
#define EN(j) (((PH_MASK) >> (j)) & 1)
#define SEAM(k) do { if (IN(k) && IN((k) + 1)) xcd_barrier(bar); } while (0)

    if (EN(0) && IN(0)) { FRESH(); phase_prologue(F, args); } SEAM(0);
    if (EN(1) && IN(1)) { FRESH(); phase_r0(F, args); } SEAM(1);
    for (int l = 0; l < 2; ++l) {
        const bool last = (l == 1); const int pb = 2 + 9 * l;
        const pg8::bf16_t* HX = (const pg8::bf16_t*)(F.ws + WS_HX);
        if (EN(2) && IN(pb + 0)) {
            pg8::Gemm g{HX, (const pg8::bf16_t*)(F.ws + WS_WIN + (size_t)l * 72 * MiB), MROWS, NIN, DM};
            pg8::StaticOrder S; S.init(MROWS / 256, NIN, F.G, (int)blockIdx.x, 0);
            pg8::EpiBf16 E{(pg8::bf16_t*)(F.ws + WS_P), NIN};
            pg8::gemm_phase<pg8::EpiBf16, pg8::StaticOrder, true>(F.lds + RING_OFF, g, S, E);
        } SEAM(pb + 0);
        if (EN(3) && IN(pb + 1)) { FRESH(); phase_qkpost(F, args, l); } SEAM(pb + 1);
        if (EN(4) && IN(pb + 2)) { FRESH(); phase_attention(F, args, l, last); } SEAM(pb + 2);
        if (EN(5) && IN(pb + 3)) {
            pg8::Gemm g{(const pg8::bf16_t*)(F.ws + WS_O), (const pg8::bf16_t*)(F.ws + WS_WOUT + (size_t)l * 32 * MiB), MROWS, DM, DM};
            pg8::StaticOrder S; S.init(last ? 32 : 34, DM, F.G, (int)blockIdx.x, last ? 1 : 0);
            pg8::EpiBf16 E{(pg8::bf16_t*)(F.ws + WS_Y), DM};
            pg8::gemm_phase<pg8::EpiBf16, pg8::StaticOrder, true>(F.lds + RING_OFF, g, S, E);
        } SEAM(pb + 3);
        if (EN(6) && IN(pb + 4)) { FRESH(); phase_r1(F, args, l, last); } SEAM(pb + 4);
        if (EN(7) && IN(pb + 5)) {
            pg8::Gemm g{HX, (const pg8::bf16_t*)(F.ws + WS_WUP + (size_t)l * 172 * MiB), MROWS, NUP, DM};
            pg8::StaticOrder S; S.init(last ? 32 : 34, NUP, F.G, (int)blockIdx.x, last ? 1 : 0);
            pg8::EpiBf16 E{(pg8::bf16_t*)(F.ws + WS_U), NUP};
            pg8::gemm_phase<pg8::EpiBf16, pg8::StaticOrder, true>(F.lds + RING_OFF, g, S, E);
        } SEAM(pb + 5);
        if (EN(8) && IN(pb + 6)) { FRESH(); phase_conv(F, args, l, last); } SEAM(pb + 6);
        if (EN(9) && IN(pb + 7)) {
            pg8::Gemm g{(const pg8::bf16_t*)(F.ws + WS_ACT), (const pg8::bf16_t*)(F.ws + WS_WDN + (size_t)l * 86 * MiB), MROWS, DM, DFF};
            pg8::StaticOrder S; S.init(last ? 32 : 34, DM, F.G, (int)blockIdx.x, last ? 1 : 0);
            pg8::EpiBf16 E{(pg8::bf16_t*)(F.ws + WS_Y), DM};
            pg8::gemm_phase<pg8::EpiBf16, pg8::StaticOrder, true>(F.lds + RING_OFF, g, S, E);
        } SEAM(pb + 7);
        if (EN(10) && IN(pb + 8)) { FRESH(); phase_r2(F, args, l, last); } SEAM(pb + 8);
    }
#undef IN
#undef SEAM
}

extern "C" void kernel_launch(void* const* d_in, const int* in_sizes, int n_in, void* d_out, int out_size, void* d_ws, size_t ws_size, hipStream_t stream) {
    static int grid = 0;
    if (grid == 0) {
        if (n_in != 24 || in_sizes[0] != NB * SEQ * DM || out_size != NB * SEQ * DM || ws_size < WS_END) {
            fprintf(stderr, "kernel_launch: unexpected shapes: n_in %d in0 %d out %d ws %zu (need %zu); nothing launched\n", n_in, n_in > 0 ? in_sizes[0] : -1, out_size, ws_size, (size_t)WS_END); grid = -1; return; }
        int dev = 0, cus = 0, per_cu = 0;
        if (hipGetDevice(&dev) != hipSuccess || hipDeviceGetAttribute(&cus, hipDeviceAttributeMultiprocessorCount, dev) != hipSuccess) { grid = -1; return; }
        if (hipFuncSetAttribute((const void*)fwd_kernel, hipFuncAttributeMaxDynamicSharedMemorySize, LDS_BYTES) != hipSuccess) { fprintf(stderr, "kernel_launch: hipFuncSetAttribute failed\n"); grid = -1; return; }
        if (hipOccupancyMaxActiveBlocksPerMultiprocessor(&per_cu, (const void*)fwd_kernel, NWAVES * 64, LDS_BYTES) != hipSuccess || per_cu < 1)
            fprintf(stderr, "kernel_launch: note: occupancy query reports %d workgroups per CU\n", per_cu);
        (void)hipGetLastError();
        grid = cus;
    }
    if (grid < 0) return;
    if (hipMemsetAsync((char*)d_ws + WS_CTL, 0, CTL_ZERO_BYTES, stream) != hipSuccess) return;
    Args a{};
    for (int i = 0; i < 24; ++i) a.in[i] = (const float*)d_in[i];
    a.out = (float*)d_out; a.ws = (unsigned char*)d_ws;
#if MK_SINGLE
    a.ph_lo = 0; a.ph_hi = NPHASE;
    hipLaunchKernelGGL(fwd_kernel, dim3(grid), dim3(NWAVES * 64), LDS_BYTES, stream, a);
#else
    for (int p = 0; p < NPHASE; ++p) { a.ph_lo = p; a.ph_hi = p + 1; hipLaunchKernelGGL(fwd_kernel, dim3(grid), dim3(NWAVES * 64), LDS_BYTES, stream, a); }
#endif
    const hipError_t le = hipPeekAtLastError();
    if (le != hipSuccess) fprintf(stderr, "kernel_launch: launch failed: %s\n", hipGetErrorName(le));
}
```

```cpp
#include <hip/hip_runtime.h>
#include <cstdio>
#include <cstdint>

#ifndef MK_SINGLE
#define MK_SINGLE 1
#endif

namespace pg8 {
#define PG8_LAS __attribute__((address_space(3)))
typedef unsigned short bf16_t;
typedef short bf16x8 __attribute__((ext_vector_type(8)));
typedef float f32x4 __attribute__((ext_vector_type(4)));
typedef unsigned u32x4 __attribute__((ext_vector_type(4)));
constexpr int BM = 256, BK = 64, HALF = 128, HTB = HALF * BK * 2, STAGE_BYTES = 8 * HTB, NXCD = 8, WGM = 8;

__host__ __device__ __forceinline__ int lds_byte(int r, int c) { const int st = (r >> 4) * 2 + (c >> 5), rr = r & 15, cc = c & 31, ob = rr * 64 + cc * 2; return st * 1024 + (ob ^ (((ob >> 9) & 1) << 5)); }
__host__ __device__ __forceinline__ void stage_rc(int b, int& R, int& C) { const int st = b / 1024, sb = b % 1024, swz = sb ^ (((sb >> 9) & 1) << 5); R = (st >> 1) * 16 + swz / 64; C = (st & 1) * 32 + (swz % 64) / 2; }
__host__ __device__ __forceinline__ int perm32(int rho) { const int n = rho >> 4, i = rho & 15; return 8 * (i >> 2) + 4 * n + (i & 3); }

struct Unit { int pm, pn; };
struct Gemm { const bf16_t* A; const bf16_t* Bt; int M, N, K; };

struct StaticOrder {
    int nM, nN, nwg, G, c, skip;
    __host__ __device__ void init(int nM_, int N, int G_, int c_, int skip_) { nM = nM_; nN = N / BM; nwg = nM * nN; G = G_; c = c_; skip = skip_; }
    __host__ __device__ bool next(int i, Unit& u) const {
        const long L = (long)i * G + c; if (L >= nwg) return false;
        int wgid = (int)L; { const int q = nwg / NXCD, r = nwg % NXCD, xcd = wgid % NXCD, off = wgid / NXCD; wgid = (xcd < r ? xcd * (q + 1) : r * (q + 1) + (xcd - r) * q) + off; }
        const int nig = WGM * nN, gid = wgid / nig, fm = gid * WGM, gsz = (nM - fm) < WGM ? (nM - fm) : WGM;
        u.pm = fm + ((wgid % nig) % gsz); u.pn = (wgid % nig) / gsz;
        if (skip && u.pm >= 16) u.pm += 1;
        return true;
    }
    __device__ __forceinline__ void a_ready(const Unit&) const {}
    __device__ __forceinline__ void done(const Unit&) const {}
};

__device__ __forceinline__ unsigned cvt_pk_bf16(float lo, float hi) { unsigned r; asm volatile("v_cvt_pk_bf16_f32 %0, %1, %2" : "=v"(r) : "v"(lo), "v"(hi)); return r; }

struct EpiBf16 {
    static constexpr bool PERM = true, AFTER_DRAIN = false;
    bf16_t* O; int ldc;
    __device__ __forceinline__ void operator()(const f32x4 (&acc)[2][2][4][2], const Unit& u, int wr, int wc, int fr, int fq) const {
        const int row0 = u.pm * BM + wr * 64 + fr; const int col0 = u.pn * BM + wc * 32 + 8 * fq;
#pragma unroll
        for (int ai = 0; ai < 2; ++ai)
#pragma unroll
            for (int m = 0; m < 4; ++m) { bf16_t* rowp = O + (size_t)(row0 + ai * HALF + m * 16) * ldc + col0;
#pragma unroll
                for (int bj = 0; bj < 2; ++bj) { const f32x4 v0 = acc[ai][bj][m][0], v1 = acc[ai][bj][m][1];
                    u32x4 w; w.x = cvt_pk_bf16(v0[0], v0[1]); w.y = cvt_pk_bf16(v0[2], v0[3]); w.z = cvt_pk_bf16(v1[0], v1[1]); w.w = cvt_pk_bf16(v1[2], v1[3]);
                    *(u32x4*)(rowp + bj * HALF) = w; } }
    }
};

template <class Epi, class Sched, bool ALIGN_EPI = false>
__device__ __forceinline__ void gemm_phase(PG8_LAS unsigned char* lds, const Gemm g, const Sched& S, const Epi& E) {
    int tid_ = threadIdx.x; asm volatile("" : "+v"(tid_));
    const int tid = tid_, wid = __builtin_amdgcn_readfirstlane(tid >> 6), lane = tid & 63, wr = wid >> 2, wc = wid & 3, fr = lane & 15, fq = lane >> 4;
    const int K = g.K, nt = K / BK;
    unsigned voffA[2], voffB[2];
#pragma unroll
    for (int i = 0; i < 2; ++i) { int R, C; stage_rc(tid * 16 + i * 8192, R, C); const int Rb = Epi::PERM ? ((R & ~31) + perm32(R & 31)) : R;
        voffA[i] = (unsigned)(R * K + C) * 2u; voffB[i] = (unsigned)(Rb * K + C) * 2u; }
    const size_t kstep = (size_t)(BK * 2);
    const size_t hstep = (size_t)HALF * K * 2;
    const size_t tstep = 2 * hstep;
    const unsigned ldsw = (unsigned)wid * 1024u;
    const int aoff = lds_byte(wr * 64 + fr, fq * 8), boff = lds_byte(wc * 32 + fr, fq * 8);
#define PG8_SA(b, h) (((b) * 2 + (h)) * HTB)
#define PG8_SB(b, h) ((4 + (b) * 2 + (h)) * HTB)
#define PG8_STAGE(bufoff, gbase, voff) do { _Pragma("unroll") for (int _i = 0; _i < 2; ++_i) \
        __builtin_amdgcn_global_load_lds((const unsigned*)((const char*)(gbase) + (voff)[_i]), (PG8_LAS unsigned*)(lds + (bufoff) + ldsw + _i * 8192), 16, 0, 0); } while (0)
#define PG8_LDA(dst, b, h) do { _Pragma("unroll") for (int m = 0; m < 4; ++m) _Pragma("unroll") for (int k = 0; k < 2; ++k) dst[m][k] = *(const PG8_LAS bf16x8*)(lds + PG8_SA(b, h) + aoff + m * 2048 + k * 1024); } while (0)
#define PG8_LDB(dst, b, h) do { _Pragma("unroll") for (int n = 0; n < 2; ++n) _Pragma("unroll") for (int k = 0; k < 2; ++k) dst[n][k] = *(const PG8_LAS bf16x8*)(lds + PG8_SB(b, h) + boff + n * 2048 + k * 1024); } while (0)
#define PG8_MMA(ai, bj, At, Bt) do { __builtin_amdgcn_s_setprio(1); _Pragma("unroll") for (int m = 0; m < 4; ++m) _Pragma("unroll") for (int n = 0; n < 2; ++n) _Pragma("unroll") for (int k = 0; k < 2; ++k) \
        acc[ai][bj][m][n] = __builtin_amdgcn_mfma_f32_16x16x32_bf16(Bt[n][k], At[m][k], acc[ai][bj][m][n], 0, 0, 0); __builtin_amdgcn_s_setprio(0); } while (0)
#define PG8_WAIT_V(n) asm volatile("s_waitcnt vmcnt(" #n ")" ::: "memory")
#define PG8_WAIT_L(n) asm volatile("s_waitcnt lgkmcnt(" #n ")" ::: "memory")
#define PG8_BAR __builtin_amdgcn_s_barrier()
#define PG8_SCHED __builtin_amdgcn_sched_barrier(0)
    Unit cur, nxt; int ui = 0;
    if (!S.next(0, cur)) return;
    f32x4 acc[2][2][4][2];
#pragma unroll
    for (int a = 0; a < 2; ++a)
#pragma unroll
        for (int b = 0; b < 2; ++b)
#pragma unroll
            for (int m = 0; m < 4; ++m)
#pragma unroll
                for (int n = 0; n < 2; ++n) acc[a][b][m][n] = (f32x4){0.f, 0.f, 0.f, 0.f};
    bf16x8 At[4][2], B0[2][2], B1[2][2];
    const char* cA = (const char*)g.A + (size_t)cur.pm * tstep; const char* cB = (const char*)g.Bt + (size_t)cur.pn * tstep;
    S.a_ready(cur);
    PG8_STAGE(PG8_SB(0, 0), cB, voffB); PG8_STAGE(PG8_SB(0, 1), cB + hstep, voffB); PG8_STAGE(PG8_SA(0, 0), cA, voffA); PG8_STAGE(PG8_SA(0, 1), cA + hstep, voffA);
    if (wr == 1) PG8_BAR;
    PG8_WAIT_V(2); PG8_BAR;
    PG8_STAGE(PG8_SB(1, 0), cB + kstep, voffB); PG8_STAGE(PG8_SA(1, 0), cA + kstep, voffA); PG8_STAGE(PG8_SB(1, 1), cB + hstep + kstep, voffB);
    PG8_WAIT_V(6); PG8_BAR;
    for (;;) {
        const bool has_next = S.next(ui + 1, nxt);
        const char* nA = has_next ? (const char*)g.A + (size_t)nxt.pm * tstep : cA; const char* nB = has_next ? (const char*)g.Bt + (size_t)nxt.pn * tstep : cB;
        for (int t = 0; t < nt; t += 2) {
            const bool last = (t == nt - 2);
            const char* a1 = cA + (size_t)(t + 1) * kstep;
            const char* a2 = last ? nA : cA + (size_t)(t + 2) * kstep; const char* b2 = last ? nB : cB + (size_t)(t + 2) * kstep;
            const char* a3 = a2 + kstep; const char* b3 = b2 + kstep;
            if (last && has_next) S.a_ready(nxt);
            PG8_LDB(B0, 0, 0); PG8_LDB(B1, 0, 1); PG8_SCHED; PG8_LDA(At, 0, 0); PG8_STAGE(PG8_SA(1, 1), a1 + hstep, voffA);
            PG8_WAIT_V(8); PG8_WAIT_L(0); PG8_BAR; PG8_MMA(0, 0, At, B0); PG8_MMA(0, 1, At, B1); PG8_BAR; PG8_SCHED;
            PG8_LDA(At, 0, 1); PG8_STAGE(PG8_SB(0, 0), b2, voffB); PG8_STAGE(PG8_SB(0, 1), b2 + hstep, voffB); PG8_STAGE(PG8_SA(0, 0), a2, voffA);
            PG8_WAIT_V(8); PG8_WAIT_L(0); PG8_BAR; PG8_MMA(1, 0, At, B0); PG8_MMA(1, 1, At, B1); PG8_BAR; PG8_SCHED;
            PG8_LDB(B0, 1, 0); PG8_LDB(B1, 1, 1); PG8_SCHED; PG8_LDA(At, 1, 0); PG8_STAGE(PG8_SA(0, 1), a2 + hstep, voffA);
            PG8_WAIT_V(8); PG8_WAIT_L(0); PG8_BAR; PG8_MMA(0, 0, At, B0); PG8_MMA(0, 1, At, B1); PG8_BAR; PG8_SCHED;
            PG8_LDA(At, 1, 1); PG8_STAGE(PG8_SB(1, 0), b3, voffB); PG8_STAGE(PG8_SB(1, 1), b3 + hstep, voffB); PG8_STAGE(PG8_SA(1, 0), a3, voffA);
            PG8_WAIT_V(8); PG8_WAIT_L(0); PG8_BAR; PG8_MMA(1, 0, At, B0); PG8_MMA(1, 1, At, B1); PG8_BAR; PG8_SCHED;
        }
        if constexpr (ALIGN_EPI) { if (wr == 0) PG8_BAR; }
        if constexpr (!Epi::AFTER_DRAIN) { E(acc, cur, wr, wc, fr, fq); S.done(cur); }
        if (!has_next) break;
#pragma unroll
        for (int a = 0; a < 2; ++a)
#pragma unroll
            for (int b = 0; b < 2; ++b)
#pragma unroll
                for (int m = 0; m < 4; ++m)
#pragma unroll
                    for (int n = 0; n < 2; ++n) acc[a][b][m][n] = (f32x4){0.f, 0.f, 0.f, 0.f};
        cur = nxt; cA = nA; cB = nB; ++ui;
        if constexpr (ALIGN_EPI) { if (wr == 1) PG8_BAR; }
    }
    PG8_WAIT_V(0);
    if constexpr (!ALIGN_EPI) { if (wr == 0) PG8_BAR; }
    PG8_BAR;
#undef PG8_SA
#undef PG8_SB
#undef PG8_STAGE
#undef PG8_LDA
#undef PG8_LDB
#undef PG8_MMA
#undef PG8_WAIT_V
#undef PG8_WAIT_L
#undef PG8_BAR
#undef PG8_SCHED
}
}

namespace att {
#define ALAS __attribute__((address_space(3)))
typedef unsigned short bf16;
typedef short bf16x8 __attribute__((ext_vector_type(8)));
typedef short s16x4 __attribute__((ext_vector_type(4)));
typedef float f32x16 __attribute__((ext_vector_type(16)));
typedef unsigned u32x4 __attribute__((ext_vector_type(4)));
constexpr int LDP = 9216, LDO = 4096;
constexpr int SLOT = 32768;
constexpr int WSCR_OFF = 131072 + 1024, BIAS_OFF = WSCR_OFF + 2048, SHM_END = BIAS_OFF + 2048;
constexpr int NCTX_T = 4;
#define KSWZ(row, colB) ((row) * 256 + ((colB) ^ (((row) & 7) << 4)))
#define SBAR() __builtin_amdgcn_sched_barrier(0)
__device__ __forceinline__ int crow(int r, int hi) { return (r & 3) + 8 * (r >> 2) + 4 * hi; }
__device__ __forceinline__ unsigned cvtpk(float lo, float hi) { unsigned r; asm volatile("v_cvt_pk_bf16_f32 %0, %1, %2" : "=v"(r) : "v"(lo), "v"(hi)); return r; }

__device__ __forceinline__ void partialSM(f32x16& p0, f32x16& p1, float& m_reg, float& mn, float& alpha, const float C, const float thr_raw) {
    float pmax = p0[0];
#pragma unroll
    for (int r = 1; r < 16; ++r) pmax = fmaxf(pmax, p0[r]);
#pragma unroll
    for (int r = 0; r < 16; ++r) pmax = fmaxf(pmax, p1[r]);
    { auto rr = __builtin_amdgcn_permlane32_swap(__float_as_uint(pmax), __float_as_uint(pmax), false, false);
      pmax = fmaxf(__uint_as_float(rr[0]), __uint_as_float(rr[1])); }
    if (__builtin_expect(__all(pmax - m_reg <= thr_raw), 1)) { mn = m_reg; alpha = 1.f; }
    else { mn = fmaxf(m_reg, pmax); alpha = __builtin_amdgcn_exp2f((m_reg - mn) * C); m_reg = mn; }
    const float mnC = -mn * C;
#pragma unroll
    for (int r = 0; r < 16; ++r) p0[r] = fmaf(p0[r], C, mnC);
#pragma unroll
    for (int r = 0; r < 16; ++r) p1[r] = fmaf(p1[r], C, mnC);
#pragma unroll
    for (int r = 0; r < 16; ++r) p0[r] = __builtin_amdgcn_exp2f(p0[r]);
}
__device__ __forceinline__ void finishSM(f32x16& p0, f32x16& p1, float alpha, float& l_reg, bf16x8& pa0, bf16x8& pa1, bf16x8& pa2, bf16x8& pa3) {
#pragma unroll
    for (int r = 0; r < 16; ++r) p1[r] = __builtin_amdgcn_exp2f(p1[r]);
    float ps = 0;
#pragma unroll
    for (int r = 0; r < 16; ++r) ps += p0[r];
#pragma unroll
    for (int r = 0; r < 16; ++r) ps += p1[r];
    { auto rr = __builtin_amdgcn_permlane32_swap(__float_as_uint(ps), __float_as_uint(ps), false, false);
      ps = __uint_as_float(rr[0]) + __uint_as_float(rr[1]); }
    l_reg = l_reg * alpha + ps;
#define PK4(P, BASE, OUT) do { unsigned a0 = cvtpk(P[BASE + 0], P[BASE + 1]), a1 = cvtpk(P[BASE + 2], P[BASE + 3]);   \
    unsigned b0 = cvtpk(P[BASE + 4], P[BASE + 5]), b1 = cvtpk(P[BASE + 6], P[BASE + 7]);                              \
    auto r0 = __builtin_amdgcn_permlane32_swap(a0, b0, false, false); auto r1 = __builtin_amdgcn_permlane32_swap(a1, b1, false, false); \
    u32x4 w = {r0[0], r1[0], r0[1], r1[1]}; OUT = __builtin_bit_cast(bf16x8, w); } while (0)
    PK4(p0, 0, pa0); PK4(p0, 8, pa1); PK4(p1, 0, pa2); PK4(p1, 8, pa3);
#undef PK4
}
template <int D0LO, int D0N>
__device__ __forceinline__ void qkt(f32x16& p0, f32x16& p1, const ALAS char* Ks, const bf16x8* qr, int r32, int hi) {
    p0 = f32x16{}; p1 = f32x16{};
#pragma unroll
    for (int d0 = D0LO; d0 < D0LO + D0N; ++d0) { const int cb = (d0 * 16 + hi * 8) * 2;
        const bf16x8 b0 = *(const ALAS bf16x8*)(Ks + KSWZ(r32, cb));
        const bf16x8 b1 = *(const ALAS bf16x8*)(Ks + KSWZ(32 + r32, cb));
        p0 = __builtin_amdgcn_mfma_f32_32x32x16_bf16(b0, qr[d0], p0, 0, 0, 0);
        p1 = __builtin_amdgcn_mfma_f32_32x32x16_bf16(b1, qr[d0], p1, 0, 0, 0); }
}
__device__ __forceinline__ int v_st(int k, int c) { const int kk = (k & ~0xC) | ((k & 4) << 1) | ((k & 8) >> 1); return ((kk >> 3) * 4 + (c >> 5)) * 512 + ((kk & 7) * 32 + (c & 31)) * 2; }
__device__ __forceinline__ int v_rd_base(int lane) { return ((lane & 3) << 3) | (((lane >> 2) & 3) << 6) | (((lane >> 4) & 1) << 5) | (((lane >> 5) & 1) << 8); }
constexpr int v_rd_off(int d0, int ks, int half) { return d0 * 512 + ks * 4096 + half * 2048; }
template <int OFF> __device__ __forceinline__ s16x4 tr_read(int vb) {
    s16x4 r; asm volatile("ds_read_b64_tr_b16 %0, %1 offset:%2" : "=&v"(r) : "v"(vb), "i"(OFF) : "memory"); return r;
}
template <int D0> __device__ __forceinline__ void pv_one(f32x16& od, int vb, bf16x8 pa0, bf16x8 pa1, bf16x8 pa2, bf16x8 pa3) {
    const s16x4 l0 = tr_read<v_rd_off(D0, 0, 0)>(vb), h0 = tr_read<v_rd_off(D0, 0, 1)>(vb), l1 = tr_read<v_rd_off(D0, 1, 0)>(vb), h1 = tr_read<v_rd_off(D0, 1, 1)>(vb);
    const s16x4 l2 = tr_read<v_rd_off(D0, 2, 0)>(vb), h2 = tr_read<v_rd_off(D0, 2, 1)>(vb), l3 = tr_read<v_rd_off(D0, 3, 0)>(vb), h3 = tr_read<v_rd_off(D0, 3, 1)>(vb);
    asm volatile("s_waitcnt lgkmcnt(0)" ::: "memory"); SBAR();
#define PK(L, H) (bf16x8){L[0], L[1], L[2], L[3], H[0], H[1], H[2], H[3]}
    od = __builtin_amdgcn_mfma_f32_32x32x16_bf16(pa0, PK(l0, h0), od, 0, 0, 0);
    od = __builtin_amdgcn_mfma_f32_32x32x16_bf16(pa1, PK(l1, h1), od, 0, 0, 0);
    od = __builtin_amdgcn_mfma_f32_32x32x16_bf16(pa2, PK(l2, h2), od, 0, 0, 0);
    od = __builtin_amdgcn_mfma_f32_32x32x16_bf16(pa3, PK(l3, h3), od, 0, 0, 0);
#undef PK
}
__device__ __forceinline__ void pv_d0(f32x16* o, int vb, bf16x8 pa0, bf16x8 pa1, bf16x8 pa2, bf16x8 pa3) {
    pv_one<0>(o[0], vb, pa0, pa1, pa2, pa3); pv_one<1>(o[1], vb, pa0, pa1, pa2, pa3); pv_one<2>(o[2], vb, pa0, pa1, pa2, pa3); pv_one<3>(o[3], vb, pa0, pa1, pa2, pa3);
}

template <int MASK>
__device__ __forceinline__ void apply_mask(f32x16& p0, f32x16& p1, int j, int loc0, int qp, int hi, const ALAS float* bias) {
    if constexpr (MASK == 2) {
        if (j >= NCTX_T) { const int kbase = loc0 + 64 * (j - NCTX_T);
#pragma unroll
            for (int r = 0; r < 16; ++r) { const int d0 = qp - (kbase + crow(r, hi)); const int d1 = d0 - 32;
                if (d0 > 128 || d0 < -128) p0[r] = -1e30f;
                if (d1 > 128 || d1 < -128) p1[r] = -1e30f; } }
    } else if constexpr (MASK == 3) {
        if (j >= NCTX_T) { const int kbase = loc0 + 64 * (j - NCTX_T);
            const int qrow = qp >> 6, qcol = qp & 63; const int rs = min(max(qrow - 4, 0), 56), cs = min(max(qcol - 8, 0), 48);
            const int kr = kbase >> 6; const int dr = kr - rs;
            if (dr < 0 || dr >= 8) {
#pragma unroll
                for (int r = 0; r < 16; ++r) { p0[r] = -1e30f; p1[r] = -1e30f; }
            } else {
                const ALAS float* brow = bias + (kr - qrow + 7) * 31 + 15 - qcol;
#pragma unroll
                for (int r = 0; r < 16; ++r) { const int kc0 = crow(r, hi), kc1 = kc0 + 32;
                    const bool ok0 = (unsigned)(kc0 - cs) < 16u, ok1 = (unsigned)(kc1 - cs) < 16u;
                    const float b0 = brow[ok0 ? kc0 : qcol], b1 = brow[ok1 ? kc1 : qcol];
                    p0[r] = ok0 ? p0[r] + b0 : -1e30f; p1[r] = ok1 ? p1[r] + b1 : -1e30f; }
            }
        }
    }
}

template <int MASK, int D0LO, int D0N>
__device__ __forceinline__ void attn_core(f32x16 (&o)[4], float& m_reg, float& l_reg, const bf16* __restrict__ Qw, const bf16* __restrict__ Kb, const bf16* __restrict__ Vb,
                                          const int nloc, const int loc0, const int qp, const float C, const float thr_raw, ALAS char* lds) {
    int tid_ = threadIdx.x; asm volatile("" : "+v"(tid_));
    const int tid = tid_, wid = __builtin_amdgcn_readfirstlane(tid >> 6), lane = tid & 63, r32 = lane & 31, hi = lane >> 5;
    ALAS float* ws = (ALAS float*)(lds + WSCR_OFF) + wid * 64; ALAS float* al_l = ws + 32;
    const ALAS float* bias = (const ALAS float*)(lds + BIAS_OFF);
    unsigned voffK[2], voffV[2];
#pragma unroll
    for (int i = 0; i < 2; ++i) { const int q = (wid + 8 * i) * 64 + lane;
        { const int row = q >> 4, cc = (q & 15) ^ (row & 7); voffK[i] = (unsigned)(row * (LDP * 2) + cc * 16); }
        { const int kk = (q >> 7) * 8 + ((q & 31) >> 2), c = ((q >> 5) & 3) * 32 + (q & 3) * 8; const int k = (kk & ~0xC) | ((kk & 4) << 1) | ((kk & 8) >> 1); voffV[i] = (unsigned)(k * (LDP * 2) + c * 2); } }
    const int NT = NCTX_T + nloc;
#define KOFF(j) ((j) < NCTX_T ? 4096 + 64 * (j) : loc0 + 64 * ((j) - NCTX_T))
#define ISSUE(j) do { const size_t _ro = (size_t)KOFF(j) * (LDP * 2); const char* _gk = (const char*)Kb + _ro; const char* _gv = (const char*)Vb + _ro; ALAS char* _sl = lds + ((j) & 3) * SLOT + wid * 1024; \
    _Pragma("unroll") for (int _i = 0; _i < 2; ++_i) __builtin_amdgcn_global_load_lds((const unsigned*)(_gk + voffK[_i]), (ALAS unsigned*)(_sl + _i * 8192), 16, 0, 0); \
    _Pragma("unroll") for (int _i = 0; _i < 2; ++_i) __builtin_amdgcn_global_load_lds((const unsigned*)(_gv + voffV[_i]), (ALAS unsigned*)(_sl + 16384 + _i * 8192), 16, 0, 0); } while (0)
#define WAITBAR(n) do { asm volatile("s_waitcnt vmcnt(" #n ") lgkmcnt(0)" ::: "memory"); __builtin_amdgcn_s_barrier(); asm volatile("" ::: "memory"); } while (0)
#define RESC(a) do { if (__any((a) < 1.f)) { if (hi == 0) al_l[r32] = (a); asm volatile("s_waitcnt lgkmcnt(0)" ::: "memory"); \
    _Pragma("unroll") for (int d = 0; d < 4; ++d) _Pragma("unroll") for (int r = 0; r < 16; ++r) o[d][r] *= al_l[crow(r, hi)]; } } while (0)
    asm volatile("s_waitcnt vmcnt(0)" ::: "memory");
    m_reg = -1e30f; l_reg = 0.f;
#pragma unroll
    for (int d = 0; d < 4; ++d) o[d] = f32x16{};
    bf16x8 qr[8];
#pragma unroll
    for (int d0 = 0; d0 < 8; ++d0) qr[d0] = *(const bf16x8*)(Qw + d0 * 16);
    ISSUE(0); ISSUE(1); ISSUE(2);
    const int vb0 = (int)(uintptr_t)lds + 16384 + v_rd_base(lane);
    f32x16 pA0, pA1, pB0, pB1; float mnA, mnB, alA, alB; bf16x8 pa0, pa1, pa2, pa3;
    WAITBAR(8);
    qkt<D0LO, D0N>(pA0, pA1, lds, qr, r32, hi); apply_mask<MASK>(pA0, pA1, 0, loc0, qp, hi, bias); partialSM(pA0, pA1, m_reg, mnA, alA, C, thr_raw);
    WAITBAR(4);
    ISSUE(3);
    for (int j = 1; j + 1 < NT; j += 2) {
        SBAR(); qkt<D0LO, D0N>(pB0, pB1, lds + (j & 3) * SLOT, qr, r32, hi);
        finishSM(pA0, pA1, alA, l_reg, pa0, pa1, pa2, pa3); SBAR();
        pv_d0(o, vb0 + ((j - 1) & 3) * SLOT, pa0, pa1, pa2, pa3); apply_mask<MASK>(pB0, pB1, j, loc0, qp, hi, bias); partialSM(pB0, pB1, m_reg, mnB, alB, C, thr_raw);
        if (j + 2 < NT) { WAITBAR(4); } else { WAITBAR(0); }
        if (j + 3 < NT) ISSUE(j + 3);
        RESC(alB);
        SBAR(); qkt<D0LO, D0N>(pA0, pA1, lds + ((j + 1) & 3) * SLOT, qr, r32, hi);
        finishSM(pB0, pB1, alB, l_reg, pa0, pa1, pa2, pa3); SBAR();
        pv_d0(o, vb0 + (j & 3) * SLOT, pa0, pa1, pa2, pa3); apply_mask<MASK>(pA0, pA1, j + 1, loc0, qp, hi, bias); partialSM(pA0, pA1, m_reg, mnA, alA, C, thr_raw);
        if (j + 3 < NT) { WAITBAR(4); } else { WAITBAR(0); }
        if (j + 4 < NT) ISSUE(j + 4);
        RESC(alA);
    }
    SBAR(); qkt<D0LO, D0N>(pB0, pB1, lds + ((NT - 1) & 3) * SLOT, qr, r32, hi);
    finishSM(pA0, pA1, alA, l_reg, pa0, pa1, pa2, pa3); SBAR();
    pv_d0(o, vb0 + ((NT - 2) & 3) * SLOT, pa0, pa1, pa2, pa3); apply_mask<MASK>(pB0, pB1, NT - 1, loc0, qp, hi, bias); partialSM(pB0, pB1, m_reg, mnB, alB, C, thr_raw);
    RESC(alB);
    finishSM(pB0, pB1, alB, l_reg, pa0, pa1, pa2, pa3); SBAR();
    pv_d0(o, vb0 + ((NT - 1) & 3) * SLOT, pa0, pa1, pa2, pa3);
#undef KOFF
#undef ISSUE
#undef WAITBAR
#undef RESC
}
}

constexpr int NWAVES = 8;
constexpr int DM = 4096, NB = 2, SEQ = 4096, CTXL = 256, TPB = SEQ + CTXL  , MROWS = NB * TPB  ;
constexpr int NIN = 9216, DFF = 11008, NUP = 2 * DFF, NADA = 6 * DM;
constexpr int QA = 0, QB_ = 1024, QC = 2048, QD = 3072, KA = 4096, VA = 4352, KB_ = 4608, VB_ = 5632, KC = 6656, VC = 6912, KD = 7168, VD = 8192;
constexpr float EPS = 1e-6f;
constexpr int NPHASE = 20;

constexpr size_t MiB = 1u << 20;
constexpr size_t WS_CTL = 0, CTL_ZERO_BYTES = 1 * MiB;
constexpr size_t WS_MOD = 1 * MiB;
constexpr size_t WS_TAB = 2 * MiB;
constexpr size_t WS_WIN = 4 * MiB;
constexpr size_t WS_WOUT = WS_WIN + 2 * 72 * MiB;
constexpr size_t WS_WUP = WS_WOUT + 2 * 32 * MiB;
constexpr size_t WS_WDN = WS_WUP + 2 * 172 * MiB;
constexpr size_t WS_XS = WS_WDN + 2 * 86 * MiB;
constexpr size_t WS_HX = WS_XS + 136 * MiB;
constexpr size_t WS_P = WS_HX + 68 * MiB;
constexpr size_t WS_O = WS_P + 153 * MiB;
constexpr size_t WS_Y = WS_O + 68 * MiB;
constexpr size_t WS_U = WS_Y + 68 * MiB;
constexpr size_t WS_ACT = WS_U + 366 * MiB;
constexpr size_t WS_STASH = WS_ACT + 183 * MiB;
constexpr size_t WS_END = WS_STASH + 32 * MiB;
static_assert((size_t)MROWS * NUP * 2 <= 366 * MiB && (size_t)MROWS * DFF * 2 <= 183 * MiB && (size_t)MROWS * NIN * 2 <= 153 * MiB, "ws map");
constexpr int CW_BAR = 4096;

constexpr int RING_OFF = 0, RING_BYTES = 131072;
constexpr int LDSCTL_OFF = RING_BYTES, MISC_OFF = LDSCTL_OFF + 320;
constexpr int LDS_BYTES = 147456;
static_assert(att::SHM_END <= LDS_BYTES && att::WSCR_OFF >= MISC_OFF + 128, "attention LDS map");

#define GAS __attribute__((address_space(1)))
#define LAS __attribute__((address_space(3)))
typedef unsigned short bf16;
typedef unsigned v4u __attribute__((ext_vector_type(4)));
typedef unsigned v2u __attribute__((ext_vector_type(2)));
typedef float f32x4 __attribute__((ext_vector_type(4)));
typedef float f32x2 __attribute__((ext_vector_type(2)));
typedef GAS unsigned gu32;
#define RLX_AGENT __ATOMIC_RELAXED, __HIP_MEMORY_SCOPE_AGENT
#define LDS_WAIT() asm volatile("s_waitcnt lgkmcnt(0)" ::: "memory")
#define VM_WAIT() asm volatile("s_waitcnt vmcnt(0)" ::: "memory")
__device__ __forceinline__ unsigned f2bf(float f) { unsigned u = __builtin_bit_cast(unsigned, f); return (u + 0x7fffu + ((u >> 16) & 1u)) >> 16; }
__device__ __forceinline__ unsigned pk2(float lo, float hi) { return f2bf(lo) | (f2bf(hi) << 16); }
__device__ __forceinline__ float bf_lo(unsigned w) { return __uint_as_float(w << 16); }
__device__ __forceinline__ float bf_hi(unsigned w) { return __uint_as_float(w & 0xffff0000u); }

#define XB_TMO      128
#define XB_XCNT(j)  (256  + 64 * (j))
#define XB_XSUB(j)  (1280 + 64 * (j))
#define XB_XGEN(j)  (2304 + 64 * (j))
#define XB_TOP      3328
#define XB_TOPGEN   3392
#define XCD_BAR_WORDS 3456
#define XB_SPIN_CAP (1u << 24)

__device__ __forceinline__ unsigned xb_ld(unsigned* p)              { return __hip_atomic_load(p, __ATOMIC_RELAXED, __HIP_MEMORY_SCOPE_AGENT); }
__device__ __forceinline__ unsigned xb_add(unsigned* p, unsigned v) { return __hip_atomic_fetch_add(p, v, __ATOMIC_RELAXED, __HIP_MEMORY_SCOPE_AGENT); }
__device__ __forceinline__ unsigned xb_xcc_id() { return (unsigned)__builtin_amdgcn_s_getreg((3 << 11) | 20) & 0xFu; }
#define XB_SPIN(cond, bar) do { unsigned _sp = 0; while (cond) { __builtin_amdgcn_s_sleep(1); \
    if ((++_sp & 255u) == 0u) { if (xb_ld(&(bar)[XB_TMO])) break; if (_sp > XB_SPIN_CAP) { atomicAdd(&(bar)[XB_TMO], 1u); break; } } } } while (0)

struct XcdBarrier { unsigned* bar; unsigned x; volatile LAS unsigned* st; };

__device__ __forceinline__ XcdBarrier xcd_barrier_post(unsigned* bar, volatile LAS unsigned* st) {
    XcdBarrier b; b.bar = bar; b.x = xb_xcc_id(); b.st = st;
    if (threadIdx.x == 0) (void)xb_add(&bar[XB_XCNT(b.x)], 1u);
    return b;
}
__device__ __forceinline__ void xcd_barrier_complete(unsigned* bar, unsigned x, unsigned& nloc, unsigned& nx) {
    const unsigned G = gridDim.x * gridDim.y * gridDim.z;
    unsigned sum, cnt, mine, sp = 0u;
    for (;;) {
        sum = 0u; cnt = 0u; mine = 0u;
#pragma unroll
        for (unsigned j = 0; j < 16; ++j) { const unsigned c = xb_ld(&bar[XB_XCNT(j)]); sum += c; cnt += (c > 0u) ? 1u : 0u; mine = (j == x) ? c : mine; }
        if (sum == G) break;
        __builtin_amdgcn_s_sleep(1);
        if ((++sp & 255u) == 0u) { if (xb_ld(&bar[XB_TMO])) break; if (sp > XB_SPIN_CAP) { atomicAdd(&bar[XB_TMO], 1u); break; } }
    }
    nloc = mine > 0u ? mine : 1u; nx = cnt > 0u ? cnt : 1u;
}
__device__ __forceinline__ void xcd_barrier(const XcdBarrier& b) {
    asm volatile("s_waitcnt vmcnt(0)" ::: "memory");
    __syncthreads();
    if (threadIdx.x == 0) {
        unsigned* bar = b.bar;
        __builtin_amdgcn_s_waitcnt(0);
        unsigned nloc = b.st[0], nx = b.st[1];
        if (nloc == 0u) { xcd_barrier_complete(bar, b.x, nloc, nx); b.st[0] = nloc; b.st[1] = nx; }
        const unsigned old = xb_add(&bar[XB_XSUB(b.x)], 1u);
        const unsigned gen = old / nloc;
        if (old + 1u == (gen + 1u) * nloc) {
            __builtin_amdgcn_fence(__ATOMIC_RELEASE, "agent");
            asm volatile("s_waitcnt vmcnt(0)" ::: "memory");
            const unsigned og = xb_add(&bar[XB_TOP], 1u);
            const unsigned tg = og / nx;
            if (og + 1u == (tg + 1u) * nx) xb_add(&bar[XB_TOPGEN], 1u);
            else XB_SPIN(xb_ld(&bar[XB_TOPGEN]) == tg, bar);
            __builtin_amdgcn_fence(__ATOMIC_ACQUIRE, "agent");
            xb_add(&bar[XB_XGEN(b.x)], 1u);
            asm volatile("s_waitcnt vmcnt(0)" ::: "memory");
        } else {
            XB_SPIN(xb_ld(&bar[XB_XGEN(b.x)]) == gen, bar);
            __builtin_amdgcn_fence(__ATOMIC_ACQUIRE, "agent");
            asm volatile("s_waitcnt vmcnt(0)" ::: "memory");
        }
    }
    __syncthreads();
}

struct Args {
    const float* in[24]; float* out; unsigned char* ws; int ph_lo, ph_hi;
};
struct Frame {
    LAS unsigned char* lds;
    int tid, lane, wave, vcu, G;
    unsigned char* ws;
};

__device__ __forceinline__ float wave_sum(float v) {
#pragma unroll
    for (int o = 1; o < 64; o <<= 1) v += __shfl_xor(v, o);
    return v;
}

__device__ const float INV32[32] = {
    1.0f, 0.74989420933f, 0.56234132519f, 0.42169650343f, 0.31622776602f, 0.23713737057f, 0.17782794100f, 0.13335214322f,
    0.1f, 0.074989420933f, 0.056234132519f, 0.042169650343f, 0.031622776602f, 0.023713737057f, 0.017782794100f, 0.013335214322f,
    0.01f, 0.0074989420933f, 0.0056234132519f, 0.0042169650343f, 0.0031622776602f, 0.0023713737057f, 0.0017782794100f, 0.0013335214322f,
    0.001f, 0.00074989420933f, 0.00056234132519f, 0.00042169650343f, 0.00031622776602f, 0.00023713737057f, 0.00017782794100f, 0.00013335214322f };
__device__ const float INV16[16] = {
    1.0f, 0.56234132519f, 0.31622776602f, 0.17782794100f, 0.1f, 0.056234132519f, 0.031622776602f, 0.017782794100f,
    0.01f, 0.0056234132519f, 0.0031622776602f, 0.0017782794100f, 0.001f, 0.00056234132519f, 0.00031622776602f, 0.00017782794100f };

__device__ __forceinline__ void sincos_acc(float af, float& c, float& s) {
    const double a = (double)af; const double kd = __builtin_rint(a * 0.63661977236758134308); const int k = (int)kd;
    const double r = (a - kd * 1.57079632679489655800) - kd * 6.12323399573676603587e-17; const double r2 = r * r;
    const double sn = r * (1.0 + r2 * (-1.0 / 6 + r2 * (1.0 / 120 + r2 * (-1.0 / 5040 + r2 * (1.0 / 362880 + r2 * (-1.0 / 39916800 + r2 * (1.0 / 6227020800.0)))))));
    const double cs = 1.0 + r2 * (-0.5 + r2 * (1.0 / 24 + r2 * (-1.0 / 720 + r2 * (1.0 / 40320 + r2 * (-1.0 / 3628800 + r2 * (1.0 / 479001600.0 + r2 * (-1.0 / 87178291200.0)))))));
    double cc, ss;
    switch (k & 3) { case 0: cc = cs; ss = sn; break; case 1: cc = -sn; ss = cs; break; case 2: cc = -cs; ss = -sn; break; default: cc = sn; ss = -cs; break; }
    c = (float)cc; s = (float)ss;
}

__device__ __forceinline__ void p0_transpose_item(const float* W, int K, int N, bf16* WT, LAS float* scr, int item, int lane) {
    const int nblk = N / 32, kb = item / nblk, nb = item % nblk, k0 = 64 * kb, n0 = 32 * nb;
#pragma unroll 8
    for (int i = 0; i < 32; ++i) { const int kk = 2 * i + (lane >> 5); scr[kk * 33 + (lane & 31)] = W[(size_t)(k0 + kk) * N + n0 + (lane & 31)]; }
    LDS_WAIT(); asm volatile("" ::: "memory");
    const int c = lane & 7;
#pragma unroll
    for (int j = 0; j < 4; ++j) { const int n = (lane >> 3) + 8 * j; const LAS float* s = scr + (8 * c) * 33 + n;
        v4u o; o.x = pk2(s[0 * 33], s[1 * 33]); o.y = pk2(s[2 * 33], s[3 * 33]); o.z = pk2(s[4 * 33], s[5 * 33]); o.w = pk2(s[6 * 33], s[7 * 33]);
        *(GAS v4u*)(WT + (size_t)(n0 + n) * K + k0 + 8 * c) = o; }
    LDS_WAIT(); asm volatile("" ::: "memory");
}

__device__ __forceinline__ float silu_f(float x) { return x / (1.f + __expf(-x)); }

__device__ __forceinline__ void phase_prologue(Frame& F, const Args& a) {
    const float* c_in = a.in[1]; const float* cctx = a.in[3]; const float* w_ada = a.in[4]; const float* b_ada = a.in[5];
    float* mod = (float*)(F.ws + WS_MOD);
    if (F.vcu == 0) {
        f32x2* thd = (f32x2*)(F.ws + WS_TAB);
        for (int e = F.tid; e < 64 * 32; e += NWAVES * 64) { const int pos = e >> 5, i = e & 31; float c, s; sincos_acc((float)pos * INV32[i], c, s); thd[e] = (f32x2){c, s}; }
        f32x2* tdh = (f32x2*)(F.ws + WS_TAB + 16384);
        for (int e = F.tid; e < 64 * 16; e += NWAVES * 64) { const int pos = e >> 4, i = e & 15; float c, s; sincos_acc((float)pos * INV16[i], c, s); tdh[e] = (f32x2){c, s}; }
        if (F.tid < 2) { const int l = F.tid; float s1 = 0.f, s2 = 0.f;
            for (int i = 0; i < 64; ++i) { s1 += a.in[14][l * 64 + i] * a.in[15][l * 64 + i]; s2 += a.in[16][l * 64 + i] * a.in[17][l * 64 + i]; }
            const float lam_init = 0.8f - 0.6f * expf(-0.3f * (float)l);
            float* lam = (float*)(F.ws + WS_TAB + 32768); lam[l * 2 + 0] = expf(s1) - expf(s2) + lam_init; lam[l * 2 + 1] = 1.f - lam_init; }
    }
    {
        LAS float* sv = (LAS float*)(F.lds + RING_OFF);
        LAS float* red = (LAS float*)(F.lds + RING_OFF + 49152);
        for (int e = F.tid; e < 3 * DM; e += NWAVES * 64) { const int v = e / DM, k = e % DM; const float x = v < 2 ? c_in[v * DM + k] : cctx[k]; sv[e] = silu_f(x); }
        __syncthreads();
        const int cg = F.lane & 15, kq = F.lane >> 4;
        for (int it = F.vcu; it < 2 * (NADA / 64); it += F.G) {
            const int l = it / (NADA / 64), ch = it % (NADA / 64);
            const float* W = w_ada + (size_t)l * DM * NADA + ch * 64 + cg * 4;
            f32x4 a0 = {0.f, 0.f, 0.f, 0.f}, a1 = a0, a2 = a0;
#pragma unroll 8
            for (int s = 0; s < DM / 32; ++s) { const int k = s * 32 + F.wave * 4 + kq; const f32x4 w = *(const GAS f32x4*)(W + (size_t)k * NADA);
                a0 += w * sv[k]; a1 += w * sv[DM + k]; a2 += w * sv[2 * DM + k]; }
#pragma unroll
            for (int e = 0; e < 4; ++e) { a0[e] += __shfl_xor(a0[e], 16); a0[e] += __shfl_xor(a0[e], 32); a1[e] += __shfl_xor(a1[e], 16); a1[e] += __shfl_xor(a1[e], 32); a2[e] += __shfl_xor(a2[e], 16); a2[e] += __shfl_xor(a2[e], 32); }
            if (kq == 0) {
#pragma unroll
                for (int e = 0; e < 4; ++e) { red[(F.wave * 3 + 0) * 64 + cg * 4 + e] = a0[e]; red[(F.wave * 3 + 1) * 64 + cg * 4 + e] = a1[e]; red[(F.wave * 3 + 2) * 64 + cg * 4 + e] = a2[e]; } }
            __syncthreads();
            if (F.tid < 192) { const int v = F.tid / 64, cidx = F.tid % 64; float s = 0.f;
#pragma unroll
                for (int w = 0; w < 8; ++w) s += red[(w * 3 + v) * 64 + cidx];
                const int col = ch * 64 + cidx; mod[((size_t)l * 3 + v) * NADA + col] = s + b_ada[(size_t)l * NADA + col]; }
            __syncthreads();
        }
    }
    {
        __syncthreads();
        LAS float* scr = (LAS float*)(F.lds + RING_OFF + F.wave * 16384);
        const int gw = F.vcu * NWAVES + F.wave, NGW = F.G * NWAVES;
        constexpr int I_IN = (DM / 64) * (NIN / 32), I_OUT = (DM / 64) * (DM / 32), I_UP = (DM / 64) * (NUP / 32), I_DN = (DFF / 64) * (DM / 32);
        constexpr int PER_L = I_IN + I_OUT + I_UP + I_DN;
        for (int it = gw; it < 2 * PER_L; it += NGW) {
            const int l = it / PER_L; int r = it % PER_L;
            if (r < I_IN) { p0_transpose_item(a.in[10] + (size_t)l * DM * NIN, DM, NIN, (bf16*)(F.ws + WS_WIN + (size_t)l * 72 * MiB), scr, r, F.lane); continue; } r -= I_IN;
            if (r < I_OUT) { p0_transpose_item(a.in[11] + (size_t)l * DM * DM, DM, DM, (bf16*)(F.ws + WS_WOUT + (size_t)l * 32 * MiB), scr, r, F.lane); continue; } r -= I_OUT;
            if (r < I_UP) { p0_transpose_item(a.in[21] + (size_t)l * DM * NUP, DM, NUP, (bf16*)(F.ws + WS_WUP + (size_t)l * 172 * MiB), scr, r, F.lane); continue; } r -= I_UP;
            p0_transpose_item(a.in[23] + (size_t)l * DFF * DM, DFF, DM, (bf16*)(F.ws + WS_WDN + (size_t)l * 86 * MiB), scr, r, F.lane);
        }
    }
}

struct RowRegs { f32x4 v[16]; };
__device__ __forceinline__ float row_sumsq(const RowRegs& r) {
    float s = 0.f;
#pragma unroll
    for (int j = 0; j < 16; ++j) s += (r.v[j].x * r.v[j].x + r.v[j].y * r.v[j].y) + (r.v[j].z * r.v[j].z + r.v[j].w * r.v[j].w);
    return wave_sum(s);
}
__device__ __forceinline__ void row_load_f32(RowRegs& r, const float* p, int lane) {
    const GAS f32x4* q = (const GAS f32x4*)p + lane;
#pragma unroll
    for (int j = 0; j < 16; ++j) r.v[j] = q[64 * j];
}
__device__ __forceinline__ void row_load_bf16(RowRegs& r, const bf16* p, int lane) {
    const GAS v2u* q = (const GAS v2u*)p + lane;
#pragma unroll
    for (int j = 0; j < 16; ++j) { const v2u w = q[64 * j]; r.v[j] = (f32x4){bf_lo(w.x), bf_hi(w.x), bf_lo(w.y), bf_hi(w.y)}; }
}
__device__ __forceinline__ void row_store_f32(const RowRegs& r, float* p, int lane) {
    GAS f32x4* q = (GAS f32x4*)p + lane;
#pragma unroll
    for (int j = 0; j < 16; ++j) q[64 * j] = r.v[j];
}
__device__ __forceinline__ void row_modnorm_store(const RowRegs& x, float rstd, const float* g, const float* sc, const float* sh, bf16* out, int lane) {
    GAS v2u* q = (GAS v2u*)out + lane;
#pragma unroll
    for (int j = 0; j < 16; ++j) { const int c = 4 * lane + 256 * j;
        const f32x4 gv = *(const GAS f32x4*)(g + c), sv = *(const GAS f32x4*)(sc + c), hv = *(const GAS f32x4*)(sh + c);
        const f32x4 y = (x.v[j] * rstd) * gv * (sv + 1.f) + hv;
        v2u w; w.x = pk2(y.x, y.y); w.y = pk2(y.z, y.w); q[64 * j] = w; }
}
__device__ __forceinline__ void row_residual(RowRegs& x, const RowRegs& y, float rstd, const float* g, const float* gate, int lane) {
#pragma unroll
    for (int j = 0; j < 16; ++j) { const int c = 4 * lane + 256 * j;
        const f32x4 gv = *(const GAS f32x4*)(g + c), tv = *(const GAS f32x4*)(gate + c);
        x.v[j] = x.v[j] + tv * ((y.v[j] * rstd) * gv); }
}

__device__ __forceinline__ void phase_r0(Frame& F, const Args& a) {
    const float* mod = (const float*)(F.ws + WS_MOD); float* xs = (float*)(F.ws + WS_XS); bf16* hx = (bf16*)(F.ws + WS_HX);
    const int gw = F.vcu * NWAVES + F.wave, NGW = F.G * NWAVES;
    for (int m = gw; m < MROWS; m += NGW) {
        const int b = m / TPB, t = m % TPB; const bool lat = t < SEQ;
        const float* src = lat ? a.in[0] + ((size_t)b * SEQ + t) * DM : a.in[2] + ((size_t)b * CTXL + (t - SEQ)) * DM;
        RowRegs x; row_load_f32(x, src, F.lane);
        row_store_f32(x, xs + (size_t)m * DM, F.lane);
        const float rstd = 1.f / sqrtf(row_sumsq(x) * (1.f / DM) + EPS);
        const float* mv = mod + (size_t)(0 * 3 + (lat ? b : 2)) * NADA;
        row_modnorm_store(x, rstd, a.in[6]  , mv + DM, mv, hx + (size_t)m * DM, F.lane);
    }
}
__device__ __forceinline__ void phase_r1(Frame& F, const Args& a, int l, bool last) {
    const float* mod = (const float*)(F.ws + WS_MOD); float* xs = (float*)(F.ws + WS_XS); bf16* hx = (bf16*)(F.ws + WS_HX); const bf16* yb = (const bf16*)(F.ws + WS_Y);
    const int gw = F.vcu * NWAVES + F.wave, NGW = F.G * NWAVES;
    for (int m = gw; m < MROWS; m += NGW) {
        const int b = m / TPB, t = m % TPB; const bool lat = t < SEQ;
        if (last && !lat) continue;
        const float* mv = mod + (size_t)(l * 3 + (lat ? b : 2)) * NADA;
        RowRegs x, y; row_load_f32(x, xs + (size_t)m * DM, F.lane); row_load_bf16(y, yb + (size_t)m * DM, F.lane);
        const float rstd_y = 1.f / sqrtf(row_sumsq(y) * (1.f / DM) + EPS);
        row_residual(x, y, rstd_y, a.in[7] + (size_t)l * DM, mv + 2 * DM, F.lane);
        row_store_f32(x, xs + (size_t)m * DM, F.lane);
        const float rstd = 1.f / sqrtf(row_sumsq(x) * (1.f / DM) + EPS);
        row_modnorm_store(x, rstd, a.in[8] + (size_t)l * DM, mv + 4 * DM, mv + 3 * DM, hx + (size_t)m * DM, F.lane);
    }
}
__device__ __forceinline__ void phase_r2(Frame& F, const Args& a, int l, bool last) {
    const float* mod = (const float*)(F.ws + WS_MOD); float* xs = (float*)(F.ws + WS_XS); bf16* hx = (bf16*)(F.ws + WS_HX); const bf16* yb = (const bf16*)(F.ws + WS_Y);
    const int gw = F.vcu * NWAVES + F.wave, NGW = F.G * NWAVES;
    for (int m = gw; m < MROWS; m += NGW) {
        const int b = m / TPB, t = m % TPB; const bool lat = t < SEQ;
        if (last && !lat) continue;
        const float* mv = mod + (size_t)(l * 3 + (lat ? b : 2)) * NADA;
        RowRegs x, y; row_load_f32(x, xs + (size_t)m * DM, F.lane); row_load_bf16(y, yb + (size_t)m * DM, F.lane);
        const float rstd_y = 1.f / sqrtf(row_sumsq(y) * (1.f / DM) + EPS);
        row_residual(x, y, rstd_y, a.in[9] + (size_t)l * DM, mv + 5 * DM, F.lane);
        if (last) { row_store_f32(x, a.out + ((size_t)b * SEQ + t) * DM, F.lane); continue; }
        row_store_f32(x, xs + (size_t)m * DM, F.lane);
        const float rstd = 1.f / sqrtf(row_sumsq(x) * (1.f / DM) + EPS);
        const float* mn = mod + (size_t)((l + 1) * 3 + (lat ? b : 2)) * NADA;
        row_modnorm_store(x, rstd, a.in[6] + (size_t)(l + 1) * DM, mn + DM, mn, hx + (size_t)m * DM, F.lane);
    }
}

__device__ __forceinline__ void phase_qkpost(Frame& F, const Args& a, int l) {
    bf16* P = (bf16*)(F.ws + WS_P);
    const f32x2* thd = (const f32x2*)(F.ws + WS_TAB); const f32x2* tdh = (const f32x2*)(F.ws + WS_TAB + 16384);
    const float* gq = a.in[12] + l * 128; const float* gk = a.in[13] + l * 128;
    const int gw = F.vcu * NWAVES + F.wave, NGW = F.G * NWAVES; const int lane = F.lane;
    const float gq0 = gq[2 * lane], gq1 = gq[2 * lane + 1], gk0 = gk[2 * lane], gk1 = gk[2 * lane + 1];
    for (int m = gw; m < MROWS; m += NGW) {
        const int t = m % TPB; const bool lat = t < SEQ;
        unsigned* row = (unsigned*)(P + (size_t)m * NIN);
        const int grow = (t >> 6) & 63, gcol = t & 63;
        f32x2 cs_hd = {1.f, 0.f}, cs_dh = {1.f, 0.f};
        if (lat) { cs_hd = thd[(lane < 32 ? grow : gcol) * 32 + (lane & 31)]; const int pp = lane & 31; cs_dh = tdh[(pp < 16 ? grow : gcol) * 16 + (pp & 15)]; }
#define QK_CHUNK(colbase, kind) do { unsigned* p = row + ((colbase) >> 1) + lane; const unsigned w = *p; float x0 = bf_lo(w), x1 = bf_hi(w); \
        if ((kind) == 0 || (kind) == 3) { const float ss = wave_sum(x0 * x0 + x1 * x1); const float rstd = 1.f / sqrtf(ss * (1.f / 128.f) + EPS); \
            x0 = x0 * rstd * ((kind) == 0 ? gq0 : gk0); x1 = x1 * rstd * ((kind) == 0 ? gq1 : gk1); } \
        const f32x2 cs = ((kind) == 1) ? cs_dh : cs_hd; const float y0 = x0 * cs.x - x1 * cs.y, y1 = x0 * cs.y + x1 * cs.x; *p = pk2(y0, y1); } while (0)
        if (lat) {
#pragma unroll 4
            for (int h = 0; h < 8; ++h) QK_CHUNK(QA + h * 128, 0);
#pragma unroll 4
            for (int h = 0; h < 8; ++h) QK_CHUNK(QB_ + h * 128, 1);
#pragma unroll 4
            for (int h = 0; h < 8; ++h) QK_CHUNK(QC + h * 128, 2);
#pragma unroll
            for (int h = 0; h < 2; ++h) QK_CHUNK(KA + h * 128, 3);
#pragma unroll 4
            for (int h = 0; h < 8; ++h) QK_CHUNK(KB_ + h * 128, 1);
#pragma unroll
            for (int h = 0; h < 2; ++h) QK_CHUNK(KC + h * 128, 2);
        } else {
#pragma unroll 4
            for (int h = 0; h < 8; ++h) QK_CHUNK(QA + h * 128, 0);
#pragma unroll
            for (int h = 0; h < 2; ++h) QK_CHUNK(KA + h * 128, 3);
        }
#undef QK_CHUNK
    }
}

__device__ __forceinline__ void phase_conv(Frame& F, const Args& a, int l, bool last) {
    const bf16* U = (const bf16*)(F.ws + WS_U); bf16* ACT = (bf16*)(F.ws + WS_ACT);
    const float* cw = a.in[22] + (size_t)l * 3 * NUP;
    const int gw = F.vcu * NWAVES + F.wave, NGW = F.G * NWAVES;
    constexpr int NCS = DFF / 256  , NBAND = MROWS / 32  ;
    for (int it = gw; it < NBAND * NCS; it += NGW) {
        const int band = it / NCS, cs = it % NCS; const int m0 = band * 32; const int t0 = m0 % TPB;
        if (last && t0 >= SEQ) continue;
        const int seq_lo = (t0 < SEQ) ? (m0 - t0) : (m0 - t0 + SEQ), seq_hi = (t0 < SEQ) ? (m0 - t0 + SEQ) : (m0 - t0 + TPB);
        const int col = cs * 256 + 4 * F.lane;
        f32x4 wg[3], wv[3];
#pragma unroll
        for (int j = 0; j < 3; ++j) { wg[j] = *(const GAS f32x4*)(cw + (size_t)j * NUP + col); wv[j] = *(const GAS f32x4*)(cw + (size_t)j * NUP + DFF + col); }
        f32x4 g0, g1, g2, v0, v1, v2;
#define LD_ROW(gm, G_, V_) do { if ((gm) >= seq_lo && (gm) < seq_hi) { const v2u wg_ = *(const GAS v2u*)(U + (size_t)(gm) * NUP + col); const v2u wv_ = *(const GAS v2u*)(U + (size_t)(gm) * NUP + DFF + col); \
            G_ = (f32x4){bf_lo(wg_.x), bf_hi(wg_.x), bf_lo(wg_.y), bf_hi(wg_.y)}; V_ = (f32x4){bf_lo(wv_.x), bf_hi(wv_.x), bf_lo(wv_.y), bf_hi(wv_.y)}; } \
            else { G_ = (f32x4){0.f, 0.f, 0.f, 0.f}; V_ = G_; } } while (0)
        LD_ROW(m0 - 1, g0, v0); LD_ROW(m0, g1, v1);
#pragma unroll 4
        for (int r = 0; r < 32; ++r) { const int m = m0 + r;
            LD_ROW(m + 1, g2, v2);
            const f32x4 gg = g0 * wg[0] + g1 * wg[1] + g2 * wg[2]; const f32x4 vv = v0 * wv[0] + v1 * wv[1] + v2 * wv[2];
            f32x4 o;
#pragma unroll
            for (int e = 0; e < 4; ++e) o[e] = gg[e] / (1.f + __expf(-gg[e])) * vv[e];
            v2u w; w.x = pk2(o.x, o.y); w.y = pk2(o.z, o.w);
            *(GAS v2u*)(ACT + (size_t)m * DFF + col) = w;
            g0 = g1; g1 = g2; v0 = v1; v1 = v2; }
#undef LD_ROW
    }
}

template <int MASK>
__device__ __forceinline__ void attn_std_unit(Frame& F, const bf16* P, bf16* O, int b, int qrow0  , int qcol, int kcol, int vcol, int ocol,
                                              int nloc, int loc0, float sink, bool has_sink) {
    using namespace att;
    int lane_ = F.lane; asm volatile("" : "+v"(lane_));
    int lane = lane_, wid = F.wave, r32 = lane & 31, hi = lane >> 5;
    constexpr float SCALE = 0.088388347648318440f; constexpr float C = SCALE * 1.4426950408889634f;
    const size_t base = (size_t)b * TPB;
    const bf16* Qw = P + (base + qrow0 + wid * 32 + r32) * LDP + qcol + hi * 8;
    f32x16 o[4]; float m_reg, l_reg;
    attn_core<MASK, 0, 8>(o, m_reg, l_reg, Qw, P + base * LDP + kcol, P + base * LDP + vcol, nloc, loc0, qrow0 + wid * 32 + r32, C, 8.f / SCALE, (ALAS char*)F.lds);
    if (has_sink) l_reg += __builtin_amdgcn_exp2f(sink * 1.4426950408889634f - m_reg * C);
    asm volatile("" : "+v"(lane_)); lane = lane_; r32 = lane & 31; hi = lane >> 5;
    ALAS float* li_l = (ALAS float*)((ALAS char*)F.lds + WSCR_OFF) + wid * 64;
    if (hi == 0) li_l[r32] = l_reg; asm volatile("s_waitcnt lgkmcnt(0)" ::: "memory");
    bf16* Ow = O + (base + qrow0 + wid * 32) * LDO + ocol;
#pragma unroll
    for (int r = 0; r < 16; ++r) { const int orow = crow(r, hi); const float rl = __builtin_amdgcn_rcpf(li_l[orow]);
#pragma unroll
        for (int d0 = 0; d0 < 4; ++d0) Ow[(size_t)orow * LDO + d0 * 32 + r32] = (bf16)f2bf(o[d0][r] * rl); }
}
__device__ __forceinline__ void attn_diff_unit(Frame& F, const bf16* P, bf16* O, int b, int qrow0, int h, int nloc, int loc0, float lam, float omli, const float* gsub) {
    using namespace att;
    int lane_ = F.lane; asm volatile("" : "+v"(lane_));
    int lane = lane_, wid = F.wave, r32 = lane & 31, hi = lane >> 5;
    constexpr float SCALE = 0.125f; constexpr float C = SCALE * 1.4426950408889634f;
    const size_t base = (size_t)b * TPB;
    const bf16* Qw = P + (base + qrow0 + wid * 32 + r32) * LDP + QB_ + h * 128 + hi * 8;
    const bf16* Kb = P + base * LDP + KB_ + h * 128; const bf16* Vb = P + base * LDP + VB_ + h * 128;
    ALAS float* li_l = (ALAS float*)((ALAS char*)F.lds + WSCR_OFF) + wid * 64;
    f32x16 o[4]; float m_reg, l_reg;
    attn_core<0, 4, 4>(o, m_reg, l_reg, Qw, Kb, Vb, nloc, loc0, 0, C, 8.f / SCALE, (ALAS char*)F.lds);
    asm volatile("" : "+v"(lane_)); lane = lane_; r32 = lane & 31; hi = lane >> 5;
    if (hi == 0) li_l[r32] = l_reg; asm volatile("s_waitcnt lgkmcnt(0)" ::: "memory");
    { float* stash = (float*)(F.ws + WS_STASH) + ((size_t)blockIdx.x * 8 + wid) * 4096 + lane;
#pragma unroll
    for (int d0 = 0; d0 < 4; ++d0) { float* sp = stash + d0 * 1024; asm volatile("" : "+v"(sp));
#pragma unroll
        for (int r = 0; r < 16; ++r) sp[r * 64] = o[d0][r] * __builtin_amdgcn_rcpf(li_l[crow(r, hi)]); } }
    __syncthreads();
    attn_core<0, 0, 4>(o, m_reg, l_reg, Qw, Kb, Vb, nloc, loc0, 0, C, 8.f / SCALE, (ALAS char*)F.lds);
    asm volatile("" : "+v"(lane_)); lane = lane_; r32 = lane & 31; hi = lane >> 5;
    if (hi == 0) li_l[r32] = l_reg; asm volatile("s_waitcnt lgkmcnt(0)" ::: "memory");
    float* stash = (float*)(F.ws + WS_STASH) + ((size_t)blockIdx.x * 8 + wid) * 4096 + lane;
    float g4[4];
#pragma unroll
    for (int d0 = 0; d0 < 4; ++d0) g4[d0] = gsub[d0 * 32 + r32] * omli;
    bf16* Ow = O + (base + qrow0 + wid * 32) * LDO + QB_ + h * 128;
#pragma unroll
    for (int r = 0; r < 16; ++r) { const int orow = crow(r, hi); const float rl = __builtin_amdgcn_rcpf(li_l[orow]);
        float v[4]; float ss = 0.f;
#pragma unroll
        for (int d0 = 0; d0 < 4; ++d0) { v[d0] = o[d0][r] * rl - lam * stash[(d0 * 16 + r) * 64]; ss += v[d0] * v[d0]; }
        ss += __shfl_xor(ss, 1); ss += __shfl_xor(ss, 2); ss += __shfl_xor(ss, 4); ss += __shfl_xor(ss, 8); ss += __shfl_xor(ss, 16);
        const float rstd = 1.f / sqrtf(ss * (1.f / 128.f) + EPS);
#pragma unroll
        for (int d0 = 0; d0 < 4; ++d0) Ow[(size_t)orow * LDO + d0 * 32 + r32] = (bf16)f2bf(v[d0] * rstd * g4[d0]); }
}

__device__ __forceinline__ void phase_attention(Frame& F, const Args& a, int l, bool last) {
    const bf16* P = (const bf16*)(F.ws + WS_P); bf16* O = (bf16*)(F.ws + WS_O);
    const float* lamv = (const float*)(F.ws + WS_TAB + 32768); const float lam = lamv[l * 2], omli = lamv[l * 2 + 1];
    const float* sinkv = a.in[19] + l * 8; const float* gsub = a.in[18] + l * 128; const float* nab = a.in[20] + (size_t)l * 8 * 15 * 31;
#ifndef ATT_MASK
#define ATT_MASK 15
#endif
    if (ATT_MASK & 1) for (int u = F.vcu; u < (last ? 256 : 272); u += F.G) {
        int b, h, qrow0, nloc;
        if (u < 256) { b = u >> 7; h = (u >> 4) & 7; qrow0 = (u & 15) * 256; nloc = 64; } else { const int e = u - 256; b = e >> 3; h = e & 7; qrow0 = SEQ; nloc = 0; }
        __syncthreads(); attn_diff_unit(F, P, O, b, qrow0, h, nloc, 0, lam, omli, gsub);
    }
    if (ATT_MASK & 2) for (int u = F.vcu; u < (last ? 256 : 304); u += F.G) {
        int b, qrow0, qcol, kcol, vcol, nloc; float sink = 0.f; bool has_sink = false;
        if (u < 256) { const int h = (u >> 4) & 7, qb = u & 15; b = u >> 7; qrow0 = qb * 256; qcol = QA + h * 128; kcol = KA + (h >> 2) * 128; vcol = VA + (h >> 2) * 128; nloc = 64; }
        else { const int e = u - 256, g = e >> 4, h = e & 7; b = (e >> 3) & 1; qrow0 = SEQ; nloc = 0;
            if (g == 0) { qcol = QA + h * 128; kcol = KA + (h >> 2) * 128; vcol = VA + (h >> 2) * 128; }
            else if (g == 1) { qcol = QC + h * 128; kcol = KC + (h >> 2) * 128; vcol = VC + (h >> 2) * 128; sink = sinkv[h]; has_sink = true; }
            else { qcol = QD + h * 128; kcol = KD + h * 128; vcol = VD + h * 128; } }
        __syncthreads(); attn_std_unit<0>(F, P, O, b, qrow0, qcol, kcol, vcol, qcol, nloc, 0, sink, has_sink);
    }
    if (ATT_MASK & 4) for (int u = F.vcu; u < 256; u += F.G) { const int b = u >> 7, h = (u >> 4) & 7, qb = u & 15;
        const int lo = max(qb * 256 - 128, 0), hiK = min(qb * 256 + 384, SEQ);
        __syncthreads(); attn_std_unit<2>(F, P, O, b, qb * 256, QC + h * 128, KC + (h >> 2) * 128, VC + (h >> 2) * 128, QC + h * 128, (hiK - lo) / 64, lo, sinkv[h], true); }
    if (ATT_MASK & 8) for (int u = F.vcu; u < 256; u += F.G) { const int b = u >> 7, h = (u >> 4) & 7, qb = u & 15;
        const int r0 = qb * 4; int rlo, nrow;
        if (r0 == 0) { rlo = 0; nrow = 8; } else if (r0 == 60) { rlo = 56; nrow = 8; } else { rlo = min(r0 - 4, 52); nrow = 12; }
        __syncthreads();
        { LAS float* bl = (LAS float*)(F.lds + att::BIAS_OFF); for (int e = F.tid; e < 15 * 31; e += NWAVES * 64) bl[e] = nab[h * 465 + e] * 11.313708498984761f; }
        attn_std_unit<3>(F, P, O, b, qb * 256, QD + h * 128, KD + h * 128, VD + h * 128, QD + h * 128, nrow, rlo * 64, 0.f, false); }
    __syncthreads();
}

__global__ void __launch_bounds__(NWAVES * 64, 2) fwd_kernel(Args args) {
    extern __shared__ __attribute__((aligned(16))) unsigned char lds[];
    Frame F;
    F.lds = (LAS unsigned char*)lds;
    volatile LAS unsigned* MISC = (volatile LAS unsigned*)(F.lds + MISC_OFF);
    F.tid = threadIdx.x; F.lane = F.tid & 63; F.wave = __builtin_amdgcn_readfirstlane(F.tid >> 6);
    F.G = gridDim.x; { const int bx = blockIdx.x; F.vcu = (F.G % 8 == 0) ? (bx % 8) * (F.G / 8) + bx / 8 : bx; }
    F.ws = args.ws;
    gu32* ctl = (gu32*)(F.ws + WS_CTL);
    for (int u = F.tid; u < (LDS_BYTES - LDSCTL_OFF) / 4; u += NWAVES * 64) ((LAS unsigned*)(F.lds + LDSCTL_OFF))[u] = 0u;
    __syncthreads();
    const int lo = args.ph_lo, hi = args.ph_hi;
    XcdBarrier bar; bar.bar = (unsigned*)(ctl + CW_BAR); bar.x = 0; bar.st = nullptr;
    if (hi - lo > 1) bar = xcd_barrier_post((unsigned*)(ctl + CW_BAR), MISC + 8);
#ifndef PH_MASK
#define PH_MASK 0x7ff
#endif
#define IN(k) (lo <= (k) && (k) < hi)
#define FRESH() asm volatile("" : "+v"(F.tid), "+v"(F.lane))
#define EN(j) (((PH_MASK) >> (j)) & 1)
#define SEAM(k) do { if (IN(k) && IN((k) + 1)) xcd_barrier(bar); } while (0)

    if (EN(0) && IN(0)) { FRESH(); phase_prologue(F, args); } SEAM(0);
    if (EN(1) && IN(1)) { FRESH(); phase_r0(F, args); } SEAM(1);
    for (int l = 0; l < 2; ++l) {
        const bool last = (l == 1); const int pb = 2 + 9 * l;
        const pg8::bf16_t* HX = (const pg8::bf16_t*)(F.ws + WS_HX);
        if (EN(2) && IN(pb + 0)) {
            pg8::Gemm g{HX, (const pg8::bf16_t*)(F.ws + WS_WIN + (size_t)l * 72 * MiB), MROWS, NIN, DM};
            pg8::StaticOrder S; S.init(MROWS / 256, NIN, F.G, (int)blockIdx.x, 0);
            pg8::EpiBf16 E{(pg8::bf16_t*)(F.ws + WS_P), NIN};
            pg8::gemm_phase<pg8::EpiBf16, pg8::StaticOrder, true>(F.lds + RING_OFF, g, S, E);
        } SEAM(pb + 0);
        if (EN(3) && IN(pb + 1)) { FRESH(); phase_qkpost(F, args, l); } SEAM(pb + 1);
        if (EN(4) && IN(pb + 2)) { FRESH(); phase_attention(F, args, l, last); } SEAM(pb + 2);
        if (EN(5) && IN(pb + 3)) {
            pg8::Gemm g{(const pg8::bf16_t*)(F.ws + WS_O), (const pg8::bf16_t*)(F.ws + WS_WOUT + (size_t)l * 32 * MiB), MROWS, DM, DM};
            pg8::StaticOrder S; S.init(last ? 32 : 34, DM, F.G, (int)blockIdx.x, last ? 1 : 0);
            pg8::EpiBf16 E{(pg8::bf16_t*)(F.ws + WS_Y), DM};
            pg8::gemm_phase<pg8::EpiBf16, pg8::StaticOrder, true>(F.lds + RING_OFF, g, S, E);
        } SEAM(pb + 3);
        if (EN(6) && IN(pb + 4)) { FRESH(); phase_r1(F, args, l, last); } SEAM(pb + 4);
        if (EN(7) && IN(pb + 5)) {
            pg8::Gemm g{HX, (const pg8::bf16_t*)(F.ws + WS_WUP + (size_t)l * 172 * MiB), MROWS, NUP, DM};
            pg8::StaticOrder S; S.init(last ? 32 : 34, NUP, F.G, (int)blockIdx.x, last ? 1 : 0);
            pg8::EpiBf16 E{(pg8::bf16_t*)(F.ws + WS_U), NUP};
            pg8::gemm_phase<pg8::EpiBf16, pg8::StaticOrder, true>(F.lds + RING_OFF, g, S, E);
        } SEAM(pb + 5);
        if (EN(8) && IN(pb + 6)) { FRESH(); phase_conv(F, args, l, last); } SEAM(pb + 6);
        if (EN(9) && IN(pb + 7)) {
            pg8::Gemm g{(const pg8::bf16_t*)(F.ws + WS_ACT), (const pg8::bf16_t*)(F.ws + WS_WDN + (size_t)l * 86 * MiB), MROWS, DM, DFF};
            pg8::StaticOrder S; S.init(last ? 32 : 34, DM, F.G, (int)blockIdx.x, last ? 1 : 0);
            pg8::EpiBf16 E{(pg8::bf16_t*)(F.ws + WS_Y), DM};
            pg8::gemm_phase<pg8::EpiBf16, pg8::StaticOrder, true>(F.lds + RING_OFF, g, S, E);
        } SEAM(pb + 7);
        if (EN(10) && IN(pb + 8)) { FRESH(); phase_r2(F, args, l, last); } SEAM(pb + 8);
    }
#undef IN
#undef SEAM
}

extern "C" void kernel_launch(void* const* d_in, const int* in_sizes, int n_in, void* d_out, int out_size, void* d_ws, size_t ws_size, hipStream_t stream) {
    static int grid = 0;
    if (grid == 0) {
        if (n_in != 24 || in_sizes[0] != NB * SEQ * DM || out_size != NB * SEQ * DM || ws_size < WS_END) {
            fprintf(stderr, "kernel_launch: unexpected shapes: n_in %d in0 %d out %d ws %zu (need %zu); nothing launched\n", n_in, n_in > 0 ? in_sizes[0] : -1, out_size, ws_size, (size_t)WS_END); grid = -1; return; }
        int dev = 0, cus = 0, per_cu = 0;
        if (hipGetDevice(&dev) != hipSuccess || hipDeviceGetAttribute(&cus, hipDeviceAttributeMultiprocessorCount, dev) != hipSuccess) { grid = -1; return; }
        if (hipFuncSetAttribute((const void*)fwd_kernel, hipFuncAttributeMaxDynamicSharedMemorySize, LDS_BYTES) != hipSuccess) { fprintf(stderr, "kernel_launch: hipFuncSetAttribute failed\n"); grid = -1; return; }
        if (hipOccupancyMaxActiveBlocksPerMultiprocessor(&per_cu, (const void*)fwd_kernel, NWAVES * 64, LDS_BYTES) != hipSuccess || per_cu < 1)
            fprintf(stderr, "kernel_launch: note: occupancy query reports %d workgroups per CU\n", per_cu);
        (void)hipGetLastError();
        grid = cus;
    }
    if (grid < 0) return;
    if (hipMemsetAsync((char*)d_ws + WS_CTL, 0, CTL_ZERO_BYTES, stream) != hipSuccess) return;
    Args a{};
    for (int i = 0; i < 24; ++i) a.in[i] = (const float*)d_in[i];
    a.out = (float*)d_out; a.ws = (unsigned char*)d_ws;
#if MK_SINGLE
    a.ph_lo = 0; a.ph_hi = NPHASE;
    hipLaunchKernelGGL(fwd_kernel, dim3(grid), dim3(NWAVES * 64), LDS_BYTES, stream, a);
#else
    for (int p = 0; p < NPHASE; ++p) { a.ph_lo = p; a.ph_hi = p + 1; hipLaunchKernelGGL(fwd_kernel, dim3(grid), dim3(NWAVES * 64), LDS_BYTES, stream, a); }
#endif
    const hipError_t le = hipPeekAtLastError();
    if (le != hipSuccess) fprintf(stderr, "kernel_launch: launch failed: %s\n", hipGetErrorName(le));
}
```

```cpp
#include <hip/hip_runtime.h>
#include <cstdio>
#include <cstdint>

#ifndef MK_SINGLE
#define MK_SINGLE 1
#endif

namespace pg8 {
#define PG8_LAS __attribute__((address_space(3)))
typedef unsigned short bf16_t;
typedef short bf16x8 __attribute__((ext_vector_type(8)));
typedef float f32x4 __attribute__((ext_vector_type(4)));
typedef unsigned u32x4 __attribute__((ext_vector_type(4)));
constexpr int BM = 256, BK = 64, HALF = 128, HTB = HALF * BK * 2, STAGE_BYTES = 8 * HTB, NXCD = 8, WGM = 8;

__host__ __device__ __forceinline__ int lds_byte(int r, int c) { const int st = (r >> 4) * 2 + (c >> 5), rr = r & 15, cc = c & 31, ob = rr * 64 + cc * 2; return st * 1024 + (ob ^ (((ob >> 9) & 1) << 5)); }
__host__ __device__ __forceinline__ void stage_rc(int b, int& R, int& C) { const int st = b / 1024, sb = b % 1024, swz = sb ^ (((sb >> 9) & 1) << 5); R = (st >> 1) * 16 + swz / 64; C = (st & 1) * 32 + (swz % 64) / 2; }
__host__ __device__ __forceinline__ int perm32(int rho) { const int n = rho >> 4, i = rho & 15; return 8 * (i >> 2) + 4 * n + (i & 3); }

struct Unit { int pm, pn; };
struct Gemm { const bf16_t* A; const bf16_t* Bt; int M, N, K; };

struct StaticOrder {
    int nM, nN, nwg, G, c, skip;
    __host__ __device__ void init(int nM_, int N, int G_, int c_, int skip_) { nM = nM_; nN = N / BM; nwg = nM * nN; G = G_; c = c_; skip = skip_; }
    __host__ __device__ bool next(int i, Unit& u) const {
        const long L = (long)i * G + c; if (L >= nwg) return false;
        int wgid = (int)L; { const int q = nwg / NXCD, r = nwg % NXCD, xcd = wgid % NXCD, off = wgid / NXCD; wgid = (xcd < r ? xcd * (q + 1) : r * (q + 1) + (xcd - r) * q) + off; }
        const int nig = WGM * nN, gid = wgid / nig, fm = gid * WGM, gsz = (nM - fm) < WGM ? (nM - fm) : WGM;
        u.pm = fm + ((wgid % nig) % gsz); u.pn = (wgid % nig) / gsz;
        if (skip && u.pm >= 16) u.pm += 1;
        return true;
    }
    __device__ __forceinline__ void a_ready(const Unit&) const {}
    __device__ __forceinline__ void done(const Unit&) const {}
};

__device__ __forceinline__ unsigned cvt_pk_bf16(float lo, float hi) { unsigned r; asm volatile("v_cvt_pk_bf16_f32 %0, %1, %2" : "=v"(r) : "v"(lo), "v"(hi)); return r; }

struct EpiBf16 {
    static constexpr bool PERM = true, AFTER_DRAIN = false;
    bf16_t* O; int ldc;
    __device__ __forceinline__ void operator()(const f32x4 (&acc)[2][2][4][2], const Unit& u, int wr, int wc, int fr, int fq) const {
        const int row0 = u.pm * BM + wr * 64 + fr; const int col0 = u.pn * BM + wc * 32 + 8 * fq;
#pragma unroll
        for (int ai = 0; ai < 2; ++ai)
#pragma unroll
            for (int m = 0; m < 4; ++m) { bf16_t* rowp = O + (size_t)(row0 + ai * HALF + m * 16) * ldc + col0;
#pragma unroll
                for (int bj = 0; bj < 2; ++bj) { const f32x4 v0 = acc[ai][bj][m][0], v1 = acc[ai][bj][m][1];
                    u32x4 w; w.x = cvt_pk_bf16(v0[0], v0[1]); w.y = cvt_pk_bf16(v0[2], v0[3]); w.z = cvt_pk_bf16(v1[0], v1[1]); w.w = cvt_pk_bf16(v1[2], v1[3]);
                    *(u32x4*)(rowp + bj * HALF) = w; } }
    }
};

template <class Epi, class Sched, bool ALIGN_EPI = false>
__device__ __forceinline__ void gemm_phase(PG8_LAS unsigned char* lds, const Gemm g, const Sched& S, const Epi& E) {
    int tid_ = threadIdx.x; asm volatile("" : "+v"(tid_));
    const int tid = tid_, wid = __builtin_amdgcn_readfirstlane(tid >> 6), lane = tid & 63, wr = wid >> 2, wc = wid & 3, fr = lane & 15, fq = lane >> 4;
    const int K = g.K, nt = K / BK;
    unsigned voffA[2], voffB[2];
#pragma unroll
    for (int i = 0; i < 2; ++i) { int R, C; stage_rc(tid * 16 + i * 8192, R, C); const int Rb = Epi::PERM ? ((R & ~31) + perm32(R & 31)) : R;
        voffA[i] = (unsigned)(R * K + C) * 2u; voffB[i] = (unsigned)(Rb * K + C) * 2u; }
    const size_t kstep = (size_t)(BK * 2);
    const size_t hstep = (size_t)HALF * K * 2;
    const size_t tstep = 2 * hstep;
    const unsigned ldsw = (unsigned)wid * 1024u;
    const int aoff = lds_byte(wr * 64 + fr, fq * 8), boff = lds_byte(wc * 32 + fr, fq * 8);
#define PG8_SA(b, h) (((b) * 2 + (h)) * HTB)
#define PG8_SB(b, h) ((4 + (b) * 2 + (h)) * HTB)
#define PG8_STAGE(bufoff, gbase, voff) do { _Pragma("unroll") for (int _i = 0; _i < 2; ++_i) \
        __builtin_amdgcn_global_load_lds((const unsigned*)((const char*)(gbase) + (voff)[_i]), (PG8_LAS unsigned*)(lds + (bufoff) + ldsw + _i * 8192), 16, 0, 0); } while (0)
#define PG8_LDA(dst, b, h) do { _Pragma("unroll") for (int m = 0; m < 4; ++m) _Pragma("unroll") for (int k = 0; k < 2; ++k) dst[m][k] = *(const PG8_LAS bf16x8*)(lds + PG8_SA(b, h) + aoff + m * 2048 + k * 1024); } while (0)
#define PG8_LDB(dst, b, h) do { _Pragma("unroll") for (int n = 0; n < 2; ++n) _Pragma("unroll") for (int k = 0; k < 2; ++k) dst[n][k] = *(const PG8_LAS bf16x8*)(lds + PG8_SB(b, h) + boff + n * 2048 + k * 1024); } while (0)
#define PG8_MMA(ai, bj, At, Bt) do { __builtin_amdgcn_s_setprio(1); _Pragma("unroll") for (int m = 0; m < 4; ++m) _Pragma("unroll") for (int n = 0; n < 2; ++n) _Pragma("unroll") for (int k = 0; k < 2; ++k) \
        acc[ai][bj][m][n] = __builtin_amdgcn_mfma_f32_16x16x32_bf16(Bt[n][k], At[m][k], acc[ai][bj][m][n], 0, 0, 0); __builtin_amdgcn_s_setprio(0); } while (0)
#define PG8_WAIT_V(n) asm volatile("s_waitcnt vmcnt(" #n ")" ::: "memory")
#define PG8_WAIT_L(n) asm volatile("s_waitcnt lgkmcnt(" #n ")" ::: "memory")
#define PG8_BAR __builtin_amdgcn_s_barrier()
#define PG8_SCHED __builtin_amdgcn_sched_barrier(0)
    Unit cur, nxt; int ui = 0;
    if (!S.next(0, cur)) return;
    f32x4 acc[2][2][4][2];
#pragma unroll
    for (int a = 0; a < 2; ++a)
#pragma unroll
        for (int b = 0; b < 2; ++b)
#pragma unroll
            for (int m = 0; m < 4; ++m)
#pragma unroll
                for (int n = 0; n < 2; ++n) acc[a][b][m][n] = (f32x4){0.f, 0.f, 0.f, 0.f};
    bf16x8 At[4][2], B0[2][2], B1[2][2];
    const char* cA = (const char*)g.A + (size_t)cur.pm * tstep; const char* cB = (const char*)g.Bt + (size_t)cur.pn * tstep;
    S.a_ready(cur);
    PG8_STAGE(PG8_SB(0, 0), cB, voffB); PG8_STAGE(PG8_SB(0, 1), cB + hstep, voffB); PG8_STAGE(PG8_SA(0, 0), cA, voffA); PG8_STAGE(PG8_SA(0, 1), cA + hstep, voffA);
    if (wr == 1) PG8_BAR;
    PG8_WAIT_V(2); PG8_BAR;
    PG8_STAGE(PG8_SB(1, 0), cB + kstep, voffB); PG8_STAGE(PG8_SA(1, 0), cA + kstep, voffA); PG8_STAGE(PG8_SB(1, 1), cB + hstep + kstep, voffB);
    PG8_WAIT_V(6); PG8_BAR;
    for (;;) {
        const bool has_next = S.next(ui + 1, nxt);
        const char* nA = has_next ? (const char*)g.A + (size_t)nxt.pm * tstep : cA; const char* nB = has_next ? (const char*)g.Bt + (size_t)nxt.pn * tstep : cB;
        for (int t = 0; t < nt; t += 2) {
            const bool last = (t == nt - 2);
            const char* a1 = cA + (size_t)(t + 1) * kstep;
            const char* a2 = last ? nA : cA + (size_t)(t + 2) * kstep; const char* b2 = last ? nB : cB + (size_t)(t + 2) * kstep;
            const char* a3 = a2 + kstep; const char* b3 = b2 + kstep;
            if (last && has_next) S.a_ready(nxt);
            PG8_LDB(B0, 0, 0); PG8_LDB(B1, 0, 1); PG8_SCHED; PG8_LDA(At, 0, 0); PG8_STAGE(PG8_SA(1, 1), a1 + hstep, voffA);
            PG8_WAIT_V(8); PG8_WAIT_L(0); PG8_BAR; PG8_MMA(0, 0, At, B0); PG8_MMA(0, 1, At, B1); PG8_BAR; PG8_SCHED;
            PG8_LDA(At, 0, 1); PG8_STAGE(PG8_SB(0, 0), b2, voffB); PG8_STAGE(PG8_SB(0, 1), b2 + hstep, voffB); PG8_STAGE(PG8_SA(0, 0), a2, voffA);
            PG8_WAIT_V(8); PG8_WAIT_L(0); PG8_BAR; PG8_MMA(1, 0, At, B0); PG8_MMA(1, 1, At, B1); PG8_BAR; PG8_SCHED;
            PG8_LDB(B0, 1, 0); PG8_LDB(B1, 1, 1); PG8_SCHED; PG8_LDA(At, 1, 0); PG8_STAGE(PG8_SA(0, 1), a2 + hstep, voffA);
            PG8_WAIT_V(8); PG8_WAIT_L(0); PG8_BAR; PG8_MMA(0, 0, At, B0); PG8_MMA(0, 1, At, B1); PG8_BAR; PG8_SCHED;
            PG8_LDA(At, 1, 1); PG8_STAGE(PG8_SB(1, 0), b3, voffB); PG8_STAGE(PG8_SB(1, 1), b3 + hstep, voffB); PG8_STAGE(PG8_SA(1, 0), a3, voffA);
            PG8_WAIT_V(8); PG8_WAIT_L(0); PG8_BAR; PG8_MMA(1, 0, At, B0); PG8_MMA(1, 1, At, B1); PG8_BAR; PG8_SCHED;
        }
        if constexpr (ALIGN_EPI) { if (wr == 0) PG8_BAR; }
        if constexpr (!Epi::AFTER_DRAIN) { E(acc, cur, wr, wc, fr, fq); S.done(cur); }
        if (!has_next) break;
#pragma unroll
        for (int a = 0; a < 2; ++a)
#pragma unroll
            for (int b = 0; b < 2; ++b)
#pragma unroll
                for (int m = 0; m < 4; ++m)
#pragma unroll
                    for (int n = 0; n < 2; ++n) acc[a][b][m][n] = (f32x4){0.f, 0.f, 0.f, 0.f};
        cur = nxt; cA = nA; cB = nB; ++ui;
        if constexpr (ALIGN_EPI) { if (wr == 1) PG8_BAR; }
    }
    PG8_WAIT_V(0);
    if constexpr (!ALIGN_EPI) { if (wr == 0) PG8_BAR; }
    PG8_BAR;
#undef PG8_SA
#undef PG8_SB
#undef PG8_STAGE
#undef PG8_LDA
#undef PG8_LDB
#undef PG8_MMA
#undef PG8_WAIT_V
#undef PG8_WAIT_L
#undef PG8_BAR
#undef PG8_SCHED
}
}

namespace att {
#define ALAS __attribute__((address_space(3)))
typedef unsigned short bf16;
typedef short bf16x8 __attribute__((ext_vector_type(8)));
typedef short s16x4 __attribute__((ext_vector_type(4)));
typedef float f32x16 __attribute__((ext_vector_type(16)));
typedef unsigned u32x4 __attribute__((ext_vector_type(4)));
constexpr int LDP = 9216, LDO = 4096;
constexpr int SLOT = 32768;
constexpr int WSCR_OFF = 131072 + 1024, BIAS_OFF = WSCR_OFF + 2048, SHM_END = BIAS_OFF + 2048;
constexpr int NCTX_T = 4;
#define KSWZ(row, colB) ((row) * 256 + ((colB) ^ (((row) & 7) << 4)))
#define SBAR() __builtin_amdgcn_sched_barrier(0)
__device__ __forceinline__ int crow(int r, int hi) { return (r & 3) + 8 * (r >> 2) + 4 * hi; }
__device__ __forceinline__ unsigned cvtpk(float lo, float hi) { unsigned r; asm volatile("v_cvt_pk_bf16_f32 %0, %1, %2" : "=v"(r) : "v"(lo), "v"(hi)); return r; }

__device__ __forceinline__ void partialSM(f32x16& p0, f32x16& p1, float& m_reg, float& mn, float& alpha, const float C, const float thr_raw) {
    float pmax = p0[0];
#pragma unroll
    for (int r = 1; r < 16; ++r) pmax = fmaxf(pmax, p0[r]);
#pragma unroll
    for (int r = 0; r < 16; ++r) pmax = fmaxf(pmax, p1[r]);
    { auto rr = __builtin_amdgcn_permlane32_swap(__float_as_uint(pmax), __float_as_uint(pmax), false, false);
      pmax = fmaxf(__uint_as_float(rr[0]), __uint_as_float(rr[1])); }
    if (__builtin_expect(__all(pmax - m_reg <= thr_raw), 1)) { mn = m_reg; alpha = 1.f; }
    else { mn = fmaxf(m_reg, pmax); alpha = __builtin_amdgcn_exp2f((m_reg - mn) * C); m_reg = mn; }
    const float mnC = -mn * C;
#pragma unroll
    for (int r = 0; r < 16; ++r) p0[r] = fmaf(p0[r], C, mnC);
#pragma unroll
    for (int r = 0; r < 16; ++r) p1[r] = fmaf(p1[r], C, mnC);
#pragma unroll
    for (int r = 0; r < 16; ++r) p0[r] = __builtin_amdgcn_exp2f(p0[r]);
}
__device__ __forceinline__ void finishSM(f32x16& p0, f32x16& p1, float alpha, float& l_reg, bf16x8& pa0, bf16x8& pa1, bf16x8& pa2, bf16x8& pa3) {
#pragma unroll
    for (int r = 0; r < 16; ++r) p1[r] = __builtin_amdgcn_exp2f(p1[r]);
    float ps = 0;
#pragma unroll
    for (int r = 0; r < 16; ++r) ps += p0[r];
#pragma unroll
    for (int r = 0; r < 16; ++r) ps += p1[r];
    { auto rr = __builtin_amdgcn_permlane32_swap(__float_as_uint(ps), __float_as_uint(ps), false, false);
      ps = __uint_as_float(rr[0]) + __uint_as_float(rr[1]); }
    l_reg = l_reg * alpha + ps;
#define PK4(P, BASE, OUT) do { unsigned a0 = cvtpk(P[BASE + 0], P[BASE + 1]), a1 = cvtpk(P[BASE + 2], P[BASE + 3]);   \
    unsigned b0 = cvtpk(P[BASE + 4], P[BASE + 5]), b1 = cvtpk(P[BASE + 6], P[BASE + 7]);                              \
    auto r0 = __builtin_amdgcn_permlane32_swap(a0, b0, false, false); auto r1 = __builtin_amdgcn_permlane32_swap(a1, b1, false, false); \
    u32x4 w = {r0[0], r1[0], r0[1], r1[1]}; OUT = __builtin_bit_cast(bf16x8, w); } while (0)
    PK4(p0, 0, pa0); PK4(p0, 8, pa1); PK4(p1, 0, pa2); PK4(p1, 8, pa3);
#undef PK4
}
template <int D0LO, int D0N>
__device__ __forceinline__ void qkt(f32x16& p0, f32x16& p1, const ALAS char* Ks, const bf16x8* qr, int r32, int hi) {
    p0 = f32x16{}; p1 = f32x16{};
#pragma unroll
    for (int d0 = D0LO; d0 < D0LO + D0N; ++d0) { const int cb = (d0 * 16 + hi * 8) * 2;
        const bf16x8 b0 = *(const ALAS bf16x8*)(Ks + KSWZ(r32, cb));
        const bf16x8 b1 = *(const ALAS bf16x8*)(Ks + KSWZ(32 + r32, cb));
        p0 = __builtin_amdgcn_mfma_f32_32x32x16_bf16(b0, qr[d0], p0, 0, 0, 0);
        p1 = __builtin_amdgcn_mfma_f32_32x32x16_bf16(b1, qr[d0], p1, 0, 0, 0); }
}
__device__ __forceinline__ int v_st(int k, int c) { const int kk = (k & ~0xC) | ((k & 4) << 1) | ((k & 8) >> 1); return ((kk >> 3) * 4 + (c >> 5)) * 512 + ((kk & 7) * 32 + (c & 31)) * 2; }
__device__ __forceinline__ int v_rd_base(int lane) { return ((lane & 3) << 3) | (((lane >> 2) & 3) << 6) | (((lane >> 4) & 1) << 5) | (((lane >> 5) & 1) << 8); }
constexpr int v_rd_off(int d0, int ks, int half) { return d0 * 512 + ks * 4096 + half * 2048; }
template <int OFF> __device__ __forceinline__ s16x4 tr_read(int vb) {
    s16x4 r; asm volatile("ds_read_b64_tr_b16 %0, %1 offset:%2" : "=&v"(r) : "v"(vb), "i"(OFF) : "memory"); return r;
}
template <int D0> __device__ __forceinline__ void pv_one(f32x16& od, int vb, bf16x8 pa0, bf16x8 pa1, bf16x8 pa2, bf16x8 pa3) {
    const s16x4 l0 = tr_read<v_rd_off(D0, 0, 0)>(vb), h0 = tr_read<v_rd_off(D0, 0, 1)>(vb), l1 = tr_read<v_rd_off(D0, 1, 0)>(vb), h1 = tr_read<v_rd_off(D0, 1, 1)>(vb);
    const s16x4 l2 = tr_read<v_rd_off(D0, 2, 0)>(vb), h2 = tr_read<v_rd_off(D0, 2, 1)>(vb), l3 = tr_read<v_rd_off(D0, 3, 0)>(vb), h3 = tr_read<v_rd_off(D0, 3, 1)>(vb);
    asm volatile("s_waitcnt lgkmcnt(0)" ::: "memory"); SBAR();
#define PK(L, H) (bf16x8){L[0], L[1], L[2], L[3], H[0], H[1], H[2], H[3]}
    od = __builtin_amdgcn_mfma_f32_32x32x16_bf16(pa0, PK(l0, h0), od, 0, 0, 0);
    od = __builtin_amdgcn_mfma_f32_32x32x16_bf16(pa1, PK(l1, h1), od, 0, 0, 0);
    od = __builtin_amdgcn_mfma_f32_32x32x16_bf16(pa2, PK(l2, h2), od, 0, 0, 0);
    od = __builtin_amdgcn_mfma_f32_32x32x16_bf16(pa3, PK(l3, h3), od, 0, 0, 0);
#undef PK
}
__device__ __forceinline__ void pv_d0(f32x16* o, int vb, bf16x8 pa0, bf16x8 pa1, bf16x8 pa2, bf16x8 pa3) {
    pv_one<0>(o[0], vb, pa0, pa1, pa2, pa3); pv_one<1>(o[1], vb, pa0, pa1, pa2, pa3); pv_one<2>(o[2], vb, pa0, pa1, pa2, pa3); pv_one<3>(o[3], vb, pa0, pa1, pa2, pa3);
}

template <int MASK>
__device__ __forceinline__ void apply_mask(f32x16& p0, f32x16& p1, int j, int loc0, int qp, int hi, const ALAS float* bias) {
    if constexpr (MASK == 2) {
        if (j >= NCTX_T) { const int kbase = loc0 + 64 * (j - NCTX_T);
#pragma unroll
            for (int r = 0; r < 16; ++r) { const int d0 = qp - (kbase + crow(r, hi)); const int d1 = d0 - 32;
                if (d0 > 128 || d0 < -128) p0[r] = -1e30f;
                if (d1 > 128 || d1 < -128) p1[r] = -1e30f; } }
    } else if constexpr (MASK == 3) {
        if (j >= NCTX_T) { const int kbase = loc0 + 64 * (j - NCTX_T);
            const int qrow = qp >> 6, qcol = qp & 63; const int rs = min(max(qrow - 4, 0), 56), cs = min(max(qcol - 8, 0), 48);
            const int kr = kbase >> 6; const int dr = kr - rs;
            if (dr < 0 || dr >= 8) {
#pragma unroll
                for (int r = 0; r < 16; ++r) { p0[r] = -1e30f; p1[r] = -1e30f; }
            } else {
                const ALAS float* brow = bias + (kr - qrow + 7) * 31 + 15 - qcol;
#pragma unroll
                for (int r = 0; r < 16; ++r) { const int kc0 = crow(r, hi), kc1 = kc0 + 32;
                    const bool ok0 = (unsigned)(kc0 - cs) < 16u, ok1 = (unsigned)(kc1 - cs) < 16u;
                    const float b0 = brow[ok0 ? kc0 : qcol], b1 = brow[ok1 ? kc1 : qcol];
                    p0[r] = ok0 ? p0[r] + b0 : -1e30f; p1[r] = ok1 ? p1[r] + b1 : -1e30f; }
            }
        }
    }
}

template <int MASK, int D0LO, int D0N>
__device__ __forceinline__ void attn_core(f32x16 (&o)[4], float& m_reg, float& l_reg, const bf16* __restrict__ Qw, const bf16* __restrict__ Kb, const bf16* __restrict__ Vb,
                                          const int nloc, const int loc0, const int qp, const float C, const float thr_raw, ALAS char* lds) {
    int tid_ = threadIdx.x; asm volatile("" : "+v"(tid_));
    const int tid = tid_, wid = __builtin_amdgcn_readfirstlane(tid >> 6), lane = tid & 63, r32 = lane & 31, hi = lane >> 5;
    ALAS float* ws = (ALAS float*)(lds + WSCR_OFF) + wid * 64; ALAS float* al_l = ws + 32;
    const ALAS float* bias = (const ALAS float*)(lds + BIAS_OFF);
    unsigned voffK[2], voffV[2];
#pragma unroll
    for (int i = 0; i < 2; ++i) { const int q = (wid + 8 * i) * 64 + lane;
        { const int row = q >> 4, cc = (q & 15) ^ (row & 7); voffK[i] = (unsigned)(row * (LDP * 2) + cc * 16); }
        { const int kk = (q >> 7) * 8 + ((q & 31) >> 2), c = ((q >> 5) & 3) * 32 + (q & 3) * 8; const int k = (kk & ~0xC) | ((kk & 4) << 1) | ((kk & 8) >> 1); voffV[i] = (unsigned)(k * (LDP * 2) + c * 2); } }
    const int NT = NCTX_T + nloc;
#define KOFF(j) ((j) < NCTX_T ? 4096 + 64 * (j) : loc0 + 64 * ((j) - NCTX_T))
#define ISSUE(j) do { const size_t _ro = (size_t)KOFF(j) * (LDP * 2); const char* _gk = (const char*)Kb + _ro; const char* _gv = (const char*)Vb + _ro; ALAS char* _sl = lds + ((j) & 3) * SLOT + wid * 1024; \
    _Pragma("unroll") for (int _i = 0; _i < 2; ++_i) __builtin_amdgcn_global_load_lds((const unsigned*)(_gk + voffK[_i]), (ALAS unsigned*)(_sl + _i * 8192), 16, 0, 0); \
    _Pragma("unroll") for (int _i = 0; _i < 2; ++_i) __builtin_amdgcn_global_load_lds((const unsigned*)(_gv + voffV[_i]), (ALAS unsigned*)(_sl + 16384 + _i * 8192), 16, 0, 0); } while (0)
#define WAITBAR(n) do { asm volatile("s_waitcnt vmcnt(" #n ") lgkmcnt(0)" ::: "memory"); __builtin_amdgcn_s_barrier(); asm volatile("" ::: "memory"); } while (0)
#define RESC(a) do { if (__any((a) < 1.f)) { if (hi == 0) al_l[r32] = (a); asm volatile("s_waitcnt lgkmcnt(0)" ::: "memory"); \
    _Pragma("unroll") for (int d = 0; d < 4; ++d) _Pragma("unroll") for (int r = 0; r < 16; ++r) o[d][r] *= al_l[crow(r, hi)]; } } while (0)
    asm volatile("s_waitcnt vmcnt(0)" ::: "memory");
    m_reg = -1e30f; l_reg = 0.f;
#pragma unroll
    for (int d = 0; d < 4; ++d) o[d] = f32x16{};
    bf16x8 qr[8];
#pragma unroll
    for (int d0 = 0; d0 < 8; ++d0) qr[d0] = *(const bf16x8*)(Qw + d0 * 16);
    ISSUE(0); ISSUE(1); ISSUE(2);
    const int vb0 = (int)(uintptr_t)lds + 16384 + v_rd_base(lane);
    f32x16 pA0, pA1, pB0, pB1; float mnA, mnB, alA, alB; bf16x8 pa0, pa1, pa2, pa3;
    WAITBAR(8);
    qkt<D0LO, D0N>(pA0, pA1, lds, qr, r32, hi); apply_mask<MASK>(pA0, pA1, 0, loc0, qp, hi, bias); partialSM(pA0, pA1, m_reg, mnA, alA, C, thr_raw);
    WAITBAR(4);
    ISSUE(3);
    for (int j = 1; j + 1 < NT; j += 2) {
        SBAR(); qkt<D0LO, D0N>(pB0, pB1, lds + (j & 3) * SLOT, qr, r32, hi);
        finishSM(pA0, pA1, alA, l_reg, pa0, pa1, pa2, pa3); SBAR();
        pv_d0(o, vb0 + ((j - 1) & 3) * SLOT, pa0, pa1, pa2, pa3); apply_mask<MASK>(pB0, pB1, j, loc0, qp, hi, bias); partialSM(pB0, pB1, m_reg, mnB, alB, C, thr_raw);
        if (j + 2 < NT) { WAITBAR(4); } else { WAITBAR(0); }
        if (j + 3 < NT) ISSUE(j + 3);
        RESC(alB);
        SBAR(); qkt<D0LO, D0N>(pA0, pA1, lds + ((j + 1) & 3) * SLOT, qr, r32, hi);
        finishSM(pB0, pB1, alB, l_reg, pa0, pa1, pa2, pa3); SBAR();
        pv_d0(o, vb0 + (j & 3) * SLOT, pa0, pa1, pa2, pa3); apply_mask<MASK>(pA0, pA1, j + 1, loc0, qp, hi, bias); partialSM(pA0, pA1, m_reg, mnA, alA, C, thr_raw);
        if (j + 3 < NT) { WAITBAR(4); } else { WAITBAR(0); }
        if (j + 4 < NT) ISSUE(j + 4);
        RESC(alA);
    }
    SBAR(); qkt<D0LO, D0N>(pB0, pB1, lds + ((NT - 1) & 3) * SLOT, qr, r32, hi);
    finishSM(pA0, pA1, alA, l_reg, pa0, pa1, pa2, pa3); SBAR();
    pv_d0(o, vb0 + ((NT - 2) & 3) * SLOT, pa0, pa1, pa2, pa3); apply_mask<MASK>(pB0, pB1, NT - 1, loc0, qp, hi, bias); partialSM(pB0, pB1, m_reg, mnB, alB, C, thr_raw);
    RESC(alB);
    finishSM(pB0, pB1, alB, l_reg, pa0, pa1, pa2, pa3); SBAR();
    pv_d0(o, vb0 + ((NT - 1) & 3) * SLOT, pa0, pa1, pa2, pa3);
#undef KOFF
#undef ISSUE
#undef WAITBAR
#undef RESC
}
}

constexpr int NWAVES = 8;
constexpr int DM = 4096, NB = 2, SEQ = 4096, CTXL = 256, TPB = SEQ + CTXL  , MROWS = NB * TPB  ;
constexpr int NIN = 9216, DFF = 11008, NUP = 2 * DFF, NADA = 6 * DM;
constexpr int QA = 0, QB_ = 1024, QC = 2048, QD = 3072, KA = 4096, VA = 4352, KB_ = 4608, VB_ = 5632, KC = 6656, VC = 6912, KD = 7168, VD = 8192;
constexpr float EPS = 1e-6f;
constexpr int NPHASE = 20;

constexpr size_t MiB = 1u << 20;
constexpr size_t WS_CTL = 0, CTL_ZERO_BYTES = 1 * MiB;
constexpr size_t WS_MOD = 1 * MiB;
constexpr size_t WS_TAB = 2 * MiB;
constexpr size_t WS_WIN = 4 * MiB;
constexpr size_t WS_WOUT = WS_WIN + 2 * 72 * MiB;
constexpr size_t WS_WUP = WS_WOUT + 2 * 32 * MiB;
constexpr size_t WS_WDN = WS_WUP + 2 * 172 * MiB;
constexpr size_t WS_XS = WS_WDN + 2 * 86 * MiB;
constexpr size_t WS_HX = WS_XS + 136 * MiB;
constexpr size_t WS_P = WS_HX + 68 * MiB;
constexpr size_t WS_O = WS_P + 153 * MiB;
constexpr size_t WS_Y = WS_O + 68 * MiB;
constexpr size_t WS_U = WS_Y + 68 * MiB;
constexpr size_t WS_ACT = WS_U + 366 * MiB;
constexpr size_t WS_STASH = WS_ACT + 183 * MiB;
constexpr size_t WS_END = WS_STASH + 32 * MiB;
static_assert((size_t)MROWS * NUP * 2 <= 366 * MiB && (size_t)MROWS * DFF * 2 <= 183 * MiB && (size_t)MROWS * NIN * 2 <= 153 * MiB, "ws map");
constexpr int CW_BAR = 4096;

constexpr int RING_OFF = 0, RING_BYTES = 131072;
constexpr int LDSCTL_OFF = RING_BYTES, MISC_OFF = LDSCTL_OFF + 320;
constexpr int LDS_BYTES = 147456;
static_assert(att::SHM_END <= LDS_BYTES && att::WSCR_OFF >= MISC_OFF + 128, "attention LDS map");

#define GAS __attribute__((address_space(1)))
#define LAS __attribute__((address_space(3)))
typedef unsigned short bf16;
typedef unsigned v4u __attribute__((ext_vector_type(4)));
typedef unsigned v2u __attribute__((ext_vector_type(2)));
typedef float f32x4 __attribute__((ext_vector_type(4)));
typedef float f32x2 __attribute__((ext_vector_type(2)));
typedef GAS unsigned gu32;
#define RLX_AGENT __ATOMIC_RELAXED, __HIP_MEMORY_SCOPE_AGENT
#define LDS_WAIT() asm volatile("s_waitcnt lgkmcnt(0)" ::: "memory")
#define VM_WAIT() asm volatile("s_waitcnt vmcnt(0)" ::: "memory")
__device__ __forceinline__ unsigned f2bf(float f) { unsigned u = __builtin_bit_cast(unsigned, f); return (u + 0x7fffu + ((u >> 16) & 1u)) >> 16; }
__device__ __forceinline__ unsigned pk2(float lo, float hi) { return f2bf(lo) | (f2bf(hi) << 16); }
__device__ __forceinline__ float bf_lo(unsigned w) { return __uint_as_float(w << 16); }
__device__ __forceinline__ float bf_hi(unsigned w) { return __uint_as_float(w & 0xffff0000u); }

#define XB_TMO      128
#define XB_XCNT(j)  (256  + 64 * (j))
#define XB_XSUB(j)  (1280 + 64 * (j))
#define XB_XGEN(j)  (2304 + 64 * (j))
#define XB_TOP      3328
#define XB_TOPGEN   3392
#define XCD_BAR_WORDS 3456
#define XB_SPIN_CAP (1u << 24)

__device__ __forceinline__ unsigned xb_ld(unsigned* p)              { return __hip_atomic_load(p, __ATOMIC_RELAXED, __HIP_MEMORY_SCOPE_AGENT); }
__device__ __forceinline__ unsigned xb_add(unsigned* p, unsigned v) { return __hip_atomic_fetch_add(p, v, __ATOMIC_RELAXED, __HIP_MEMORY_SCOPE_AGENT); }
__device__ __forceinline__ unsigned xb_xcc_id() { return (unsigned)__builtin_amdgcn_s_getreg((3 << 11) | 20) & 0xFu; }
#define XB_SPIN(cond, bar) do { unsigned _sp = 0; while (cond) { __builtin_amdgcn_s_sleep(1); \
    if ((++_sp & 255u) == 0u) { if (xb_ld(&(bar)[XB_TMO])) break; if (_sp > XB_SPIN_CAP) { atomicAdd(&(bar)[XB_TMO], 1u); break; } } } } while (0)

struct XcdBarrier { unsigned* bar; unsigned x; volatile LAS unsigned* st; };

__device__ __forceinline__ XcdBarrier xcd_barrier_post(unsigned* bar, volatile LAS unsigned* st) {
    XcdBarrier b; b.bar = bar; b.x = xb_xcc_id(); b.st = st;
    if (threadIdx.x == 0) (void)xb_add(&bar[XB_XCNT(b.x)], 1u);
    return b;
}
__device__ __forceinline__ void xcd_barrier_complete(unsigned* bar, unsigned x, unsigned& nloc, unsigned& nx) {
    const unsigned G = gridDim.x * gridDim.y * gridDim.z;
    unsigned sum, cnt, mine, sp = 0u;
    for (;;) {
        sum = 0u; cnt = 0u; mine = 0u;
#pragma unroll
        for (unsigned j = 0; j < 16; ++j) { const unsigned c = xb_ld(&bar[XB_XCNT(j)]); sum += c; cnt += (c > 0u) ? 1u : 0u; mine = (j == x) ? c : mine; }
        if (sum == G) break;
        __builtin_amdgcn_s_sleep(1);
        if ((++sp & 255u) == 0u) { if (xb_ld(&bar[XB_TMO])) break; if (sp > XB_SPIN_CAP) { atomicAdd(&bar[XB_TMO], 1u); break; } }
    }
    nloc = mine > 0u ? mine : 1u; nx = cnt > 0u ? cnt : 1u;
}
__device__ __forceinline__ void xcd_barrier(const XcdBarrier& b) {
    asm volatile("s_waitcnt vmcnt(0)" ::: "memory");
    __syncthreads();
    if (threadIdx.x == 0) {
        unsigned* bar = b.bar;
        __builtin_amdgcn_s_waitcnt(0);
        unsigned nloc = b.st[0], nx = b.st[1];
        if (nloc == 0u) { xcd_barrier_complete(bar, b.x, nloc, nx); b.st[0] = nloc; b.st[1] = nx; }
        const unsigned old = xb_add(&bar[XB_XSUB(b.x)], 1u);
        const unsigned gen = old / nloc;
        if (old + 1u == (gen + 1u) * nloc) {
            __builtin_amdgcn_fence(__ATOMIC_RELEASE, "agent");
            asm volatile("s_waitcnt vmcnt(0)" ::: "memory");
            const unsigned og = xb_add(&bar[XB_TOP], 1u);
            const unsigned tg = og / nx;
            if (og + 1u == (tg + 1u) * nx) xb_add(&bar[XB_TOPGEN], 1u);
            else XB_SPIN(xb_ld(&bar[XB_TOPGEN]) == tg, bar);
            __builtin_amdgcn_fence(__ATOMIC_ACQUIRE, "agent");
            xb_add(&bar[XB_XGEN(b.x)], 1u);
            asm volatile("s_waitcnt vmcnt(0)" ::: "memory");
        } else {
            XB_SPIN(xb_ld(&bar[XB_XGEN(b.x)]) == gen, bar);
            __builtin_amdgcn_fence(__ATOMIC_ACQUIRE, "agent");
            asm volatile("s_waitcnt vmcnt(0)" ::: "memory");
        }
    }
    __syncthreads();
}

struct Args {
    const float* in[24]; float* out; unsigned char* ws; int ph_lo, ph_hi;
};
struct Frame {
    LAS unsigned char* lds;
    int tid, lane, wave, vcu, G;
    unsigned char* ws;
};

__device__ __forceinline__ float wave_sum(float v) {
#pragma unroll
    for (int o = 1; o < 64; o <<= 1) v += __shfl_xor(v, o);
    return v;
}

__device__ const float INV32[32] = {
    1.0f, 0.74989420933f, 0.56234132519f, 0.42169650343f, 0.31622776602f, 0.23713737057f, 0.17782794100f, 0.13335214322f,
    0.1f, 0.074989420933f, 0.056234132519f, 0.042169650343f, 0.031622776602f, 0.023713737057f, 0.017782794100f, 0.013335214322f,
    0.01f, 0.0074989420933f, 0.0056234132519f, 0.0042169650343f, 0.0031622776602f, 0.0023713737057f, 0.0017782794100f, 0.0013335214322f,
    0.001f, 0.00074989420933f, 0.00056234132519f, 0.00042169650343f, 0.00031622776602f, 0.00023713737057f, 0.00017782794100f, 0.00013335214322f };
__device__ const float INV16[16] = {
    1.0f, 0.56234132519f, 0.31622776602f, 0.17782794100f, 0.1f, 0.056234132519f, 0.031622776602f, 0.017782794100f,
    0.01f, 0.0056234132519f, 0.0031622776602f, 0.0017782794100f, 0.001f, 0.00056234132519f, 0.00031622776602f, 0.00017782794100f };

__device__ __forceinline__ void sincos_acc(float af, float& c, float& s) {
    const double a = (double)af; const double kd = __builtin_rint(a * 0.63661977236758134308); const int k = (int)kd;
    const double r = (a - kd * 1.57079632679489655800) - kd * 6.12323399573676603587e-17; const double r2 = r * r;
    const double sn = r * (1.0 + r2 * (-1.0 / 6 + r2 * (1.0 / 120 + r2 * (-1.0 / 5040 + r2 * (1.0 / 362880 + r2 * (-1.0 / 39916800 + r2 * (1.0 / 6227020800.0)))))));
    const double cs = 1.0 + r2 * (-0.5 + r2 * (1.0 / 24 + r2 * (-1.0 / 720 + r2 * (1.0 / 40320 + r2 * (-1.0 / 3628800 + r2 * (1.0 / 479001600.0 + r2 * (-1.0 / 87178291200.0)))))));
    double cc, ss;
    switch (k & 3) { case 0: cc = cs; ss = sn; break; case 1: cc = -sn; ss = cs; break; case 2: cc = -cs; ss = -sn; break; default: cc = sn; ss = -cs; break; }
    c = (float)cc; s = (float)ss;
}

__device__ __forceinline__ void p0_transpose_item(const float* W, int K, int N, bf16* WT, LAS float* scr, int item, int lane) {
    const int nblk = N / 32, kb = item / nblk, nb = item % nblk, k0 = 64 * kb, n0 = 32 * nb;
#pragma unroll 8
    for (int i = 0; i < 32; ++i) { const int kk = 2 * i + (lane >> 5); scr[kk * 33 + (lane & 31)] = W[(size_t)(k0 + kk) * N + n0 + (lane & 31)]; }
    LDS_WAIT(); asm volatile("" ::: "memory");
    const int c = lane & 7;
#pragma unroll
    for (int j = 0; j < 4; ++j) { const int n = (lane >> 3) + 8 * j; const LAS float* s = scr + (8 * c) * 33 + n;
        v4u o; o.x = pk2(s[0 * 33], s[1 * 33]); o.y = pk2(s[2 * 33], s[3 * 33]); o.z = pk2(s[4 * 33], s[5 * 33]); o.w = pk2(s[6 * 33], s[7 * 33]);
        *(GAS v4u*)(WT + (size_t)(n0 + n) * K + k0 + 8 * c) = o; }
    LDS_WAIT(); asm volatile("" ::: "memory");
}

__device__ __forceinline__ float silu_f(float x) { return x / (1.f + __expf(-x)); }

__device__ __forceinline__ void phase_prologue(Frame& F, const Args& a) {
    const float* c_in = a.in[1]; const float* cctx = a.in[3]; const float* w_ada = a.in[4]; const float* b_ada = a.in[5];
    float* mod = (float*)(F.ws + WS_MOD);
    if (F.vcu == 0) {
        f32x2* thd = (f32x2*)(F.ws + WS_TAB);
        for (int e = F.tid; e < 64 * 32; e += NWAVES * 64) { const int pos = e >> 5, i = e & 31; float c, s; sincos_acc((float)pos * INV32[i], c, s); thd[e] = (f32x2){c, s}; }
        f32x2* tdh = (f32x2*)(F.ws + WS_TAB + 16384);
        for (int e = F.tid; e < 64 * 16; e += NWAVES * 64) { const int pos = e >> 4, i = e & 15; float c, s; sincos_acc((float)pos * INV16[i], c, s); tdh[e] = (f32x2){c, s}; }
        if (F.tid < 2) { const int l = F.tid; float s1 = 0.f, s2 = 0.f;
            for (int i = 0; i < 64; ++i) { s1 += a.in[14][l * 64 + i] * a.in[15][l * 64 + i]; s2 += a.in[16][l * 64 + i] * a.in[17][l * 64 + i]; }
            const float lam_init = 0.8f - 0.6f * expf(-0.3f * (float)l);
            float* lam = (float*)(F.ws + WS_TAB + 32768); lam[l * 2 + 0] = expf(s1) - expf(s2) + lam_init; lam[l * 2 + 1] = 1.f - lam_init; }
    }
    {
        LAS float* sv = (LAS float*)(F.lds + RING_OFF);
        LAS float* red = (LAS float*)(F.lds + RING_OFF + 49152);
        for (int e = F.tid; e < 3 * DM; e += NWAVES * 64) { const int v = e / DM, k = e % DM; const float x = v < 2 ? c_in[v * DM + k] : cctx[k]; sv[e] = silu_f(x); }
        __syncthreads();
        const int cg = F.lane & 15, kq = F.lane >> 4;
        for (int it = F.vcu; it < 2 * (NADA / 64); it += F.G) {
            const int l = it / (NADA / 64), ch = it % (NADA / 64);
            const float* W = w_ada + (size_t)l * DM * NADA + ch * 64 + cg * 4;
            f32x4 a0 = {0.f, 0.f, 0.f, 0.f}, a1 = a0, a2 = a0;
#pragma unroll 8
            for (int s = 0; s < DM / 32; ++s) { const int k = s * 32 + F.wave * 4 + kq; const f32x4 w = *(const GAS f32x4*)(W + (size_t)k * NADA);
                a0 += w * sv[k]; a1 += w * sv[DM + k]; a2 += w * sv[2 * DM + k]; }
#pragma unroll
            for (int e = 0; e < 4; ++e) { a0[e] += __shfl_xor(a0[e], 16); a0[e] += __shfl_xor(a0[e], 32); a1[e] += __shfl_xor(a1[e], 16); a1[e] += __shfl_xor(a1[e], 32); a2[e] += __shfl_xor(a2[e], 16); a2[e] += __shfl_xor(a2[e], 32); }
            if (kq == 0) {
#pragma unroll
                for (int e = 0; e < 4; ++e) { red[(F.wave * 3 + 0) * 64 + cg * 4 + e] = a0[e]; red[(F.wave * 3 + 1) * 64 + cg * 4 + e] = a1[e]; red[(F.wave * 3 + 2) * 64 + cg * 4 + e] = a2[e]; } }
            __syncthreads();
            if (F.tid < 192) { const int v = F.tid / 64, cidx = F.tid % 64; float s = 0.f;
#pragma unroll
                for (int w = 0; w < 8; ++w) s += red[(w * 3 + v) * 64 + cidx];
                const int col = ch * 64 + cidx; mod[((size_t)l * 3 + v) * NADA + col] = s + b_ada[(size_t)l * NADA + col]; }
            __syncthreads();
        }
    }
    {
        __syncthreads();
        LAS float* scr = (LAS float*)(F.lds + RING_OFF + F.wave * 16384);
        const int gw = F.vcu * NWAVES + F.wave, NGW = F.G * NWAVES;
        constexpr int I_IN = (DM / 64) * (NIN / 32), I_OUT = (DM / 64) * (DM / 32), I_UP = (DM / 64) * (NUP / 32), I_DN = (DFF / 64) * (DM / 32);
        constexpr int PER_L = I_IN + I_OUT + I_UP + I_DN;
        for (int it = gw; it < 2 * PER_L; it += NGW) {
            const int l = it / PER_L; int r = it % PER_L;
            if (r < I_IN) { p0_transpose_item(a.in[10] + (size_t)l * DM * NIN, DM, NIN, (bf16*)(F.ws + WS_WIN + (size_t)l * 72 * MiB), scr, r, F.lane); continue; } r -= I_IN;
            if (r < I_OUT) { p0_transpose_item(a.in[11] + (size_t)l * DM * DM, DM, DM, (bf16*)(F.ws + WS_WOUT + (size_t)l * 32 * MiB), scr, r, F.lane); continue; } r -= I_OUT;
            if (r < I_UP) { p0_transpose_item(a.in[21] + (size_t)l * DM * NUP, DM, NUP, (bf16*)(F.ws + WS_WUP + (size_t)l * 172 * MiB), scr, r, F.lane); continue; } r -= I_UP;
            p0_transpose_item(a.in[23] + (size_t)l * DFF * DM, DFF, DM, (bf16*)(F.ws + WS_WDN + (size_t)l * 86 * MiB), scr, r, F.lane);
        }
    }
}

struct RowRegs { f32x4 v[16]; };
__device__ __forceinline__ float row_sumsq(const RowRegs& r) {
    float s = 0.f;
#pragma unroll
    for (int j = 0; j < 16; ++j) s += (r.v[j].x * r.v[j].x + r.v[j].y * r.v[j].y) + (r.v[j].z * r.v[j].z + r.v[j].w * r.v[j].w);
    return wave_sum(s);
}
__device__ __forceinline__ void row_load_f32(RowRegs& r, const float* p, int lane) {
    const GAS f32x4* q = (const GAS f32x4*)p + lane;
#pragma unroll
    for (int j = 0; j < 16; ++j) r.v[j] = q[64 * j];
}
__device__ __forceinline__ void row_load_bf16(RowRegs& r, const bf16* p, int lane) {
    const GAS v2u* q = (const GAS v2u*)p + lane;
#pragma unroll
    for (int j = 0; j < 16; ++j) { const v2u w = q[64 * j]; r.v[j] = (f32x4){bf_lo(w.x), bf_hi(w.x), bf_lo(w.y), bf_hi(w.y)}; }
}
__device__ __forceinline__ void row_store_f32(const RowRegs& r, float* p, int lane) {
    GAS f32x4* q = (GAS f32x4*)p + lane;
#pragma unroll
    for (int j = 0; j < 16; ++j) q[64 * j] = r.v[j];
}
__device__ __forceinline__ void row_modnorm_store(const RowRegs& x, float rstd, const float* g, const float* sc, const float* sh, bf16* out, int lane) {
    GAS v2u* q = (GAS v2u*)out + lane;
#pragma unroll
    for (int j = 0; j < 16; ++j) { const int c = 4 * lane + 256 * j;
        const f32x4 gv = *(const GAS f32x4*)(g + c), sv = *(const GAS f32x4*)(sc + c), hv = *(const GAS f32x4*)(sh + c);
        const f32x4 y = (x.v[j] * rstd) * gv * (sv + 1.f) + hv;
        v2u w; w.x = pk2(y.x, y.y); w.y = pk2(y.z, y.w); q[64 * j] = w; }
}
__device__ __forceinline__ void row_residual(RowRegs& x, const RowRegs& y, float rstd, const float* g, const float* gate, int lane) {
#pragma unroll
    for (int j = 0; j < 16; ++j) { const int c = 4 * lane + 256 * j;
        const f32x4 gv = *(const GAS f32x4*)(g + c), tv = *(const GAS f32x4*)(gate + c);
        x.v[j] = x.v[j] + tv * ((y.v[j] * rstd) * gv); }
}

__device__ __forceinline__ void phase_r0(Frame& F, const Args& a) {
    const float* mod = (const float*)(F.ws + WS_MOD); float* xs = (float*)(F.ws + WS_XS); bf16* hx = (bf16*)(F.ws + WS_HX);
    const int gw = F.vcu * NWAVES + F.wave, NGW = F.G * NWAVES;
    for (int m = gw; m < MROWS; m += NGW) {
        const int b = m / TPB, t = m % TPB; const bool lat = t < SEQ;
        const float* src = lat ? a.in[0] + ((size_t)b * SEQ + t) * DM : a.in[2] + ((size_t)b * CTXL + (t - SEQ)) * DM;
        RowRegs x; row_load_f32(x, src, F.lane);
        row_store_f32(x, xs + (size_t)m * DM, F.lane);
        const float rstd = 1.f / sqrtf(row_sumsq(x) * (1.f / DM) + EPS);
        const float* mv = mod + (size_t)(0 * 3 + (lat ? b : 2)) * NADA;
        row_modnorm_store(x, rstd, a.in[6]  , mv + DM, mv, hx + (size_t)m * DM, F.lane);
    }
}
__device__ __forceinline__ void phase_r1(Frame& F, const Args& a, int l, bool last) {
    const float* mod = (const float*)(F.ws + WS_MOD); float* xs = (float*)(F.ws + WS_XS); bf16* hx = (bf16*)(F.ws + WS_HX); const bf16* yb = (const bf16*)(F.ws + WS_Y);
    const int gw = F.vcu * NWAVES + F.wave, NGW = F.G * NWAVES;
    for (int m = gw; m < MROWS; m += NGW) {
        const int b = m / TPB, t = m % TPB; const bool lat = t < SEQ;
        if (last && !lat) continue;
        const float* mv = mod + (size_t)(l * 3 + (lat ? b : 2)) * NADA;
        RowRegs x, y; row_load_f32(x, xs + (size_t)m * DM, F.lane); row_load_bf16(y, yb + (size_t)m * DM, F.lane);
        const float rstd_y = 1.f / sqrtf(row_sumsq(y) * (1.f / DM) + EPS);
        row_residual(x, y, rstd_y, a.in[7] + (size_t)l * DM, mv + 2 * DM, F.lane);
        row_store_f32(x, xs + (size_t)m * DM, F.lane);
        const float rstd = 1.f / sqrtf(row_sumsq(x) * (1.f / DM) + EPS);
        row_modnorm_store(x, rstd, a.in[8] + (size_t)l * DM, mv + 4 * DM, mv + 3 * DM, hx + (size_t)m * DM, F.lane);
    }
}
__device__ __forceinline__ void phase_r2(Frame& F, const Args& a, int l, bool last) {
    const float* mod = (const float*)(F.ws + WS_MOD); float* xs = (float*)(F.ws + WS_XS); bf16* hx = (bf16*)(F.ws + WS_HX); const bf16* yb = (const bf16*)(F.ws + WS_Y);
    const int gw = F.vcu * NWAVES + F.wave, NGW = F.G * NWAVES;
    for (int m = gw; m < MROWS; m += NGW) {
        const int b = m / TPB, t = m % TPB; const bool lat = t < SEQ;
        if (last && !lat) continue;
        const float* mv = mod + (size_t)(l * 3 + (lat ? b : 2)) * NADA;
        RowRegs x, y; row_load_f32(x, xs + (size_t)m * DM, F.lane); row_load_bf16(y, yb + (size_t)m * DM, F.lane);
        const float rstd_y = 1.f / sqrtf(row_sumsq(y) * (1.f / DM) + EPS);
        row_residual(x, y, rstd_y, a.in[9] + (size_t)l * DM, mv + 5 * DM, F.lane);
        if (last) { row_store_f32(x, a.out + ((size_t)b * SEQ + t) * DM, F.lane); continue; }
        row_store_f32(x, xs + (size_t)m * DM, F.lane);
        const float rstd = 1.f / sqrtf(row_sumsq(x) * (1.f / DM) + EPS);
        const float* mn = mod + (size_t)((l + 1) * 3 + (lat ? b : 2)) * NADA;
        row_modnorm_store(x, rstd, a.in[6] + (size_t)(l + 1) * DM, mn + DM, mn, hx + (size_t)m * DM, F.lane);
    }
}

__device__ __forceinline__ void phase_qkpost(Frame& F, const Args& a, int l) {
    bf16* P = (bf16*)(F.ws + WS_P);
    const f32x2* thd = (const f32x2*)(F.ws + WS_TAB); const f32x2* tdh = (const f32x2*)(F.ws + WS_TAB + 16384);
    const float* gq = a.in[12] + l * 128; const float* gk = a.in[13] + l * 128;
    const int gw = F.vcu * NWAVES + F.wave, NGW = F.G * NWAVES; const int lane = F.lane;
    const float gq0 = gq[2 * lane], gq1 = gq[2 * lane + 1], gk0 = gk[2 * lane], gk1 = gk[2 * lane + 1];
    for (int m = gw; m < MROWS; m += NGW) {
        const int t = m % TPB; const bool lat = t < SEQ;
        unsigned* row = (unsigned*)(P + (size_t)m * NIN);
        const int grow = (t >> 6) & 63, gcol = t & 63;
        f32x2 cs_hd = {1.f, 0.f}, cs_dh = {1.f, 0.f};
        if (lat) { cs_hd = thd[(lane < 32 ? grow : gcol) * 32 + (lane & 31)]; const int pp = lane & 31; cs_dh = tdh[(pp < 16 ? grow : gcol) * 16 + (pp & 15)]; }
#define QK_CHUNK(colbase, kind) do { unsigned* p = row + ((colbase) >> 1) + lane; const unsigned w = *p; float x0 = bf_lo(w), x1 = bf_hi(w); \
        if ((kind) == 0 || (kind) == 3) { const float ss = wave_sum(x0 * x0 + x1 * x1); const float rstd = 1.f / sqrtf(ss * (1.f / 128.f) + EPS); \
            x0 = x0 * rstd * ((kind) == 0 ? gq0 : gk0); x1 = x1 * rstd * ((kind) == 0 ? gq1 : gk1); } \
        const f32x2 cs = ((kind) == 1) ? cs_dh : cs_hd; const float y0 = x0 * cs.x - x1 * cs.y, y1 = x0 * cs.y + x1 * cs.x; *p = pk2(y0, y1); } while (0)
        if (lat) {
#pragma unroll 4
            for (int h = 0; h < 8; ++h) QK_CHUNK(QA + h * 128, 0);
#pragma unroll 4
            for (int h = 0; h < 8; ++h) QK_CHUNK(QB_ + h * 128, 1);
#pragma unroll 4
            for (int h = 0; h < 8; ++h) QK_CHUNK(QC + h * 128, 2);
#pragma unroll
            for (int h = 0; h < 2; ++h) QK_CHUNK(KA + h * 128, 3);
#pragma unroll 4
            for (int h = 0; h < 8; ++h) QK_CHUNK(KB_ + h * 128, 1);
#pragma unroll
            for (int h = 0; h < 2; ++h) QK_CHUNK(KC + h * 128, 2);
        } else {
#pragma unroll 4
            for (int h = 0; h < 8; ++h) QK_CHUNK(QA + h * 128, 0);
#pragma unroll
            for (int h = 0; h < 2; ++h) QK_CHUNK(KA + h * 128, 3);
        }
#undef QK_CHUNK
    }
}

__device__ __forceinline__ void phase_conv(Frame& F, const Args& a, int l, bool last) {
    const bf16* U = (const bf16*)(F.ws + WS_U); bf16* ACT = (bf16*)(F.ws + WS_ACT);
    const float* cw = a.in[22] + (size_t)l * 3 * NUP;
    const int gw = F.vcu * NWAVES + F.wave, NGW = F.G * NWAVES;
    constexpr int NCS = DFF / 256  , NBAND = MROWS / 32  ;
    const int half = F.lane >> 5, l32 = F.lane & 31;
    for (int it = gw; it < NBAND * NCS; it += NGW) {
        const int band = it % NBAND, cs = it / NBAND; const int mb = band * 32; const int t0 = mb % TPB;
        if (last && t0 >= SEQ) continue;
        const int seq_lo = (t0 < SEQ) ? (mb - t0) : (mb - t0 + SEQ), seq_hi = (t0 < SEQ) ? (mb - t0 + SEQ) : (mb - t0 + TPB);
        const int m0 = mb + half * 16;
        const int col = cs * 256 + 8 * l32;
        f32x4 wg[3][2], wv[3][2];
#pragma unroll
        for (int j = 0; j < 3; ++j)
#pragma unroll
            for (int q = 0; q < 2; ++q) { wg[j][q] = *(const GAS f32x4*)(cw + (size_t)j * NUP + col + 4 * q); wv[j][q] = *(const GAS f32x4*)(cw + (size_t)j * NUP + DFF + col + 4 * q); }
#pragma unroll 1
        for (int hb = 0; hb < 2; ++hb) {
        const int mh = m0 + 8 * hb;
        v4u rg[10], rv[10];
#pragma unroll
        for (int r = 0; r < 10; ++r) { const int gm = mh - 1 + r;
            if (gm >= seq_lo && gm < seq_hi) { rg[r] = *(const GAS v4u*)(U + (size_t)gm * NUP + col); rv[r] = *(const GAS v4u*)(U + (size_t)gm * NUP + DFF + col); }
            else { rg[r] = (v4u){0u, 0u, 0u, 0u}; rv[r] = rg[r]; } }
#pragma unroll
        for (int r = 0; r < 8; ++r) {
            v4u ow;
#pragma unroll
            for (int q = 0; q < 4; ++q) {
                const int qq = q >> 1, e0 = (q & 1) * 2;
                const float g_lo = bf_lo(rg[r][q]) * wg[0][qq][e0] + bf_lo(rg[r + 1][q]) * wg[1][qq][e0] + bf_lo(rg[r + 2][q]) * wg[2][qq][e0];
                const float g_hi = bf_hi(rg[r][q]) * wg[0][qq][e0 + 1] + bf_hi(rg[r + 1][q]) * wg[1][qq][e0 + 1] + bf_hi(rg[r + 2][q]) * wg[2][qq][e0 + 1];
                const float v_lo = bf_lo(rv[r][q]) * wv[0][qq][e0] + bf_lo(rv[r + 1][q]) * wv[1][qq][e0] + bf_lo(rv[r + 2][q]) * wv[2][qq][e0];
                const float v_hi = bf_hi(rv[r][q]) * wv[0][qq][e0 + 1] + bf_hi(rv[r + 1][q]) * wv[1][qq][e0 + 1] + bf_hi(rv[r + 2][q]) * wv[2][qq][e0 + 1];
                ow[q] = pk2(g_lo / (1.f + __expf(-g_lo)) * v_lo, g_hi / (1.f + __expf(-g_hi)) * v_hi);
            }
            *(GAS v4u*)(ACT + (size_t)(mh + r) * DFF + col) = ow;
        }
        }
    }
}

template <int MASK>
__device__ __forceinline__ void attn_std_unit(Frame& F, const bf16* P, bf16* O, int b, int qrow0  , int qcol, int kcol, int vcol, int ocol,
                                              int nloc, int loc0, float sink, bool has_sink) {
    using namespace att;
    int lane_ = F.lane; asm volatile("" : "+v"(lane_));
    int lane = lane_, wid = F.wave, r32 = lane & 31, hi = lane >> 5;
    constexpr float SCALE = 0.088388347648318440f; constexpr float C = SCALE * 1.4426950408889634f;
    const size_t base = (size_t)b * TPB;
    const bf16* Qw = P + (base + qrow0 + wid * 32 + r32) * LDP + qcol + hi * 8;
    f32x16 o[4]; float m_reg, l_reg;
    attn_core<MASK, 0, 8>(o, m_reg, l_reg, Qw, P + base * LDP + kcol, P + base * LDP + vcol, nloc, loc0, qrow0 + wid * 32 + r32, C, 8.f / SCALE, (ALAS char*)F.lds);
    if (has_sink) l_reg += __builtin_amdgcn_exp2f(sink * 1.4426950408889634f - m_reg * C);
    asm volatile("" : "+v"(lane_)); lane = lane_; r32 = lane & 31; hi = lane >> 5;
    ALAS float* li_l = (ALAS float*)((ALAS char*)F.lds + WSCR_OFF) + wid * 64;
    if (hi == 0) li_l[r32] = l_reg; asm volatile("s_waitcnt lgkmcnt(0)" ::: "memory");
    bf16* Ow = O + (base + qrow0 + wid * 32) * LDO + ocol;
#pragma unroll
    for (int r = 0; r < 16; ++r) { const int orow = crow(r, hi); const float rl = __builtin_amdgcn_rcpf(li_l[orow]);
#pragma unroll
        for (int d0 = 0; d0 < 4; ++d0) Ow[(size_t)orow * LDO + d0 * 32 + r32] = (bf16)f2bf(o[d0][r] * rl); }
}
__device__ __forceinline__ void attn_diff_unit(Frame& F, const bf16* P, bf16* O, int b, int qrow0, int h, int nloc, int loc0, float lam, float omli, const float* gsub) {
    using namespace att;
    int lane_ = F.lane; asm volatile("" : "+v"(lane_));
    int lane = lane_, wid = F.wave, r32 = lane & 31, hi = lane >> 5;
    constexpr float SCALE = 0.125f; constexpr float C = SCALE * 1.4426950408889634f;
    const size_t base = (size_t)b * TPB;
    const bf16* Qw = P + (base + qrow0 + wid * 32 + r32) * LDP + QB_ + h * 128 + hi * 8;
    const bf16* Kb = P + base * LDP + KB_ + h * 128; const bf16* Vb = P + base * LDP + VB_ + h * 128;
    ALAS float* li_l = (ALAS float*)((ALAS char*)F.lds + WSCR_OFF) + wid * 64;
    f32x16 o[4]; float m_reg, l_reg;
    attn_core<0, 4, 4>(o, m_reg, l_reg, Qw, Kb, Vb, nloc, loc0, 0, C, 8.f / SCALE, (ALAS char*)F.lds);
    asm volatile("" : "+v"(lane_)); lane = lane_; r32 = lane & 31; hi = lane >> 5;
    if (hi == 0) li_l[r32] = l_reg; asm volatile("s_waitcnt lgkmcnt(0)" ::: "memory");
    { float* stash = (float*)(F.ws + WS_STASH) + ((size_t)blockIdx.x * 8 + wid) * 4096 + lane;
#pragma unroll
    for (int d0 = 0; d0 < 4; ++d0) { float* sp = stash + d0 * 1024; asm volatile("" : "+v"(sp));
#pragma unroll
        for (int r = 0; r < 16; ++r) sp[r * 64] = o[d0][r] * __builtin_amdgcn_rcpf(li_l[crow(r, hi)]); } }
    __syncthreads();
    attn_core<0, 0, 4>(o, m_reg, l_reg, Qw, Kb, Vb, nloc, loc0, 0, C, 8.f / SCALE, (ALAS char*)F.lds);
    asm volatile("" : "+v"(lane_)); lane = lane_; r32 = lane & 31; hi = lane >> 5;
    if (hi == 0) li_l[r32] = l_reg; asm volatile("s_waitcnt lgkmcnt(0)" ::: "memory");
    float* stash = (float*)(F.ws + WS_STASH) + ((size_t)blockIdx.x * 8 + wid) * 4096 + lane;
    float g4[4];
#pragma unroll
    for (int d0 = 0; d0 < 4; ++d0) g4[d0] = gsub[d0 * 32 + r32] * omli;
    bf16* Ow = O + (base + qrow0 + wid * 32) * LDO + QB_ + h * 128;
#pragma unroll
    for (int r = 0; r < 16; ++r) { const int orow = crow(r, hi); const float rl = __builtin_amdgcn_rcpf(li_l[orow]);
        float v[4]; float ss = 0.f;
#pragma unroll
        for (int d0 = 0; d0 < 4; ++d0) { v[d0] = o[d0][r] * rl - lam * stash[(d0 * 16 + r) * 64]; ss += v[d0] * v[d0]; }
        ss += __shfl_xor(ss, 1); ss += __shfl_xor(ss, 2); ss += __shfl_xor(ss, 4); ss += __shfl_xor(ss, 8); ss += __shfl_xor(ss, 16);
        const float rstd = 1.f / sqrtf(ss * (1.f / 128.f) + EPS);
#pragma unroll
        for (int d0 = 0; d0 < 4; ++d0) Ow[(size_t)orow * LDO + d0 * 32 + r32] = (bf16)f2bf(v[d0] * rstd * g4[d0]); }
}

__device__ __forceinline__ void phase_attention(Frame& F, const Args& a, int l, bool last) {
    const bf16* P = (const bf16*)(F.ws + WS_P); bf16* O = (bf16*)(F.ws + WS_O);
    const float* lamv = (const float*)(F.ws + WS_TAB + 32768); const float lam = lamv[l * 2], omli = lamv[l * 2 + 1];
    const float* sinkv = a.in[19] + l * 8; const float* gsub = a.in[18] + l * 128; const float* nab = a.in[20] + (size_t)l * 8 * 15 * 31;
#ifndef ATT_MASK
#define ATT_MASK 15
#endif
    if (ATT_MASK & 1) for (int u = F.vcu; u < (last ? 256 : 272); u += F.G) {
        int b, h, qrow0, nloc;
        if (u < 256) { b = u >> 7; h = (u >> 4) & 7; qrow0 = (u & 15) * 256; nloc = 64; } else { const int e = u - 256; b = e >> 3; h = e & 7; qrow0 = SEQ; nloc = 0; }
        __syncthreads(); attn_diff_unit(F, P, O, b, qrow0, h, nloc, 0, lam, omli, gsub);
    }
    if (ATT_MASK & 2) for (int u = F.vcu; u < (last ? 256 : 304); u += F.G) {
        int b, qrow0, qcol, kcol, vcol, nloc; float sink = 0.f; bool has_sink = false;
        if (u < 256) { const int h = (u >> 4) & 7, qb = u & 15; b = u >> 7; qrow0 = qb * 256; qcol = QA + h * 128; kcol = KA + (h >> 2) * 128; vcol = VA + (h >> 2) * 128; nloc = 64; }
        else { const int e = u - 256, g = e >> 4, h = e & 7; b = (e >> 3) & 1; qrow0 = SEQ; nloc = 0;
            if (g == 0) { qcol = QA + h * 128; kcol = KA + (h >> 2) * 128; vcol = VA + (h >> 2) * 128; }
            else if (g == 1) { qcol = QC + h * 128; kcol = KC + (h >> 2) * 128; vcol = VC + (h >> 2) * 128; sink = sinkv[h]; has_sink = true; }
            else { qcol = QD + h * 128; kcol = KD + h * 128; vcol = VD + h * 128; } }
        __syncthreads(); attn_std_unit<0>(F, P, O, b, qrow0, qcol, kcol, vcol, qcol, nloc, 0, sink, has_sink);
    }
    if (ATT_MASK & 4) for (int u = F.vcu; u < 256; u += F.G) { const int b = u >> 7, h = (u >> 4) & 7, qb = u & 15;
        const int lo = max(qb * 256 - 128, 0), hiK = min(qb * 256 + 384, SEQ);
        __syncthreads(); attn_std_unit<2>(F, P, O, b, qb * 256, QC + h * 128, KC + (h >> 2) * 128, VC + (h >> 2) * 128, QC + h * 128, (hiK - lo) / 64, lo, sinkv[h], true); }
    if (ATT_MASK & 8) for (int u = F.vcu; u < 256; u += F.G) { const int b = u >> 7, h = (u >> 4) & 7, qb = u & 15;
        const int r0 = qb * 4; int rlo, nrow;
        if (r0 == 0) { rlo = 0; nrow = 8; } else if (r0 == 60) { rlo = 56; nrow = 8; } else { rlo = min(r0 - 4, 52); nrow = 12; }
        __syncthreads();
        { LAS float* bl = (LAS float*)(F.lds + att::BIAS_OFF); for (int e = F.tid; e < 15 * 31; e += NWAVES * 64) bl[e] = nab[h * 465 + e] * 11.313708498984761f; }
        attn_std_unit<3>(F, P, O, b, qb * 256, QD + h * 128, KD + h * 128, VD + h * 128, QD + h * 128, nrow, rlo * 64, 0.f, false); }
    __syncthreads();
}

__global__ void __launch_bounds__(NWAVES * 64, 2) fwd_kernel(Args args) {
    extern __shared__ __attribute__((aligned(16))) unsigned char lds[];
    Frame F;
    F.lds = (LAS unsigned char*)lds;
    volatile LAS unsigned* MISC = (volatile LAS unsigned*)(F.lds + MISC_OFF);
    F.tid = threadIdx.x; F.lane = F.tid & 63; F.wave = __builtin_amdgcn_readfirstlane(F.tid >> 6);
    F.G = gridDim.x; { const int bx = blockIdx.x; F.vcu = (F.G % 8 == 0) ? (bx % 8) * (F.G / 8) + bx / 8 : bx; }
    F.ws = args.ws;
    gu32* ctl = (gu32*)(F.ws + WS_CTL);
    for (int u = F.tid; u < (LDS_BYTES - LDSCTL_OFF) / 4; u += NWAVES * 64) ((LAS unsigned*)(F.lds + LDSCTL_OFF))[u] = 0u;
    __syncthreads();
    const int lo = args.ph_lo, hi = args.ph_hi;
    XcdBarrier bar; bar.bar = (unsigned*)(ctl + CW_BAR); bar.x = 0; bar.st = nullptr;
    if (hi - lo > 1) bar = xcd_barrier_post((unsigned*)(ctl + CW_BAR), MISC + 8);
#ifndef PH_MASK
#define PH_MASK 0x7ff
#endif
#ifndef REP_PRO
#define REP_PRO 1
#endif
#ifndef REP_ATT
#define REP_ATT 1
#endif
#ifndef REP_GEMM
#define REP_GEMM 1
#endif
#ifndef REP_CONV
#define REP_CONV 1
#endif
#define IN(k) (lo <= (k) && (k) < hi)
#define FRESH() asm volatile("" : "+v"(F.tid), "+v"(F.lane))
#define EN(j) (((PH_MASK) >> (j)) & 1)
#define SEAM(k) do { if (IN(k) && IN((k) + 1)) xcd_barrier(bar); } while (0)

    if (EN(0) && IN(0)) { for (int rep = 0; rep < REP_PRO; ++rep) { FRESH(); phase_prologue(F, args); __syncthreads(); } } SEAM(0);
    if (EN(1) && IN(1)) { FRESH(); phase_r0(F, args); } SEAM(1);
    for (int l = 0; l < 2; ++l) {
        const bool last = (l == 1); const int pb = 2 + 9 * l;
        const pg8::bf16_t* HX = (const pg8::bf16_t*)(F.ws + WS_HX);
        if (EN(2) && IN(pb + 0)) {
            pg8::Gemm g{HX, (const pg8::bf16_t*)(F.ws + WS_WIN + (size_t)l * 72 * MiB), MROWS, NIN, DM};
            pg8::StaticOrder S; S.init(MROWS / 256, NIN, F.G, (int)blockIdx.x, 0);
            pg8::EpiBf16 E{(pg8::bf16_t*)(F.ws + WS_P), NIN};
            pg8::gemm_phase<pg8::EpiBf16, pg8::StaticOrder, true>(F.lds + RING_OFF, g, S, E);
            if (REP_GEMM > 1) pg8::gemm_phase<pg8::EpiBf16, pg8::StaticOrder, true>(F.lds + RING_OFF, g, S, E);
        } SEAM(pb + 0);
        if (EN(3) && IN(pb + 1)) { FRESH(); phase_qkpost(F, args, l); } SEAM(pb + 1);
        if (EN(4) && IN(pb + 2)) { for (int rep = 0; rep < REP_ATT; ++rep) { FRESH(); phase_attention(F, args, l, last); } } SEAM(pb + 2);
        if (EN(5) && IN(pb + 3)) {
            pg8::Gemm g{(const pg8::bf16_t*)(F.ws + WS_O), (const pg8::bf16_t*)(F.ws + WS_WOUT + (size_t)l * 32 * MiB), MROWS, DM, DM};
            pg8::StaticOrder S; S.init(last ? 32 : 34, DM, F.G, (int)blockIdx.x, last ? 1 : 0);
            pg8::EpiBf16 E{(pg8::bf16_t*)(F.ws + WS_Y), DM};
            pg8::gemm_phase<pg8::EpiBf16, pg8::StaticOrder, true>(F.lds + RING_OFF, g, S, E);
            if (REP_GEMM > 1) pg8::gemm_phase<pg8::EpiBf16, pg8::StaticOrder, true>(F.lds + RING_OFF, g, S, E);
        } SEAM(pb + 3);
        if (EN(6) && IN(pb + 4)) { FRESH(); phase_r1(F, args, l, last); } SEAM(pb + 4);
        if (EN(7) && IN(pb + 5)) {
            pg8::Gemm g{HX, (const pg8::bf16_t*)(F.ws + WS_WUP + (size_t)l * 172 * MiB), MROWS, NUP, DM};
            pg8::StaticOrder S; S.init(last ? 32 : 34, NUP, F.G, (int)blockIdx.x, last ? 1 : 0);
            pg8::EpiBf16 E{(pg8::bf16_t*)(F.ws + WS_U), NUP};
            pg8::gemm_phase<pg8::EpiBf16, pg8::StaticOrder, true>(F.lds + RING_OFF, g, S, E);
            if (REP_GEMM > 1) pg8::gemm_phase<pg8::EpiBf16, pg8::StaticOrder, true>(F.lds + RING_OFF, g, S, E);
        } SEAM(pb + 5);
        if (EN(8) && IN(pb + 6)) { for (int rep = 0; rep < REP_CONV; ++rep) { FRESH(); phase_conv(F, args, l, last); } } SEAM(pb + 6);
        if (EN(9) && IN(pb + 7)) {
            pg8::Gemm g{(const pg8::bf16_t*)(F.ws + WS_ACT), (const pg8::bf16_t*)(F.ws + WS_WDN + (size_t)l * 86 * MiB), MROWS, DM, DFF};
            pg8::StaticOrder S; S.init(last ? 32 : 34, DM, F.G, (int)blockIdx.x, last ? 1 : 0);
            pg8::EpiBf16 E{(pg8::bf16_t*)(F.ws + WS_Y), DM};
            pg8::gemm_phase<pg8::EpiBf16, pg8::StaticOrder, true>(F.lds + RING_OFF, g, S, E);
            if (REP_GEMM > 1) pg8::gemm_phase<pg8::EpiBf16, pg8::StaticOrder, true>(F.lds + RING_OFF, g, S, E);
        } SEAM(pb + 7);
        if (EN(10) && IN(pb + 8)) { FRESH(); phase_r2(F, args, l, last); } SEAM(pb + 8);
    }
#undef IN
#undef SEAM
}

extern "C" void kernel_launch(void* const* d_in, const int* in_sizes, int n_in, void* d_out, int out_size, void* d_ws, size_t ws_size, hipStream_t stream) {
    static int grid = 0;
    if (grid == 0) {
        if (n_in != 24 || in_sizes[0] != NB * SEQ * DM || out_size != NB * SEQ * DM || ws_size < WS_END) {
            fprintf(stderr, "kernel_launch: unexpected shapes: n_in %d in0 %d out %d ws %zu (need %zu); nothing launched\n", n_in, n_in > 0 ? in_sizes[0] : -1, out_size, ws_size, (size_t)WS_END); grid = -1; return; }
        int dev = 0, cus = 0, per_cu = 0;
        if (hipGetDevice(&dev) != hipSuccess || hipDeviceGetAttribute(&cus, hipDeviceAttributeMultiprocessorCount, dev) != hipSuccess) { grid = -1; return; }
        if (hipFuncSetAttribute((const void*)fwd_kernel, hipFuncAttributeMaxDynamicSharedMemorySize, LDS_BYTES) != hipSuccess) { fprintf(stderr, "kernel_launch: hipFuncSetAttribute failed\n"); grid = -1; return; }
        if (hipOccupancyMaxActiveBlocksPerMultiprocessor(&per_cu, (const void*)fwd_kernel, NWAVES * 64, LDS_BYTES) != hipSuccess || per_cu < 1)
            fprintf(stderr, "kernel_launch: note: occupancy query reports %d workgroups per CU\n", per_cu);
        (void)hipGetLastError();
        grid = cus;
    }
    if (grid < 0) return;
    if (hipMemsetAsync((char*)d_ws + WS_CTL, 0, CTL_ZERO_BYTES, stream) != hipSuccess) return;
    Args a{};
    for (int i = 0; i < 24; ++i) a.in[i] = (const float*)d_in[i];
    a.out = (float*)d_out; a.ws = (unsigned char*)d_ws;
#if MK_SINGLE
    a.ph_lo = 0; a.ph_hi = NPHASE;
    hipLaunchKernelGGL(fwd_kernel, dim3(grid), dim3(NWAVES * 64), LDS_BYTES, stream, a);
#else
    for (int p = 0; p < NPHASE; ++p) { a.ph_lo = p; a.ph_hi = p + 1; hipLaunchKernelGGL(fwd_kernel, dim3(grid), dim3(NWAVES * 64), LDS_BYTES, stream, a); }
#endif
    const hipError_t le = hipPeekAtLastError();
    if (le != hipSuccess) fprintf(stderr, "kernel_launch: launch failed: %s\n", hipGetErrorName(le));
}
```

```cpp
#include <hip/hip_runtime.h>
#include <cstdio>
#include <cstdint>

#ifndef MK_SINGLE
#define MK_SINGLE 1
#endif

namespace pg8 {
#define PG8_LAS __attribute__((address_space(3)))
typedef unsigned short bf16_t;
typedef short bf16x8 __attribute__((ext_vector_type(8)));
typedef float f32x4 __attribute__((ext_vector_type(4)));
typedef unsigned u32x4 __attribute__((ext_vector_type(4)));
constexpr int BM = 256, BK = 64, HALF = 128, HTB = HALF * BK * 2, STAGE_BYTES = 8 * HTB, NXCD = 8, WGM = 8;

__host__ __device__ __forceinline__ int lds_byte(int r, int c) { const int st = (r >> 4) * 2 + (c >> 5), rr = r & 15, cc = c & 31, ob = rr * 64 + cc * 2; return st * 1024 + (ob ^ (((ob >> 9) & 1) << 5)); }
__host__ __device__ __forceinline__ void stage_rc(int b, int& R, int& C) { const int st = b / 1024, sb = b % 1024, swz = sb ^ (((sb >> 9) & 1) << 5); R = (st >> 1) * 16 + swz / 64; C = (st & 1) * 32 + (swz % 64) / 2; }
__host__ __device__ __forceinline__ int perm32(int rho) { const int n = rho >> 4, i = rho & 15; return 8 * (i >> 2) + 4 * n + (i & 3); }

struct Unit { int pm, pn, kt0, nt, slab; };
struct Gemm { const bf16_t* A; const bf16_t* Bt; int M, N, K; };

struct StaticOrder {
    int nM, nN, nwg, G, c, skip, ntk;
    __host__ __device__ void init(int nM_, int N, int K, int G_, int c_, int skip_) { nM = nM_; nN = N / BM; nwg = nM * nN; G = G_; c = c_; skip = skip_; ntk = K / BK; }
    __host__ __device__ bool at(long L, Unit& u) const {
        if (L >= nwg) return false;
        int wgid = (int)L; { const int q = nwg / NXCD, r = nwg % NXCD, xcd = wgid % NXCD, off = wgid / NXCD; wgid = (xcd < r ? xcd * (q + 1) : r * (q + 1) + (xcd - r) * q) + off; }
        const int nig = WGM * nN, gid = wgid / nig, fm = gid * WGM, gsz = (nM - fm) < WGM ? (nM - fm) : WGM;
        u.pm = fm + ((wgid % nig) % gsz); u.pn = (wgid % nig) / gsz; u.kt0 = 0; u.nt = ntk; u.slab = -1;
        if (skip && u.pm >= 16) u.pm += 1;
        return true;
    }
    __host__ __device__ bool next(int i, Unit& u) const { return at((long)i * G + c, u); }
    __device__ __forceinline__ void a_ready(const Unit&) const {}
    __device__ __forceinline__ void done(const Unit&) const {}
};
struct SplitOrder {
    StaticOrder so; int ca, cb;
    __host__ __device__ void init(int N, int K, int G_, int c_) { so.init(32, N, K, G_, c_, 1); const int ntk = K / BK; ca = ((ntk / 8 + 1) / 2) * 2; cb = (ntk - 6 * ca) / 2; if (6 * ca + 2 * cb != ntk || (cb & 1) || cb <= 0) { ca = ntk / 8; cb = ca; } }
    __host__ __device__ bool next(int i, Unit& u) const {
        const long L = (long)i * so.G + so.c;
        if (L < so.nwg) return so.at(L, u);
        const int q = (int)(L - so.nwg); if (ca == 0 || q >= 256) return false;
        const int ch = q & 7, pn = (q >> 3) & 15, pp = q >> 7;
        u.pm = pp ? 33 : 16; u.pn = pn; u.slab = ch; u.kt0 = ch < 6 ? ca * ch : 6 * ca + cb * (ch - 6); u.nt = ch < 6 ? ca : cb;
        return true;
    }
    __device__ __forceinline__ void a_ready(const Unit&) const {}
    __device__ __forceinline__ void done(const Unit&) const {}
};

__device__ __forceinline__ unsigned cvt_pk_bf16(float lo, float hi) { unsigned r; asm volatile("v_cvt_pk_bf16_f32 %0, %1, %2" : "=v"(r) : "v"(lo), "v"(hi)); return r; }

struct EpiBf16 {
    static constexpr bool PERM = true, AFTER_DRAIN = false;
    bf16_t* O; int ldc;
    __device__ __forceinline__ void operator()(const f32x4 (&acc)[2][2][4][2], const Unit& u, int wr, int wc, int fr, int fq) const {
        const int row0 = u.pm * BM + wr * 64 + fr; const int col0 = u.pn * BM + wc * 32 + 8 * fq;
#pragma unroll
        for (int ai = 0; ai < 2; ++ai)
#pragma unroll
            for (int m = 0; m < 4; ++m) { bf16_t* rowp = O + (size_t)(row0 + ai * HALF + m * 16) * ldc + col0;
#pragma unroll
                for (int bj = 0; bj < 2; ++bj) { const f32x4 v0 = acc[ai][bj][m][0], v1 = acc[ai][bj][m][1];
                    u32x4 w; w.x = cvt_pk_bf16(v0[0], v0[1]); w.y = cvt_pk_bf16(v0[2], v0[3]); w.z = cvt_pk_bf16(v1[0], v1[1]); w.w = cvt_pk_bf16(v1[2], v1[3]);
                    *(u32x4*)(rowp + bj * HALF) = w; } }
    }
};

struct EpiSplit {
    static constexpr bool PERM = true, AFTER_DRAIN = false;
    bf16_t* O; float* part; int ldc;
    __device__ __forceinline__ void operator()(const f32x4 (&acc)[2][2][4][2], const Unit& u, int wr, int wc, int fr, int fq) const {
        const int col0 = u.pn * BM + wc * 32 + 8 * fq;
        if (u.slab < 0) {
            const int row0 = u.pm * BM + wr * 64 + fr;
#pragma unroll
            for (int ai = 0; ai < 2; ++ai)
#pragma unroll
                for (int m = 0; m < 4; ++m) { bf16_t* rowp = O + (size_t)(row0 + ai * HALF + m * 16) * ldc + col0;
#pragma unroll
                    for (int bj = 0; bj < 2; ++bj) { const f32x4 v0 = acc[ai][bj][m][0], v1 = acc[ai][bj][m][1];
                        u32x4 w; w.x = cvt_pk_bf16(v0[0], v0[1]); w.y = cvt_pk_bf16(v0[2], v0[3]); w.z = cvt_pk_bf16(v1[0], v1[1]); w.w = cvt_pk_bf16(v1[2], v1[3]);
                        *(u32x4*)(rowp + bj * HALF) = w; } }
        } else {
            const int row0 = (u.pm == 16 ? 0 : 256) + wr * 64 + fr; float* pb = part + (size_t)u.slab * 512 * ldc;
#pragma unroll
            for (int ai = 0; ai < 2; ++ai)
#pragma unroll
                for (int m = 0; m < 4; ++m) { float* rowp = pb + (size_t)(row0 + ai * HALF + m * 16) * ldc + col0;
#pragma unroll
                    for (int bj = 0; bj < 2; ++bj) { *(f32x4*)(rowp + bj * HALF) = acc[ai][bj][m][0]; *(f32x4*)(rowp + bj * HALF + 4) = acc[ai][bj][m][1]; } }
        }
    }
};

struct EpiInProj {
    static constexpr bool PERM = true, AFTER_DRAIN = false;
    bf16_t* O; int ldc; const float* thd; const float* tdh; const float* gq; const float* gk; PG8_LAS float* xch;
    __device__ __forceinline__ void operator()(f32x4 (&acc)[2][2][4][2], const Unit& u, int wr, int wc, int fr, int fq) const {
        const int pmb = u.pm % 17; const bool ctx = (pmb == 16); const int pn = u.pn;
        const int kind = pn < 4 ? 1 : pn < 8 ? 2 : pn < 12 ? 3 : pn < 16 ? 0 : pn == 16 ? 4 : pn < 18 ? 0 : pn < 22 ? 2 : pn == 26 ? 3 : 0;
        if (kind == 1 || kind == 4) {
            const float* g = (kind == 1 ? gq : gk) + wc * 32 + 8 * fq;
            const f32x4 g0 = *(const f32x4*)g, g1 = *(const f32x4*)(g + 4);
#pragma unroll
            for (int ai = 0; ai < 2; ++ai)
#pragma unroll
                for (int m = 0; m < 4; ++m)
#pragma unroll
                    for (int bj = 0; bj < 2; ++bj) { const f32x4 a = acc[ai][bj][m][0], b = acc[ai][bj][m][1];
                        float s = (a[0] * a[0] + a[1] * a[1]) + (a[2] * a[2] + a[3] * a[3]) + (b[0] * b[0] + b[1] * b[1]) + (b[2] * b[2] + b[3] * b[3]);
                        s += __shfl_xor(s, 16); s += __shfl_xor(s, 32);
                        if (fq == 0) xch[((ai * HALF + wr * 64 + m * 16 + fr) * 2 + bj) * 4 + wc] = s; }
            asm volatile("s_waitcnt lgkmcnt(0)" ::: "memory"); __builtin_amdgcn_s_barrier(); asm volatile("" ::: "memory");
#pragma unroll
            for (int ai = 0; ai < 2; ++ai)
#pragma unroll
                for (int m = 0; m < 4; ++m)
#pragma unroll
                    for (int bj = 0; bj < 2; ++bj) { const f32x4 p = *(const PG8_LAS f32x4*)(xch + ((ai * HALF + wr * 64 + m * 16 + fr) * 2 + bj) * 4);
                        const float rstd = __builtin_amdgcn_rsqf(((p[0] + p[1]) + (p[2] + p[3])) * (1.f / 128.f) + 1e-6f);
                        acc[ai][bj][m][0] = acc[ai][bj][m][0] * rstd * g0; acc[ai][bj][m][1] = acc[ai][bj][m][1] * rstd * g1; }
        }
        if (kind != 0 && !ctx) {
            const bool dh = (kind == 2);
#pragma unroll
            for (int ai = 0; ai < 2; ++ai)
#pragma unroll
                for (int m = 0; m < 4; ++m) { const int t = pmb * 256 + ai * HALF + wr * 64 + m * 16 + fr; const int grow = t >> 6, gcol = t & 63;
                    const float* tp = dh ? tdh + (size_t)((((wc & 1) == 0) ? grow : gcol) * 16 + 4 * fq) * 2 : thd + (size_t)(((wc < 2) ? grow : gcol) * 32 + 16 * (wc & 1) + 4 * fq) * 2;
                    const f32x4 c01 = *(const f32x4*)tp, c23 = *(const f32x4*)(tp + 4);
#pragma unroll
                    for (int bj = 0; bj < 2; ++bj) { f32x4 a = acc[ai][bj][m][0], b = acc[ai][bj][m][1];
                        acc[ai][bj][m][0] = (f32x4){a[0] * c01[0] - a[1] * c01[1], a[0] * c01[1] + a[1] * c01[0], a[2] * c01[2] - a[3] * c01[3], a[2] * c01[3] + a[3] * c01[2]};
                        acc[ai][bj][m][1] = (f32x4){b[0] * c23[0] - b[1] * c23[1], b[0] * c23[1] + b[1] * c23[0], b[2] * c23[2] - b[3] * c23[3], b[2] * c23[3] + b[3] * c23[2]}; } }
        }
        const int row0 = u.pm * BM + wr * 64 + fr; const int col0 = u.pn * BM + wc * 32 + 8 * fq;
#pragma unroll
        for (int ai = 0; ai < 2; ++ai)
#pragma unroll
            for (int m = 0; m < 4; ++m) { bf16_t* rowp = O + (size_t)(row0 + ai * HALF + m * 16) * ldc + col0;
#pragma unroll
                for (int bj = 0; bj < 2; ++bj) { const f32x4 v0 = acc[ai][bj][m][0], v1 = acc[ai][bj][m][1];
                    u32x4 w; w.x = cvt_pk_bf16(v0[0], v0[1]); w.y = cvt_pk_bf16(v0[2], v0[3]); w.z = cvt_pk_bf16(v1[0], v1[1]); w.w = cvt_pk_bf16(v1[2], v1[3]);
                    *(u32x4*)(rowp + bj * HALF) = w; } }
    }
};

template <class Epi, class Sched, bool ALIGN_EPI = false>
__device__ __forceinline__ void gemm_phase(PG8_LAS unsigned char* lds, const Gemm g, const Sched& S, const Epi& E) {
    int tid_ = threadIdx.x; asm volatile("" : "+v"(tid_));
    const int tid = tid_, wid = __builtin_amdgcn_readfirstlane(tid >> 6), lane = tid & 63, wr = wid >> 2, wc = wid & 3, fr = lane & 15, fq = lane >> 4;
    const int K = g.K;
    unsigned voffA[2], voffB[2];
#pragma unroll
    for (int i = 0; i < 2; ++i) { int R, C; stage_rc(tid * 16 + i * 8192, R, C); const int Rb = Epi::PERM ? ((R & ~31) + perm32(R & 31)) : R;
        voffA[i] = (unsigned)(R * K + C) * 2u; voffB[i] = (unsigned)(Rb * K + C) * 2u; }
    const size_t kstep = (size_t)(BK * 2);
    const size_t hstep = (size_t)HALF * K * 2;
    const size_t tstep = 2 * hstep;
    const unsigned ldsw = (unsigned)wid * 1024u;
    const int aoff = lds_byte(wr * 64 + fr, fq * 8), boff = lds_byte(wc * 32 + fr, fq * 8);
#define PG8_SA(b, h) (((b) * 2 + (h)) * HTB)
#define PG8_SB(b, h) ((4 + (b) * 2 + (h)) * HTB)
#define PG8_STAGE(bufoff, gbase, voff) do { _Pragma("unroll") for (int _i = 0; _i < 2; ++_i) \
        __builtin_amdgcn_global_load_lds((const unsigned*)((const char*)(gbase) + (voff)[_i]), (PG8_LAS unsigned*)(lds + (bufoff) + ldsw + _i * 8192), 16, 0, 0); } while (0)
#define PG8_LDA(dst, b, h) do { _Pragma("unroll") for (int m = 0; m < 4; ++m) _Pragma("unroll") for (int k = 0; k < 2; ++k) dst[m][k] = *(const PG8_LAS bf16x8*)(lds + PG8_SA(b, h) + aoff + m * 2048 + k * 1024); } while (0)
#define PG8_LDB(dst, b, h) do { _Pragma("unroll") for (int n = 0; n < 2; ++n) _Pragma("unroll") for (int k = 0; k < 2; ++k) dst[n][k] = *(const PG8_LAS bf16x8*)(lds + PG8_SB(b, h) + boff + n * 2048 + k * 1024); } while (0)
#define PG8_MMA(ai, bj, At, Bt) do { __builtin_amdgcn_s_setprio(1); _Pragma("unroll") for (int m = 0; m < 4; ++m) _Pragma("unroll") for (int n = 0; n < 2; ++n) _Pragma("unroll") for (int k = 0; k < 2; ++k) \
        acc[ai][bj][m][n] = __builtin_amdgcn_mfma_f32_16x16x32_bf16(Bt[n][k], At[m][k], acc[ai][bj][m][n], 0, 0, 0); __builtin_amdgcn_s_setprio(0); } while (0)
#define PG8_WAIT_V(n) asm volatile("s_waitcnt vmcnt(" #n ")" ::: "memory")
#define PG8_WAIT_L(n) asm volatile("s_waitcnt lgkmcnt(" #n ")" ::: "memory")
#define PG8_BAR __builtin_amdgcn_s_barrier()
#define PG8_SCHED __builtin_amdgcn_sched_barrier(0)
    Unit cur, nxt; int ui = 0;
    if (!S.next(0, cur)) return;
    f32x4 acc[2][2][4][2];
#pragma unroll
    for (int a = 0; a < 2; ++a)
#pragma unroll
        for (int b = 0; b < 2; ++b)
#pragma unroll
            for (int m = 0; m < 4; ++m)
#pragma unroll
                for (int n = 0; n < 2; ++n) acc[a][b][m][n] = (f32x4){0.f, 0.f, 0.f, 0.f};
    bf16x8 At[4][2], B0[2][2], B1[2][2];
    const char* cA = (const char*)g.A + (size_t)cur.pm * tstep + (size_t)cur.kt0 * kstep; const char* cB = (const char*)g.Bt + (size_t)cur.pn * tstep + (size_t)cur.kt0 * kstep;
    S.a_ready(cur);
    PG8_STAGE(PG8_SB(0, 0), cB, voffB); PG8_STAGE(PG8_SB(0, 1), cB + hstep, voffB); PG8_STAGE(PG8_SA(0, 0), cA, voffA); PG8_STAGE(PG8_SA(0, 1), cA + hstep, voffA);
    if (wr == 1) PG8_BAR;
    PG8_WAIT_V(2); PG8_BAR;
    PG8_STAGE(PG8_SB(1, 0), cB + kstep, voffB); PG8_STAGE(PG8_SA(1, 0), cA + kstep, voffA); PG8_STAGE(PG8_SB(1, 1), cB + hstep + kstep, voffB);
    PG8_WAIT_V(6); PG8_BAR;
    for (;;) {
        const bool has_next = S.next(ui + 1, nxt);
        const char* nA = has_next ? (const char*)g.A + (size_t)nxt.pm * tstep + (size_t)nxt.kt0 * kstep : cA; const char* nB = has_next ? (const char*)g.Bt + (size_t)nxt.pn * tstep + (size_t)nxt.kt0 * kstep : cB;
        const int nt = cur.nt;
        for (int t = 0; t < nt; t += 2) {
            const bool last = (t == nt - 2);
            const char* a1 = cA + (size_t)(t + 1) * kstep;
            const char* a2 = last ? nA : cA + (size_t)(t + 2) * kstep; const char* b2 = last ? nB : cB + (size_t)(t + 2) * kstep;
            const char* a3 = a2 + kstep; const char* b3 = b2 + kstep;
            if (last && has_next) S.a_ready(nxt);
            PG8_LDB(B0, 0, 0); PG8_LDB(B1, 0, 1); PG8_SCHED; PG8_LDA(At, 0, 0); PG8_STAGE(PG8_SA(1, 1), a1 + hstep, voffA);
            PG8_WAIT_V(8); PG8_WAIT_L(0); PG8_BAR; PG8_MMA(0, 0, At, B0); PG8_MMA(0, 1, At, B1); PG8_BAR; PG8_SCHED;
            PG8_LDA(At, 0, 1); PG8_STAGE(PG8_SB(0, 0), b2, voffB); PG8_STAGE(PG8_SB(0, 1), b2 + hstep, voffB); PG8_STAGE(PG8_SA(0, 0), a2, voffA);
            PG8_WAIT_V(8); PG8_WAIT_L(0); PG8_BAR; PG8_MMA(1, 0, At, B0); PG8_MMA(1, 1, At, B1); PG8_BAR; PG8_SCHED;
            PG8_LDB(B0, 1, 0); PG8_LDB(B1, 1, 1); PG8_SCHED; PG8_LDA(At, 1, 0); PG8_STAGE(PG8_SA(0, 1), a2 + hstep, voffA);
            PG8_WAIT_V(8); PG8_WAIT_L(0); PG8_BAR; PG8_MMA(0, 0, At, B0); PG8_MMA(0, 1, At, B1); PG8_BAR; PG8_SCHED;
            PG8_LDA(At, 1, 1); PG8_STAGE(PG8_SB(1, 0), b3, voffB); PG8_STAGE(PG8_SB(1, 1), b3 + hstep, voffB); PG8_STAGE(PG8_SA(1, 0), a3, voffA);
            PG8_WAIT_V(8); PG8_WAIT_L(0); PG8_BAR; PG8_MMA(1, 0, At, B0); PG8_MMA(1, 1, At, B1); PG8_BAR; PG8_SCHED;
        }
        if constexpr (ALIGN_EPI) { if (wr == 0) PG8_BAR; }
        if constexpr (!Epi::AFTER_DRAIN) { E(acc, cur, wr, wc, fr, fq); S.done(cur); }
        if (!has_next) break;
#pragma unroll
        for (int a = 0; a < 2; ++a)
#pragma unroll
            for (int b = 0; b < 2; ++b)
#pragma unroll
                for (int m = 0; m < 4; ++m)
#pragma unroll
                    for (int n = 0; n < 2; ++n) acc[a][b][m][n] = (f32x4){0.f, 0.f, 0.f, 0.f};
        cur = nxt; cA = nA; cB = nB; ++ui;
        if constexpr (ALIGN_EPI) { if (wr == 1) PG8_BAR; }
    }
    PG8_WAIT_V(0);
    if constexpr (!ALIGN_EPI) { if (wr == 0) PG8_BAR; }
    PG8_BAR;
#undef PG8_SA
#undef PG8_SB
#undef PG8_STAGE
#undef PG8_LDA
#undef PG8_LDB
#undef PG8_MMA
#undef PG8_WAIT_V
#undef PG8_WAIT_L
#undef PG8_BAR
#undef PG8_SCHED
}
}

namespace att {
#define ALAS __attribute__((address_space(3)))
typedef unsigned short bf16;
typedef short bf16x8 __attribute__((ext_vector_type(8)));
typedef short s16x4 __attribute__((ext_vector_type(4)));
typedef float f32x16 __attribute__((ext_vector_type(16)));
typedef unsigned u32x4 __attribute__((ext_vector_type(4)));
constexpr int LDP = 9216, LDO = 4096;
constexpr int SLOT = 32768;
constexpr int WSCR_OFF = 131072 + 1024, BIAS_OFF = WSCR_OFF + 2048, SHM_END = BIAS_OFF + 2048;
constexpr int NCTX_T = 4;
#define KSWZ(row, colB) ((row) * 256 + ((colB) ^ (((row) & 7) << 4)))
#define SBAR() __builtin_amdgcn_sched_barrier(0)
__device__ __forceinline__ int crow(int r, int hi) { return (r & 3) + 8 * (r >> 2) + 4 * hi; }
__device__ __forceinline__ unsigned cvtpk(float lo, float hi) { unsigned r; asm volatile("v_cvt_pk_bf16_f32 %0, %1, %2" : "=v"(r) : "v"(lo), "v"(hi)); return r; }

__device__ __forceinline__ void partialSM(f32x16& p0, f32x16& p1, float& m_reg, float& mn, float& alpha, const float C, const float thr_raw) {
    float pmax = p0[0];
#pragma unroll
    for (int r = 1; r < 16; ++r) pmax = fmaxf(pmax, p0[r]);
#pragma unroll
    for (int r = 0; r < 16; ++r) pmax = fmaxf(pmax, p1[r]);
    { auto rr = __builtin_amdgcn_permlane32_swap(__float_as_uint(pmax), __float_as_uint(pmax), false, false);
      pmax = fmaxf(__uint_as_float(rr[0]), __uint_as_float(rr[1])); }
    if (__builtin_expect(__all(pmax - m_reg <= thr_raw), 1)) { mn = m_reg; alpha = 1.f; }
    else { mn = fmaxf(m_reg, pmax); alpha = __builtin_amdgcn_exp2f((m_reg - mn) * C); m_reg = mn; }
    const float mnC = -mn * C;
#pragma unroll
    for (int r = 0; r < 16; ++r) p0[r] = fmaf(p0[r], C, mnC);
#pragma unroll
    for (int r = 0; r < 16; ++r) p1[r] = fmaf(p1[r], C, mnC);
#pragma unroll
    for (int r = 0; r < 16; ++r) p0[r] = __builtin_amdgcn_exp2f(p0[r]);
}
__device__ __forceinline__ void finishSM(f32x16& p0, f32x16& p1, float alpha, float& l_reg, bf16x8& pa0, bf16x8& pa1, bf16x8& pa2, bf16x8& pa3) {
#pragma unroll
    for (int r = 0; r < 16; ++r) p1[r] = __builtin_amdgcn_exp2f(p1[r]);
    float ps = 0;
#pragma unroll
    for (int r = 0; r < 16; ++r) ps += p0[r];
#pragma unroll
    for (int r = 0; r < 16; ++r) ps += p1[r];
    { auto rr = __builtin_amdgcn_permlane32_swap(__float_as_uint(ps), __float_as_uint(ps), false, false);
      ps = __uint_as_float(rr[0]) + __uint_as_float(rr[1]); }
    l_reg = l_reg * alpha + ps;
#define PK4(P, BASE, OUT) do { unsigned a0 = cvtpk(P[BASE + 0], P[BASE + 1]), a1 = cvtpk(P[BASE + 2], P[BASE + 3]);   \
    unsigned b0 = cvtpk(P[BASE + 4], P[BASE + 5]), b1 = cvtpk(P[BASE + 6], P[BASE + 7]);                              \
    auto r0 = __builtin_amdgcn_permlane32_swap(a0, b0, false, false); auto r1 = __builtin_amdgcn_permlane32_swap(a1, b1, false, false); \
    u32x4 w = {r0[0], r1[0], r0[1], r1[1]}; OUT = __builtin_bit_cast(bf16x8, w); } while (0)
    PK4(p0, 0, pa0); PK4(p0, 8, pa1); PK4(p1, 0, pa2); PK4(p1, 8, pa3);
#undef PK4
}
template <int D0LO, int D0N>
__device__ __forceinline__ void qkt(f32x16& p0, f32x16& p1, const ALAS char* Ks, const bf16x8* qr, int r32, int hi) {
    p0 = f32x16{}; p1 = f32x16{};
#pragma unroll
    for (int d0 = D0LO; d0 < D0LO + D0N; ++d0) { const int cb = (d0 * 16 + hi * 8) * 2;
        const bf16x8 b0 = *(const ALAS bf16x8*)(Ks + KSWZ(r32, cb));
        const bf16x8 b1 = *(const ALAS bf16x8*)(Ks + KSWZ(32 + r32, cb));
        p0 = __builtin_amdgcn_mfma_f32_32x32x16_bf16(b0, qr[d0], p0, 0, 0, 0);
        p1 = __builtin_amdgcn_mfma_f32_32x32x16_bf16(b1, qr[d0], p1, 0, 0, 0); }
}
__device__ __forceinline__ int v_st(int k, int c) { const int kk = (k & ~0xC) | ((k & 4) << 1) | ((k & 8) >> 1); return ((kk >> 3) * 4 + (c >> 5)) * 512 + ((kk & 7) * 32 + (c & 31)) * 2; }
__device__ __forceinline__ int v_rd_base(int lane) { return ((lane & 3) << 3) | (((lane >> 2) & 3) << 6) | (((lane >> 4) & 1) << 5) | (((lane >> 5) & 1) << 8); }
constexpr int v_rd_off(int d0, int ks, int half) { return d0 * 512 + ks * 4096 + half * 2048; }
template <int OFF> __device__ __forceinline__ s16x4 tr_read(int vb) {
    s16x4 r; asm volatile("ds_read_b64_tr_b16 %0, %1 offset:%2" : "=&v"(r) : "v"(vb), "i"(OFF) : "memory"); return r;
}
template <int D0> __device__ __forceinline__ void pv_one(f32x16& od, int vb, bf16x8 pa0, bf16x8 pa1, bf16x8 pa2, bf16x8 pa3) {
    const s16x4 l0 = tr_read<v_rd_off(D0, 0, 0)>(vb), h0 = tr_read<v_rd_off(D0, 0, 1)>(vb), l1 = tr_read<v_rd_off(D0, 1, 0)>(vb), h1 = tr_read<v_rd_off(D0, 1, 1)>(vb);
    const s16x4 l2 = tr_read<v_rd_off(D0, 2, 0)>(vb), h2 = tr_read<v_rd_off(D0, 2, 1)>(vb), l3 = tr_read<v_rd_off(D0, 3, 0)>(vb), h3 = tr_read<v_rd_off(D0, 3, 1)>(vb);
    asm volatile("s_waitcnt lgkmcnt(0)" ::: "memory"); SBAR();
#define PK(L, H) (bf16x8){L[0], L[1], L[2], L[3], H[0], H[1], H[2], H[3]}
    od = __builtin_amdgcn_mfma_f32_32x32x16_bf16(pa0, PK(l0, h0), od, 0, 0, 0);
    od = __builtin_amdgcn_mfma_f32_32x32x16_bf16(pa1, PK(l1, h1), od, 0, 0, 0);
    od = __builtin_amdgcn_mfma_f32_32x32x16_bf16(pa2, PK(l2, h2), od, 0, 0, 0);
    od = __builtin_amdgcn_mfma_f32_32x32x16_bf16(pa3, PK(l3, h3), od, 0, 0, 0);
#undef PK
}
__device__ __forceinline__ void pv_d0(f32x16* o, int vb, bf16x8 pa0, bf16x8 pa1, bf16x8 pa2, bf16x8 pa3) {
    pv_one<0>(o[0], vb, pa0, pa1, pa2, pa3); pv_one<1>(o[1], vb, pa0, pa1, pa2, pa3); pv_one<2>(o[2], vb, pa0, pa1, pa2, pa3); pv_one<3>(o[3], vb, pa0, pa1, pa2, pa3);
}

template <int MASK>
__device__ __forceinline__ void apply_mask(f32x16& p0, f32x16& p1, int j, int loc0, int qp, int hi, const ALAS float* bias) {
    if constexpr (MASK == 2) {
        if (j >= NCTX_T) { const int kbase = loc0 + 64 * (j - NCTX_T);
#pragma unroll
            for (int r = 0; r < 16; ++r) { const int d0 = qp - (kbase + crow(r, hi)); const int d1 = d0 - 32;
                if (d0 > 128 || d0 < -128) p0[r] = -1e30f;
                if (d1 > 128 || d1 < -128) p1[r] = -1e30f; } }
    } else if constexpr (MASK == 3) {
        if (j >= NCTX_T) { const int kbase = loc0 + 64 * (j - NCTX_T);
            const int qrow = qp >> 6, qcol = qp & 63; const int rs = min(max(qrow - 4, 0), 56), cs = min(max(qcol - 8, 0), 48);
            const int kr = kbase >> 6; const int dr = kr - rs;
            if (dr < 0 || dr >= 8) {
#pragma unroll
                for (int r = 0; r < 16; ++r) { p0[r] = -1e30f; p1[r] = -1e30f; }
            } else {
                const ALAS float* brow = bias + (kr - qrow + 7) * 31 + 15 - qcol;
#pragma unroll
                for (int r = 0; r < 16; ++r) { const int kc0 = crow(r, hi), kc1 = kc0 + 32;
                    const bool ok0 = (unsigned)(kc0 - cs) < 16u, ok1 = (unsigned)(kc1 - cs) < 16u;
                    const float b0 = brow[ok0 ? kc0 : qcol], b1 = brow[ok1 ? kc1 : qcol];
                    p0[r] = ok0 ? p0[r] + b0 : -1e30f; p1[r] = ok1 ? p1[r] + b1 : -1e30f;
                    if ((r & 3) == 3) asm volatile("" ::: "memory"); }
            }
        }
    }
}

template <int MASK, int D0LO, int D0N>
__device__ __forceinline__ void attn_core(f32x16 (&o)[4], float& m_reg, float& l_reg, const bf16* __restrict__ Qw, const bf16* __restrict__ Kb, const bf16* __restrict__ Vb,
                                          const int nloc, const int loc0, const int qp, const float C, const float thr_raw, ALAS char* lds) {
    int tid_ = threadIdx.x; asm volatile("" : "+v"(tid_));
    const int tid = tid_, wid = __builtin_amdgcn_readfirstlane(tid >> 6), lane = tid & 63, r32 = lane & 31, hi = lane >> 5;
    ALAS float* ws = (ALAS float*)(lds + WSCR_OFF) + wid * 64; ALAS float* al_l = ws + 32;
    const ALAS float* bias = (const ALAS float*)(lds + BIAS_OFF);
    unsigned voffK[2], voffV[2];
#pragma unroll
    for (int i = 0; i < 2; ++i) { const int q = (wid + 8 * i) * 64 + lane;
        { const int row = q >> 4, cc = (q & 15) ^ (row & 7); voffK[i] = (unsigned)(row * (LDP * 2) + cc * 16); }
        { const int kk = (q >> 7) * 8 + ((q & 31) >> 2), c = ((q >> 5) & 3) * 32 + (q & 3) * 8; const int k = (kk & ~0xC) | ((kk & 4) << 1) | ((kk & 8) >> 1); voffV[i] = (unsigned)(k * (LDP * 2) + c * 2); } }
    const int NT = NCTX_T + nloc;
#define KOFF(j) ((j) < NCTX_T ? 4096 + 64 * (j) : loc0 + 64 * ((j) - NCTX_T))
#define ISSUE(j) do { const size_t _ro = (size_t)KOFF(j) * (LDP * 2); const char* _gk = (const char*)Kb + _ro; const char* _gv = (const char*)Vb + _ro; ALAS char* _sl = lds + ((j) & 3) * SLOT + wid * 1024; \
    _Pragma("unroll") for (int _i = 0; _i < 2; ++_i) __builtin_amdgcn_global_load_lds((const unsigned*)(_gk + voffK[_i]), (ALAS unsigned*)(_sl + _i * 8192), 16, 0, 0); \
    _Pragma("unroll") for (int _i = 0; _i < 2; ++_i) __builtin_amdgcn_global_load_lds((const unsigned*)(_gv + voffV[_i]), (ALAS unsigned*)(_sl + 16384 + _i * 8192), 16, 0, 0); } while (0)
#define WAITBAR(n) do { asm volatile("s_waitcnt vmcnt(" #n ") lgkmcnt(0)" ::: "memory"); __builtin_amdgcn_s_barrier(); asm volatile("" ::: "memory"); } while (0)
#define RESC(a) do { if (__any((a) < 1.f)) { if (hi == 0) al_l[r32] = (a); asm volatile("s_waitcnt lgkmcnt(0)" ::: "memory"); \
    _Pragma("unroll") for (int d = 0; d < 4; ++d) _Pragma("unroll") for (int r = 0; r < 16; ++r) o[d][r] *= al_l[crow(r, hi)]; } } while (0)
    asm volatile("s_waitcnt vmcnt(0)" ::: "memory");
    m_reg = -1e30f; l_reg = 0.f;
#pragma unroll
    for (int d = 0; d < 4; ++d) o[d] = f32x16{};
    bf16x8 qr[8];
#pragma unroll
    for (int d0 = 0; d0 < 8; ++d0) qr[d0] = *(const bf16x8*)(Qw + d0 * 16);
    ISSUE(0); ISSUE(1); ISSUE(2);
    const int vb0 = (int)(uintptr_t)lds + 16384 + v_rd_base(lane);
    f32x16 pA0, pA1, pB0, pB1; float mnA, mnB, alA, alB; bf16x8 pa0, pa1, pa2, pa3;
    WAITBAR(8);
    qkt<D0LO, D0N>(pA0, pA1, lds, qr, r32, hi); apply_mask<MASK>(pA0, pA1, 0, loc0, qp, hi, bias); partialSM(pA0, pA1, m_reg, mnA, alA, C, thr_raw);
    WAITBAR(4);
    ISSUE(3);
    for (int j = 1; j + 1 < NT; j += 2) {
        SBAR(); qkt<D0LO, D0N>(pB0, pB1, lds + (j & 3) * SLOT, qr, r32, hi);
        finishSM(pA0, pA1, alA, l_reg, pa0, pa1, pa2, pa3); SBAR();
        pv_d0(o, vb0 + ((j - 1) & 3) * SLOT, pa0, pa1, pa2, pa3); apply_mask<MASK>(pB0, pB1, j, loc0, qp, hi, bias); partialSM(pB0, pB1, m_reg, mnB, alB, C, thr_raw);
        if (j + 2 < NT) { WAITBAR(4); } else { WAITBAR(0); }
        if (j + 3 < NT) ISSUE(j + 3);
        RESC(alB);
        SBAR(); qkt<D0LO, D0N>(pA0, pA1, lds + ((j + 1) & 3) * SLOT, qr, r32, hi);
        finishSM(pB0, pB1, alB, l_reg, pa0, pa1, pa2, pa3); SBAR();
        pv_d0(o, vb0 + (j & 3) * SLOT, pa0, pa1, pa2, pa3); apply_mask<MASK>(pA0, pA1, j + 1, loc0, qp, hi, bias); partialSM(pA0, pA1, m_reg, mnA, alA, C, thr_raw);
        if (j + 3 < NT) { WAITBAR(4); } else { WAITBAR(0); }
        if (j + 4 < NT) ISSUE(j + 4);
        RESC(alA);
    }
    SBAR(); qkt<D0LO, D0N>(pB0, pB1, lds + ((NT - 1) & 3) * SLOT, qr, r32, hi);
    finishSM(pA0, pA1, alA, l_reg, pa0, pa1, pa2, pa3); SBAR();
    pv_d0(o, vb0 + ((NT - 2) & 3) * SLOT, pa0, pa1, pa2, pa3); apply_mask<MASK>(pB0, pB1, NT - 1, loc0, qp, hi, bias); partialSM(pB0, pB1, m_reg, mnB, alB, C, thr_raw);
    RESC(alB);
    finishSM(pB0, pB1, alB, l_reg, pa0, pa1, pa2, pa3); SBAR();
    pv_d0(o, vb0 + ((NT - 1) & 3) * SLOT, pa0, pa1, pa2, pa3);
#undef KOFF
#undef ISSUE
#undef WAITBAR
#undef RESC
}
}

constexpr int NWAVES = 8;
constexpr int DM = 4096, NB = 2, SEQ = 4096, CTXL = 256, TPB = SEQ + CTXL  , MROWS = NB * TPB  ;
constexpr int NIN = 9216, DFF = 11008, NUP = 2 * DFF, NADA = 6 * DM;
constexpr int QA = 0, QB_ = 1024, QC = 2048, QD = 3072, KA = 4096, VA = 4352, KB_ = 4608, VB_ = 5632, KC = 6656, VC = 6912, KD = 7168, VD = 8192;
constexpr float EPS = 1e-6f;
constexpr int NPHASE = 18;

constexpr size_t MiB = 1u << 20;
constexpr size_t WS_CTL = 0, CTL_ZERO_BYTES = 1 * MiB;
constexpr size_t WS_MOD = 1 * MiB;
constexpr size_t WS_TAB = 2 * MiB;
constexpr size_t WS_WIN = 4 * MiB;
constexpr size_t WS_WOUT = WS_WIN + 2 * 72 * MiB;
constexpr size_t WS_WUP = WS_WOUT + 2 * 32 * MiB;
constexpr size_t WS_WDN = WS_WUP + 2 * 172 * MiB;
constexpr size_t WS_XS = WS_WDN + 2 * 86 * MiB;
constexpr size_t WS_HX = WS_XS + 136 * MiB;
constexpr size_t WS_P = WS_HX + 68 * MiB;
constexpr size_t WS_O = WS_P + 153 * MiB;
constexpr size_t WS_Y = WS_O + 68 * MiB;
constexpr size_t WS_U = WS_Y + 68 * MiB;
constexpr size_t WS_ACT = WS_U + 366 * MiB;
constexpr size_t WS_STASH = WS_ACT + 183 * MiB;
constexpr size_t WS_PART = WS_STASH + 32 * MiB;
constexpr size_t WS_END = WS_PART + 64 * MiB;
static_assert((size_t)MROWS * NUP * 2 <= 366 * MiB && (size_t)MROWS * DFF * 2 <= 183 * MiB && (size_t)MROWS * NIN * 2 <= 153 * MiB, "ws map");
constexpr int CW_BAR = 4096;

constexpr int RING_OFF = 0, RING_BYTES = 131072;
constexpr int LDSCTL_OFF = RING_BYTES, MISC_OFF = LDSCTL_OFF + 320;
constexpr int LDS_BYTES = 147456;
constexpr int XCH_OFF = att::SHM_END;
static_assert(XCH_OFF + 8192 <= LDS_BYTES && att::WSCR_OFF >= MISC_OFF + 128, "LDS map");

#define GAS __attribute__((address_space(1)))
#define LAS __attribute__((address_space(3)))
typedef unsigned short bf16;
typedef unsigned v4u __attribute__((ext_vector_type(4)));
typedef unsigned v2u __attribute__((ext_vector_type(2)));
typedef float f32x4 __attribute__((ext_vector_type(4)));
typedef float f32x2 __attribute__((ext_vector_type(2)));
typedef GAS unsigned gu32;
#define RLX_AGENT __ATOMIC_RELAXED, __HIP_MEMORY_SCOPE_AGENT
#define LDS_WAIT() asm volatile("s_waitcnt lgkmcnt(0)" ::: "memory")
#define VM_WAIT() asm volatile("s_waitcnt vmcnt(0)" ::: "memory")
__device__ __forceinline__ unsigned f2bf(float f) { unsigned u = __builtin_bit_cast(unsigned, f); return (u + 0x7fffu + ((u >> 16) & 1u)) >> 16; }
__device__ __forceinline__ unsigned pk2(float lo, float hi) { return f2bf(lo) | (f2bf(hi) << 16); }
__device__ __forceinline__ float bf_lo(unsigned w) { return __uint_as_float(w << 16); }
__device__ __forceinline__ float bf_hi(unsigned w) { return __uint_as_float(w & 0xffff0000u); }

#define XB_TMO      128
#define XB_XCNT(j)  (256  + 64 * (j))
#define XB_XSUB(j)  (1280 + 64 * (j))
#define XB_XGEN(j)  (2304 + 64 * (j))
#define XB_TOP      3328
#define XB_TOPGEN   3392
#define XCD_BAR_WORDS 3456
#define XB_SPIN_CAP (1u << 24)

__device__ __forceinline__ unsigned xb_ld(unsigned* p)              { return __hip_atomic_load(p, __ATOMIC_RELAXED, __HIP_MEMORY_SCOPE_AGENT); }
__device__ __forceinline__ unsigned xb_add(unsigned* p, unsigned v) { return __hip_atomic_fetch_add(p, v, __ATOMIC_RELAXED, __HIP_MEMORY_SCOPE_AGENT); }
__device__ __forceinline__ unsigned xb_xcc_id() { return (unsigned)__builtin_amdgcn_s_getreg((3 << 11) | 20) & 0xFu; }
#define XB_SPIN(cond, bar) do { unsigned _sp = 0; while (cond) { __builtin_amdgcn_s_sleep(1); \
    if ((++_sp & 255u) == 0u) { if (xb_ld(&(bar)[XB_TMO])) break; if (_sp > XB_SPIN_CAP) { atomicAdd(&(bar)[XB_TMO], 1u); break; } } } } while (0)

struct XcdBarrier { unsigned* bar; unsigned x; volatile LAS unsigned* st; };

__device__ __forceinline__ XcdBarrier xcd_barrier_post(unsigned* bar, volatile LAS unsigned* st) {
    XcdBarrier b; b.bar = bar; b.x = xb_xcc_id(); b.st = st;
    if (threadIdx.x == 0) (void)xb_add(&bar[XB_XCNT(b.x)], 1u);
    return b;
}
__device__ __forceinline__ void xcd_barrier_complete(unsigned* bar, unsigned x, unsigned& nloc, unsigned& nx) {
    const unsigned G = gridDim.x * gridDim.y * gridDim.z;
    unsigned sum, cnt, mine, sp = 0u;
    for (;;) {
        sum = 0u; cnt = 0u; mine = 0u;
#pragma unroll
        for (unsigned j = 0; j < 16; ++j) { const unsigned c = xb_ld(&bar[XB_XCNT(j)]); sum += c; cnt += (c > 0u) ? 1u : 0u; mine = (j == x) ? c : mine; }
        if (sum == G) break;
        __builtin_amdgcn_s_sleep(1);
        if ((++sp & 255u) == 0u) { if (xb_ld(&bar[XB_TMO])) break; if (sp > XB_SPIN_CAP) { atomicAdd(&bar[XB_TMO], 1u); break; } }
    }
    nloc = mine > 0u ? mine : 1u; nx = cnt > 0u ? cnt : 1u;
}
__device__ __forceinline__ void xcd_barrier(const XcdBarrier& b) {
    asm volatile("s_waitcnt vmcnt(0)" ::: "memory");
    __syncthreads();
    if (threadIdx.x == 0) {
        unsigned* bar = b.bar;
        __builtin_amdgcn_s_waitcnt(0);
        unsigned nloc = b.st[0], nx = b.st[1];
        if (nloc == 0u) { xcd_barrier_complete(bar, b.x, nloc, nx); b.st[0] = nloc; b.st[1] = nx; }
        const unsigned old = xb_add(&bar[XB_XSUB(b.x)], 1u);
        const unsigned gen = old / nloc;
        if (old + 1u == (gen + 1u) * nloc) {
            __builtin_amdgcn_fence(__ATOMIC_RELEASE, "agent");
            asm volatile("s_waitcnt vmcnt(0)" ::: "memory");
            const unsigned og = xb_add(&bar[XB_TOP], 1u);
            const unsigned tg = og / nx;
            if (og + 1u == (tg + 1u) * nx) xb_add(&bar[XB_TOPGEN], 1u);
            else XB_SPIN(xb_ld(&bar[XB_TOPGEN]) == tg, bar);
            __builtin_amdgcn_fence(__ATOMIC_ACQUIRE, "agent");
            xb_add(&bar[XB_XGEN(b.x)], 1u);
            asm volatile("s_waitcnt vmcnt(0)" ::: "memory");
        } else {
            XB_SPIN(xb_ld(&bar[XB_XGEN(b.x)]) == gen, bar);
            __builtin_amdgcn_fence(__ATOMIC_ACQUIRE, "agent");
            asm volatile("s_waitcnt vmcnt(0)" ::: "memory");
        }
    }
    __syncthreads();
}

struct Args {
    const float* in[24]; float* out; unsigned char* ws; int ph_lo, ph_hi;
};
typedef __attribute__((address_space(4))) const Args* KArgs;
struct Frame {
    LAS unsigned char* lds;
    int tid, lane, wave, vcu, G;
    unsigned char* ws;
};

__device__ __forceinline__ int fresh_bx() { int bx = blockIdx.x; asm volatile("" : "+s"(bx)); return bx; }
__device__ __forceinline__ float wave_sum(float v) {
#pragma unroll
    for (int o = 1; o < 64; o <<= 1) v += __shfl_xor(v, o);
    return v;
}

__device__ const float INV32[32] = {
    1.0f, 0.74989420933f, 0.56234132519f, 0.42169650343f, 0.31622776602f, 0.23713737057f, 0.17782794100f, 0.13335214322f,
    0.1f, 0.074989420933f, 0.056234132519f, 0.042169650343f, 0.031622776602f, 0.023713737057f, 0.017782794100f, 0.013335214322f,
    0.01f, 0.0074989420933f, 0.0056234132519f, 0.0042169650343f, 0.0031622776602f, 0.0023713737057f, 0.0017782794100f, 0.0013335214322f,
    0.001f, 0.00074989420933f, 0.00056234132519f, 0.00042169650343f, 0.00031622776602f, 0.00023713737057f, 0.00017782794100f, 0.00013335214322f };
__device__ const float INV16[16] = {
    1.0f, 0.56234132519f, 0.31622776602f, 0.17782794100f, 0.1f, 0.056234132519f, 0.031622776602f, 0.017782794100f,
    0.01f, 0.0056234132519f, 0.0031622776602f, 0.0017782794100f, 0.001f, 0.00056234132519f, 0.00031622776602f, 0.00017782794100f };

__device__ __forceinline__ void sincos_acc(float af, float& c, float& s) {
    const double a = (double)af; const double kd = __builtin_rint(a * 0.63661977236758134308); const int k = (int)kd;
    const double r = (a - kd * 1.57079632679489655800) - kd * 6.12323399573676603587e-17; const double r2 = r * r;
    const double sn = r * (1.0 + r2 * (-1.0 / 6 + r2 * (1.0 / 120 + r2 * (-1.0 / 5040 + r2 * (1.0 / 362880 + r2 * (-1.0 / 39916800 + r2 * (1.0 / 6227020800.0)))))));
    const double cs = 1.0 + r2 * (-0.5 + r2 * (1.0 / 24 + r2 * (-1.0 / 720 + r2 * (1.0 / 40320 + r2 * (-1.0 / 3628800 + r2 * (1.0 / 479001600.0 + r2 * (-1.0 / 87178291200.0)))))));
    double cc, ss;
    switch (k & 3) { case 0: cc = cs; ss = sn; break; case 1: cc = -sn; ss = cs; break; case 2: cc = -cs; ss = -sn; break; default: cc = sn; ss = -cs; break; }
    c = (float)cc; s = (float)ss;
}

__device__ __forceinline__ void p0_transpose_item(const float* W, int K, int N, bf16* WT, LAS float* scr, int item, int lane) {
    const int nblk = N / 32, kb = item / nblk, nb = item % nblk, k0 = 64 * kb, n0 = 32 * nb;
#pragma unroll 8
    for (int i = 0; i < 32; ++i) { const int kk = 2 * i + (lane >> 5); scr[kk * 33 + (lane & 31)] = W[(size_t)(k0 + kk) * N + n0 + (lane & 31)]; }
    LDS_WAIT(); asm volatile("" ::: "memory");
    const int c = lane & 7;
#pragma unroll
    for (int j = 0; j < 4; ++j) { const int n = (lane >> 3) + 8 * j; const LAS float* s = scr + (8 * c) * 33 + n;
        v4u o; o.x = pk2(s[0 * 33], s[1 * 33]); o.y = pk2(s[2 * 33], s[3 * 33]); o.z = pk2(s[4 * 33], s[5 * 33]); o.w = pk2(s[6 * 33], s[7 * 33]);
        *(GAS v4u*)(WT + (size_t)(n0 + n) * K + k0 + 8 * c) = o; }
    LDS_WAIT(); asm volatile("" ::: "memory");
}

__device__ __forceinline__ float silu_f(float x) { return x / (1.f + __expf(-x)); }

__device__ __forceinline__ void phase_prologue(Frame& F, KArgs a) {
    const float* c_in = a->in[1]; const float* cctx = a->in[3]; const float* w_ada = a->in[4]; const float* b_ada = a->in[5];
    float* mod = (float*)(F.ws + WS_MOD);
    if (F.vcu == 0) {
        f32x2* thd = (f32x2*)(F.ws + WS_TAB);
        for (int e = F.tid; e < 64 * 32; e += NWAVES * 64) { const int pos = e >> 5, i = e & 31; float c, s; sincos_acc((float)pos * INV32[i], c, s); thd[e] = (f32x2){c, s}; }
        f32x2* tdh = (f32x2*)(F.ws + WS_TAB + 16384);
        for (int e = F.tid; e < 64 * 16; e += NWAVES * 64) { const int pos = e >> 4, i = e & 15; float c, s; sincos_acc((float)pos * INV16[i], c, s); tdh[e] = (f32x2){c, s}; }
        if (F.tid < 2) { const int l = F.tid; float s1 = 0.f, s2 = 0.f;
            for (int i = 0; i < 64; ++i) { s1 += a->in[14][l * 64 + i] * a->in[15][l * 64 + i]; s2 += a->in[16][l * 64 + i] * a->in[17][l * 64 + i]; }
            const float lam_init = 0.8f - 0.6f * expf(-0.3f * (float)l);
            float* lam = (float*)(F.ws + WS_TAB + 32768); lam[l * 2 + 0] = expf(s1) - expf(s2) + lam_init; lam[l * 2 + 1] = 1.f - lam_init; }
    }
    {
        LAS float* sv = (LAS float*)(F.lds + RING_OFF);
        LAS float* red = (LAS float*)(F.lds + RING_OFF + 49152);
        for (int e = F.tid; e < 3 * DM; e += NWAVES * 64) { const int v = e / DM, k = e % DM; const float x = v < 2 ? c_in[v * DM + k] : cctx[k]; sv[e] = silu_f(x); }
        __syncthreads();
        const int cg = F.lane & 15, kq = F.lane >> 4;
        for (int it = F.vcu; it < 2 * (NADA / 64); it += F.G) {
            const int l = it / (NADA / 64), ch = it % (NADA / 64);
            const float* W = w_ada + (size_t)l * DM * NADA + ch * 64 + cg * 4;
            f32x4 a0 = {0.f, 0.f, 0.f, 0.f}, a1 = a0, a2 = a0;
#pragma unroll 8
            for (int s = 0; s < DM / 32; ++s) { const int k = s * 32 + F.wave * 4 + kq; const f32x4 w = *(const GAS f32x4*)(W + (size_t)k * NADA);
                a0 += w * sv[k]; a1 += w * sv[DM + k]; a2 += w * sv[2 * DM + k]; }
#pragma unroll
            for (int e = 0; e < 4; ++e) { a0[e] += __shfl_xor(a0[e], 16); a0[e] += __shfl_xor(a0[e], 32); a1[e] += __shfl_xor(a1[e], 16); a1[e] += __shfl_xor(a1[e], 32); a2[e] += __shfl_xor(a2[e], 16); a2[e] += __shfl_xor(a2[e], 32); }
            if (kq == 0) {
#pragma unroll
                for (int e = 0; e < 4; ++e) { red[(F.wave * 3 + 0) * 64 + cg * 4 + e] = a0[e]; red[(F.wave * 3 + 1) * 64 + cg * 4 + e] = a1[e]; red[(F.wave * 3 + 2) * 64 + cg * 4 + e] = a2[e]; } }
            __syncthreads();
            if (F.tid < 192) { const int v = F.tid / 64, cidx = F.tid % 64; float s = 0.f;
#pragma unroll
                for (int w = 0; w < 8; ++w) s += red[(w * 3 + v) * 64 + cidx];
                const int col = ch * 64 + cidx; mod[((size_t)l * 3 + v) * NADA + col] = s + b_ada[(size_t)l * NADA + col]; }
            __syncthreads();
        }
    }
    {
        __syncthreads();
        LAS float* scr = (LAS float*)(F.lds + RING_OFF + F.wave * 16384);
        const int gw = F.vcu * NWAVES + F.wave, NGW = F.G * NWAVES;
        constexpr int I_IN = (DM / 64) * (NIN / 32), I_OUT = (DM / 64) * (DM / 32), I_UP = (DM / 64) * (NUP / 32), I_DN = (DFF / 64) * (DM / 32);
        constexpr int PER_L = I_IN + I_OUT + I_UP + I_DN;
        for (int it = gw; it < 2 * PER_L; it += NGW) {
            const int l = it / PER_L; int r = it % PER_L;
            if (r < I_IN) { p0_transpose_item(a->in[10] + (size_t)l * DM * NIN, DM, NIN, (bf16*)(F.ws + WS_WIN + (size_t)l * 72 * MiB), scr, r, F.lane); continue; } r -= I_IN;
            if (r < I_OUT) { p0_transpose_item(a->in[11] + (size_t)l * DM * DM, DM, DM, (bf16*)(F.ws + WS_WOUT + (size_t)l * 32 * MiB), scr, r, F.lane); continue; } r -= I_OUT;
            if (r < I_UP) { p0_transpose_item(a->in[21] + (size_t)l * DM * NUP, DM, NUP, (bf16*)(F.ws + WS_WUP + (size_t)l * 172 * MiB), scr, r, F.lane); continue; } r -= I_UP;
            p0_transpose_item(a->in[23] + (size_t)l * DFF * DM, DFF, DM, (bf16*)(F.ws + WS_WDN + (size_t)l * 86 * MiB), scr, r, F.lane);
        }
    }
}

struct RowRegs { f32x4 v[16]; };
__device__ __forceinline__ float row_sumsq(const RowRegs& r) {
    float s = 0.f;
#pragma unroll
    for (int j = 0; j < 16; ++j) s += (r.v[j].x * r.v[j].x + r.v[j].y * r.v[j].y) + (r.v[j].z * r.v[j].z + r.v[j].w * r.v[j].w);
    return wave_sum(s);
}
__device__ __forceinline__ void row_load_f32(RowRegs& r, const float* p, int lane) {
    const GAS f32x4* q = (const GAS f32x4*)p + lane;
#pragma unroll
    for (int j = 0; j < 16; ++j) r.v[j] = q[64 * j];
}
__device__ __forceinline__ void row_load_bf16(RowRegs& r, const bf16* p, int lane) {
    const GAS v2u* q = (const GAS v2u*)p + lane;
#pragma unroll
    for (int j = 0; j < 16; ++j) { const v2u w = q[64 * j]; r.v[j] = (f32x4){bf_lo(w.x), bf_hi(w.x), bf_lo(w.y), bf_hi(w.y)}; }
}
__device__ __forceinline__ void row_store_f32(const RowRegs& r, float* p, int lane) {
    GAS f32x4* q = (GAS f32x4*)p + lane;
#pragma unroll
    for (int j = 0; j < 16; ++j) q[64 * j] = r.v[j];
}
__device__ __forceinline__ void row_modnorm_store(const RowRegs& x, float rstd, const float* g, const float* sc, const float* sh, bf16* out, int lane) {
    GAS v2u* q = (GAS v2u*)out + lane;
#pragma unroll
    for (int j = 0; j < 16; ++j) { const int c = 4 * lane + 256 * j;
        const f32x4 gv = *(const GAS f32x4*)(g + c), sv = *(const GAS f32x4*)(sc + c), hv = *(const GAS f32x4*)(sh + c);
        const f32x4 y = (x.v[j] * rstd) * gv * (sv + 1.f) + hv;
        v2u w; w.x = pk2(y.x, y.y); w.y = pk2(y.z, y.w); q[64 * j] = w; }
}
__device__ __forceinline__ void row_residual(RowRegs& x, const RowRegs& y, float rstd, const float* g, const float* gate, int lane) {
#pragma unroll
    for (int j = 0; j < 16; ++j) { const int c = 4 * lane + 256 * j;
        const f32x4 gv = *(const GAS f32x4*)(g + c), tv = *(const GAS f32x4*)(gate + c);
        x.v[j] = x.v[j] + tv * ((y.v[j] * rstd) * gv); }
}

__device__ __forceinline__ void row_load_part(RowRegs& r, const float* part, int lrow, int lane) {
#pragma unroll
    for (int j = 0; j < 16; ++j) r.v[j] = (f32x4){0.f, 0.f, 0.f, 0.f};
#pragma unroll 2
    for (int c = 0; c < 8; ++c) { const GAS f32x4* q = (const GAS f32x4*)(part + ((size_t)c * 512 + lrow) * DM) + lane;
#pragma unroll
        for (int j = 0; j < 16; ++j) r.v[j] += q[64 * j]; }
}

__device__ __forceinline__ void phase_r0(Frame& F, KArgs a) {
    const float* mod = (const float*)(F.ws + WS_MOD); float* xs = (float*)(F.ws + WS_XS); bf16* hx = (bf16*)(F.ws + WS_HX);
    const int gw = F.vcu * NWAVES + F.wave, NGW = F.G * NWAVES;
    for (int m = gw; m < MROWS; m += NGW) {
        const int b = m / TPB, t = m % TPB; const bool lat = t < SEQ;
        const float* src = lat ? a->in[0] + ((size_t)b * SEQ + t) * DM : a->in[2] + ((size_t)b * CTXL + (t - SEQ)) * DM;
        RowRegs x; row_load_f32(x, src, F.lane);
        row_store_f32(x, xs + (size_t)m * DM, F.lane);
        const float rstd = 1.f / sqrtf(row_sumsq(x) * (1.f / DM) + EPS);
        const float* mv = mod + (size_t)(0 * 3 + (lat ? b : 2)) * NADA;
        row_modnorm_store(x, rstd, a->in[6]  , mv + DM, mv, hx + (size_t)m * DM, F.lane);
    }
}
__device__ __forceinline__ void phase_r1(Frame& F, KArgs a, int l, bool last) {
    const float* mod = (const float*)(F.ws + WS_MOD); float* xs = (float*)(F.ws + WS_XS); bf16* hx = (bf16*)(F.ws + WS_HX); const bf16* yb = (const bf16*)(F.ws + WS_Y);
    const int gw = F.vcu * NWAVES + F.wave, NGW = F.G * NWAVES;
    for (int m = gw; m < MROWS; m += NGW) {
        const int b = m / TPB, t = m % TPB; const bool lat = t < SEQ;
        if (last && !lat) continue;
        const float* mv = mod + (size_t)(l * 3 + (lat ? b : 2)) * NADA;
        RowRegs x, y; row_load_f32(x, xs + (size_t)m * DM, F.lane);
        if (lat) row_load_bf16(y, yb + (size_t)m * DM, F.lane); else row_load_part(y, (const float*)(F.ws + WS_PART), b * 256 + (t - SEQ), F.lane);
        const float rstd_y = 1.f / sqrtf(row_sumsq(y) * (1.f / DM) + EPS);
        row_residual(x, y, rstd_y, a->in[7] + (size_t)l * DM, mv + 2 * DM, F.lane);
        row_store_f32(x, xs + (size_t)m * DM, F.lane);
        const float rstd = 1.f / sqrtf(row_sumsq(x) * (1.f / DM) + EPS);
        row_modnorm_store(x, rstd, a->in[8] + (size_t)l * DM, mv + 4 * DM, mv + 3 * DM, hx + (size_t)m * DM, F.lane);
    }
}
__device__ __forceinline__ void phase_r2(Frame& F, KArgs a, int l, bool last) {
    const float* mod = (const float*)(F.ws + WS_MOD); float* xs = (float*)(F.ws + WS_XS); bf16* hx = (bf16*)(F.ws + WS_HX); const bf16* yb = (const bf16*)(F.ws + WS_Y);
    const int gw = F.vcu * NWAVES + F.wave, NGW = F.G * NWAVES;
    for (int m = gw; m < MROWS; m += NGW) {
        const int b = m / TPB, t = m % TPB; const bool lat = t < SEQ;
        if (last && !lat) continue;
        const float* mv = mod + (size_t)(l * 3 + (lat ? b : 2)) * NADA;
        RowRegs x, y; row_load_f32(x, xs + (size_t)m * DM, F.lane);
        if (lat) row_load_bf16(y, yb + (size_t)m * DM, F.lane); else row_load_part(y, (const float*)(F.ws + WS_PART), b * 256 + (t - SEQ), F.lane);
        const float rstd_y = 1.f / sqrtf(row_sumsq(y) * (1.f / DM) + EPS);
        row_residual(x, y, rstd_y, a->in[9] + (size_t)l * DM, mv + 5 * DM, F.lane);
        if (last) { row_store_f32(x, a->out + ((size_t)b * SEQ + t) * DM, F.lane); continue; }
        row_store_f32(x, xs + (size_t)m * DM, F.lane);
        const float rstd = 1.f / sqrtf(row_sumsq(x) * (1.f / DM) + EPS);
        const float* mn = mod + (size_t)((l + 1) * 3 + (lat ? b : 2)) * NADA;
        row_modnorm_store(x, rstd, a->in[6] + (size_t)(l + 1) * DM, mn + DM, mn, hx + (size_t)m * DM, F.lane);
    }
}

__device__ __forceinline__ void phase_conv(Frame& F, KArgs a, int l, bool last) {
    const bf16* U = (const bf16*)(F.ws + WS_U); bf16* ACT = (bf16*)(F.ws + WS_ACT);
    const float* cw = a->in[22] + (size_t)l * 3 * NUP;
    const int gw = F.vcu * NWAVES + F.wave, NGW = F.G * NWAVES;
    constexpr int NCS = DFF / 256  , NBAND = MROWS / 32  ;
    const int half = F.lane >> 5, l32 = F.lane & 31;
    for (int it = gw; it < NBAND * NCS; it += NGW) {
        const int band = it % NBAND, cs = it / NBAND; const int mb = band * 32; const int t0 = mb % TPB;
        if (last && t0 >= SEQ) continue;
        const int seq_lo = (t0 < SEQ) ? (mb - t0) : (mb - t0 + SEQ), seq_hi = (t0 < SEQ) ? (mb - t0 + SEQ) : (mb - t0 + TPB);
        const int m0 = mb + half * 16;
        const int col = cs * 256 + 8 * l32;
        f32x4 wg[3][2], wv[3][2];
#pragma unroll
        for (int j = 0; j < 3; ++j)
#pragma unroll
            for (int q = 0; q < 2; ++q) { wg[j][q] = *(const GAS f32x4*)(cw + (size_t)j * NUP + col + 4 * q); wv[j][q] = *(const GAS f32x4*)(cw + (size_t)j * NUP + DFF + col + 4 * q); }
#pragma unroll 1
        for (int hb = 0; hb < 2; ++hb) {
        const int mh = m0 + 8 * hb;
        v4u rg[10], rv[10];
#pragma unroll
        for (int r = 0; r < 10; ++r) { const int gm = mh - 1 + r;
            if (gm >= seq_lo && gm < seq_hi) { rg[r] = *(const GAS v4u*)(U + (size_t)gm * NUP + col); rv[r] = *(const GAS v4u*)(U + (size_t)gm * NUP + DFF + col); }
            else { rg[r] = (v4u){0u, 0u, 0u, 0u}; rv[r] = rg[r]; } }
#pragma unroll
        for (int r = 0; r < 8; ++r) {
            v4u ow;
#pragma unroll
            for (int q = 0; q < 4; ++q) {
                const int qq = q >> 1, e0 = (q & 1) * 2;
                const float g_lo = bf_lo(rg[r][q]) * wg[0][qq][e0] + bf_lo(rg[r + 1][q]) * wg[1][qq][e0] + bf_lo(rg[r + 2][q]) * wg[2][qq][e0];
                const float g_hi = bf_hi(rg[r][q]) * wg[0][qq][e0 + 1] + bf_hi(rg[r + 1][q]) * wg[1][qq][e0 + 1] + bf_hi(rg[r + 2][q]) * wg[2][qq][e0 + 1];
                const float v_lo = bf_lo(rv[r][q]) * wv[0][qq][e0] + bf_lo(rv[r + 1][q]) * wv[1][qq][e0] + bf_lo(rv[r + 2][q]) * wv[2][qq][e0];
                const float v_hi = bf_hi(rv[r][q]) * wv[0][qq][e0 + 1] + bf_hi(rv[r + 1][q]) * wv[1][qq][e0 + 1] + bf_hi(rv[r + 2][q]) * wv[2][qq][e0 + 1];
                ow[q] = pk2(g_lo / (1.f + __expf(-g_lo)) * v_lo, g_hi / (1.f + __expf(-g_hi)) * v_hi);
            }
            *(GAS v4u*)(ACT + (size_t)(mh + r) * DFF + col) = ow;
        }
        }
    }
}

template <int MASK>
__device__ __forceinline__ void attn_std_unit(Frame& F, const bf16* P, bf16* O, int b, int qrow0  , int qcol, int kcol, int vcol, int ocol,
                                              int nloc, int loc0, float sink, bool has_sink) {
    using namespace att;
    int lane_ = F.lane; asm volatile("" : "+v"(lane_));
    int lane = lane_, wid = F.wave, r32 = lane & 31, hi = lane >> 5;
    constexpr float SCALE = 0.088388347648318440f; constexpr float C = SCALE * 1.4426950408889634f;
    const size_t base = (size_t)b * TPB;
    const bf16* Qw = P + (base + qrow0 + wid * 32 + r32) * LDP + qcol + hi * 8;
    f32x16 o[4]; float m_reg, l_reg;
    attn_core<MASK, 0, 8>(o, m_reg, l_reg, Qw, P + base * LDP + kcol, P + base * LDP + vcol, nloc, loc0, qrow0 + wid * 32 + r32, C, 8.f / SCALE, (ALAS char*)F.lds);
    if (has_sink) l_reg += __builtin_amdgcn_exp2f(sink * 1.4426950408889634f - m_reg * C);
    asm volatile("" : "+v"(lane_)); lane = lane_; r32 = lane & 31; hi = lane >> 5;
    ALAS float* li_l = (ALAS float*)((ALAS char*)F.lds + WSCR_OFF) + wid * 64;
    if (hi == 0) li_l[r32] = l_reg; asm volatile("s_waitcnt lgkmcnt(0)" ::: "memory");
    bf16* Ow = O + (base + qrow0 + wid * 32) * LDO + ocol;
#pragma unroll
    for (int r = 0; r < 16; ++r) { const int orow = crow(r, hi); const float rl = __builtin_amdgcn_rcpf(li_l[orow]);
#pragma unroll
        for (int d0 = 0; d0 < 4; ++d0) Ow[(size_t)orow * LDO + d0 * 32 + r32] = (bf16)f2bf(o[d0][r] * rl); }
}
__device__ __forceinline__ void attn_diff_unit(Frame& F, const bf16* P, bf16* O, int b, int qrow0, int h, int nloc, int loc0, float lam, float omli, const float* gsub) {
    using namespace att;
    int lane_ = F.lane; asm volatile("" : "+v"(lane_));
    int lane = lane_, wid = F.wave, r32 = lane & 31, hi = lane >> 5;
    constexpr float SCALE = 0.125f; constexpr float C = SCALE * 1.4426950408889634f;
    const size_t base = (size_t)b * TPB;
    const bf16* Qw = P + (base + qrow0 + wid * 32 + r32) * LDP + QB_ + h * 128 + hi * 8;
    const bf16* Kb = P + base * LDP + KB_ + h * 128; const bf16* Vb = P + base * LDP + VB_ + h * 128;
    ALAS float* li_l = (ALAS float*)((ALAS char*)F.lds + WSCR_OFF) + wid * 64;
    f32x16 o[4]; float m_reg, l_reg;
    attn_core<0, 4, 4>(o, m_reg, l_reg, Qw, Kb, Vb, nloc, loc0, 0, C, 8.f / SCALE, (ALAS char*)F.lds);
    asm volatile("" : "+v"(lane_)); lane = lane_; r32 = lane & 31; hi = lane >> 5;
    if (hi == 0) li_l[r32] = l_reg; asm volatile("s_waitcnt lgkmcnt(0)" ::: "memory");
    { float* stash = (float*)(F.ws + WS_STASH) + ((size_t)blockIdx.x * 8 + wid) * 4096 + lane;
#pragma unroll
    for (int d0 = 0; d0 < 4; ++d0) { float* sp = stash + d0 * 1024; asm volatile("" : "+v"(sp));
#pragma unroll
        for (int r = 0; r < 16; ++r) sp[r * 64] = o[d0][r] * __builtin_amdgcn_rcpf(li_l[crow(r, hi)]); } }
    __syncthreads();
    attn_core<0, 0, 4>(o, m_reg, l_reg, Qw, Kb, Vb, nloc, loc0, 0, C, 8.f / SCALE, (ALAS char*)F.lds);
    asm volatile("" : "+v"(lane_)); lane = lane_; r32 = lane & 31; hi = lane >> 5;
    if (hi == 0) li_l[r32] = l_reg; asm volatile("s_waitcnt lgkmcnt(0)" ::: "memory");
    float* stash = (float*)(F.ws + WS_STASH) + ((size_t)blockIdx.x * 8 + wid) * 4096 + lane;
    float g4[4];
#pragma unroll
    for (int d0 = 0; d0 < 4; ++d0) g4[d0] = gsub[d0 * 32 + r32] * omli;
    bf16* Ow = O + (base + qrow0 + wid * 32) * LDO + QB_ + h * 128;
#pragma unroll
    for (int r = 0; r < 16; ++r) { const int orow = crow(r, hi); const float rl = __builtin_amdgcn_rcpf(li_l[orow]);
        float v[4]; float ss = 0.f;
#pragma unroll
        for (int d0 = 0; d0 < 4; ++d0) { v[d0] = o[d0][r] * rl - lam * stash[(d0 * 16 + r) * 64]; ss += v[d0] * v[d0]; }
        ss += __shfl_xor(ss, 1); ss += __shfl_xor(ss, 2); ss += __shfl_xor(ss, 4); ss += __shfl_xor(ss, 8); ss += __shfl_xor(ss, 16);
        const float rstd = 1.f / sqrtf(ss * (1.f / 128.f) + EPS);
#pragma unroll
        for (int d0 = 0; d0 < 4; ++d0) Ow[(size_t)orow * LDO + d0 * 32 + r32] = (bf16)f2bf(v[d0] * rstd * g4[d0]); }
}

__device__ __forceinline__ void phase_attention(Frame& F, KArgs a, int l, bool last) {
    const bf16* P = (const bf16*)(F.ws + WS_P); bf16* O = (bf16*)(F.ws + WS_O);
    const float* lamv = (const float*)(F.ws + WS_TAB + 32768); const float lam = lamv[l * 2], omli = lamv[l * 2 + 1];
    const float* sinkv = a->in[19] + l * 8; const float* gsub = a->in[18] + l * 128; const float* nab = a->in[20] + (size_t)l * 8 * 15 * 31;
#ifndef ATT_MASK
#define ATT_MASK 15
#endif
    if (ATT_MASK & 1) for (int u = F.vcu; u < (last ? 256 : 272); u += F.G) {
        int b, h, qrow0, nloc;
        if (u < 256) { b = u >> 7; h = (u >> 4) & 7; qrow0 = (u & 15) * 256; nloc = 64; } else { const int e = u - 256; b = e >> 3; h = e & 7; qrow0 = SEQ; nloc = 0; }
        __syncthreads(); attn_diff_unit(F, P, O, b, qrow0, h, nloc, 0, lam, omli, gsub);
    }
    if (ATT_MASK & 2) for (int u = F.vcu; u < (last ? 256 : 304); u += F.G) {
        int b, qrow0, qcol, kcol, vcol, nloc; float sink = 0.f; bool has_sink = false;
        if (u < 256) { const int h = (u >> 4) & 7, qb = u & 15; b = u >> 7; qrow0 = qb * 256; qcol = QA + h * 128; kcol = KA + (h >> 2) * 128; vcol = VA + (h >> 2) * 128; nloc = 64; }
        else { const int e = u - 256, g = e >> 4, h = e & 7; b = (e >> 3) & 1; qrow0 = SEQ; nloc = 0;
            if (g == 0) { qcol = QA + h * 128; kcol = KA + (h >> 2) * 128; vcol = VA + (h >> 2) * 128; }
            else if (g == 1) { qcol = QC + h * 128; kcol = KC + (h >> 2) * 128; vcol = VC + (h >> 2) * 128; sink = sinkv[h]; has_sink = true; }
            else { qcol = QD + h * 128; kcol = KD + h * 128; vcol = VD + h * 128; } }
        __syncthreads(); attn_std_unit<0>(F, P, O, b, qrow0, qcol, kcol, vcol, qcol, nloc, 0, sink, has_sink);
    }
    if (ATT_MASK & 4) for (int u = F.vcu; u < 256; u += F.G) { const int b = u >> 7, h = (u >> 4) & 7, qb = u & 15;
        const int lo = max(qb * 256 - 128, 0), hiK = min(qb * 256 + 384, SEQ);
        __syncthreads(); attn_std_unit<2>(F, P, O, b, qb * 256, QC + h * 128, KC + (h >> 2) * 128, VC + (h >> 2) * 128, QC + h * 128, (hiK - lo) / 64, lo, sinkv[h], true); }
    if (ATT_MASK & 8) for (int u = F.vcu; u < 256; u += F.G) { const int b = u >> 7, h = (u >> 4) & 7, qb = u & 15;
        const int r0 = qb * 4; int rlo, nrow;
        if (r0 == 0) { rlo = 0; nrow = 8; } else if (r0 == 60) { rlo = 56; nrow = 8; } else { rlo = min(r0 - 4, 52); nrow = 12; }
        __syncthreads();
        { LAS float* bl = (LAS float*)(F.lds + att::BIAS_OFF); for (int e = F.tid; e < 15 * 31; e += NWAVES * 64) bl[e] = nab[h * 465 + e] * 11.313708498984761f; }
        attn_std_unit<3>(F, P, O, b, qb * 256, QD + h * 128, KD + h * 128, VD + h * 128, QD + h * 128, nrow, rlo * 64, 0.f, false); }
    __syncthreads();
}

__global__ void __launch_bounds__(NWAVES * 64, 2) fwd_kernel(Args args) {
    extern __shared__ __attribute__((aligned(16))) unsigned char lds[];
    Frame F;
    F.lds = (LAS unsigned char*)lds;
    volatile LAS unsigned* MISC = (volatile LAS unsigned*)(F.lds + MISC_OFF);
    F.tid = threadIdx.x; F.lane = F.tid & 63; F.wave = __builtin_amdgcn_readfirstlane(F.tid >> 6);
    F.G = gridDim.x; { const int bx = blockIdx.x; F.vcu = (F.G % 8 == 0) ? (bx % 8) * (F.G / 8) + bx / 8 : bx; }
    KArgs ap = (KArgs)__builtin_amdgcn_kernarg_segment_ptr();
    F.ws = ap->ws;
    gu32* ctl = (gu32*)(F.ws + WS_CTL);
    for (int u = F.tid; u < (LDS_BYTES - LDSCTL_OFF) / 4; u += NWAVES * 64) ((LAS unsigned*)(F.lds + LDSCTL_OFF))[u] = 0u;
    __syncthreads();
    const int lo = ap->ph_lo, hi = ap->ph_hi;
    XcdBarrier bar; bar.bar = (unsigned*)(ctl + CW_BAR); bar.x = 0; bar.st = nullptr;
    if (hi - lo > 1) bar = xcd_barrier_post((unsigned*)(ctl + CW_BAR), MISC + 8);
#ifndef PH_MASK
#define PH_MASK 0x7ff
#endif
#ifndef REP_PRO
#define REP_PRO 1
#endif
#ifndef REP_ATT
#define REP_ATT 1
#endif
#ifndef REP_GEMM
#define REP_GEMM 1
#endif
#ifndef REP_CONV
#define REP_CONV 1
#endif
#define IN(k) (lo <= (k) && (k) < hi)
#define FRESH() asm volatile("" : "+v"(F.tid), "+v"(F.lane), "+s"(ap))
#define EN(j) (((PH_MASK) >> (j)) & 1)
#define SEAM(k) do { if (IN(k) && IN((k) + 1)) xcd_barrier(bar); } while (0)

    if (EN(0) && IN(0)) { for (int rep = 0; rep < REP_PRO; ++rep) { FRESH(); phase_prologue(F, ap); __syncthreads(); } } SEAM(0);
    if (EN(1) && IN(1)) { FRESH(); phase_r0(F, ap); } SEAM(1);
    for (int l = 0; l < 2; ++l) {
        const bool last = (l == 1); const int pb = 2 + 8 * l;
        const pg8::bf16_t* HX = (const pg8::bf16_t*)(F.ws + WS_HX);
        if (EN(2) && IN(pb + 0)) {
            pg8::Gemm g{HX, (const pg8::bf16_t*)(F.ws + WS_WIN + (size_t)l * 72 * MiB), MROWS, NIN, DM};
            pg8::StaticOrder S; S.init(MROWS / 256, NIN, DM, F.G, fresh_bx(), 0);
            pg8::EpiInProj E{(pg8::bf16_t*)(F.ws + WS_P), NIN, (const float*)(F.ws + WS_TAB), (const float*)(F.ws + WS_TAB + 16384), ap->in[12] + l * 128, ap->in[13] + l * 128, (LAS float*)(F.lds + XCH_OFF)};
            pg8::gemm_phase<pg8::EpiInProj, pg8::StaticOrder, true>(F.lds + RING_OFF, g, S, E);
        } SEAM(pb + 0);
        if (EN(4) && IN(pb + 1)) { for (int rep = 0; rep < REP_ATT; ++rep) { FRESH(); phase_attention(F, ap, l, last); } } SEAM(pb + 1);
        if (EN(5) && IN(pb + 2)) {
            pg8::Gemm g{(const pg8::bf16_t*)(F.ws + WS_O), (const pg8::bf16_t*)(F.ws + WS_WOUT + (size_t)l * 32 * MiB), MROWS, DM, DM};
            pg8::SplitOrder S; S.init(DM, DM, F.G, fresh_bx()); if (last) S.ca = 0;
            pg8::EpiSplit E{(pg8::bf16_t*)(F.ws + WS_Y), (float*)(F.ws + WS_PART), DM};
            pg8::gemm_phase<pg8::EpiSplit, pg8::SplitOrder, true>(F.lds + RING_OFF, g, S, E);
        } SEAM(pb + 2);
        if (EN(6) && IN(pb + 3)) { FRESH(); phase_r1(F, ap, l, last); } SEAM(pb + 3);
        if (EN(7) && IN(pb + 4)) {
            pg8::Gemm g{HX, (const pg8::bf16_t*)(F.ws + WS_WUP + (size_t)l * 172 * MiB), MROWS, NUP, DM};
            pg8::StaticOrder S; S.init(last ? 32 : 34, NUP, DM, F.G, fresh_bx(), last ? 1 : 0);
            pg8::EpiBf16 E{(pg8::bf16_t*)(F.ws + WS_U), NUP};
            pg8::gemm_phase<pg8::EpiBf16, pg8::StaticOrder, true>(F.lds + RING_OFF, g, S, E);
        } SEAM(pb + 4);
        if (EN(8) && IN(pb + 5)) { for (int rep = 0; rep < REP_CONV; ++rep) { FRESH(); phase_conv(F, ap, l, last); } } SEAM(pb + 5);
        if (EN(9) && IN(pb + 6)) {
            pg8::Gemm g{(const pg8::bf16_t*)(F.ws + WS_ACT), (const pg8::bf16_t*)(F.ws + WS_WDN + (size_t)l * 86 * MiB), MROWS, DM, DFF};
            pg8::SplitOrder S; S.init(DM, DFF, F.G, fresh_bx()); if (last) S.ca = 0;
            pg8::EpiSplit E{(pg8::bf16_t*)(F.ws + WS_Y), (float*)(F.ws + WS_PART), DM};
            pg8::gemm_phase<pg8::EpiSplit, pg8::SplitOrder, true>(F.lds + RING_OFF, g, S, E);
        } SEAM(pb + 6);
        if (EN(10) && IN(pb + 7)) { FRESH(); phase_r2(F, ap, l, last); } SEAM(pb + 7);
    }
#undef IN
#undef SEAM
}

extern "C" void kernel_launch(void* const* d_in, const int* in_sizes, int n_in, void* d_out, int out_size, void* d_ws, size_t ws_size, hipStream_t stream) {
    static int grid = 0;
    if (grid == 0) {
        if (n_in != 24 || in_sizes[0] != NB * SEQ * DM || out_size != NB * SEQ * DM || ws_size < WS_END) {
            fprintf(stderr, "kernel_launch: unexpected shapes: n_in %d in0 %d out %d ws %zu (need %zu); nothing launched\n", n_in, n_in > 0 ? in_sizes[0] : -1, out_size, ws_size, (size_t)WS_END); grid = -1; return; }
        int dev = 0, cus = 0, per_cu = 0;
        if (hipGetDevice(&dev) != hipSuccess || hipDeviceGetAttribute(&cus, hipDeviceAttributeMultiprocessorCount, dev) != hipSuccess) { grid = -1; return; }
        if (hipFuncSetAttribute((const void*)fwd_kernel, hipFuncAttributeMaxDynamicSharedMemorySize, LDS_BYTES) != hipSuccess) { fprintf(stderr, "kernel_launch: hipFuncSetAttribute failed\n"); grid = -1; return; }
        if (hipOccupancyMaxActiveBlocksPerMultiprocessor(&per_cu, (const void*)fwd_kernel, NWAVES * 64, LDS_BYTES) != hipSuccess || per_cu < 1)
            fprintf(stderr, "kernel_launch: note: occupancy query reports %d workgroups per CU\n", per_cu);
        (void)hipGetLastError();
        grid = cus;
    }
    if (grid < 0) return;
    if (hipMemsetAsync((char*)d_ws + WS_CTL, 0, CTL_ZERO_BYTES, stream) != hipSuccess) return;
    Args a{};
    for (int i = 0; i < 24; ++i) a.in[i] = (const float*)d_in[i];
    a.out = (float*)d_out; a.ws = (unsigned char*)d_ws;
#if MK_SINGLE
    a.ph_lo = 0; a.ph_hi = NPHASE;
    hipLaunchKernelGGL(fwd_kernel, dim3(grid), dim3(NWAVES * 64), LDS_BYTES, stream, a);
#else
    for (int p = 0; p < NPHASE; ++p) { a.ph_lo = p; a.ph_hi = p + 1; hipLaunchKernelGGL(fwd_kernel, dim3(grid), dim3(NWAVES * 64), LDS_BYTES, stream, a); }
#endif
    const hipError_t le = hipPeekAtLastError();
    if (le != hipSuccess) fprintf(stderr, "kernel_launch: launch failed: %s\n", hipGetErrorName(le));
}
```

```cpp
#include <hip/hip_runtime.h>
#include <cstdio>
#include <cstdint>

#ifndef MK_SINGLE
#define MK_SINGLE 1
#endif

namespace pg8 {
#define PG8_LAS __attribute__((address_space(3)))
typedef unsigned short bf16_t;
typedef short bf16x8 __attribute__((ext_vector_type(8)));
typedef float f32x4 __attribute__((ext_vector_type(4)));
typedef unsigned u32x4 __attribute__((ext_vector_type(4)));
constexpr int BM = 256, BK = 64, HALF = 128, HTB = HALF * BK * 2, STAGE_BYTES = 8 * HTB, NXCD = 8, WGM = 8;

__host__ __device__ __forceinline__ int lds_byte(int r, int c) { const int st = (r >> 4) * 2 + (c >> 5), rr = r & 15, cc = c & 31, ob = rr * 64 + cc * 2; return st * 1024 + (ob ^ (((ob >> 9) & 1) << 5)); }
__host__ __device__ __forceinline__ void stage_rc(int b, int& R, int& C) { const int st = b / 1024, sb = b % 1024, swz = sb ^ (((sb >> 9) & 1) << 5); R = (st >> 1) * 16 + swz / 64; C = (st & 1) * 32 + (swz % 64) / 2; }
__host__ __device__ __forceinline__ int perm32(int rho) { const int n = rho >> 4, i = rho & 15; return 8 * (i >> 2) + 4 * n + (i & 3); }

struct Unit { int pm, pn, kt0, nt, slab; };
struct Gemm { const bf16_t* A; const bf16_t* Bt; int M, N, K; };

struct StaticOrder {
    int nM, nN, nwg, G, c, skip, ntk;
    __host__ __device__ void init(int nM_, int N, int K, int G_, int c_, int skip_) { nM = nM_; nN = N / BM; nwg = nM * nN; G = G_; c = c_; skip = skip_; ntk = K / BK; }
    __host__ __device__ bool at(long L, Unit& u) const {
        if (L >= nwg) return false;
        int wgid = (int)L; { const int q = nwg / NXCD, r = nwg % NXCD, xcd = wgid % NXCD, off = wgid / NXCD; wgid = (xcd < r ? xcd * (q + 1) : r * (q + 1) + (xcd - r) * q) + off; }
        const int nig = WGM * nN, gid = wgid / nig, fm = gid * WGM, gsz = (nM - fm) < WGM ? (nM - fm) : WGM;
        u.pm = fm + ((wgid % nig) % gsz); u.pn = (wgid % nig) / gsz; u.kt0 = 0; u.nt = ntk; u.slab = -1;
        if (skip && u.pm >= 16) u.pm += 1;
        return true;
    }
    __host__ __device__ bool next(int i, Unit& u) const { return at((long)i * G + c, u); }
    __device__ __forceinline__ void a_ready(const Unit&) const {}
    __device__ __forceinline__ void done(const Unit&) const {}
};
struct SplitOrder {
    StaticOrder so; int ca, cb;
    __host__ __device__ void init(int N, int K, int G_, int c_) { so.init(32, N, K, G_, c_, 1); const int ntk = K / BK; ca = ((ntk / 8 + 1) / 2) * 2; cb = (ntk - 6 * ca) / 2; if (6 * ca + 2 * cb != ntk || (cb & 1) || cb <= 0) { ca = ntk / 8; cb = ca; } }
    __host__ __device__ bool next(int i, Unit& u) const {
        const long L = (long)i * so.G + so.c;
        if (L < so.nwg) return so.at(L, u);
        const int q = (int)(L - so.nwg); if (ca == 0 || q >= 256) return false;
        const int ch = q & 7, pn = (q >> 3) & 15, pp = q >> 7;
        u.pm = pp ? 33 : 16; u.pn = pn; u.slab = ch; u.kt0 = ch < 6 ? ca * ch : 6 * ca + cb * (ch - 6); u.nt = ch < 6 ? ca : cb;
        return true;
    }
    __device__ __forceinline__ void a_ready(const Unit&) const {}
    __device__ __forceinline__ void done(const Unit&) const {}
};

__device__ __forceinline__ unsigned cvt_pk_bf16(float lo, float hi) { unsigned r; asm volatile("v_cvt_pk_bf16_f32 %0, %1, %2" : "=v"(r) : "v"(lo), "v"(hi)); return r; }

struct EpiBf16 {
    static constexpr bool PERM = true, AFTER_DRAIN = false;
    bf16_t* O; int ldc;
    __device__ __forceinline__ void operator()(const f32x4 (&acc)[2][2][4][2], const Unit& u, int wr, int wc, int fr, int fq) const {
        const int row0 = u.pm * BM + wr * 64 + fr; const int col0 = u.pn * BM + wc * 32 + 8 * fq;
#pragma unroll
        for (int ai = 0; ai < 2; ++ai)
#pragma unroll
            for (int m = 0; m < 4; ++m) { bf16_t* rowp = O + (size_t)(row0 + ai * HALF + m * 16) * ldc + col0;
#pragma unroll
                for (int bj = 0; bj < 2; ++bj) { const f32x4 v0 = acc[ai][bj][m][0], v1 = acc[ai][bj][m][1];
                    u32x4 w; w.x = cvt_pk_bf16(v0[0], v0[1]); w.y = cvt_pk_bf16(v0[2], v0[3]); w.z = cvt_pk_bf16(v1[0], v1[1]); w.w = cvt_pk_bf16(v1[2], v1[3]);
                    *(u32x4*)(rowp + bj * HALF) = w; } }
    }
};

struct EpiSplit {
    static constexpr bool PERM = true, AFTER_DRAIN = false;
    bf16_t* O; float* part; int ldc;
    __device__ __forceinline__ void operator()(const f32x4 (&acc)[2][2][4][2], const Unit& u, int wr, int wc, int fr, int fq) const {
        const int col0 = u.pn * BM + wc * 32 + 8 * fq;
        if (u.slab < 0) {
            const int row0 = u.pm * BM + wr * 64 + fr;
#pragma unroll
            for (int ai = 0; ai < 2; ++ai)
#pragma unroll
                for (int m = 0; m < 4; ++m) { bf16_t* rowp = O + (size_t)(row0 + ai * HALF + m * 16) * ldc + col0;
#pragma unroll
                    for (int bj = 0; bj < 2; ++bj) { const f32x4 v0 = acc[ai][bj][m][0], v1 = acc[ai][bj][m][1];
                        u32x4 w; w.x = cvt_pk_bf16(v0[0], v0[1]); w.y = cvt_pk_bf16(v0[2], v0[3]); w.z = cvt_pk_bf16(v1[0], v1[1]); w.w = cvt_pk_bf16(v1[2], v1[3]);
                        *(u32x4*)(rowp + bj * HALF) = w; } }
        } else {
            const int row0 = (u.pm == 16 ? 0 : 256) + wr * 64 + fr; float* pb = part + (size_t)u.slab * 512 * ldc;
#pragma unroll
            for (int ai = 0; ai < 2; ++ai)
#pragma unroll
                for (int m = 0; m < 4; ++m) { float* rowp = pb + (size_t)(row0 + ai * HALF + m * 16) * ldc + col0;
#pragma unroll
                    for (int bj = 0; bj < 2; ++bj) { *(f32x4*)(rowp + bj * HALF) = acc[ai][bj][m][0]; *(f32x4*)(rowp + bj * HALF + 4) = acc[ai][bj][m][1]; } }
        }
    }
};

struct EpiInProj {
    static constexpr bool PERM = true, AFTER_DRAIN = false;
    bf16_t* O; int ldc; const float* thd; const float* tdh; const float* gq; const float* gk; PG8_LAS float* xch;
    __device__ __forceinline__ void operator()(f32x4 (&acc)[2][2][4][2], const Unit& u, int wr, int wc, int fr, int fq) const {
        const int pmb = u.pm % 17; const bool ctx = (pmb == 16); const int pn = u.pn;
        const int kind = pn < 4 ? 1 : pn < 8 ? 2 : pn < 12 ? 3 : pn < 16 ? 0 : pn == 16 ? 4 : pn < 18 ? 0 : pn < 22 ? 2 : pn == 26 ? 3 : 0;
        if (kind == 1 || kind == 4) {
            const float* g = (kind == 1 ? gq : gk) + wc * 32 + 8 * fq;
            const f32x4 g0 = *(const f32x4*)g, g1 = *(const f32x4*)(g + 4);
#pragma unroll
            for (int ai = 0; ai < 2; ++ai)
#pragma unroll
                for (int m = 0; m < 4; ++m)
#pragma unroll
                    for (int bj = 0; bj < 2; ++bj) { const f32x4 a = acc[ai][bj][m][0], b = acc[ai][bj][m][1];
                        float s = (a[0] * a[0] + a[1] * a[1]) + (a[2] * a[2] + a[3] * a[3]) + (b[0] * b[0] + b[1] * b[1]) + (b[2] * b[2] + b[3] * b[3]);
                        s += __shfl_xor(s, 16); s += __shfl_xor(s, 32);
                        if (fq == 0) xch[((ai * HALF + wr * 64 + m * 16 + fr) * 2 + bj) * 4 + wc] = s; }
            asm volatile("s_waitcnt lgkmcnt(0)" ::: "memory"); __builtin_amdgcn_s_barrier(); asm volatile("" ::: "memory");
#pragma unroll
            for (int ai = 0; ai < 2; ++ai)
#pragma unroll
                for (int m = 0; m < 4; ++m)
#pragma unroll
                    for (int bj = 0; bj < 2; ++bj) { const f32x4 p = *(const PG8_LAS f32x4*)(xch + ((ai * HALF + wr * 64 + m * 16 + fr) * 2 + bj) * 4);
                        const float rstd = __builtin_amdgcn_rsqf(((p[0] + p[1]) + (p[2] + p[3])) * (1.f / 128.f) + 1e-6f);
                        acc[ai][bj][m][0] = acc[ai][bj][m][0] * rstd * g0; acc[ai][bj][m][1] = acc[ai][bj][m][1] * rstd * g1; }
        }
        if (kind != 0 && !ctx) {
            const bool dh = (kind == 2);
#pragma unroll
            for (int ai = 0; ai < 2; ++ai)
#pragma unroll
                for (int m = 0; m < 4; ++m) { const int t = pmb * 256 + ai * HALF + wr * 64 + m * 16 + fr; const int grow = t >> 6, gcol = t & 63;
                    const float* tp = dh ? tdh + (size_t)((((wc & 1) == 0) ? grow : gcol) * 16 + 4 * fq) * 2 : thd + (size_t)(((wc < 2) ? grow : gcol) * 32 + 16 * (wc & 1) + 4 * fq) * 2;
                    const f32x4 c01 = *(const f32x4*)tp, c23 = *(const f32x4*)(tp + 4);
#pragma unroll
                    for (int bj = 0; bj < 2; ++bj) { f32x4 a = acc[ai][bj][m][0], b = acc[ai][bj][m][1];
                        acc[ai][bj][m][0] = (f32x4){a[0] * c01[0] - a[1] * c01[1], a[0] * c01[1] + a[1] * c01[0], a[2] * c01[2] - a[3] * c01[3], a[2] * c01[3] + a[3] * c01[2]};
                        acc[ai][bj][m][1] = (f32x4){b[0] * c23[0] - b[1] * c23[1], b[0] * c23[1] + b[1] * c23[0], b[2] * c23[2] - b[3] * c23[3], b[2] * c23[3] + b[3] * c23[2]}; } }
        }
        const int row0 = u.pm * BM + wr * 64 + fr; const int col0 = u.pn * BM + wc * 32 + 8 * fq;
#pragma unroll
        for (int ai = 0; ai < 2; ++ai)
#pragma unroll
            for (int m = 0; m < 4; ++m) { bf16_t* rowp = O + (size_t)(row0 + ai * HALF + m * 16) * ldc + col0;
#pragma unroll
                for (int bj = 0; bj < 2; ++bj) { const f32x4 v0 = acc[ai][bj][m][0], v1 = acc[ai][bj][m][1];
                    u32x4 w; w.x = cvt_pk_bf16(v0[0], v0[1]); w.y = cvt_pk_bf16(v0[2], v0[3]); w.z = cvt_pk_bf16(v1[0], v1[1]); w.w = cvt_pk_bf16(v1[2], v1[3]);
                    *(u32x4*)(rowp + bj * HALF) = w; } }
    }
};

template <class Epi, class Sched, bool ALIGN_EPI = false>
__device__ __forceinline__ void gemm_phase(PG8_LAS unsigned char* lds, const Gemm g, const Sched& S, const Epi& E) {
    int tid_ = threadIdx.x; asm volatile("" : "+v"(tid_));
    const int tid = tid_, wid = __builtin_amdgcn_readfirstlane(tid >> 6), lane = tid & 63, wr = wid >> 2, wc = wid & 3, fr = lane & 15, fq = lane >> 4;
    const int K = g.K;
    unsigned voffA[2], voffB[2];
#pragma unroll
    for (int i = 0; i < 2; ++i) { int R, C; stage_rc(tid * 16 + i * 8192, R, C); const int Rb = Epi::PERM ? ((R & ~31) + perm32(R & 31)) : R;
        voffA[i] = (unsigned)(R * K + C) * 2u; voffB[i] = (unsigned)(Rb * K + C) * 2u; }
    const size_t kstep = (size_t)(BK * 2);
    const size_t hstep = (size_t)HALF * K * 2;
    const size_t tstep = 2 * hstep;
    const unsigned ldsw = (unsigned)wid * 1024u;
    const int aoff = lds_byte(wr * 64 + fr, fq * 8), boff = lds_byte(wc * 32 + fr, fq * 8);
#define PG8_SA(b, h) (((b) * 2 + (h)) * HTB)
#define PG8_SB(b, h) ((4 + (b) * 2 + (h)) * HTB)
#define PG8_STAGE(bufoff, gbase, voff) do { _Pragma("unroll") for (int _i = 0; _i < 2; ++_i) \
        __builtin_amdgcn_global_load_lds((const unsigned*)((const char*)(gbase) + (voff)[_i]), (PG8_LAS unsigned*)(lds + (bufoff) + ldsw + _i * 8192), 16, 0, 0); } while (0)
#define PG8_LDA(dst, b, h) do { _Pragma("unroll") for (int m = 0; m < 4; ++m) _Pragma("unroll") for (int k = 0; k < 2; ++k) dst[m][k] = *(const PG8_LAS bf16x8*)(lds + PG8_SA(b, h) + aoff + m * 2048 + k * 1024); } while (0)
#define PG8_LDB(dst, b, h) do { _Pragma("unroll") for (int n = 0; n < 2; ++n) _Pragma("unroll") for (int k = 0; k < 2; ++k) dst[n][k] = *(const PG8_LAS bf16x8*)(lds + PG8_SB(b, h) + boff + n * 2048 + k * 1024); } while (0)
#define PG8_MMA(ai, bj, At, Bt) do { __builtin_amdgcn_s_setprio(1); _Pragma("unroll") for (int m = 0; m < 4; ++m) _Pragma("unroll") for (int n = 0; n < 2; ++n) _Pragma("unroll") for (int k = 0; k < 2; ++k) \
        acc[ai][bj][m][n] = __builtin_amdgcn_mfma_f32_16x16x32_bf16(Bt[n][k], At[m][k], acc[ai][bj][m][n], 0, 0, 0); __builtin_amdgcn_s_setprio(0); } while (0)
#define PG8_WAIT_V(n) asm volatile("s_waitcnt vmcnt(" #n ")" ::: "memory")
#define PG8_WAIT_L(n) asm volatile("s_waitcnt lgkmcnt(" #n ")" ::: "memory")
#define PG8_BAR __builtin_amdgcn_s_barrier()
#define PG8_SCHED __builtin_amdgcn_sched_barrier(0)
    Unit cur, nxt; int ui = 0;
    if (!S.next(0, cur)) return;
    f32x4 acc[2][2][4][2];
#pragma unroll
    for (int a = 0; a < 2; ++a)
#pragma unroll
        for (int b = 0; b < 2; ++b)
#pragma unroll
            for (int m = 0; m < 4; ++m)
#pragma unroll
                for (int n = 0; n < 2; ++n) acc[a][b][m][n] = (f32x4){0.f, 0.f, 0.f, 0.f};
    bf16x8 At[4][2], B0[2][2], B1[2][2];
    const char* cA = (const char*)g.A + (size_t)cur.pm * tstep + (size_t)cur.kt0 * kstep; const char* cB = (const char*)g.Bt + (size_t)cur.pn * tstep + (size_t)cur.kt0 * kstep;
    S.a_ready(cur);
    PG8_STAGE(PG8_SB(0, 0), cB, voffB); PG8_STAGE(PG8_SB(0, 1), cB + hstep, voffB); PG8_STAGE(PG8_SA(0, 0), cA, voffA); PG8_STAGE(PG8_SA(0, 1), cA + hstep, voffA);
    if (wr == 1) PG8_BAR;
    PG8_WAIT_V(2); PG8_BAR;
    PG8_STAGE(PG8_SB(1, 0), cB + kstep, voffB); PG8_STAGE(PG8_SA(1, 0), cA + kstep, voffA); PG8_STAGE(PG8_SB(1, 1), cB + hstep + kstep, voffB);
    PG8_WAIT_V(6); PG8_BAR;
    for (;;) {
        const bool has_next = S.next(ui + 1, nxt);
        const char* nA = has_next ? (const char*)g.A + (size_t)nxt.pm * tstep + (size_t)nxt.kt0 * kstep : cA; const char* nB = has_next ? (const char*)g.Bt + (size_t)nxt.pn * tstep + (size_t)nxt.kt0 * kstep : cB;
        const int nt = cur.nt;
        for (int t = 0; t < nt; t += 2) {
            const bool last = (t == nt - 2);
            const char* a1 = cA + (size_t)(t + 1) * kstep;
            const char* a2 = last ? nA : cA + (size_t)(t + 2) * kstep; const char* b2 = last ? nB : cB + (size_t)(t + 2) * kstep;
            const char* a3 = a2 + kstep; const char* b3 = b2 + kstep;
            if (last && has_next) S.a_ready(nxt);
            PG8_LDB(B0, 0, 0); PG8_LDB(B1, 0, 1); PG8_SCHED; PG8_LDA(At, 0, 0); PG8_STAGE(PG8_SA(1, 1), a1 + hstep, voffA);
            PG8_WAIT_V(8); PG8_WAIT_L(0); PG8_BAR; PG8_MMA(0, 0, At, B0); PG8_MMA(0, 1, At, B1); PG8_BAR; PG8_SCHED;
            PG8_LDA(At, 0, 1); PG8_STAGE(PG8_SB(0, 0), b2, voffB); PG8_STAGE(PG8_SB(0, 1), b2 + hstep, voffB); PG8_STAGE(PG8_SA(0, 0), a2, voffA);
            PG8_WAIT_V(8); PG8_WAIT_L(0); PG8_BAR; PG8_MMA(1, 0, At, B0); PG8_MMA(1, 1, At, B1); PG8_BAR; PG8_SCHED;
            PG8_LDB(B0, 1, 0); PG8_LDB(B1, 1, 1); PG8_SCHED; PG8_LDA(At, 1, 0); PG8_STAGE(PG8_SA(0, 1), a2 + hstep, voffA);
            PG8_WAIT_V(8); PG8_WAIT_L(0); PG8_BAR; PG8_MMA(0, 0, At, B0); PG8_MMA(0, 1, At, B1); PG8_BAR; PG8_SCHED;
            PG8_LDA(At, 1, 1); PG8_STAGE(PG8_SB(1, 0), b3, voffB); PG8_STAGE(PG8_SB(1, 1), b3 + hstep, voffB); PG8_STAGE(PG8_SA(1, 0), a3, voffA);
            PG8_WAIT_V(8); PG8_WAIT_L(0); PG8_BAR; PG8_MMA(1, 0, At, B0); PG8_MMA(1, 1, At, B1); PG8_BAR; PG8_SCHED;
        }
        if constexpr (ALIGN_EPI) { if (wr == 0) PG8_BAR; }
        if constexpr (!Epi::AFTER_DRAIN) { E(acc, cur, wr, wc, fr, fq); S.done(cur); }
        if (!has_next) break;
#pragma unroll
        for (int a = 0; a < 2; ++a)
#pragma unroll
            for (int b = 0; b < 2; ++b)
#pragma unroll
                for (int m = 0; m < 4; ++m)
#pragma unroll
                    for (int n = 0; n < 2; ++n) acc[a][b][m][n] = (f32x4){0.f, 0.f, 0.f, 0.f};
        cur = nxt; cA = nA; cB = nB; ++ui;
        if constexpr (ALIGN_EPI) { if (wr == 1) PG8_BAR; }
    }
    PG8_WAIT_V(0);
    if constexpr (!ALIGN_EPI) { if (wr == 0) PG8_BAR; }
    PG8_BAR;
#undef PG8_SA
#undef PG8_SB
#undef PG8_STAGE
#undef PG8_LDA
#undef PG8_LDB
#undef PG8_MMA
#undef PG8_WAIT_V
#undef PG8_WAIT_L
#undef PG8_BAR
#undef PG8_SCHED
}
}

namespace att {
#define ALAS __attribute__((address_space(3)))
typedef unsigned short bf16;
typedef short bf16x8 __attribute__((ext_vector_type(8)));
typedef short s16x4 __attribute__((ext_vector_type(4)));
typedef float f32x16 __attribute__((ext_vector_type(16)));
typedef unsigned u32x4 __attribute__((ext_vector_type(4)));
constexpr int LDP = 9216, LDO = 4096;
constexpr int SLOT = 32768;
constexpr int WSCR_OFF = 131072 + 1024, BIAS_OFF = WSCR_OFF + 2048, SHM_END = BIAS_OFF + 2048;
constexpr int NCTX_T = 4;
#define KSWZ(row, colB) ((row) * 256 + ((colB) ^ (((row) & 7) << 4)))
#define SBAR() __builtin_amdgcn_sched_barrier(0)
__device__ __forceinline__ int crow(int r, int hi) { return (r & 3) + 8 * (r >> 2) + 4 * hi; }
__device__ __forceinline__ unsigned cvtpk(float lo, float hi) { unsigned r; asm volatile("v_cvt_pk_bf16_f32 %0, %1, %2" : "=v"(r) : "v"(lo), "v"(hi)); return r; }

__device__ __forceinline__ void partialSM(f32x16& p0, f32x16& p1, float& m_reg, float& mn, float& alpha, const float C, const float thr_raw) {
    float pmax = p0[0];
#pragma unroll
    for (int r = 1; r < 16; ++r) pmax = fmaxf(pmax, p0[r]);
#pragma unroll
    for (int r = 0; r < 16; ++r) pmax = fmaxf(pmax, p1[r]);
    { auto rr = __builtin_amdgcn_permlane32_swap(__float_as_uint(pmax), __float_as_uint(pmax), false, false);
      pmax = fmaxf(__uint_as_float(rr[0]), __uint_as_float(rr[1])); }
    if (__builtin_expect(__all(pmax - m_reg <= thr_raw), 1)) { mn = m_reg; alpha = 1.f; }
    else { mn = fmaxf(m_reg, pmax); alpha = __builtin_amdgcn_exp2f((m_reg - mn) * C); m_reg = mn; }
    const float mnC = -mn * C;
#pragma unroll
    for (int r = 0; r < 16; ++r) p0[r] = fmaf(p0[r], C, mnC);
#pragma unroll
    for (int r = 0; r < 16; ++r) p1[r] = fmaf(p1[r], C, mnC);
#pragma unroll
    for (int r = 0; r < 16; ++r) p0[r] = __builtin_amdgcn_exp2f(p0[r]);
}
__device__ __forceinline__ void finishSM(f32x16& p0, f32x16& p1, float alpha, float& l_reg, bf16x8& pa0, bf16x8& pa1, bf16x8& pa2, bf16x8& pa3) {
#pragma unroll
    for (int r = 0; r < 16; ++r) p1[r] = __builtin_amdgcn_exp2f(p1[r]);
    float ps = 0;
#pragma unroll
    for (int r = 0; r < 16; ++r) ps += p0[r];
#pragma unroll
    for (int r = 0; r < 16; ++r) ps += p1[r];
    { auto rr = __builtin_amdgcn_permlane32_swap(__float_as_uint(ps), __float_as_uint(ps), false, false);
      ps = __uint_as_float(rr[0]) + __uint_as_float(rr[1]); }
    l_reg = l_reg * alpha + ps;
#define PK4(P, BASE, OUT) do { unsigned a0 = cvtpk(P[BASE + 0], P[BASE + 1]), a1 = cvtpk(P[BASE + 2], P[BASE + 3]);   \
    unsigned b0 = cvtpk(P[BASE + 4], P[BASE + 5]), b1 = cvtpk(P[BASE + 6], P[BASE + 7]);                              \
    auto r0 = __builtin_amdgcn_permlane32_swap(a0, b0, false, false); auto r1 = __builtin_amdgcn_permlane32_swap(a1, b1, false, false); \
    u32x4 w = {r0[0], r1[0], r0[1], r1[1]}; OUT = __builtin_bit_cast(bf16x8, w); } while (0)
    PK4(p0, 0, pa0); PK4(p0, 8, pa1); PK4(p1, 0, pa2); PK4(p1, 8, pa3);
#undef PK4
}
template <int D0LO, int D0N>
__device__ __forceinline__ void qkt(f32x16& p0, f32x16& p1, const ALAS char* Ks, const bf16x8* qr, int r32, int hi) {
    p0 = f32x16{}; p1 = f32x16{};
#pragma unroll
    for (int d0 = D0LO; d0 < D0LO + D0N; ++d0) { const int cb = (d0 * 16 + hi * 8) * 2;
        const bf16x8 b0 = *(const ALAS bf16x8*)(Ks + KSWZ(r32, cb));
        const bf16x8 b1 = *(const ALAS bf16x8*)(Ks + KSWZ(32 + r32, cb));
        p0 = __builtin_amdgcn_mfma_f32_32x32x16_bf16(b0, qr[d0], p0, 0, 0, 0);
        p1 = __builtin_amdgcn_mfma_f32_32x32x16_bf16(b1, qr[d0], p1, 0, 0, 0); }
}
__device__ __forceinline__ int v_st(int k, int c) { const int kk = (k & ~0xC) | ((k & 4) << 1) | ((k & 8) >> 1); return ((kk >> 3) * 4 + (c >> 5)) * 512 + ((kk & 7) * 32 + (c & 31)) * 2; }
__device__ __forceinline__ int v_rd_base(int lane) { return ((lane & 3) << 3) | (((lane >> 2) & 3) << 6) | (((lane >> 4) & 1) << 5) | (((lane >> 5) & 1) << 8); }
constexpr int v_rd_off(int d0, int ks, int half) { return d0 * 512 + ks * 4096 + half * 2048; }
template <int OFF> __device__ __forceinline__ s16x4 tr_read(int vb) {
    s16x4 r; asm volatile("ds_read_b64_tr_b16 %0, %1 offset:%2" : "=&v"(r) : "v"(vb), "i"(OFF) : "memory"); return r;
}
template <int D0> __device__ __forceinline__ void pv_one(f32x16& od, int vb, bf16x8 pa0, bf16x8 pa1, bf16x8 pa2, bf16x8 pa3) {
    const s16x4 l0 = tr_read<v_rd_off(D0, 0, 0)>(vb), h0 = tr_read<v_rd_off(D0, 0, 1)>(vb), l1 = tr_read<v_rd_off(D0, 1, 0)>(vb), h1 = tr_read<v_rd_off(D0, 1, 1)>(vb);
    const s16x4 l2 = tr_read<v_rd_off(D0, 2, 0)>(vb), h2 = tr_read<v_rd_off(D0, 2, 1)>(vb), l3 = tr_read<v_rd_off(D0, 3, 0)>(vb), h3 = tr_read<v_rd_off(D0, 3, 1)>(vb);
    asm volatile("s_waitcnt lgkmcnt(0)" ::: "memory"); SBAR();
#define PK(L, H) (bf16x8){L[0], L[1], L[2], L[3], H[0], H[1], H[2], H[3]}
    od = __builtin_amdgcn_mfma_f32_32x32x16_bf16(pa0, PK(l0, h0), od, 0, 0, 0);
    od = __builtin_amdgcn_mfma_f32_32x32x16_bf16(pa1, PK(l1, h1), od, 0, 0, 0);
    od = __builtin_amdgcn_mfma_f32_32x32x16_bf16(pa2, PK(l2, h2), od, 0, 0, 0);
    od = __builtin_amdgcn_mfma_f32_32x32x16_bf16(pa3, PK(l3, h3), od, 0, 0, 0);
#undef PK
}
__device__ __forceinline__ void pv_d0(f32x16* o, int vb, bf16x8 pa0, bf16x8 pa1, bf16x8 pa2, bf16x8 pa3) {
    pv_one<0>(o[0], vb, pa0, pa1, pa2, pa3); pv_one<1>(o[1], vb, pa0, pa1, pa2, pa3); pv_one<2>(o[2], vb, pa0, pa1, pa2, pa3); pv_one<3>(o[3], vb, pa0, pa1, pa2, pa3);
}

template <int MASK>
__device__ __forceinline__ void apply_mask(f32x16& p0, f32x16& p1, int j, int loc0, int qp, int hi, const ALAS float* bias) {
    if constexpr (MASK == 2) {
        if (j >= NCTX_T) { const int kbase = loc0 + 64 * (j - NCTX_T);
#pragma unroll
            for (int r = 0; r < 16; ++r) { const int d0 = qp - (kbase + crow(r, hi)); const int d1 = d0 - 32;
                if (d0 > 128 || d0 < -128) p0[r] = -1e30f;
                if (d1 > 128 || d1 < -128) p1[r] = -1e30f; } }
    } else if constexpr (MASK == 3) {
        if (j >= NCTX_T) { const int kbase = loc0 + 64 * (j - NCTX_T);
            const int qrow = qp >> 6, qcol = qp & 63; const int rs = min(max(qrow - 4, 0), 56), cs = min(max(qcol - 8, 0), 48);
            const int kr = kbase >> 6; const int dr = kr - rs;
            if (dr < 0 || dr >= 8) {
#pragma unroll
                for (int r = 0; r < 16; ++r) { p0[r] = -1e30f; p1[r] = -1e30f; }
            } else {
                const ALAS float* brow = bias + (kr - qrow + 7) * 31 + 15 - qcol;
#pragma unroll
                for (int r = 0; r < 16; ++r) { const int kc0 = crow(r, hi), kc1 = kc0 + 32;
                    const bool ok0 = (unsigned)(kc0 - cs) < 16u, ok1 = (unsigned)(kc1 - cs) < 16u;
                    const float b0 = brow[ok0 ? kc0 : qcol], b1 = brow[ok1 ? kc1 : qcol];
                    p0[r] = ok0 ? p0[r] + b0 : -1e30f; p1[r] = ok1 ? p1[r] + b1 : -1e30f;
                    if ((r & 3) == 3) asm volatile("" ::: "memory"); }
            }
        }
    }
}

template <int MASK, int D0LO, int D0N>
__device__ __forceinline__ void attn_core(f32x16 (&o)[4], float& m_reg, float& l_reg, const bf16* __restrict__ Qw, const bf16* __restrict__ Kb, const bf16* __restrict__ Vb,
                                          const int nloc, const int loc0, const int qp, const float C, const float thr_raw, ALAS char* lds) {
    int tid_ = threadIdx.x; asm volatile("" : "+v"(tid_));
    const int tid = tid_, wid = __builtin_amdgcn_readfirstlane(tid >> 6), lane = tid & 63, r32 = lane & 31, hi = lane >> 5;
    ALAS float* ws = (ALAS float*)(lds + WSCR_OFF) + wid * 64; ALAS float* al_l = ws + 32;
    const ALAS float* bias = (const ALAS float*)(lds + BIAS_OFF);
    unsigned voffK[2], voffV[2];
#pragma unroll
    for (int i = 0; i < 2; ++i) { const int q = (wid + 8 * i) * 64 + lane;
        { const int row = q >> 4, cc = (q & 15) ^ (row & 7); voffK[i] = (unsigned)(row * (LDP * 2) + cc * 16); }
        { const int kk = (q >> 7) * 8 + ((q & 31) >> 2), c = ((q >> 5) & 3) * 32 + (q & 3) * 8; const int k = (kk & ~0xC) | ((kk & 4) << 1) | ((kk & 8) >> 1); voffV[i] = (unsigned)(k * (LDP * 2) + c * 2); } }
    const int NT = NCTX_T + nloc;
#define KOFF(j) ((j) < NCTX_T ? 4096 + 64 * (j) : loc0 + 64 * ((j) - NCTX_T))
#define ISSUE(j) do { const size_t _ro = (size_t)KOFF(j) * (LDP * 2); const char* _gk = (const char*)Kb + _ro; const char* _gv = (const char*)Vb + _ro; ALAS char* _sl = lds + ((j) & 3) * SLOT + wid * 1024; \
    _Pragma("unroll") for (int _i = 0; _i < 2; ++_i) __builtin_amdgcn_global_load_lds((const unsigned*)(_gk + voffK[_i]), (ALAS unsigned*)(_sl + _i * 8192), 16, 0, 0); \
    _Pragma("unroll") for (int _i = 0; _i < 2; ++_i) __builtin_amdgcn_global_load_lds((const unsigned*)(_gv + voffV[_i]), (ALAS unsigned*)(_sl + 16384 + _i * 8192), 16, 0, 0); } while (0)
#define WAITBAR(n) do { asm volatile("s_waitcnt vmcnt(" #n ") lgkmcnt(0)" ::: "memory"); __builtin_amdgcn_s_barrier(); asm volatile("" ::: "memory"); } while (0)
#define RESC(a) do { if (__any((a) < 1.f)) { if (hi == 0) al_l[r32] = (a); asm volatile("s_waitcnt lgkmcnt(0)" ::: "memory"); \
    _Pragma("unroll") for (int d = 0; d < 4; ++d) _Pragma("unroll") for (int r = 0; r < 16; ++r) o[d][r] *= al_l[crow(r, hi)]; } } while (0)
    asm volatile("s_waitcnt vmcnt(0)" ::: "memory");
    m_reg = -1e30f; l_reg = 0.f;
#pragma unroll
    for (int d = 0; d < 4; ++d) o[d] = f32x16{};
    bf16x8 qr[8];
#pragma unroll
    for (int d0 = 0; d0 < 8; ++d0) qr[d0] = *(const bf16x8*)(Qw + d0 * 16);
    ISSUE(0); ISSUE(1); ISSUE(2);
    const int vb0 = (int)(uintptr_t)lds + 16384 + v_rd_base(lane);
    f32x16 pA0, pA1, pB0, pB1; float mnA, mnB, alA, alB; bf16x8 pa0, pa1, pa2, pa3;
    WAITBAR(8);
    qkt<D0LO, D0N>(pA0, pA1, lds, qr, r32, hi); apply_mask<MASK>(pA0, pA1, 0, loc0, qp, hi, bias); partialSM(pA0, pA1, m_reg, mnA, alA, C, thr_raw);
    WAITBAR(4);
    ISSUE(3);
    for (int j = 1; j + 1 < NT; j += 2) {
        SBAR(); qkt<D0LO, D0N>(pB0, pB1, lds + (j & 3) * SLOT, qr, r32, hi);
        finishSM(pA0, pA1, alA, l_reg, pa0, pa1, pa2, pa3); SBAR();
        pv_d0(o, vb0 + ((j - 1) & 3) * SLOT, pa0, pa1, pa2, pa3); apply_mask<MASK>(pB0, pB1, j, loc0, qp, hi, bias); partialSM(pB0, pB1, m_reg, mnB, alB, C, thr_raw);
        if (j + 2 < NT) { WAITBAR(4); } else { WAITBAR(0); }
        if (j + 3 < NT) ISSUE(j + 3);
        RESC(alB);
        SBAR(); qkt<D0LO, D0N>(pA0, pA1, lds + ((j + 1) & 3) * SLOT, qr, r32, hi);
        finishSM(pB0, pB1, alB, l_reg, pa0, pa1, pa2, pa3); SBAR();
        pv_d0(o, vb0 + (j & 3) * SLOT, pa0, pa1, pa2, pa3); apply_mask<MASK>(pA0, pA1, j + 1, loc0, qp, hi, bias); partialSM(pA0, pA1, m_reg, mnA, alA, C, thr_raw);
        if (j + 3 < NT) { WAITBAR(4); } else { WAITBAR(0); }
        if (j + 4 < NT) ISSUE(j + 4);
        RESC(alA);
    }
    SBAR(); qkt<D0LO, D0N>(pB0, pB1, lds + ((NT - 1) & 3) * SLOT, qr, r32, hi);
    finishSM(pA0, pA1, alA, l_reg, pa0, pa1, pa2, pa3); SBAR();
    pv_d0(o, vb0 + ((NT - 2) & 3) * SLOT, pa0, pa1, pa2, pa3); apply_mask<MASK>(pB0, pB1, NT - 1, loc0, qp, hi, bias); partialSM(pB0, pB1, m_reg, mnB, alB, C, thr_raw);
    RESC(alB);
    finishSM(pB0, pB1, alB, l_reg, pa0, pa1, pa2, pa3); SBAR();
    pv_d0(o, vb0 + ((NT - 1) & 3) * SLOT, pa0, pa1, pa2, pa3);
#undef KOFF
#undef ISSUE
#undef WAITBAR
#undef RESC
}
}

constexpr int NWAVES = 8;
constexpr int DM = 4096, NB = 2, SEQ = 4096, CTXL = 256, TPB = SEQ + CTXL  , MROWS = NB * TPB  ;
constexpr int NIN = 9216, DFF = 11008, NUP = 2 * DFF, NADA = 6 * DM;
constexpr int QA = 0, QB_ = 1024, QC = 2048, QD = 3072, KA = 4096, VA = 4352, KB_ = 4608, VB_ = 5632, KC = 6656, VC = 6912, KD = 7168, VD = 8192;
constexpr float EPS = 1e-6f;
constexpr int NPHASE = 18;

constexpr size_t MiB = 1u << 20;
constexpr size_t WS_CTL = 0, CTL_ZERO_BYTES = 1 * MiB;
constexpr size_t WS_MOD = 1 * MiB;
constexpr size_t WS_TAB = 2 * MiB;
constexpr size_t WS_WIN = 4 * MiB;
constexpr size_t WS_WOUT = WS_WIN + 2 * 72 * MiB;
constexpr size_t WS_WUP = WS_WOUT + 2 * 32 * MiB;
constexpr size_t WS_WDN = WS_WUP + 2 * 172 * MiB;
constexpr size_t WS_XS = WS_WDN + 2 * 86 * MiB;
constexpr size_t WS_HX = WS_XS + 136 * MiB;
constexpr size_t WS_P = WS_HX + 68 * MiB;
constexpr size_t WS_O = WS_P + 153 * MiB;
constexpr size_t WS_Y = WS_O + 68 * MiB;
constexpr size_t WS_U = WS_Y + 68 * MiB;
constexpr size_t WS_ACT = WS_U + 366 * MiB;
constexpr size_t WS_STASH = WS_ACT + 183 * MiB;
constexpr size_t WS_PART = WS_STASH + 32 * MiB;
constexpr size_t WS_END = WS_PART + 64 * MiB;
static_assert((size_t)MROWS * NUP * 2 <= 366 * MiB && (size_t)MROWS * DFF * 2 <= 183 * MiB && (size_t)MROWS * NIN * 2 <= 153 * MiB, "ws map");
constexpr int CW_BAR = 4096;

constexpr int RING_OFF = 0, RING_BYTES = 131072;
constexpr int LDSCTL_OFF = RING_BYTES, MISC_OFF = LDSCTL_OFF + 320;
constexpr int LDS_BYTES = 147456;
constexpr int XCH_OFF = att::SHM_END;
static_assert(XCH_OFF + 8192 <= LDS_BYTES && att::WSCR_OFF >= MISC_OFF + 128, "LDS map");

#define GAS __attribute__((address_space(1)))
#define LAS __attribute__((address_space(3)))
typedef unsigned short bf16;
typedef unsigned v4u __attribute__((ext_vector_type(4)));
typedef unsigned v2u __attribute__((ext_vector_type(2)));
typedef float f32x4 __attribute__((ext_vector_type(4)));
typedef float f32x2 __attribute__((ext_vector_type(2)));
typedef GAS unsigned gu32;
#define RLX_AGENT __ATOMIC_RELAXED, __HIP_MEMORY_SCOPE_AGENT
#define LDS_WAIT() asm volatile("s_waitcnt lgkmcnt(0)" ::: "memory")
#define VM_WAIT() asm volatile("s_waitcnt vmcnt(0)" ::: "memory")
__device__ __forceinline__ unsigned f2bf(float f) { unsigned u = __builtin_bit_cast(unsigned, f); return (u + 0x7fffu + ((u >> 16) & 1u)) >> 16; }
__device__ __forceinline__ unsigned pk2(float lo, float hi) { return f2bf(lo) | (f2bf(hi) << 16); }
__device__ __forceinline__ float bf_lo(unsigned w) { return __uint_as_float(w << 16); }
__device__ __forceinline__ float bf_hi(unsigned w) { return __uint_as_float(w & 0xffff0000u); }

#define XB_TMO      128
#define XB_XCNT(j)  (256  + 64 * (j))
#define XB_XSUB(j)  (1280 + 64 * (j))
#define XB_XGEN(j)  (2304 + 64 * (j))
#define XB_TOP      3328
#define XB_TOPGEN   3392
#define XCD_BAR_WORDS 3456
#define XB_SPIN_CAP (1u << 24)

__device__ __forceinline__ unsigned xb_ld(unsigned* p)              { return __hip_atomic_load(p, __ATOMIC_RELAXED, __HIP_MEMORY_SCOPE_AGENT); }
__device__ __forceinline__ unsigned xb_add(unsigned* p, unsigned v) { return __hip_atomic_fetch_add(p, v, __ATOMIC_RELAXED, __HIP_MEMORY_SCOPE_AGENT); }
__device__ __forceinline__ unsigned xb_xcc_id() { return (unsigned)__builtin_amdgcn_s_getreg((3 << 11) | 20) & 0xFu; }
#define XB_SPIN(cond, bar) do { unsigned _sp = 0; while (cond) { __builtin_amdgcn_s_sleep(1); \
    if ((++_sp & 255u) == 0u) { if (xb_ld(&(bar)[XB_TMO])) break; if (_sp > XB_SPIN_CAP) { atomicAdd(&(bar)[XB_TMO], 1u); break; } } } } while (0)

struct XcdBarrier { unsigned* bar; unsigned x; volatile LAS unsigned* st; };

__device__ __forceinline__ XcdBarrier xcd_barrier_post(unsigned* bar, volatile LAS unsigned* st) {
    XcdBarrier b; b.bar = bar; b.x = xb_xcc_id(); b.st = st;
    if (threadIdx.x == 0) (void)xb_add(&bar[XB_XCNT(b.x)], 1u);
    return b;
}
__device__ __forceinline__ void xcd_barrier_complete(unsigned* bar, unsigned x, unsigned& nloc, unsigned& nx) {
    const unsigned G = gridDim.x * gridDim.y * gridDim.z;
    unsigned sum, cnt, mine, sp = 0u;
    for (;;) {
        sum = 0u; cnt = 0u; mine = 0u;
#pragma unroll
        for (unsigned j = 0; j < 16; ++j) { const unsigned c = xb_ld(&bar[XB_XCNT(j)]); sum += c; cnt += (c > 0u) ? 1u : 0u; mine = (j == x) ? c : mine; }
        if (sum == G) break;
        __builtin_amdgcn_s_sleep(1);
        if ((++sp & 255u) == 0u) { if (xb_ld(&bar[XB_TMO])) break; if (sp > XB_SPIN_CAP) { atomicAdd(&bar[XB_TMO], 1u); break; } }
    }
    nloc = mine > 0u ? mine : 1u; nx = cnt > 0u ? cnt : 1u;
}
__device__ __forceinline__ void xcd_barrier(const XcdBarrier& b) {
    asm volatile("s_waitcnt vmcnt(0)" ::: "memory");
    __syncthreads();
    if (threadIdx.x == 0) {
        unsigned* bar = b.bar;
        __builtin_amdgcn_s_waitcnt(0);
        unsigned nloc = b.st[0], nx = b.st[1];
        if (nloc == 0u) { xcd_barrier_complete(bar, b.x, nloc, nx); b.st[0] = nloc; b.st[1] = nx; }
        const unsigned old = xb_add(&bar[XB_XSUB(b.x)], 1u);
        const unsigned gen = old / nloc;
        if (old + 1u == (gen + 1u) * nloc) {
            __builtin_amdgcn_fence(__ATOMIC_RELEASE, "agent");
            asm volatile("s_waitcnt vmcnt(0)" ::: "memory");
            const unsigned og = xb_add(&bar[XB_TOP], 1u);
            const unsigned tg = og / nx;
            if (og + 1u == (tg + 1u) * nx) xb_add(&bar[XB_TOPGEN], 1u);
            else XB_SPIN(xb_ld(&bar[XB_TOPGEN]) == tg, bar);
            __builtin_amdgcn_fence(__ATOMIC_ACQUIRE, "agent");
            xb_add(&bar[XB_XGEN(b.x)], 1u);
            asm volatile("s_waitcnt vmcnt(0)" ::: "memory");
        } else {
            XB_SPIN(xb_ld(&bar[XB_XGEN(b.x)]) == gen, bar);
            __builtin_amdgcn_fence(__ATOMIC_ACQUIRE, "agent");
            asm volatile("s_waitcnt vmcnt(0)" ::: "memory");
        }
    }
    __syncthreads();
}

struct Args {
    const float* in[24]; float* out; unsigned char* ws; int ph_lo, ph_hi;
};
typedef __attribute__((address_space(4))) const Args* KArgs;
struct Frame {
    LAS unsigned char* lds;
    int tid, lane, wave, vcu, G;
    unsigned char* ws;
};

__device__ __forceinline__ int fresh_bx() { int bx = blockIdx.x; asm volatile("" : "+s"(bx)); return bx; }
__device__ __forceinline__ float wave_sum(float v) {
#pragma unroll
    for (int o = 1; o < 64; o <<= 1) v += __shfl_xor(v, o);
    return v;
}

__device__ const float INV32[32] = {
    1.0f, 0.74989420933f, 0.56234132519f, 0.42169650343f, 0.31622776602f, 0.23713737057f, 0.17782794100f, 0.13335214322f,
    0.1f, 0.074989420933f, 0.056234132519f, 0.042169650343f, 0.031622776602f, 0.023713737057f, 0.017782794100f, 0.013335214322f,
    0.01f, 0.0074989420933f, 0.0056234132519f, 0.0042169650343f, 0.0031622776602f, 0.0023713737057f, 0.0017782794100f, 0.0013335214322f,
    0.001f, 0.00074989420933f, 0.00056234132519f, 0.00042169650343f, 0.00031622776602f, 0.00023713737057f, 0.00017782794100f, 0.00013335214322f };
__device__ const float INV16[16] = {
    1.0f, 0.56234132519f, 0.31622776602f, 0.17782794100f, 0.1f, 0.056234132519f, 0.031622776602f, 0.017782794100f,
    0.01f, 0.0056234132519f, 0.0031622776602f, 0.0017782794100f, 0.001f, 0.00056234132519f, 0.00031622776602f, 0.00017782794100f };

__device__ __forceinline__ void sincos_acc(float af, float& c, float& s) {
    const double a = (double)af; const double kd = __builtin_rint(a * 0.63661977236758134308); const int k = (int)kd;
    const double r = (a - kd * 1.57079632679489655800) - kd * 6.12323399573676603587e-17; const double r2 = r * r;
    const double sn = r * (1.0 + r2 * (-1.0 / 6 + r2 * (1.0 / 120 + r2 * (-1.0 / 5040 + r2 * (1.0 / 362880 + r2 * (-1.0 / 39916800 + r2 * (1.0 / 6227020800.0)))))));
    const double cs = 1.0 + r2 * (-0.5 + r2 * (1.0 / 24 + r2 * (-1.0 / 720 + r2 * (1.0 / 40320 + r2 * (-1.0 / 3628800 + r2 * (1.0 / 479001600.0 + r2 * (-1.0 / 87178291200.0)))))));
    double cc, ss;
    switch (k & 3) { case 0: cc = cs; ss = sn; break; case 1: cc = -sn; ss = cs; break; case 2: cc = -cs; ss = -sn; break; default: cc = sn; ss = -cs; break; }
    c = (float)cc; s = (float)ss;
}

__device__ __forceinline__ void p0_transpose_item(const float* W, int K, int N, bf16* WT, LAS float* scr, int item, int lane) {
    const int nblk = N / 32, kb = item / nblk, nb = item % nblk, k0 = 64 * kb, n0 = 32 * nb;
#pragma unroll 8
    for (int i = 0; i < 32; ++i) { const int kk = 2 * i + (lane >> 5); scr[kk * 33 + (lane & 31)] = W[(size_t)(k0 + kk) * N + n0 + (lane & 31)]; }
    LDS_WAIT(); asm volatile("" ::: "memory");
    const int c = lane & 7;
#pragma unroll
    for (int j = 0; j < 4; ++j) { const int n = (lane >> 3) + 8 * j; const LAS float* s = scr + (8 * c) * 33 + n;
        v4u o; o.x = pk2(s[0 * 33], s[1 * 33]); o.y = pk2(s[2 * 33], s[3 * 33]); o.z = pk2(s[4 * 33], s[5 * 33]); o.w = pk2(s[6 * 33], s[7 * 33]);
        *(GAS v4u*)(WT + (size_t)(n0 + n) * K + k0 + 8 * c) = o; }
    LDS_WAIT(); asm volatile("" ::: "memory");
}

__device__ __forceinline__ float silu_f(float x) { return x / (1.f + __expf(-x)); }

__device__ __forceinline__ void phase_prologue(Frame& F, KArgs a) {
    const float* c_in = a->in[1]; const float* cctx = a->in[3]; const float* w_ada = a->in[4]; const float* b_ada = a->in[5];
    float* mod = (float*)(F.ws + WS_MOD);
    if (F.vcu == 0) {
        f32x2* thd = (f32x2*)(F.ws + WS_TAB);
        for (int e = F.tid; e < 64 * 32; e += NWAVES * 64) { const int pos = e >> 5, i = e & 31; float c, s; sincos_acc((float)pos * INV32[i], c, s); thd[e] = (f32x2){c, s}; }
        f32x2* tdh = (f32x2*)(F.ws + WS_TAB + 16384);
        for (int e = F.tid; e < 64 * 16; e += NWAVES * 64) { const int pos = e >> 4, i = e & 15; float c, s; sincos_acc((float)pos * INV16[i], c, s); tdh[e] = (f32x2){c, s}; }
        if (F.tid < 2) { const int l = F.tid; float s1 = 0.f, s2 = 0.f;
            for (int i = 0; i < 64; ++i) { s1 += a->in[14][l * 64 + i] * a->in[15][l * 64 + i]; s2 += a->in[16][l * 64 + i] * a->in[17][l * 64 + i]; }
            const float lam_init = 0.8f - 0.6f * expf(-0.3f * (float)l);
            float* lam = (float*)(F.ws + WS_TAB + 32768); lam[l * 2 + 0] = expf(s1) - expf(s2) + lam_init; lam[l * 2 + 1] = 1.f - lam_init; }
    }
    {
        LAS float* sv = (LAS float*)(F.lds + RING_OFF);
        LAS float* red = (LAS float*)(F.lds + RING_OFF + 49152);
        for (int e = F.tid; e < 3 * DM; e += NWAVES * 64) { const int v = e / DM, k = e % DM; const float x = v < 2 ? c_in[v * DM + k] : cctx[k]; sv[e] = silu_f(x); }
        __syncthreads();
        const int cg = F.lane & 15, kq = F.lane >> 4;
        for (int it = F.vcu; it < 2 * (NADA / 64); it += F.G) {
            const int l = it / (NADA / 64), ch = it % (NADA / 64);
            const float* W = w_ada + (size_t)l * DM * NADA + ch * 64 + cg * 4;
            f32x4 a0 = {0.f, 0.f, 0.f, 0.f}, a1 = a0, a2 = a0;
#pragma unroll 8
            for (int s = 0; s < DM / 32; ++s) { const int k = s * 32 + F.wave * 4 + kq; const f32x4 w = *(const GAS f32x4*)(W + (size_t)k * NADA);
                a0 += w * sv[k]; a1 += w * sv[DM + k]; a2 += w * sv[2 * DM + k]; }
#pragma unroll
            for (int e = 0; e < 4; ++e) { a0[e] += __shfl_xor(a0[e], 16); a0[e] += __shfl_xor(a0[e], 32); a1[e] += __shfl_xor(a1[e], 16); a1[e] += __shfl_xor(a1[e], 32); a2[e] += __shfl_xor(a2[e], 16); a2[e] += __shfl_xor(a2[e], 32); }
            if (kq == 0) {
#pragma unroll
                for (int e = 0; e < 4; ++e) { red[(F.wave * 3 + 0) * 64 + cg * 4 + e] = a0[e]; red[(F.wave * 3 + 1) * 64 + cg * 4 + e] = a1[e]; red[(F.wave * 3 + 2) * 64 + cg * 4 + e] = a2[e]; } }
            __syncthreads();
            if (F.tid < 192) { const int v = F.tid / 64, cidx = F.tid % 64; float s = 0.f;
#pragma unroll
                for (int w = 0; w < 8; ++w) s += red[(w * 3 + v) * 64 + cidx];
                const int col = ch * 64 + cidx; mod[((size_t)l * 3 + v) * NADA + col] = s + b_ada[(size_t)l * NADA + col]; }
            __syncthreads();
        }
    }
    {
        __syncthreads();
        LAS float* scr = (LAS float*)(F.lds + RING_OFF + F.wave * 16384);
        const int gw = F.vcu * NWAVES + F.wave, NGW = F.G * NWAVES;
        constexpr int I_IN = (DM / 64) * (NIN / 32), I_OUT = (DM / 64) * (DM / 32), I_UP = (DM / 64) * (NUP / 32), I_DN = (DFF / 64) * (DM / 32);
        constexpr int PER_L = I_IN + I_OUT + I_UP + I_DN;
        for (int it = gw; it < 2 * PER_L; it += NGW) {
            const int l = it / PER_L; int r = it % PER_L;
            if (r < I_IN) { p0_transpose_item(a->in[10] + (size_t)l * DM * NIN, DM, NIN, (bf16*)(F.ws + WS_WIN + (size_t)l * 72 * MiB), scr, r, F.lane); continue; } r -= I_IN;
            if (r < I_OUT) { p0_transpose_item(a->in[11] + (size_t)l * DM * DM, DM, DM, (bf16*)(F.ws + WS_WOUT + (size_t)l * 32 * MiB), scr, r, F.lane); continue; } r -= I_OUT;
            if (r < I_UP) { p0_transpose_item(a->in[21] + (size_t)l * DM * NUP, DM, NUP, (bf16*)(F.ws + WS_WUP + (size_t)l * 172 * MiB), scr, r, F.lane); continue; } r -= I_UP;
            p0_transpose_item(a->in[23] + (size_t)l * DFF * DM, DFF, DM, (bf16*)(F.ws + WS_WDN + (size_t)l * 86 * MiB), scr, r, F.lane);
        }
    }
}

struct RowRegs { f32x4 v[16]; };
__device__ __forceinline__ float row_sumsq(const RowRegs& r) {
    float s = 0.f;
#pragma unroll
    for (int j = 0; j < 16; ++j) s += (r.v[j].x * r.v[j].x + r.v[j].y * r.v[j].y) + (r.v[j].z * r.v[j].z + r.v[j].w * r.v[j].w);
    return wave_sum(s);
}
__device__ __forceinline__ void row_load_f32(RowRegs& r, const float* p, int lane) {
    const GAS f32x4* q = (const GAS f32x4*)p + lane;
#pragma unroll
    for (int j = 0; j < 16; ++j) r.v[j] = q[64 * j];
}
__device__ __forceinline__ void row_load_bf16(RowRegs& r, const bf16* p, int lane) {
    const GAS v2u* q = (const GAS v2u*)p + lane;
#pragma unroll
    for (int j = 0; j < 16; ++j) { const v2u w = q[64 * j]; r.v[j] = (f32x4){bf_lo(w.x), bf_hi(w.x), bf_lo(w.y), bf_hi(w.y)}; }
}
__device__ __forceinline__ void row_store_f32(const RowRegs& r, float* p, int lane) {
    GAS f32x4* q = (GAS f32x4*)p + lane;
#pragma unroll
    for (int j = 0; j < 16; ++j) q[64 * j] = r.v[j];
}
__device__ __forceinline__ void row_store_bf16(const RowRegs& r, bf16* p, int lane) {
    GAS v2u* q = (GAS v2u*)p + lane;
#pragma unroll
    for (int j = 0; j < 16; ++j) { v2u w; w.x = pk2(r.v[j].x, r.v[j].y); w.y = pk2(r.v[j].z, r.v[j].w); q[64 * j] = w; }
}
__device__ __forceinline__ void row_modnorm_store(const RowRegs& x, float rstd, const float* g, const float* sc, const float* sh, bf16* out, int lane) {
    GAS v2u* q = (GAS v2u*)out + lane;
#pragma unroll
    for (int j = 0; j < 16; ++j) { const int c = 4 * lane + 256 * j;
        const f32x4 gv = *(const GAS f32x4*)(g + c), sv = *(const GAS f32x4*)(sc + c), hv = *(const GAS f32x4*)(sh + c);
        const f32x4 y = (x.v[j] * rstd) * gv * (sv + 1.f) + hv;
        v2u w; w.x = pk2(y.x, y.y); w.y = pk2(y.z, y.w); q[64 * j] = w; }
}
__device__ __forceinline__ void row_residual(RowRegs& x, const RowRegs& y, float rstd, const float* g, const float* gate, int lane) {
#pragma unroll
    for (int j = 0; j < 16; ++j) { const int c = 4 * lane + 256 * j;
        const f32x4 gv = *(const GAS f32x4*)(g + c), tv = *(const GAS f32x4*)(gate + c);
        x.v[j] = x.v[j] + tv * ((y.v[j] * rstd) * gv); }
}

__device__ __forceinline__ void row_load_part(RowRegs& r, const float* part, int lrow, int lane) {
#pragma unroll
    for (int j = 0; j < 16; ++j) r.v[j] = (f32x4){0.f, 0.f, 0.f, 0.f};
#pragma unroll 2
    for (int c = 0; c < 8; ++c) { const GAS f32x4* q = (const GAS f32x4*)(part + ((size_t)c * 512 + lrow) * DM) + lane;
#pragma unroll
        for (int j = 0; j < 16; ++j) r.v[j] += q[64 * j]; }
}

__device__ __forceinline__ void phase_r0(Frame& F, KArgs a) {
    const float* mod = (const float*)(F.ws + WS_MOD); bf16* hx = (bf16*)(F.ws + WS_HX);
    const int gw = F.vcu * NWAVES + F.wave, NGW = F.G * NWAVES;
    for (int m = gw; m < MROWS; m += NGW) {
        const int b = m / TPB, t = m % TPB; const bool lat = t < SEQ;
        const float* src = lat ? a->in[0] + ((size_t)b * SEQ + t) * DM : a->in[2] + ((size_t)b * CTXL + (t - SEQ)) * DM;
        RowRegs x; row_load_f32(x, src, F.lane);
        const float rstd = 1.f / sqrtf(row_sumsq(x) * (1.f / DM) + EPS);
        const float* mv = mod + (size_t)(0 * 3 + (lat ? b : 2)) * NADA;
        row_modnorm_store(x, rstd, a->in[6]  , mv + DM, mv, hx + (size_t)m * DM, F.lane);
    }
}
__device__ __forceinline__ void phase_r1(Frame& F, KArgs a, int l, bool last) {
    const float* mod = (const float*)(F.ws + WS_MOD); bf16* xs = (bf16*)(F.ws + WS_XS); bf16* hx = (bf16*)(F.ws + WS_HX); const bf16* yb = (const bf16*)(F.ws + WS_Y);
    const int gw = F.vcu * NWAVES + F.wave, NGW = F.G * NWAVES;
    for (int m = gw; m < MROWS; m += NGW) {
        const int b = m / TPB, t = m % TPB; const bool lat = t < SEQ;
        if (last && !lat) continue;
        const float* mv = mod + (size_t)(l * 3 + (lat ? b : 2)) * NADA;
        RowRegs x, y;
        if (l == 0) row_load_f32(x, lat ? a->in[0] + ((size_t)b * SEQ + t) * DM : a->in[2] + ((size_t)b * CTXL + (t - SEQ)) * DM, F.lane);
        else row_load_bf16(x, xs + (size_t)m * DM, F.lane);
        if (lat) row_load_bf16(y, yb + (size_t)m * DM, F.lane); else row_load_part(y, (const float*)(F.ws + WS_PART), b * 256 + (t - SEQ), F.lane);
        const float rstd_y = 1.f / sqrtf(row_sumsq(y) * (1.f / DM) + EPS);
        row_residual(x, y, rstd_y, a->in[7] + (size_t)l * DM, mv + 2 * DM, F.lane);
        row_store_bf16(x, xs + (size_t)m * DM, F.lane);
        const float rstd = 1.f / sqrtf(row_sumsq(x) * (1.f / DM) + EPS);
        row_modnorm_store(x, rstd, a->in[8] + (size_t)l * DM, mv + 4 * DM, mv + 3 * DM, hx + (size_t)m * DM, F.lane);
    }
}
__device__ __forceinline__ void phase_r2(Frame& F, KArgs a, int l, bool last) {
    const float* mod = (const float*)(F.ws + WS_MOD); bf16* xs = (bf16*)(F.ws + WS_XS); bf16* hx = (bf16*)(F.ws + WS_HX); const bf16* yb = (const bf16*)(F.ws + WS_Y);
    const int gw = F.vcu * NWAVES + F.wave, NGW = F.G * NWAVES;
    for (int m = gw; m < MROWS; m += NGW) {
        const int b = m / TPB, t = m % TPB; const bool lat = t < SEQ;
        if (last && !lat) continue;
        const float* mv = mod + (size_t)(l * 3 + (lat ? b : 2)) * NADA;
        RowRegs x, y; row_load_bf16(x, xs + (size_t)m * DM, F.lane);
        if (lat) row_load_bf16(y, yb + (size_t)m * DM, F.lane); else row_load_part(y, (const float*)(F.ws + WS_PART), b * 256 + (t - SEQ), F.lane);
        const float rstd_y = 1.f / sqrtf(row_sumsq(y) * (1.f / DM) + EPS);
        row_residual(x, y, rstd_y, a->in[9] + (size_t)l * DM, mv + 5 * DM, F.lane);
        if (last) { row_store_f32(x, a->out + ((size_t)b * SEQ + t) * DM, F.lane); continue; }
        row_store_bf16(x, xs + (size_t)m * DM, F.lane);
        const float rstd = 1.f / sqrtf(row_sumsq(x) * (1.f / DM) + EPS);
        const float* mn = mod + (size_t)((l + 1) * 3 + (lat ? b : 2)) * NADA;
        row_modnorm_store(x, rstd, a->in[6] + (size_t)(l + 1) * DM, mn + DM, mn, hx + (size_t)m * DM, F.lane);
    }
}

__device__ __forceinline__ void phase_conv(Frame& F, KArgs a, int l, bool last) {
    const bf16* U = (const bf16*)(F.ws + WS_U); bf16* ACT = (bf16*)(F.ws + WS_ACT);
    const float* cw = a->in[22] + (size_t)l * 3 * NUP;
    const int gw = F.vcu * NWAVES + F.wave, NGW = F.G * NWAVES;
    constexpr int NCS = DFF / 256  , NBAND = MROWS / 32  ;
    const int half = F.lane >> 5, l32 = F.lane & 31;
    for (int it = gw; it < NBAND * NCS; it += NGW) {
        const int band = it % NBAND, cs = it / NBAND; const int mb = band * 32; const int t0 = mb % TPB;
        if (last && t0 >= SEQ) continue;
        const int seq_lo = (t0 < SEQ) ? (mb - t0) : (mb - t0 + SEQ), seq_hi = (t0 < SEQ) ? (mb - t0 + SEQ) : (mb - t0 + TPB);
        const int m0 = mb + half * 16;
        const int col = cs * 256 + 8 * l32;
        f32x4 wg[3][2], wv[3][2];
#pragma unroll
        for (int j = 0; j < 3; ++j)
#pragma unroll
            for (int q = 0; q < 2; ++q) { wg[j][q] = *(const GAS f32x4*)(cw + (size_t)j * NUP + col + 4 * q); wv[j][q] = *(const GAS f32x4*)(cw + (size_t)j * NUP + DFF + col + 4 * q); }
#pragma unroll 1
        for (int hb = 0; hb < 2; ++hb) {
        const int mh = m0 + 8 * hb;
        v4u rg[10], rv[10];
#pragma unroll
        for (int r = 0; r < 10; ++r) { const int gm = mh - 1 + r;
            if (gm >= seq_lo && gm < seq_hi) { rg[r] = *(const GAS v4u*)(U + (size_t)gm * NUP + col); rv[r] = *(const GAS v4u*)(U + (size_t)gm * NUP + DFF + col); }
            else { rg[r] = (v4u){0u, 0u, 0u, 0u}; rv[r] = rg[r]; } }
#pragma unroll
        for (int r = 0; r < 8; ++r) {
            v4u ow;
#pragma unroll
            for (int q = 0; q < 4; ++q) {
                const int qq = q >> 1, e0 = (q & 1) * 2;
                const float g_lo = bf_lo(rg[r][q]) * wg[0][qq][e0] + bf_lo(rg[r + 1][q]) * wg[1][qq][e0] + bf_lo(rg[r + 2][q]) * wg[2][qq][e0];
                const float g_hi = bf_hi(rg[r][q]) * wg[0][qq][e0 + 1] + bf_hi(rg[r + 1][q]) * wg[1][qq][e0 + 1] + bf_hi(rg[r + 2][q]) * wg[2][qq][e0 + 1];
                const float v_lo = bf_lo(rv[r][q]) * wv[0][qq][e0] + bf_lo(rv[r + 1][q]) * wv[1][qq][e0] + bf_lo(rv[r + 2][q]) * wv[2][qq][e0];
                const float v_hi = bf_hi(rv[r][q]) * wv[0][qq][e0 + 1] + bf_hi(rv[r + 1][q]) * wv[1][qq][e0 + 1] + bf_hi(rv[r + 2][q]) * wv[2][qq][e0 + 1];
                ow[q] = pk2(g_lo / (1.f + __expf(-g_lo)) * v_lo, g_hi / (1.f + __expf(-g_hi)) * v_hi);
            }
            *(GAS v4u*)(ACT + (size_t)(mh + r) * DFF + col) = ow;
        }
        }
    }
}

template <int MASK>
__device__ __forceinline__ void attn_std_unit(Frame& F, const bf16* P, bf16* O, int b, int qrow0  , int qcol, int kcol, int vcol, int ocol,
                                              int nloc, int loc0, float sink, bool has_sink) {
    using namespace att;
    int lane_ = F.lane; asm volatile("" : "+v"(lane_));
    int lane = lane_, wid = F.wave, r32 = lane & 31, hi = lane >> 5;
    constexpr float SCALE = 0.088388347648318440f; constexpr float C = SCALE * 1.4426950408889634f;
    const size_t base = (size_t)b * TPB;
    const bf16* Qw = P + (base + qrow0 + wid * 32 + r32) * LDP + qcol + hi * 8;
    f32x16 o[4]; float m_reg, l_reg;
    attn_core<MASK, 0, 8>(o, m_reg, l_reg, Qw, P + base * LDP + kcol, P + base * LDP + vcol, nloc, loc0, qrow0 + wid * 32 + r32, C, 8.f / SCALE, (ALAS char*)F.lds);
    if (has_sink) l_reg += __builtin_amdgcn_exp2f(sink * 1.4426950408889634f - m_reg * C);
    asm volatile("" : "+v"(lane_)); lane = lane_; r32 = lane & 31; hi = lane >> 5;
    ALAS float* li_l = (ALAS float*)((ALAS char*)F.lds + WSCR_OFF) + wid * 64;
    if (hi == 0) li_l[r32] = l_reg; asm volatile("s_waitcnt lgkmcnt(0)" ::: "memory");
    bf16* Ow = O + (base + qrow0 + wid * 32) * LDO + ocol;
#pragma unroll
    for (int r = 0; r < 16; ++r) { const int orow = crow(r, hi); const float rl = __builtin_amdgcn_rcpf(li_l[orow]);
#pragma unroll
        for (int d0 = 0; d0 < 4; ++d0) Ow[(size_t)orow * LDO + d0 * 32 + r32] = (bf16)f2bf(o[d0][r] * rl); }
}
__device__ __forceinline__ void attn_diff_unit(Frame& F, const bf16* P, bf16* O, int b, int qrow0, int h, int nloc, int loc0, float lam, float omli, const float* gsub) {
    using namespace att;
    int lane_ = F.lane; asm volatile("" : "+v"(lane_));
    int lane = lane_, wid = F.wave, r32 = lane & 31, hi = lane >> 5;
    constexpr float SCALE = 0.125f; constexpr float C = SCALE * 1.4426950408889634f;
    const size_t base = (size_t)b * TPB;
    const bf16* Qw = P + (base + qrow0 + wid * 32 + r32) * LDP + QB_ + h * 128 + hi * 8;
    const bf16* Kb = P + base * LDP + KB_ + h * 128; const bf16* Vb = P + base * LDP + VB_ + h * 128;
    ALAS float* li_l = (ALAS float*)((ALAS char*)F.lds + WSCR_OFF) + wid * 64;
    f32x16 o[4]; float m_reg, l_reg;
    attn_core<0, 4, 4>(o, m_reg, l_reg, Qw, Kb, Vb, nloc, loc0, 0, C, 8.f / SCALE, (ALAS char*)F.lds);
    asm volatile("" : "+v"(lane_)); lane = lane_; r32 = lane & 31; hi = lane >> 5;
    if (hi == 0) li_l[r32] = l_reg; asm volatile("s_waitcnt lgkmcnt(0)" ::: "memory");
    { float* stash = (float*)(F.ws + WS_STASH) + ((size_t)blockIdx.x * 8 + wid) * 4096 + lane;
#pragma unroll
    for (int d0 = 0; d0 < 4; ++d0) { float* sp = stash + d0 * 1024; asm volatile("" : "+v"(sp));
#pragma unroll
        for (int r = 0; r < 16; ++r) sp[r * 64] = o[d0][r] * __builtin_amdgcn_rcpf(li_l[crow(r, hi)]); } }
    __syncthreads();
    attn_core<0, 0, 4>(o, m_reg, l_reg, Qw, Kb, Vb, nloc, loc0, 0, C, 8.f / SCALE, (ALAS char*)F.lds);
    asm volatile("" : "+v"(lane_)); lane = lane_; r32 = lane & 31; hi = lane >> 5;
    if (hi == 0) li_l[r32] = l_reg; asm volatile("s_waitcnt lgkmcnt(0)" ::: "memory");
    float* stash = (float*)(F.ws + WS_STASH) + ((size_t)blockIdx.x * 8 + wid) * 4096 + lane;
    float g4[4];
#pragma unroll
    for (int d0 = 0; d0 < 4; ++d0) g4[d0] = gsub[d0 * 32 + r32] * omli;
    bf16* Ow = O + (base + qrow0 + wid * 32) * LDO + QB_ + h * 128;
#pragma unroll
    for (int r = 0; r < 16; ++r) { const int orow = crow(r, hi); const float rl = __builtin_amdgcn_rcpf(li_l[orow]);
        float v[4]; float ss = 0.f;
#pragma unroll
        for (int d0 = 0; d0 < 4; ++d0) { v[d0] = o[d0][r] * rl - lam * stash[(d0 * 16 + r) * 64]; ss += v[d0] * v[d0]; }
        ss += __shfl_xor(ss, 1); ss += __shfl_xor(ss, 2); ss += __shfl_xor(ss, 4); ss += __shfl_xor(ss, 8); ss += __shfl_xor(ss, 16);
        const float rstd = 1.f / sqrtf(ss * (1.f / 128.f) + EPS);
#pragma unroll
        for (int d0 = 0; d0 < 4; ++d0) Ow[(size_t)orow * LDO + d0 * 32 + r32] = (bf16)f2bf(v[d0] * rstd * g4[d0]); }
}

__device__ __forceinline__ void phase_attention(Frame& F, KArgs a, int l, bool last) {
    const bf16* P = (const bf16*)(F.ws + WS_P); bf16* O = (bf16*)(F.ws + WS_O);
    const float* lamv = (const float*)(F.ws + WS_TAB + 32768); const float lam = lamv[l * 2], omli = lamv[l * 2 + 1];
    const float* sinkv = a->in[19] + l * 8; const float* gsub = a->in[18] + l * 128; const float* nab = a->in[20] + (size_t)l * 8 * 15 * 31;
#ifndef ATT_MASK
#define ATT_MASK 15
#endif
    if (ATT_MASK & 1) for (int u = F.vcu; u < (last ? 256 : 272); u += F.G) {
        int b, h, qrow0, nloc;
        if (u < 256) { b = u >> 7; h = (u >> 4) & 7; qrow0 = (u & 15) * 256; nloc = 64; } else { const int e = u - 256; b = e >> 3; h = e & 7; qrow0 = SEQ; nloc = 0; }
        __syncthreads(); attn_diff_unit(F, P, O, b, qrow0, h, nloc, 0, lam, omli, gsub);
    }
    if (ATT_MASK & 2) for (int u = F.vcu; u < (last ? 256 : 304); u += F.G) {
        int b, qrow0, qcol, kcol, vcol, nloc; float sink = 0.f; bool has_sink = false;
        if (u < 256) { const int h = (u >> 4) & 7, qb = u & 15; b = u >> 7; qrow0 = qb * 256; qcol = QA + h * 128; kcol = KA + (h >> 2) * 128; vcol = VA + (h >> 2) * 128; nloc = 64; }
        else { const int e = u - 256, g = e >> 4, h = e & 7; b = (e >> 3) & 1; qrow0 = SEQ; nloc = 0;
            if (g == 0) { qcol = QA + h * 128; kcol = KA + (h >> 2) * 128; vcol = VA + (h >> 2) * 128; }
            else if (g == 1) { qcol = QC + h * 128; kcol = KC + (h >> 2) * 128; vcol = VC + (h >> 2) * 128; sink = sinkv[h]; has_sink = true; }
            else { qcol = QD + h * 128; kcol = KD + h * 128; vcol = VD + h * 128; } }
        __syncthreads(); attn_std_unit<0>(F, P, O, b, qrow0, qcol, kcol, vcol, qcol, nloc, 0, sink, has_sink);
    }
    if (ATT_MASK & 4) for (int u = F.vcu; u < 256; u += F.G) { const int b = u >> 7, h = (u >> 4) & 7, qb = u & 15;
        const int lo = max(qb * 256 - 128, 0), hiK = min(qb * 256 + 384, SEQ);
        __syncthreads(); attn_std_unit<2>(F, P, O, b, qb * 256, QC + h * 128, KC + (h >> 2) * 128, VC + (h >> 2) * 128, QC + h * 128, (hiK - lo) / 64, lo, sinkv[h], true); }
    if (ATT_MASK & 8) for (int u = F.vcu; u < 256; u += F.G) { const int b = u >> 7, h = (u >> 4) & 7, qb = u & 15;
        const int r0 = qb * 4; int rlo, nrow;
        if (r0 == 0) { rlo = 0; nrow = 8; } else if (r0 == 60) { rlo = 56; nrow = 8; } else { rlo = min(r0 - 4, 52); nrow = 12; }
        __syncthreads();
        { LAS float* bl = (LAS float*)(F.lds + att::BIAS_OFF); for (int e = F.tid; e < 15 * 31; e += NWAVES * 64) bl[e] = nab[h * 465 + e] * 11.313708498984761f; }
        attn_std_unit<3>(F, P, O, b, qb * 256, QD + h * 128, KD + h * 128, VD + h * 128, QD + h * 128, nrow, rlo * 64, 0.f, false); }
    __syncthreads();
}

__global__ void __launch_bounds__(NWAVES * 64, 2) fwd_kernel(Args args) {
    extern __shared__ __attribute__((aligned(16))) unsigned char lds[];
    Frame F;
    F.lds = (LAS unsigned char*)lds;
    volatile LAS unsigned* MISC = (volatile LAS unsigned*)(F.lds + MISC_OFF);
    F.tid = threadIdx.x; F.lane = F.tid & 63; F.wave = __builtin_amdgcn_readfirstlane(F.tid >> 6);
    F.G = gridDim.x; { const int bx = blockIdx.x; F.vcu = (F.G % 8 == 0) ? (bx % 8) * (F.G / 8) + bx / 8 : bx; }
    KArgs ap = (KArgs)__builtin_amdgcn_kernarg_segment_ptr();
    F.ws = ap->ws;
    gu32* ctl = (gu32*)(F.ws + WS_CTL);
    for (int u = F.tid; u < (LDS_BYTES - LDSCTL_OFF) / 4; u += NWAVES * 64) ((LAS unsigned*)(F.lds + LDSCTL_OFF))[u] = 0u;
    __syncthreads();
    const int lo = ap->ph_lo, hi = ap->ph_hi;
    XcdBarrier bar; bar.bar = (unsigned*)(ctl + CW_BAR); bar.x = 0; bar.st = nullptr;
    if (hi - lo > 1) bar = xcd_barrier_post((unsigned*)(ctl + CW_BAR), MISC + 8);
#ifndef PH_MASK
#define PH_MASK 0x7ff
#endif
#ifndef REP_PRO
#define REP_PRO 1
#endif
#ifndef REP_ATT
#define REP_ATT 1
#endif
#ifndef REP_GEMM
#define REP_GEMM 1
#endif
#ifndef REP_CONV
#define REP_CONV 1
#endif
#define IN(k) (lo <= (k) && (k) < hi)
#define FRESH() asm volatile("" : "+v"(F.tid), "+v"(F.lane), "+s"(ap))
#define EN(j) (((PH_MASK) >> (j)) & 1)
#define SEAM(k) do { if (IN(k) && IN((k) + 1)) xcd_barrier(bar); } while (0)

    if (EN(0) && IN(0)) { for (int rep = 0; rep < REP_PRO; ++rep) { FRESH(); phase_prologue(F, ap); __syncthreads(); } } SEAM(0);
    if (EN(1) && IN(1)) { FRESH(); phase_r0(F, ap); } SEAM(1);
    for (int l = 0; l < 2; ++l) {
        const bool last = (l == 1); const int pb = 2 + 8 * l;
        const pg8::bf16_t* HX = (const pg8::bf16_t*)(F.ws + WS_HX);
        if (EN(2) && IN(pb + 0)) {
            pg8::Gemm g{HX, (const pg8::bf16_t*)(F.ws + WS_WIN + (size_t)l * 72 * MiB), MROWS, NIN, DM};
            pg8::StaticOrder S; S.init(MROWS / 256, NIN, DM, F.G, fresh_bx(), 0);
            pg8::EpiInProj E{(pg8::bf16_t*)(F.ws + WS_P), NIN, (const float*)(F.ws + WS_TAB), (const float*)(F.ws + WS_TAB + 16384), ap->in[12] + l * 128, ap->in[13] + l * 128, (LAS float*)(F.lds + XCH_OFF)};
            pg8::gemm_phase<pg8::EpiInProj, pg8::StaticOrder, true>(F.lds + RING_OFF, g, S, E);
        } SEAM(pb + 0);
        if (EN(4) && IN(pb + 1)) { for (int rep = 0; rep < REP_ATT; ++rep) { FRESH(); phase_attention(F, ap, l, last); } } SEAM(pb + 1);
        if (EN(5) && IN(pb + 2)) {
            pg8::Gemm g{(const pg8::bf16_t*)(F.ws + WS_O), (const pg8::bf16_t*)(F.ws + WS_WOUT + (size_t)l * 32 * MiB), MROWS, DM, DM};
            pg8::SplitOrder S; S.init(DM, DM, F.G, fresh_bx()); if (last) S.ca = 0;
            pg8::EpiSplit E{(pg8::bf16_t*)(F.ws + WS_Y), (float*)(F.ws + WS_PART), DM};
            pg8::gemm_phase<pg8::EpiSplit, pg8::SplitOrder, true>(F.lds + RING_OFF, g, S, E);
        } SEAM(pb + 2);
        if (EN(6) && IN(pb + 3)) { FRESH(); phase_r1(F, ap, l, last); } SEAM(pb + 3);
        if (EN(7) && IN(pb + 4)) {
            pg8::Gemm g{HX, (const pg8::bf16_t*)(F.ws + WS_WUP + (size_t)l * 172 * MiB), MROWS, NUP, DM};
            pg8::StaticOrder S; S.init(last ? 32 : 34, NUP, DM, F.G, fresh_bx(), last ? 1 : 0);
            pg8::EpiBf16 E{(pg8::bf16_t*)(F.ws + WS_U), NUP};
            pg8::gemm_phase<pg8::EpiBf16, pg8::StaticOrder, true>(F.lds + RING_OFF, g, S, E);
        } SEAM(pb + 4);
        if (EN(8) && IN(pb + 5)) { for (int rep = 0; rep < REP_CONV; ++rep) { FRESH(); phase_conv(F, ap, l, last); } } SEAM(pb + 5);
        if (EN(9) && IN(pb + 6)) {
            pg8::Gemm g{(const pg8::bf16_t*)(F.ws + WS_ACT), (const pg8::bf16_t*)(F.ws + WS_WDN + (size_t)l * 86 * MiB), MROWS, DM, DFF};
            pg8::SplitOrder S; S.init(DM, DFF, F.G, fresh_bx()); if (last) S.ca = 0;
            pg8::EpiSplit E{(pg8::bf16_t*)(F.ws + WS_Y), (float*)(F.ws + WS_PART), DM};
            pg8::gemm_phase<pg8::EpiSplit, pg8::SplitOrder, true>(F.lds + RING_OFF, g, S, E);
        } SEAM(pb + 6);
        if (EN(10) && IN(pb + 7)) { FRESH(); phase_r2(F, ap, l, last); } SEAM(pb + 7);
    }
#undef IN
#undef SEAM
}

extern "C" void kernel_launch(void* const* d_in, const int* in_sizes, int n_in, void* d_out, int out_size, void* d_ws, size_t ws_size, hipStream_t stream) {
    static int grid = 0;
    if (grid == 0) {
        if (n_in != 24 || in_sizes[0] != NB * SEQ * DM || out_size != NB * SEQ * DM || ws_size < WS_END) {
            fprintf(stderr, "kernel_launch: unexpected shapes: n_in %d in0 %d out %d ws %zu (need %zu); nothing launched\n", n_in, n_in > 0 ? in_sizes[0] : -1, out_size, ws_size, (size_t)WS_END); grid = -1; return; }
        int dev = 0, cus = 0, per_cu = 0;
        if (hipGetDevice(&dev) != hipSuccess || hipDeviceGetAttribute(&cus, hipDeviceAttributeMultiprocessorCount, dev) != hipSuccess) { grid = -1; return; }
        if (hipFuncSetAttribute((const void*)fwd_kernel, hipFuncAttributeMaxDynamicSharedMemorySize, LDS_BYTES) != hipSuccess) { fprintf(stderr, "kernel_launch: hipFuncSetAttribute failed\n"); grid = -1; return; }
        if (hipOccupancyMaxActiveBlocksPerMultiprocessor(&per_cu, (const void*)fwd_kernel, NWAVES * 64, LDS_BYTES) != hipSuccess || per_cu < 1)
            fprintf(stderr, "kernel_launch: note: occupancy query reports %d workgroups per CU\n", per_cu);
        (void)hipGetLastError();
        grid = cus;
    }
    if (grid < 0) return;
    if (hipMemsetAsync((char*)d_ws + WS_CTL, 0, CTL_ZERO_BYTES, stream) != hipSuccess) return;
    Args a{};
    for (int i = 0; i < 24; ++i) a.in[i] = (const float*)d_in[i];
    a.out = (float*)d_out; a.ws = (unsigned char*)d_ws;
#if MK_SINGLE
    a.ph_lo = 0; a.ph_hi = NPHASE;
    hipLaunchKernelGGL(fwd_kernel, dim3(grid), dim3(NWAVES * 64), LDS_BYTES, stream, a);
#else
    for (int p = 0; p < NPHASE; ++p) { a.ph_lo = p; a.ph_hi = p + 1; hipLaunchKernelGGL(fwd_kernel, dim3(grid), dim3(NWAVES * 64), LDS_BYTES, stream, a); }
#endif
    const hipError_t le = hipPeekAtLastError();
    if (le != hipSuccess) fprintf(stderr, "kernel_launch: launch failed: %s\n", hipGetErrorName(le));
}
```

```cpp
#include <hip/hip_runtime.h>
#include <cstdio>
#include <cstdint>

#ifndef MK_SINGLE
#define MK_SINGLE 1
#endif

namespace pg8 {
#define PG8_LAS __attribute__((address_space(3)))
typedef unsigned short bf16_t;
typedef short bf16x8 __attribute__((ext_vector_type(8)));
typedef float f32x4 __attribute__((ext_vector_type(4)));
typedef unsigned u32x4 __attribute__((ext_vector_type(4)));
constexpr int BM = 256, BK = 64, HALF = 128, HTB = HALF * BK * 2, STAGE_BYTES = 8 * HTB, NXCD = 8, WGM = 8;

__host__ __device__ __forceinline__ int lds_byte(int r, int c) { const int st = (r >> 4) * 2 + (c >> 5), rr = r & 15, cc = c & 31, ob = rr * 64 + cc * 2; return st * 1024 + (ob ^ (((ob >> 9) & 1) << 5)); }
__host__ __device__ __forceinline__ void stage_rc(int b, int& R, int& C) { const int st = b / 1024, sb = b % 1024, swz = sb ^ (((sb >> 9) & 1) << 5); R = (st >> 1) * 16 + swz / 64; C = (st & 1) * 32 + (swz % 64) / 2; }
__host__ __device__ __forceinline__ int perm32(int rho) { const int n = rho >> 4, i = rho & 15; return 8 * (i >> 2) + 4 * n + (i & 3); }

struct Unit { int pm, pn, kt0, nt, slab; };
struct Gemm { const bf16_t* A; const bf16_t* Bt; int M, N, K; };

struct StaticOrder {
    int nM, nN, nwg, G, c, skip, ntk;
    __host__ __device__ void init(int nM_, int N, int K, int G_, int c_, int skip_) { nM = nM_; nN = N / BM; nwg = nM * nN; G = G_; c = c_; skip = skip_; ntk = K / BK; }
    __host__ __device__ bool at(long L, Unit& u) const {
        if (L >= nwg) return false;
        int wgid = (int)L; { const int q = nwg / NXCD, r = nwg % NXCD, xcd = wgid % NXCD, off = wgid / NXCD; wgid = (xcd < r ? xcd * (q + 1) : r * (q + 1) + (xcd - r) * q) + off; }
        const int nig = WGM * nN, gid = wgid / nig, fm = gid * WGM, gsz = (nM - fm) < WGM ? (nM - fm) : WGM;
        u.pm = fm + ((wgid % nig) % gsz); u.pn = (wgid % nig) / gsz; u.kt0 = 0; u.nt = ntk; u.slab = -1;
        if (skip && u.pm >= 16) u.pm += 1;
        return true;
    }
    __host__ __device__ bool next(int i, Unit& u) const { return at((long)i * G + c, u); }
    __device__ __forceinline__ void a_ready(const Unit&) const {}
    __device__ __forceinline__ void done(const Unit&) const {}
};
struct SplitOrder {
    StaticOrder so; int ca, cb;
    __host__ __device__ void init(int N, int K, int G_, int c_) { so.init(32, N, K, G_, c_, 1); const int ntk = K / BK; ca = ((ntk / 8 + 1) / 2) * 2; cb = (ntk - 6 * ca) / 2; if (6 * ca + 2 * cb != ntk || (cb & 1) || cb <= 0) { ca = ntk / 8; cb = ca; } }
    __host__ __device__ bool next(int i, Unit& u) const {
        const long L = (long)i * so.G + so.c;
        if (L < so.nwg) return so.at(L, u);
        const int q = (int)(L - so.nwg); if (ca == 0 || q >= 256) return false;
        const int ch = q & 7, pn = (q >> 3) & 15, pp = q >> 7;
        u.pm = pp ? 33 : 16; u.pn = pn; u.slab = ch; u.kt0 = ch < 6 ? ca * ch : 6 * ca + cb * (ch - 6); u.nt = ch < 6 ? ca : cb;
        return true;
    }
    __device__ __forceinline__ void a_ready(const Unit&) const {}
    __device__ __forceinline__ void done(const Unit&) const {}
};

__device__ __forceinline__ unsigned cvt_pk_bf16(float lo, float hi) { unsigned r; asm volatile("v_cvt_pk_bf16_f32 %0, %1, %2" : "=v"(r) : "v"(lo), "v"(hi)); return r; }

struct EpiBf16 {
    static constexpr bool PERM = true, AFTER_DRAIN = false;
    bf16_t* O; int ldc;
    __device__ __forceinline__ void operator()(const f32x4 (&acc)[2][2][4][2], const Unit& u, int wr, int wc, int fr, int fq) const {
        const int row0 = u.pm * BM + wr * 64 + fr; const int col0 = u.pn * BM + wc * 32 + 8 * fq;
#pragma unroll
        for (int ai = 0; ai < 2; ++ai)
#pragma unroll
            for (int m = 0; m < 4; ++m) { bf16_t* rowp = O + (size_t)(row0 + ai * HALF + m * 16) * ldc + col0;
#pragma unroll
                for (int bj = 0; bj < 2; ++bj) { const f32x4 v0 = acc[ai][bj][m][0], v1 = acc[ai][bj][m][1];
                    u32x4 w; w.x = cvt_pk_bf16(v0[0], v0[1]); w.y = cvt_pk_bf16(v0[2], v0[3]); w.z = cvt_pk_bf16(v1[0], v1[1]); w.w = cvt_pk_bf16(v1[2], v1[3]);
                    *(u32x4*)(rowp + bj * HALF) = w; } }
    }
};

struct EpiSplit {
    static constexpr bool PERM = true, AFTER_DRAIN = false;
    bf16_t* O; float* part; int ldc;
    __device__ __forceinline__ void operator()(const f32x4 (&acc)[2][2][4][2], const Unit& u, int wr, int wc, int fr, int fq) const {
        const int col0 = u.pn * BM + wc * 32 + 8 * fq;
        if (u.slab < 0) {
            const int row0 = u.pm * BM + wr * 64 + fr;
#pragma unroll
            for (int ai = 0; ai < 2; ++ai)
#pragma unroll
                for (int m = 0; m < 4; ++m) { bf16_t* rowp = O + (size_t)(row0 + ai * HALF + m * 16) * ldc + col0;
#pragma unroll
                    for (int bj = 0; bj < 2; ++bj) { const f32x4 v0 = acc[ai][bj][m][0], v1 = acc[ai][bj][m][1];
                        u32x4 w; w.x = cvt_pk_bf16(v0[0], v0[1]); w.y = cvt_pk_bf16(v0[2], v0[3]); w.z = cvt_pk_bf16(v1[0], v1[1]); w.w = cvt_pk_bf16(v1[2], v1[3]);
                        *(u32x4*)(rowp + bj * HALF) = w; } }
        } else {
            const int row0 = (u.pm == 16 ? 0 : 256) + wr * 64 + fr; float* pb = part + (size_t)u.slab * 512 * ldc;
#pragma unroll
            for (int ai = 0; ai < 2; ++ai)
#pragma unroll
                for (int m = 0; m < 4; ++m) { float* rowp = pb + (size_t)(row0 + ai * HALF + m * 16) * ldc + col0;
#pragma unroll
                    for (int bj = 0; bj < 2; ++bj) { *(f32x4*)(rowp + bj * HALF) = acc[ai][bj][m][0]; *(f32x4*)(rowp + bj * HALF + 4) = acc[ai][bj][m][1]; } }
        }
    }
};

struct EpiInProj {
    static constexpr bool PERM = true, AFTER_DRAIN = false;
    bf16_t* O; int ldc; const float* thd; const float* tdh; const float* gq; const float* gk; PG8_LAS float* xch;
    __device__ __forceinline__ void operator()(f32x4 (&acc)[2][2][4][2], const Unit& u, int wr, int wc, int fr, int fq) const {
        const int pmb = u.pm % 17; const bool ctx = (pmb == 16); const int pn = u.pn;
        const int kind = pn < 4 ? 1 : pn < 8 ? 2 : pn < 12 ? 3 : pn < 16 ? 0 : pn == 16 ? 4 : pn < 18 ? 0 : pn < 22 ? 2 : pn == 26 ? 3 : 0;
        if (kind == 1 || kind == 4) {
            const float* g = (kind == 1 ? gq : gk) + wc * 32 + 8 * fq;
            const f32x4 g0 = *(const f32x4*)g, g1 = *(const f32x4*)(g + 4);
#pragma unroll
            for (int ai = 0; ai < 2; ++ai)
#pragma unroll
                for (int m = 0; m < 4; ++m)
#pragma unroll
                    for (int bj = 0; bj < 2; ++bj) { const f32x4 a = acc[ai][bj][m][0], b = acc[ai][bj][m][1];
                        float s = (a[0] * a[0] + a[1] * a[1]) + (a[2] * a[2] + a[3] * a[3]) + (b[0] * b[0] + b[1] * b[1]) + (b[2] * b[2] + b[3] * b[3]);
                        s += __shfl_xor(s, 16); s += __shfl_xor(s, 32);
                        if (fq == 0) xch[((ai * HALF + wr * 64 + m * 16 + fr) * 2 + bj) * 4 + wc] = s; }
            asm volatile("s_waitcnt lgkmcnt(0)" ::: "memory"); __builtin_amdgcn_s_barrier(); asm volatile("" ::: "memory");
#pragma unroll
            for (int ai = 0; ai < 2; ++ai)
#pragma unroll
                for (int m = 0; m < 4; ++m)
#pragma unroll
                    for (int bj = 0; bj < 2; ++bj) { const f32x4 p = *(const PG8_LAS f32x4*)(xch + ((ai * HALF + wr * 64 + m * 16 + fr) * 2 + bj) * 4);
                        const float rstd = __builtin_amdgcn_rsqf(((p[0] + p[1]) + (p[2] + p[3])) * (1.f / 128.f) + 1e-6f);
                        acc[ai][bj][m][0] = acc[ai][bj][m][0] * rstd * g0; acc[ai][bj][m][1] = acc[ai][bj][m][1] * rstd * g1; }
        }
        if (kind != 0 && !ctx) {
            const bool dh = (kind == 2);
#pragma unroll
            for (int ai = 0; ai < 2; ++ai)
#pragma unroll
                for (int m = 0; m < 4; ++m) { const int t = pmb * 256 + ai * HALF + wr * 64 + m * 16 + fr; const int grow = t >> 6, gcol = t & 63;
                    const float* tp = dh ? tdh + (size_t)((((wc & 1) == 0) ? grow : gcol) * 16 + 4 * fq) * 2 : thd + (size_t)(((wc < 2) ? grow : gcol) * 32 + 16 * (wc & 1) + 4 * fq) * 2;
                    const f32x4 c01 = *(const f32x4*)tp, c23 = *(const f32x4*)(tp + 4);
#pragma unroll
                    for (int bj = 0; bj < 2; ++bj) { f32x4 a = acc[ai][bj][m][0], b = acc[ai][bj][m][1];
                        acc[ai][bj][m][0] = (f32x4){a[0] * c01[0] - a[1] * c01[1], a[0] * c01[1] + a[1] * c01[0], a[2] * c01[2] - a[3] * c01[3], a[2] * c01[3] + a[3] * c01[2]};
                        acc[ai][bj][m][1] = (f32x4){b[0] * c23[0] - b[1] * c23[1], b[0] * c23[1] + b[1] * c23[0], b[2] * c23[2] - b[3] * c23[3], b[2] * c23[3] + b[3] * c23[2]}; } }
        }
        const int row0 = u.pm * BM + wr * 64 + fr; const int col0 = u.pn * BM + wc * 32 + 8 * fq;
#pragma unroll
        for (int ai = 0; ai < 2; ++ai)
#pragma unroll
            for (int m = 0; m < 4; ++m) { bf16_t* rowp = O + (size_t)(row0 + ai * HALF + m * 16) * ldc + col0;
#pragma unroll
                for (int bj = 0; bj < 2; ++bj) { const f32x4 v0 = acc[ai][bj][m][0], v1 = acc[ai][bj][m][1];
                    u32x4 w; w.x = cvt_pk_bf16(v0[0], v0[1]); w.y = cvt_pk_bf16(v0[2], v0[3]); w.z = cvt_pk_bf16(v1[0], v1[1]); w.w = cvt_pk_bf16(v1[2], v1[3]);
                    *(u32x4*)(rowp + bj * HALF) = w; } }
    }
};

struct EpiUpConv {
    static constexpr bool PERM = true, AFTER_DRAIN = false;
    bf16_t* ACT; float* side; const float* cw; PG8_LAS float* xb; int dff;
    static __device__ __forceinline__ float dppf(float old, float src, const int ctrl_sel) {
        const int o = __float_as_int(old), s = __float_as_int(src); int r;
        if (ctrl_sel == 0) r = __builtin_amdgcn_update_dpp(o, s, 0x111, 0xF, 0xF, false);
        else if (ctrl_sel == 1) r = __builtin_amdgcn_update_dpp(o, s, 0x101, 0xF, 0xF, false);
        else if (ctrl_sel == 2) r = __builtin_amdgcn_update_dpp(o, s, 0x121, 0xF, 0xF, false);
        else r = __builtin_amdgcn_update_dpp(o, s, 0x12F, 0xF, 0xF, false);
        return __int_as_float(r);
    }
    static __device__ __forceinline__ f32x4 dpp4(const f32x4 old, const f32x4 src, const int c) { return (f32x4){dppf(old[0], src[0], c), dppf(old[1], src[1], c), dppf(old[2], src[2], c), dppf(old[3], src[3], c)}; }
    static __device__ __forceinline__ int xidx(int ai, int wr, int wc, int which, int bj, int fq, int n) { return ((((((ai * 2 + wr) * 4 + wc) * 2 + which) * 2 + bj) * 4 + fq) * 2 + n) * 4; }
    __device__ __forceinline__ void operator()(const f32x4 (&acc)[2][2][4][2], const Unit& u, int wr, int wc, int fr, int fq) const {
        const int cbase = wc * 32 + 8 * fq;
#pragma unroll
        for (int ai = 0; ai < 2; ++ai)
#pragma unroll
            for (int bj = 0; bj < 2; ++bj)
#pragma unroll
                for (int n = 0; n < 2; ++n) {
                    if (fr == 0) *(PG8_LAS f32x4*)(xb + xidx(ai, wr, wc, 0, bj, fq, n)) = acc[ai][bj][0][n];
                    if (fr == 15) *(PG8_LAS f32x4*)(xb + xidx(ai, wr, wc, 1, bj, fq, n)) = acc[ai][bj][3][n]; }
        { float* sp = side + (size_t)u.pm * 4 * (2 * dff) + (size_t)u.pn * 256 + cbase;
          if (wr == 0 && fr < 2) {
#pragma unroll
              for (int bj = 0; bj < 2; ++bj)
#pragma unroll
                  for (int n = 0; n < 2; ++n) *(f32x4*)(sp + (size_t)fr * (2 * dff) + bj * 128 + 4 * n) = acc[0][bj][0][n]; }
          if (wr == 1 && fr >= 14) {
#pragma unroll
              for (int bj = 0; bj < 2; ++bj)
#pragma unroll
                  for (int n = 0; n < 2; ++n) *(f32x4*)(sp + (size_t)(fr - 12) * (2 * dff) + bj * 128 + 4 * n) = acc[1][bj][3][n]; } }
        asm volatile("s_waitcnt lgkmcnt(0)" ::: "memory"); __builtin_amdgcn_s_barrier(); asm volatile("" ::: "memory");
        const float* cwp = cw + u.pn * 128 + cbase;
        const f32x4 zero4 = {0.f, 0.f, 0.f, 0.f};
#pragma unroll
        for (int ai = 0; ai < 2; ++ai)
#pragma unroll
            for (int m = 0; m < 4; ++m) {
                const int beta = 2 * ai + wr;
                u32x4 w;
#pragma unroll
                for (int n = 0; n < 2; ++n) {
                    f32x4 res[2];
#pragma unroll
                    for (int bj = 0; bj < 2; ++bj) {
                        const f32x4 cur = acc[ai][bj][m][n];
                        f32x4 oldp, oldn;
                        if (m > 0) oldp = dpp4(zero4, acc[ai][bj][m - 1][n], 2);
                        else if (beta > 0) oldp = *(const PG8_LAS f32x4*)(xb + xidx((beta - 1) >> 1, (beta - 1) & 1, wc, 1, bj, fq, n));
                        else oldp = zero4;
                        if (m < 3) oldn = dpp4(zero4, acc[ai][bj][m + 1][n], 3);
                        else if (beta < 3) oldn = *(const PG8_LAS f32x4*)(xb + xidx((beta + 1) >> 1, (beta + 1) & 1, wc, 0, bj, fq, n));
                        else oldn = zero4;
                        const f32x4 prev = dpp4(oldp, cur, 0), next = dpp4(oldn, cur, 1);
                        const float* wp = cwp + bj * dff + 4 * n;
                        const f32x4 w0 = *(const f32x4*)wp, w1 = *(const f32x4*)(wp + 2 * dff), w2 = *(const f32x4*)(wp + 4 * dff);
                        res[bj] = prev * w0 + cur * w1 + next * w2;
                    }
                    f32x4 o;
#pragma unroll
                    for (int e = 0; e < 4; ++e) o[e] = res[0][e] * __builtin_amdgcn_rcpf(1.f + __expf(-res[0][e])) * res[1][e];
                    if (n == 0) { w.x = cvt_pk_bf16(o[0], o[1]); w.y = cvt_pk_bf16(o[2], o[3]); } else { w.z = cvt_pk_bf16(o[0], o[1]); w.w = cvt_pk_bf16(o[2], o[3]); }
                }
                *(u32x4*)(ACT + (size_t)(u.pm * BM + ai * HALF + wr * 64 + m * 16 + fr) * dff + u.pn * 128 + cbase) = w;
            }
    }
};

template <class Epi, class Sched, bool ALIGN_EPI = false>
__device__ __forceinline__ void gemm_phase(PG8_LAS unsigned char* lds, const Gemm g, const Sched& S, const Epi& E) {
    int tid_ = threadIdx.x; asm volatile("" : "+v"(tid_));
    const int tid = tid_, wid = __builtin_amdgcn_readfirstlane(tid >> 6), lane = tid & 63, wr = wid >> 2, wc = wid & 3, fr = lane & 15, fq = lane >> 4;
    const int K = g.K;
    unsigned voffA[2], voffB[2];
#pragma unroll
    for (int i = 0; i < 2; ++i) { int R, C; stage_rc(tid * 16 + i * 8192, R, C); const int Rb = Epi::PERM ? ((R & ~31) + perm32(R & 31)) : R;
        voffA[i] = (unsigned)(R * K + C) * 2u; voffB[i] = (unsigned)(Rb * K + C) * 2u; }
    const size_t kstep = (size_t)(BK * 2);
    const size_t hstep = (size_t)HALF * K * 2;
    const size_t tstep = 2 * hstep;
    const unsigned ldsw = (unsigned)wid * 1024u;
    const int aoff = lds_byte(wr * 64 + fr, fq * 8), boff = lds_byte(wc * 32 + fr, fq * 8);
#define PG8_SA(b, h) (((b) * 2 + (h)) * HTB)
#define PG8_SB(b, h) ((4 + (b) * 2 + (h)) * HTB)
#define PG8_STAGE(bufoff, gbase, voff) do { _Pragma("unroll") for (int _i = 0; _i < 2; ++_i) \
        __builtin_amdgcn_global_load_lds((const unsigned*)((const char*)(gbase) + (voff)[_i]), (PG8_LAS unsigned*)(lds + (bufoff) + ldsw + _i * 8192), 16, 0, 0); } while (0)
#define PG8_LDA(dst, b, h) do { _Pragma("unroll") for (int m = 0; m < 4; ++m) _Pragma("unroll") for (int k = 0; k < 2; ++k) dst[m][k] = *(const PG8_LAS bf16x8*)(lds + PG8_SA(b, h) + aoff + m * 2048 + k * 1024); } while (0)
#define PG8_LDB(dst, b, h) do { _Pragma("unroll") for (int n = 0; n < 2; ++n) _Pragma("unroll") for (int k = 0; k < 2; ++k) dst[n][k] = *(const PG8_LAS bf16x8*)(lds + PG8_SB(b, h) + boff + n * 2048 + k * 1024); } while (0)
#define PG8_MMA(ai, bj, At, Bt) do { __builtin_amdgcn_s_setprio(1); _Pragma("unroll") for (int m = 0; m < 4; ++m) _Pragma("unroll") for (int n = 0; n < 2; ++n) _Pragma("unroll") for (int k = 0; k < 2; ++k) \
        acc[ai][bj][m][n] = __builtin_amdgcn_mfma_f32_16x16x32_bf16(Bt[n][k], At[m][k], acc[ai][bj][m][n], 0, 0, 0); __builtin_amdgcn_s_setprio(0); } while (0)
#define PG8_WAIT_V(n) asm volatile("s_waitcnt vmcnt(" #n ")" ::: "memory")
#define PG8_WAIT_L(n) asm volatile("s_waitcnt lgkmcnt(" #n ")" ::: "memory")
#define PG8_BAR __builtin_amdgcn_s_barrier()
#define PG8_SCHED __builtin_amdgcn_sched_barrier(0)
    Unit cur, nxt; int ui = 0;
    if (!S.next(0, cur)) return;
    f32x4 acc[2][2][4][2];
#pragma unroll
    for (int a = 0; a < 2; ++a)
#pragma unroll
        for (int b = 0; b < 2; ++b)
#pragma unroll
            for (int m = 0; m < 4; ++m)
#pragma unroll
                for (int n = 0; n < 2; ++n) acc[a][b][m][n] = (f32x4){0.f, 0.f, 0.f, 0.f};
    bf16x8 At[4][2], B0[2][2], B1[2][2];
    const char* cA = (const char*)g.A + (size_t)cur.pm * tstep + (size_t)cur.kt0 * kstep; const char* cB = (const char*)g.Bt + (size_t)cur.pn * tstep + (size_t)cur.kt0 * kstep;
    S.a_ready(cur);
    PG8_STAGE(PG8_SB(0, 0), cB, voffB); PG8_STAGE(PG8_SB(0, 1), cB + hstep, voffB); PG8_STAGE(PG8_SA(0, 0), cA, voffA); PG8_STAGE(PG8_SA(0, 1), cA + hstep, voffA);
    if (wr == 1) PG8_BAR;
    PG8_WAIT_V(2); PG8_BAR;
    PG8_STAGE(PG8_SB(1, 0), cB + kstep, voffB); PG8_STAGE(PG8_SA(1, 0), cA + kstep, voffA); PG8_STAGE(PG8_SB(1, 1), cB + hstep + kstep, voffB);
    PG8_WAIT_V(6); PG8_BAR;
    for (;;) {
        const bool has_next = S.next(ui + 1, nxt);
        const char* nA = has_next ? (const char*)g.A + (size_t)nxt.pm * tstep + (size_t)nxt.kt0 * kstep : cA; const char* nB = has_next ? (const char*)g.Bt + (size_t)nxt.pn * tstep + (size_t)nxt.kt0 * kstep : cB;
        const int nt = cur.nt;
        for (int t = 0; t < nt; t += 2) {
            const bool last = (t == nt - 2);
            const char* a1 = cA + (size_t)(t + 1) * kstep;
            const char* a2 = last ? nA : cA + (size_t)(t + 2) * kstep; const char* b2 = last ? nB : cB + (size_t)(t + 2) * kstep;
            const char* a3 = a2 + kstep; const char* b3 = b2 + kstep;
            if (last && has_next) S.a_ready(nxt);
            PG8_LDB(B0, 0, 0); PG8_LDB(B1, 0, 1); PG8_SCHED; PG8_LDA(At, 0, 0); PG8_STAGE(PG8_SA(1, 1), a1 + hstep, voffA);
            PG8_WAIT_V(8); PG8_WAIT_L(0); PG8_BAR; PG8_MMA(0, 0, At, B0); PG8_MMA(0, 1, At, B1); PG8_BAR; PG8_SCHED;
            PG8_LDA(At, 0, 1); PG8_STAGE(PG8_SB(0, 0), b2, voffB); PG8_STAGE(PG8_SB(0, 1), b2 + hstep, voffB); PG8_STAGE(PG8_SA(0, 0), a2, voffA);
            PG8_WAIT_V(8); PG8_WAIT_L(0); PG8_BAR; PG8_MMA(1, 0, At, B0); PG8_MMA(1, 1, At, B1); PG8_BAR; PG8_SCHED;
            PG8_LDB(B0, 1, 0); PG8_LDB(B1, 1, 1); PG8_SCHED; PG8_LDA(At, 1, 0); PG8_STAGE(PG8_SA(0, 1), a2 + hstep, voffA);
            PG8_WAIT_V(8); PG8_WAIT_L(0); PG8_BAR; PG8_MMA(0, 0, At, B0); PG8_MMA(0, 1, At, B1); PG8_BAR; PG8_SCHED;
            PG8_LDA(At, 1, 1); PG8_STAGE(PG8_SB(1, 0), b3, voffB); PG8_STAGE(PG8_SB(1, 1), b3 + hstep, voffB); PG8_STAGE(PG8_SA(1, 0), a3, voffA);
            PG8_WAIT_V(8); PG8_WAIT_L(0); PG8_BAR; PG8_MMA(1, 0, At, B0); PG8_MMA(1, 1, At, B1); PG8_BAR; PG8_SCHED;
        }
        if constexpr (ALIGN_EPI) { if (wr == 0) PG8_BAR; }
        if constexpr (!Epi::AFTER_DRAIN) { E(acc, cur, wr, wc, fr, fq); S.done(cur); }
        if (!has_next) break;
#pragma unroll
        for (int a = 0; a < 2; ++a)
#pragma unroll
            for (int b = 0; b < 2; ++b)
#pragma unroll
                for (int m = 0; m < 4; ++m)
#pragma unroll
                    for (int n = 0; n < 2; ++n) acc[a][b][m][n] = (f32x4){0.f, 0.f, 0.f, 0.f};
        cur = nxt; cA = nA; cB = nB; ++ui;
        if constexpr (ALIGN_EPI) { if (wr == 1) PG8_BAR; }
    }
    PG8_WAIT_V(0);
    if constexpr (!ALIGN_EPI) { if (wr == 0) PG8_BAR; }
    PG8_BAR;
#undef PG8_SA
#undef PG8_SB
#undef PG8_STAGE
#undef PG8_LDA
#undef PG8_LDB
#undef PG8_MMA
#undef PG8_WAIT_V
#undef PG8_WAIT_L
#undef PG8_BAR
#undef PG8_SCHED
}
}

namespace att {
#define ALAS __attribute__((address_space(3)))
typedef unsigned short bf16;
typedef short bf16x8 __attribute__((ext_vector_type(8)));
typedef short s16x4 __attribute__((ext_vector_type(4)));
typedef float f32x16 __attribute__((ext_vector_type(16)));
typedef unsigned u32x4 __attribute__((ext_vector_type(4)));
constexpr int LDP = 9216, LDO = 4096;
constexpr int SLOT = 32768;
constexpr int WSCR_OFF = 131072 + 1024, BIAS_OFF = WSCR_OFF + 2048, SHM_END = BIAS_OFF + 2048;
constexpr int NCTX_T = 4;
#define KSWZ(row, colB) ((row) * 256 + ((colB) ^ (((row) & 7) << 4)))
#define SBAR() __builtin_amdgcn_sched_barrier(0)
__device__ __forceinline__ int crow(int r, int hi) { return (r & 3) + 8 * (r >> 2) + 4 * hi; }
__device__ __forceinline__ unsigned cvtpk(float lo, float hi) { unsigned r; asm volatile("v_cvt_pk_bf16_f32 %0, %1, %2" : "=v"(r) : "v"(lo), "v"(hi)); return r; }

__device__ __forceinline__ void partialSM(f32x16& p0, f32x16& p1, float& m_reg, float& mn, float& alpha, const float C, const float thr_raw) {
    float pmax = p0[0];
#pragma unroll
    for (int r = 1; r < 16; ++r) pmax = fmaxf(pmax, p0[r]);
#pragma unroll
    for (int r = 0; r < 16; ++r) pmax = fmaxf(pmax, p1[r]);
    { auto rr = __builtin_amdgcn_permlane32_swap(__float_as_uint(pmax), __float_as_uint(pmax), false, false);
      pmax = fmaxf(__uint_as_float(rr[0]), __uint_as_float(rr[1])); }
    if (__builtin_expect(__all(pmax - m_reg <= thr_raw), 1)) { mn = m_reg; alpha = 1.f; }
    else { mn = fmaxf(m_reg, pmax); alpha = __builtin_amdgcn_exp2f((m_reg - mn) * C); m_reg = mn; }
    const float mnC = -mn * C;
#pragma unroll
    for (int r = 0; r < 16; ++r) p0[r] = fmaf(p0[r], C, mnC);
#pragma unroll
    for (int r = 0; r < 16; ++r) p1[r] = fmaf(p1[r], C, mnC);
#pragma unroll
    for (int r = 0; r < 16; ++r) p0[r] = __builtin_amdgcn_exp2f(p0[r]);
}
__device__ __forceinline__ void finishSM(f32x16& p0, f32x16& p1, float alpha, float& l_reg, bf16x8& pa0, bf16x8& pa1, bf16x8& pa2, bf16x8& pa3) {
#pragma unroll
    for (int r = 0; r < 16; ++r) p1[r] = __builtin_amdgcn_exp2f(p1[r]);
    float ps = 0;
#pragma unroll
    for (int r = 0; r < 16; ++r) ps += p0[r];
#pragma unroll
    for (int r = 0; r < 16; ++r) ps += p1[r];
    { auto rr = __builtin_amdgcn_permlane32_swap(__float_as_uint(ps), __float_as_uint(ps), false, false);
      ps = __uint_as_float(rr[0]) + __uint_as_float(rr[1]); }
    l_reg = l_reg * alpha + ps;
#define PK4(P, BASE, OUT) do { unsigned a0 = cvtpk(P[BASE + 0], P[BASE + 1]), a1 = cvtpk(P[BASE + 2], P[BASE + 3]);   \
    unsigned b0 = cvtpk(P[BASE + 4], P[BASE + 5]), b1 = cvtpk(P[BASE + 6], P[BASE + 7]);                              \
    auto r0 = __builtin_amdgcn_permlane32_swap(a0, b0, false, false); auto r1 = __builtin_amdgcn_permlane32_swap(a1, b1, false, false); \
    u32x4 w = {r0[0], r1[0], r0[1], r1[1]}; OUT = __builtin_bit_cast(bf16x8, w); } while (0)
    PK4(p0, 0, pa0); PK4(p0, 8, pa1); PK4(p1, 0, pa2); PK4(p1, 8, pa3);
#undef PK4
}
template <int D0LO, int D0N>
__device__ __forceinline__ void qkt(f32x16& p0, f32x16& p1, const ALAS char* Ks, const bf16x8* qr, int r32, int hi) {
    p0 = f32x16{}; p1 = f32x16{};
#pragma unroll
    for (int d0 = D0LO; d0 < D0LO + D0N; ++d0) { const int cb = (d0 * 16 + hi * 8) * 2;
        const bf16x8 b0 = *(const ALAS bf16x8*)(Ks + KSWZ(r32, cb));
        const bf16x8 b1 = *(const ALAS bf16x8*)(Ks + KSWZ(32 + r32, cb));
        p0 = __builtin_amdgcn_mfma_f32_32x32x16_bf16(b0, qr[d0], p0, 0, 0, 0);
        p1 = __builtin_amdgcn_mfma_f32_32x32x16_bf16(b1, qr[d0], p1, 0, 0, 0); }
}
__device__ __forceinline__ int v_st(int k, int c) { const int kk = (k & ~0xC) | ((k & 4) << 1) | ((k & 8) >> 1); return ((kk >> 3) * 4 + (c >> 5)) * 512 + ((kk & 7) * 32 + (c & 31)) * 2; }
__device__ __forceinline__ int v_rd_base(int lane) { return ((lane & 3) << 3) | (((lane >> 2) & 3) << 6) | (((lane >> 4) & 1) << 5) | (((lane >> 5) & 1) << 8); }
constexpr int v_rd_off(int d0, int ks, int half) { return d0 * 512 + ks * 4096 + half * 2048; }
template <int OFF> __device__ __forceinline__ s16x4 tr_read(int vb) {
    s16x4 r; asm volatile("ds_read_b64_tr_b16 %0, %1 offset:%2" : "=&v"(r) : "v"(vb), "i"(OFF) : "memory"); return r;
}
template <int D0> __device__ __forceinline__ void pv_one(f32x16& od, int vb, bf16x8 pa0, bf16x8 pa1, bf16x8 pa2, bf16x8 pa3) {
    const s16x4 l0 = tr_read<v_rd_off(D0, 0, 0)>(vb), h0 = tr_read<v_rd_off(D0, 0, 1)>(vb), l1 = tr_read<v_rd_off(D0, 1, 0)>(vb), h1 = tr_read<v_rd_off(D0, 1, 1)>(vb);
    const s16x4 l2 = tr_read<v_rd_off(D0, 2, 0)>(vb), h2 = tr_read<v_rd_off(D0, 2, 1)>(vb), l3 = tr_read<v_rd_off(D0, 3, 0)>(vb), h3 = tr_read<v_rd_off(D0, 3, 1)>(vb);
    asm volatile("s_waitcnt lgkmcnt(0)" ::: "memory"); SBAR();
#define PK(L, H) (bf16x8){L[0], L[1], L[2], L[3], H[0], H[1], H[2], H[3]}
    od = __builtin_amdgcn_mfma_f32_32x32x16_bf16(pa0, PK(l0, h0), od, 0, 0, 0);
    od = __builtin_amdgcn_mfma_f32_32x32x16_bf16(pa1, PK(l1, h1), od, 0, 0, 0);
    od = __builtin_amdgcn_mfma_f32_32x32x16_bf16(pa2, PK(l2, h2), od, 0, 0, 0);
    od = __builtin_amdgcn_mfma_f32_32x32x16_bf16(pa3, PK(l3, h3), od, 0, 0, 0);
#undef PK
}
__device__ __forceinline__ void pv_d0(f32x16* o, int vb, bf16x8 pa0, bf16x8 pa1, bf16x8 pa2, bf16x8 pa3) {
    pv_one<0>(o[0], vb, pa0, pa1, pa2, pa3); pv_one<1>(o[1], vb, pa0, pa1, pa2, pa3); pv_one<2>(o[2], vb, pa0, pa1, pa2, pa3); pv_one<3>(o[3], vb, pa0, pa1, pa2, pa3);
}

template <int MASK>
__device__ __forceinline__ void apply_mask(f32x16& p0, f32x16& p1, int j, int loc0, int qp, int hi, const ALAS float* bias) {
    if constexpr (MASK == 2) {
        if (j >= NCTX_T) { const int kbase = loc0 + 64 * (j - NCTX_T);
#pragma unroll
            for (int r = 0; r < 16; ++r) { const int d0 = qp - (kbase + crow(r, hi)); const int d1 = d0 - 32;
                if (d0 > 128 || d0 < -128) p0[r] = -1e30f;
                if (d1 > 128 || d1 < -128) p1[r] = -1e30f; } }
    } else if constexpr (MASK == 3) {
        if (j >= NCTX_T) { const int kbase = loc0 + 64 * (j - NCTX_T);
            const int qrow = qp >> 6, qcol = qp & 63; const int rs = min(max(qrow - 4, 0), 56), cs = min(max(qcol - 8, 0), 48);
            const int kr = kbase >> 6; const int dr = kr - rs;
            if (dr < 0 || dr >= 8) {
#pragma unroll
                for (int r = 0; r < 16; ++r) { p0[r] = -1e30f; p1[r] = -1e30f; }
            } else {
                const ALAS float* brow = bias + (kr - qrow + 7) * 31 + 15 - qcol;
#pragma unroll
                for (int r = 0; r < 16; ++r) { const int kc0 = crow(r, hi), kc1 = kc0 + 32;
                    const bool ok0 = (unsigned)(kc0 - cs) < 16u, ok1 = (unsigned)(kc1 - cs) < 16u;
                    const float b0 = brow[ok0 ? kc0 : qcol], b1 = brow[ok1 ? kc1 : qcol];
                    p0[r] = ok0 ? p0[r] + b0 : -1e30f; p1[r] = ok1 ? p1[r] + b1 : -1e30f;
                    if ((r & 3) == 3) asm volatile("" ::: "memory"); }
            }
        }
    }
}

template <int MASK, int D0LO, int D0N>
__device__ __forceinline__ void attn_core(f32x16 (&o)[4], float& m_reg, float& l_reg, const bf16* __restrict__ Qw, const bf16* __restrict__ Kb, const bf16* __restrict__ Vb,
                                          const int nloc, const int loc0, const int qp, const float C, const float thr_raw, ALAS char* lds) {
    int tid_ = threadIdx.x; asm volatile("" : "+v"(tid_));
    const int tid = tid_, wid = __builtin_amdgcn_readfirstlane(tid >> 6), lane = tid & 63, r32 = lane & 31, hi = lane >> 5;
    ALAS float* ws = (ALAS float*)(lds + WSCR_OFF) + wid * 64; ALAS float* al_l = ws + 32;
    const ALAS float* bias = (const ALAS float*)(lds + BIAS_OFF);
    unsigned voffK[2], voffV[2];
#pragma unroll
    for (int i = 0; i < 2; ++i) { const int q = (wid + 8 * i) * 64 + lane;
        { const int row = q >> 4, cc = (q & 15) ^ (row & 7); voffK[i] = (unsigned)(row * (LDP * 2) + cc * 16); }
        { const int kk = (q >> 7) * 8 + ((q & 31) >> 2), c = ((q >> 5) & 3) * 32 + (q & 3) * 8; const int k = (kk & ~0xC) | ((kk & 4) << 1) | ((kk & 8) >> 1); voffV[i] = (unsigned)(k * (LDP * 2) + c * 2); } }
    const int NT = NCTX_T + nloc;
#define KOFF(j) ((j) < NCTX_T ? 4096 + 64 * (j) : loc0 + 64 * ((j) - NCTX_T))
#define ISSUE(j) do { const size_t _ro = (size_t)KOFF(j) * (LDP * 2); const char* _gk = (const char*)Kb + _ro; const char* _gv = (const char*)Vb + _ro; ALAS char* _sl = lds + ((j) & 3) * SLOT + wid * 1024; \
    _Pragma("unroll") for (int _i = 0; _i < 2; ++_i) __builtin_amdgcn_global_load_lds((const unsigned*)(_gk + voffK[_i]), (ALAS unsigned*)(_sl + _i * 8192), 16, 0, 0); \
    _Pragma("unroll") for (int _i = 0; _i < 2; ++_i) __builtin_amdgcn_global_load_lds((const unsigned*)(_gv + voffV[_i]), (ALAS unsigned*)(_sl + 16384 + _i * 8192), 16, 0, 0); } while (0)
#define WAITBAR(n) do { asm volatile("s_waitcnt vmcnt(" #n ") lgkmcnt(0)" ::: "memory"); __builtin_amdgcn_s_barrier(); asm volatile("" ::: "memory"); } while (0)
#define RESC(a) do { if (__any((a) < 1.f)) { if (hi == 0) al_l[r32] = (a); asm volatile("s_waitcnt lgkmcnt(0)" ::: "memory"); \
    _Pragma("unroll") for (int d = 0; d < 4; ++d) _Pragma("unroll") for (int r = 0; r < 16; ++r) o[d][r] *= al_l[crow(r, hi)]; } } while (0)
    asm volatile("s_waitcnt vmcnt(0)" ::: "memory");
    m_reg = -1e30f; l_reg = 0.f;
#pragma unroll
    for (int d = 0; d < 4; ++d) o[d] = f32x16{};
    bf16x8 qr[8];
#pragma unroll
    for (int d0 = 0; d0 < 8; ++d0) qr[d0] = *(const bf16x8*)(Qw + d0 * 16);
    ISSUE(0); ISSUE(1); ISSUE(2);
    const int vb0 = (int)(uintptr_t)lds + 16384 + v_rd_base(lane);
    f32x16 pA0, pA1, pB0, pB1; float mnA, mnB, alA, alB; bf16x8 pa0, pa1, pa2, pa3;
    WAITBAR(8);
    qkt<D0LO, D0N>(pA0, pA1, lds, qr, r32, hi); apply_mask<MASK>(pA0, pA1, 0, loc0, qp, hi, bias); partialSM(pA0, pA1, m_reg, mnA, alA, C, thr_raw);
    WAITBAR(4);
    ISSUE(3);
    for (int j = 1; j + 1 < NT; j += 2) {
        SBAR(); qkt<D0LO, D0N>(pB0, pB1, lds + (j & 3) * SLOT, qr, r32, hi);
        finishSM(pA0, pA1, alA, l_reg, pa0, pa1, pa2, pa3); SBAR();
        pv_d0(o, vb0 + ((j - 1) & 3) * SLOT, pa0, pa1, pa2, pa3); apply_mask<MASK>(pB0, pB1, j, loc0, qp, hi, bias); partialSM(pB0, pB1, m_reg, mnB, alB, C, thr_raw);
        if (j + 2 < NT) { WAITBAR(4); } else { WAITBAR(0); }
        if (j + 3 < NT) ISSUE(j + 3);
        RESC(alB);
        SBAR(); qkt<D0LO, D0N>(pA0, pA1, lds + ((j + 1) & 3) * SLOT, qr, r32, hi);
        finishSM(pB0, pB1, alB, l_reg, pa0, pa1, pa2, pa3); SBAR();
        pv_d0(o, vb0 + (j & 3) * SLOT, pa0, pa1, pa2, pa3); apply_mask<MASK>(pA0, pA1, j + 1, loc0, qp, hi, bias); partialSM(pA0, pA1, m_reg, mnA, alA, C, thr_raw);
        if (j + 3 < NT) { WAITBAR(4); } else { WAITBAR(0); }
        if (j + 4 < NT) ISSUE(j + 4);
        RESC(alA);
    }
    SBAR(); qkt<D0LO, D0N>(pB0, pB1, lds + ((NT - 1) & 3) * SLOT, qr, r32, hi);
    finishSM(pA0, pA1, alA, l_reg, pa0, pa1, pa2, pa3); SBAR();
    pv_d0(o, vb0 + ((NT - 2) & 3) * SLOT, pa0, pa1, pa2, pa3); apply_mask<MASK>(pB0, pB1, NT - 1, loc0, qp, hi, bias); partialSM(pB0, pB1, m_reg, mnB, alB, C, thr_raw);
    RESC(alB);
    finishSM(pB0, pB1, alB, l_reg, pa0, pa1, pa2, pa3); SBAR();
    pv_d0(o, vb0 + ((NT - 1) & 3) * SLOT, pa0, pa1, pa2, pa3);
#undef KOFF
#undef ISSUE
#undef WAITBAR
#undef RESC
}
}

constexpr int NWAVES = 8;
constexpr int DM = 4096, NB = 2, SEQ = 4096, CTXL = 256, TPB = SEQ + CTXL  , MROWS = NB * TPB  ;
constexpr int NIN = 9216, DFF = 11008, NUP = 2 * DFF, NADA = 6 * DM;
constexpr int QA = 0, QB_ = 1024, QC = 2048, QD = 3072, KA = 4096, VA = 4352, KB_ = 4608, VB_ = 5632, KC = 6656, VC = 6912, KD = 7168, VD = 8192;
constexpr float EPS = 1e-6f;
constexpr int NPHASE = 18;

constexpr size_t MiB = 1u << 20;
constexpr size_t WS_CTL = 0, CTL_ZERO_BYTES = 1 * MiB;
constexpr size_t WS_MOD = 1 * MiB;
constexpr size_t WS_TAB = 2 * MiB;
constexpr size_t WS_WIN = 4 * MiB;
constexpr size_t WS_WOUT = WS_WIN + 2 * 72 * MiB;
constexpr size_t WS_WUP = WS_WOUT + 2 * 32 * MiB;
constexpr size_t WS_WDN = WS_WUP + 2 * 172 * MiB;
constexpr size_t WS_XS = WS_WDN + 2 * 86 * MiB;
constexpr size_t WS_HX = WS_XS + 136 * MiB;
constexpr size_t WS_P = WS_HX + 68 * MiB;
constexpr size_t WS_O = WS_P + 153 * MiB;
constexpr size_t WS_Y = WS_O + 68 * MiB;
constexpr size_t WS_U = WS_Y + 68 * MiB;
constexpr size_t WS_ACT = WS_U + 366 * MiB;
constexpr size_t WS_STASH = WS_ACT + 183 * MiB;
constexpr size_t WS_PART = WS_STASH + 32 * MiB;
constexpr size_t WS_END = WS_PART + 64 * MiB;
static_assert((size_t)MROWS * NUP * 2 <= 366 * MiB && (size_t)MROWS * DFF * 2 <= 183 * MiB && (size_t)MROWS * NIN * 2 <= 153 * MiB, "ws map");
constexpr int CW_BAR = 4096;

constexpr int RING_OFF = 0, RING_BYTES = 131072;
constexpr int LDSCTL_OFF = RING_BYTES, MISC_OFF = LDSCTL_OFF + 320;
constexpr int LDS_BYTES = 147456;
constexpr int XCH_OFF = att::SHM_END;
static_assert(XCH_OFF + 8192 <= LDS_BYTES && att::WSCR_OFF >= MISC_OFF + 128, "LDS map");

#define GAS __attribute__((address_space(1)))
#define LAS __attribute__((address_space(3)))
typedef unsigned short bf16;
typedef unsigned v4u __attribute__((ext_vector_type(4)));
typedef unsigned v2u __attribute__((ext_vector_type(2)));
typedef float f32x4 __attribute__((ext_vector_type(4)));
typedef float f32x2 __attribute__((ext_vector_type(2)));
typedef GAS unsigned gu32;
#define RLX_AGENT __ATOMIC_RELAXED, __HIP_MEMORY_SCOPE_AGENT
#define LDS_WAIT() asm volatile("s_waitcnt lgkmcnt(0)" ::: "memory")
#define VM_WAIT() asm volatile("s_waitcnt vmcnt(0)" ::: "memory")
__device__ __forceinline__ unsigned f2bf(float f) { unsigned u = __builtin_bit_cast(unsigned, f); return (u + 0x7fffu + ((u >> 16) & 1u)) >> 16; }
__device__ __forceinline__ unsigned pk2(float lo, float hi) { return f2bf(lo) | (f2bf(hi) << 16); }
__device__ __forceinline__ float bf_lo(unsigned w) { return __uint_as_float(w << 16); }
__device__ __forceinline__ float bf_hi(unsigned w) { return __uint_as_float(w & 0xffff0000u); }

#define XB_TMO      128
#define XB_XCNT(j)  (256  + 64 * (j))
#define XB_XSUB(j)  (1280 + 64 * (j))
#define XB_XGEN(j)  (2304 + 64 * (j))
#define XB_TOP      3328
#define XB_TOPGEN   3392
#define XCD_BAR_WORDS 3456
#define XB_SPIN_CAP (1u << 24)

__device__ __forceinline__ unsigned xb_ld(unsigned* p)              { return __hip_atomic_load(p, __ATOMIC_RELAXED, __HIP_MEMORY_SCOPE_AGENT); }
__device__ __forceinline__ unsigned xb_add(unsigned* p, unsigned v) { return __hip_atomic_fetch_add(p, v, __ATOMIC_RELAXED, __HIP_MEMORY_SCOPE_AGENT); }
__device__ __forceinline__ unsigned xb_xcc_id() { return (unsigned)__builtin_amdgcn_s_getreg((3 << 11) | 20) & 0xFu; }
#define XB_SPIN(cond, bar) do { unsigned _sp = 0; while (cond) { __builtin_amdgcn_s_sleep(1); \
    if ((++_sp & 255u) == 0u) { if (xb_ld(&(bar)[XB_TMO])) break; if (_sp > XB_SPIN_CAP) { atomicAdd(&(bar)[XB_TMO], 1u); break; } } } } while (0)

struct XcdBarrier { unsigned* bar; unsigned x; volatile LAS unsigned* st; };

__device__ __forceinline__ XcdBarrier xcd_barrier_post(unsigned* bar, volatile LAS unsigned* st) {
    XcdBarrier b; b.bar = bar; b.x = xb_xcc_id(); b.st = st;
    if (threadIdx.x == 0) (void)xb_add(&bar[XB_XCNT(b.x)], 1u);
    return b;
}
__device__ __forceinline__ void xcd_barrier_complete(unsigned* bar, unsigned x, unsigned& nloc, unsigned& nx) {
    const unsigned G = gridDim.x * gridDim.y * gridDim.z;
    unsigned sum, cnt, mine, sp = 0u;
    for (;;) {
        sum = 0u; cnt = 0u; mine = 0u;
#pragma unroll
        for (unsigned j = 0; j < 16; ++j) { const unsigned c = xb_ld(&bar[XB_XCNT(j)]); sum += c; cnt += (c > 0u) ? 1u : 0u; mine = (j == x) ? c : mine; }
        if (sum == G) break;
        __builtin_amdgcn_s_sleep(1);
        if ((++sp & 255u) == 0u) { if (xb_ld(&bar[XB_TMO])) break; if (sp > XB_SPIN_CAP) { atomicAdd(&bar[XB_TMO], 1u); break; } }
    }
    nloc = mine > 0u ? mine : 1u; nx = cnt > 0u ? cnt : 1u;
}
__device__ __forceinline__ void xcd_barrier(const XcdBarrier& b) {
    asm volatile("s_waitcnt vmcnt(0)" ::: "memory");
    __syncthreads();
    if (threadIdx.x == 0) {
        unsigned* bar = b.bar;
        __builtin_amdgcn_s_waitcnt(0);
        unsigned nloc = b.st[0], nx = b.st[1];
        if (nloc == 0u) { xcd_barrier_complete(bar, b.x, nloc, nx); b.st[0] = nloc; b.st[1] = nx; }
        const unsigned old = xb_add(&bar[XB_XSUB(b.x)], 1u);
        const unsigned gen = old / nloc;
        if (old + 1u == (gen + 1u) * nloc) {
            __builtin_amdgcn_fence(__ATOMIC_RELEASE, "agent");
            asm volatile("s_waitcnt vmcnt(0)" ::: "memory");
            const unsigned og = xb_add(&bar[XB_TOP], 1u);
            const unsigned tg = og / nx;
            if (og + 1u == (tg + 1u) * nx) xb_add(&bar[XB_TOPGEN], 1u);
            else XB_SPIN(xb_ld(&bar[XB_TOPGEN]) == tg, bar);
            __builtin_amdgcn_fence(__ATOMIC_ACQUIRE, "agent");
            xb_add(&bar[XB_XGEN(b.x)], 1u);
            asm volatile("s_waitcnt vmcnt(0)" ::: "memory");
        } else {
            XB_SPIN(xb_ld(&bar[XB_XGEN(b.x)]) == gen, bar);
            __builtin_amdgcn_fence(__ATOMIC_ACQUIRE, "agent");
            asm volatile("s_waitcnt vmcnt(0)" ::: "memory");
        }
    }
    __syncthreads();
}

struct Args {
    const float* in[24]; float* out; unsigned char* ws; int ph_lo, ph_hi;
};
typedef __attribute__((address_space(4))) const Args* KArgs;
struct Frame {
    LAS unsigned char* lds;
    int tid, lane, wave, vcu, G;
    unsigned char* ws;
};

__device__ __forceinline__ int fresh_bx() { int bx = blockIdx.x; asm volatile("" : "+s"(bx)); return bx; }
__device__ __forceinline__ float wave_sum(float v) {
#pragma unroll
    for (int o = 1; o < 64; o <<= 1) v += __shfl_xor(v, o);
    return v;
}

__device__ const float INV32[32] = {
    1.0f, 0.74989420933f, 0.56234132519f, 0.42169650343f, 0.31622776602f, 0.23713737057f, 0.17782794100f, 0.13335214322f,
    0.1f, 0.074989420933f, 0.056234132519f, 0.042169650343f, 0.031622776602f, 0.023713737057f, 0.017782794100f, 0.013335214322f,
    0.01f, 0.0074989420933f, 0.0056234132519f, 0.0042169650343f, 0.0031622776602f, 0.0023713737057f, 0.0017782794100f, 0.0013335214322f,
    0.001f, 0.00074989420933f, 0.00056234132519f, 0.00042169650343f, 0.00031622776602f, 0.00023713737057f, 0.00017782794100f, 0.00013335214322f };
__device__ const float INV16[16] = {
    1.0f, 0.56234132519f, 0.31622776602f, 0.17782794100f, 0.1f, 0.056234132519f, 0.031622776602f, 0.017782794100f,
    0.01f, 0.0056234132519f, 0.0031622776602f, 0.0017782794100f, 0.001f, 0.00056234132519f, 0.00031622776602f, 0.00017782794100f };

__device__ __forceinline__ void sincos_acc(float af, float& c, float& s) {
    const double a = (double)af; const double kd = __builtin_rint(a * 0.63661977236758134308); const int k = (int)kd;
    const double r = (a - kd * 1.57079632679489655800) - kd * 6.12323399573676603587e-17; const double r2 = r * r;
    const double sn = r * (1.0 + r2 * (-1.0 / 6 + r2 * (1.0 / 120 + r2 * (-1.0 / 5040 + r2 * (1.0 / 362880 + r2 * (-1.0 / 39916800 + r2 * (1.0 / 6227020800.0)))))));
    const double cs = 1.0 + r2 * (-0.5 + r2 * (1.0 / 24 + r2 * (-1.0 / 720 + r2 * (1.0 / 40320 + r2 * (-1.0 / 3628800 + r2 * (1.0 / 479001600.0 + r2 * (-1.0 / 87178291200.0)))))));
    double cc, ss;
    switch (k & 3) { case 0: cc = cs; ss = sn; break; case 1: cc = -sn; ss = cs; break; case 2: cc = -cs; ss = -sn; break; default: cc = sn; ss = -cs; break; }
    c = (float)cc; s = (float)ss;
}

__device__ __forceinline__ void p0_transpose_item(const float* W, int K, int N, bf16* WT, LAS float* scr, int item, int lane, bool gv = false) {
    const int nblk = N / 32, kb = item / nblk, nb = item % nblk, k0 = 64 * kb, n0 = 32 * nb;
    const int v0 = !gv ? n0 : (n0 < DFF ? (n0 >> 7) * 256 + (n0 & 127) : ((n0 - DFF) >> 7) * 256 + 128 + ((n0 - DFF) & 127));
#pragma unroll 8
    for (int i = 0; i < 32; ++i) { const int kk = 2 * i + (lane >> 5); scr[kk * 33 + (lane & 31)] = W[(size_t)(k0 + kk) * N + n0 + (lane & 31)]; }
    LDS_WAIT(); asm volatile("" ::: "memory");
    const int c = lane & 7;
#pragma unroll
    for (int j = 0; j < 4; ++j) { const int n = (lane >> 3) + 8 * j; const LAS float* s = scr + (8 * c) * 33 + n;
        v4u o; o.x = pk2(s[0 * 33], s[1 * 33]); o.y = pk2(s[2 * 33], s[3 * 33]); o.z = pk2(s[4 * 33], s[5 * 33]); o.w = pk2(s[6 * 33], s[7 * 33]);
        *(GAS v4u*)(WT + (size_t)(v0 + n) * K + k0 + 8 * c) = o; }
    LDS_WAIT(); asm volatile("" ::: "memory");
}

__device__ __forceinline__ float silu_f(float x) { return x / (1.f + __expf(-x)); }

__device__ __forceinline__ void phase_prologue(Frame& F, KArgs a) {
    const float* c_in = a->in[1]; const float* cctx = a->in[3]; const float* w_ada = a->in[4]; const float* b_ada = a->in[5];
    float* mod = (float*)(F.ws + WS_MOD);
    if (F.vcu == 0) {
        f32x2* thd = (f32x2*)(F.ws + WS_TAB);
        for (int e = F.tid; e < 64 * 32; e += NWAVES * 64) { const int pos = e >> 5, i = e & 31; float c, s; sincos_acc((float)pos * INV32[i], c, s); thd[e] = (f32x2){c, s}; }
        f32x2* tdh = (f32x2*)(F.ws + WS_TAB + 16384);
        for (int e = F.tid; e < 64 * 16; e += NWAVES * 64) { const int pos = e >> 4, i = e & 15; float c, s; sincos_acc((float)pos * INV16[i], c, s); tdh[e] = (f32x2){c, s}; }
        if (F.tid < 2) { const int l = F.tid; float s1 = 0.f, s2 = 0.f;
            for (int i = 0; i < 64; ++i) { s1 += a->in[14][l * 64 + i] * a->in[15][l * 64 + i]; s2 += a->in[16][l * 64 + i] * a->in[17][l * 64 + i]; }
            const float lam_init = 0.8f - 0.6f * expf(-0.3f * (float)l);
            float* lam = (float*)(F.ws + WS_TAB + 32768); lam[l * 2 + 0] = expf(s1) - expf(s2) + lam_init; lam[l * 2 + 1] = 1.f - lam_init; }
    }
    {
        LAS float* sv = (LAS float*)(F.lds + RING_OFF);
        LAS float* red = (LAS float*)(F.lds + RING_OFF + 49152);
        for (int e = F.tid; e < 3 * DM; e += NWAVES * 64) { const int v = e / DM, k = e % DM; const float x = v < 2 ? c_in[v * DM + k] : cctx[k]; sv[e] = silu_f(x); }
        __syncthreads();
        const int cg = F.lane & 15, kq = F.lane >> 4;
        for (int it = F.vcu; it < 2 * (NADA / 64); it += F.G) {
            const int l = it / (NADA / 64), ch = it % (NADA / 64);
            const float* W = w_ada + (size_t)l * DM * NADA + ch * 64 + cg * 4;
            f32x4 a0 = {0.f, 0.f, 0.f, 0.f}, a1 = a0, a2 = a0;
#pragma unroll 8
            for (int s = 0; s < DM / 32; ++s) { const int k = s * 32 + F.wave * 4 + kq; const f32x4 w = *(const GAS f32x4*)(W + (size_t)k * NADA);
                a0 += w * sv[k]; a1 += w * sv[DM + k]; a2 += w * sv[2 * DM + k]; }
#pragma unroll
            for (int e = 0; e < 4; ++e) { a0[e] += __shfl_xor(a0[e], 16); a0[e] += __shfl_xor(a0[e], 32); a1[e] += __shfl_xor(a1[e], 16); a1[e] += __shfl_xor(a1[e], 32); a2[e] += __shfl_xor(a2[e], 16); a2[e] += __shfl_xor(a2[e], 32); }
            if (kq == 0) {
#pragma unroll
                for (int e = 0; e < 4; ++e) { red[(F.wave * 3 + 0) * 64 + cg * 4 + e] = a0[e]; red[(F.wave * 3 + 1) * 64 + cg * 4 + e] = a1[e]; red[(F.wave * 3 + 2) * 64 + cg * 4 + e] = a2[e]; } }
            __syncthreads();
            if (F.tid < 192) { const int v = F.tid / 64, cidx = F.tid % 64; float s = 0.f;
#pragma unroll
                for (int w = 0; w < 8; ++w) s += red[(w * 3 + v) * 64 + cidx];
                const int col = ch * 64 + cidx; mod[((size_t)l * 3 + v) * NADA + col] = s + b_ada[(size_t)l * NADA + col]; }
            __syncthreads();
        }
    }
    {
        __syncthreads();
        LAS float* scr = (LAS float*)(F.lds + RING_OFF + F.wave * 16384);
        const int gw = F.vcu * NWAVES + F.wave, NGW = F.G * NWAVES;
        constexpr int I_IN = (DM / 64) * (NIN / 32), I_OUT = (DM / 64) * (DM / 32), I_UP = (DM / 64) * (NUP / 32), I_DN = (DFF / 64) * (DM / 32);
        constexpr int PER_L = I_IN + I_OUT + I_UP + I_DN;
        for (int it = gw; it < 2 * PER_L; it += NGW) {
            const int l = it / PER_L; int r = it % PER_L;
            if (r < I_IN) { p0_transpose_item(a->in[10] + (size_t)l * DM * NIN, DM, NIN, (bf16*)(F.ws + WS_WIN + (size_t)l * 72 * MiB), scr, r, F.lane); continue; } r -= I_IN;
            if (r < I_OUT) { p0_transpose_item(a->in[11] + (size_t)l * DM * DM, DM, DM, (bf16*)(F.ws + WS_WOUT + (size_t)l * 32 * MiB), scr, r, F.lane); continue; } r -= I_OUT;
            if (r < I_UP) { p0_transpose_item(a->in[21] + (size_t)l * DM * NUP, DM, NUP, (bf16*)(F.ws + WS_WUP + (size_t)l * 172 * MiB), scr, r, F.lane, true); continue; } r -= I_UP;
            p0_transpose_item(a->in[23] + (size_t)l * DFF * DM, DFF, DM, (bf16*)(F.ws + WS_WDN + (size_t)l * 86 * MiB), scr, r, F.lane);
        }
    }
}

struct RowRegs { f32x4 v[16]; };
__device__ __forceinline__ float row_sumsq(const RowRegs& r) {
    float s = 0.f;
#pragma unroll
    for (int j = 0; j < 16; ++j) s += (r.v[j].x * r.v[j].x + r.v[j].y * r.v[j].y) + (r.v[j].z * r.v[j].z + r.v[j].w * r.v[j].w);
    return wave_sum(s);
}
__device__ __forceinline__ void row_load_f32(RowRegs& r, const float* p, int lane) {
    const GAS f32x4* q = (const GAS f32x4*)p + lane;
#pragma unroll
    for (int j = 0; j < 16; ++j) r.v[j] = q[64 * j];
}
__device__ __forceinline__ void row_load_bf16(RowRegs& r, const bf16* p, int lane) {
    const GAS v2u* q = (const GAS v2u*)p + lane;
#pragma unroll
    for (int j = 0; j < 16; ++j) { const v2u w = q[64 * j]; r.v[j] = (f32x4){bf_lo(w.x), bf_hi(w.x), bf_lo(w.y), bf_hi(w.y)}; }
}
__device__ __forceinline__ void row_store_f32(const RowRegs& r, float* p, int lane) {
    GAS f32x4* q = (GAS f32x4*)p + lane;
#pragma unroll
    for (int j = 0; j < 16; ++j) q[64 * j] = r.v[j];
}
__device__ __forceinline__ void row_store_bf16(const RowRegs& r, bf16* p, int lane) {
    GAS v2u* q = (GAS v2u*)p + lane;
#pragma unroll
    for (int j = 0; j < 16; ++j) { v2u w; w.x = pk2(r.v[j].x, r.v[j].y); w.y = pk2(r.v[j].z, r.v[j].w); q[64 * j] = w; }
}
__device__ __forceinline__ void row_modnorm_store(const RowRegs& x, float rstd, const float* g, const float* sc, const float* sh, bf16* out, int lane) {
    GAS v2u* q = (GAS v2u*)out + lane;
#pragma unroll
    for (int j = 0; j < 16; ++j) { const int c = 4 * lane + 256 * j;
        const f32x4 gv = *(const GAS f32x4*)(g + c), sv = *(const GAS f32x4*)(sc + c), hv = *(const GAS f32x4*)(sh + c);
        const f32x4 y = (x.v[j] * rstd) * gv * (sv + 1.f) + hv;
        v2u w; w.x = pk2(y.x, y.y); w.y = pk2(y.z, y.w); q[64 * j] = w; }
}
__device__ __forceinline__ void row_residual(RowRegs& x, const RowRegs& y, float rstd, const float* g, const float* gate, int lane) {
#pragma unroll
    for (int j = 0; j < 16; ++j) { const int c = 4 * lane + 256 * j;
        const f32x4 gv = *(const GAS f32x4*)(g + c), tv = *(const GAS f32x4*)(gate + c);
        x.v[j] = x.v[j] + tv * ((y.v[j] * rstd) * gv); }
}

__device__ __forceinline__ void row_load_part(RowRegs& r, const float* part, int lrow, int lane) {
#pragma unroll
    for (int j = 0; j < 16; ++j) r.v[j] = (f32x4){0.f, 0.f, 0.f, 0.f};
#pragma unroll 2
    for (int c = 0; c < 8; ++c) { const GAS f32x4* q = (const GAS f32x4*)(part + ((size_t)c * 512 + lrow) * DM) + lane;
#pragma unroll
        for (int j = 0; j < 16; ++j) r.v[j] += q[64 * j]; }
}

__device__ __forceinline__ void phase_r0(Frame& F, KArgs a) {
    const float* mod = (const float*)(F.ws + WS_MOD); bf16* hx = (bf16*)(F.ws + WS_HX);
    const int gw = F.vcu * NWAVES + F.wave, NGW = F.G * NWAVES;
    for (int m = gw; m < MROWS; m += NGW) {
        const int b = m / TPB, t = m % TPB; const bool lat = t < SEQ;
        const float* src = lat ? a->in[0] + ((size_t)b * SEQ + t) * DM : a->in[2] + ((size_t)b * CTXL + (t - SEQ)) * DM;
        RowRegs x; row_load_f32(x, src, F.lane);
        const float rstd = 1.f / sqrtf(row_sumsq(x) * (1.f / DM) + EPS);
        const float* mv = mod + (size_t)(0 * 3 + (lat ? b : 2)) * NADA;
        row_modnorm_store(x, rstd, a->in[6]  , mv + DM, mv, hx + (size_t)m * DM, F.lane);
    }
}
__device__ __forceinline__ void phase_r1(Frame& F, KArgs a, int l, bool last) {
    const float* mod = (const float*)(F.ws + WS_MOD); bf16* xs = (bf16*)(F.ws + WS_XS); bf16* hx = (bf16*)(F.ws + WS_HX); const bf16* yb = (const bf16*)(F.ws + WS_Y);
    const int gw = F.vcu * NWAVES + F.wave, NGW = F.G * NWAVES;
    for (int m = gw; m < MROWS; m += NGW) {
        const int b = m / TPB, t = m % TPB; const bool lat = t < SEQ;
        if (last && !lat) continue;
        const float* mv = mod + (size_t)(l * 3 + (lat ? b : 2)) * NADA;
        RowRegs x, y;
        if (l == 0) row_load_f32(x, lat ? a->in[0] + ((size_t)b * SEQ + t) * DM : a->in[2] + ((size_t)b * CTXL + (t - SEQ)) * DM, F.lane);
        else row_load_bf16(x, xs + (size_t)m * DM, F.lane);
        if (lat) row_load_bf16(y, yb + (size_t)m * DM, F.lane); else row_load_part(y, (const float*)(F.ws + WS_PART), b * 256 + (t - SEQ), F.lane);
        const float rstd_y = 1.f / sqrtf(row_sumsq(y) * (1.f / DM) + EPS);
        row_residual(x, y, rstd_y, a->in[7] + (size_t)l * DM, mv + 2 * DM, F.lane);
        row_store_bf16(x, xs + (size_t)m * DM, F.lane);
        const float rstd = 1.f / sqrtf(row_sumsq(x) * (1.f / DM) + EPS);
        row_modnorm_store(x, rstd, a->in[8] + (size_t)l * DM, mv + 4 * DM, mv + 3 * DM, hx + (size_t)m * DM, F.lane);
    }
}
__device__ __forceinline__ void phase_r2(Frame& F, KArgs a, int l, bool last) {
    const float* mod = (const float*)(F.ws + WS_MOD); bf16* xs = (bf16*)(F.ws + WS_XS); bf16* hx = (bf16*)(F.ws + WS_HX); const bf16* yb = (const bf16*)(F.ws + WS_Y);
    const int gw = F.vcu * NWAVES + F.wave, NGW = F.G * NWAVES;
    for (int m = gw; m < MROWS; m += NGW) {
        const int b = m / TPB, t = m % TPB; const bool lat = t < SEQ;
        if (last && !lat) continue;
        const float* mv = mod + (size_t)(l * 3 + (lat ? b : 2)) * NADA;
        RowRegs x, y; row_load_bf16(x, xs + (size_t)m * DM, F.lane);
        if (lat) row_load_bf16(y, yb + (size_t)m * DM, F.lane); else row_load_part(y, (const float*)(F.ws + WS_PART), b * 256 + (t - SEQ), F.lane);
        const float rstd_y = 1.f / sqrtf(row_sumsq(y) * (1.f / DM) + EPS);
        row_residual(x, y, rstd_y, a->in[9] + (size_t)l * DM, mv + 5 * DM, F.lane);
        if (last) { row_store_f32(x, a->out + ((size_t)b * SEQ + t) * DM, F.lane); continue; }
        row_store_bf16(x, xs + (size_t)m * DM, F.lane);
        const float rstd = 1.f / sqrtf(row_sumsq(x) * (1.f / DM) + EPS);
        const float* mn = mod + (size_t)((l + 1) * 3 + (lat ? b : 2)) * NADA;
        row_modnorm_store(x, rstd, a->in[6] + (size_t)(l + 1) * DM, mn + DM, mn, hx + (size_t)m * DM, F.lane);
    }
}

__device__ __forceinline__ void phase_fixup(Frame& F, KArgs a, int l, bool last) {
    const float* side = (const float*)(F.ws + WS_U); bf16* ACT = (bf16*)(F.ws + WS_ACT);
    const float* cw = a->in[22] + (size_t)l * 3 * NUP;
    constexpr int CG = DFF / 4;
    const int ntile = last ? 32 : 34;
    for (int idx = F.vcu * NWAVES * 64 + F.tid; idx < ntile * 2 * CG; idx += F.G * NWAVES * 64) {
        const int cg = idx % CG, e = (idx / CG) & 1, pmi = idx / (2 * CG); const int pm = (last && pmi >= 16) ? pmi + 1 : pmi; const int pmb = pm % 17;
        const int col = cg * 4, vg = (col >> 7) * 256 + (col & 127);
        const float* sb = side + (size_t)pm * 4 * NUP;
        const f32x4 zero4 = {0.f, 0.f, 0.f, 0.f};
        f32x4 pg, pv, cg_, cv, ng, nv;
        if (e == 0) {
            cg_ = *(const GAS f32x4*)(sb + vg); cv = *(const GAS f32x4*)(sb + vg + 128); ng = *(const GAS f32x4*)(sb + NUP + vg); nv = *(const GAS f32x4*)(sb + NUP + vg + 128);
            if (pmb == 0 || pmb == 16) { pg = zero4; pv = zero4; } else { pg = *(const GAS f32x4*)(sb - NUP + vg); pv = *(const GAS f32x4*)(sb - NUP + vg + 128); }
        } else {
            cg_ = *(const GAS f32x4*)(sb + 3 * (size_t)NUP + vg); cv = *(const GAS f32x4*)(sb + 3 * (size_t)NUP + vg + 128); pg = *(const GAS f32x4*)(sb + 2 * (size_t)NUP + vg); pv = *(const GAS f32x4*)(sb + 2 * (size_t)NUP + vg + 128);
            if (pmb >= 15) { ng = zero4; nv = zero4; } else { ng = *(const GAS f32x4*)(sb + 4 * (size_t)NUP + vg); nv = *(const GAS f32x4*)(sb + 4 * (size_t)NUP + vg + 128); }
        }
        const f32x4 g = pg * *(const GAS f32x4*)(cw + col) + cg_ * *(const GAS f32x4*)(cw + NUP + col) + ng * *(const GAS f32x4*)(cw + 2 * NUP + col);
        const f32x4 v = pv * *(const GAS f32x4*)(cw + DFF + col) + cv * *(const GAS f32x4*)(cw + NUP + DFF + col) + nv * *(const GAS f32x4*)(cw + 2 * NUP + DFF + col);
        f32x4 o;
#pragma unroll
        for (int k = 0; k < 4; ++k) o[k] = g[k] / (1.f + __expf(-g[k])) * v[k];
        v2u w; w.x = pk2(o.x, o.y); w.y = pk2(o.z, o.w);
        *(GAS v2u*)(ACT + (size_t)(pm * 256 + (e ? 255 : 0)) * DFF + col) = w;
    }
}

template <int MASK>
__device__ __forceinline__ void attn_std_unit(Frame& F, const bf16* P, bf16* O, int b, int qrow0  , int qcol, int kcol, int vcol, int ocol,
                                              int nloc, int loc0, float sink, bool has_sink) {
    using namespace att;
    int lane_ = F.lane; asm volatile("" : "+v"(lane_));
    int lane = lane_, wid = F.wave, r32 = lane & 31, hi = lane >> 5;
    constexpr float SCALE = 0.088388347648318440f; constexpr float C = SCALE * 1.4426950408889634f;
    const size_t base = (size_t)b * TPB;
    const bf16* Qw = P + (base + qrow0 + wid * 32 + r32) * LDP + qcol + hi * 8;
    f32x16 o[4]; float m_reg, l_reg;
    attn_core<MASK, 0, 8>(o, m_reg, l_reg, Qw, P + base * LDP + kcol, P + base * LDP + vcol, nloc, loc0, qrow0 + wid * 32 + r32, C, 8.f / SCALE, (ALAS char*)F.lds);
    if (has_sink) l_reg += __builtin_amdgcn_exp2f(sink * 1.4426950408889634f - m_reg * C);
    asm volatile("" : "+v"(lane_)); lane = lane_; r32 = lane & 31; hi = lane >> 5;
    ALAS float* li_l = (ALAS float*)((ALAS char*)F.lds + WSCR_OFF) + wid * 64;
    if (hi == 0) li_l[r32] = l_reg; asm volatile("s_waitcnt lgkmcnt(0)" ::: "memory");
    bf16* Ow = O + (base + qrow0 + wid * 32) * LDO + ocol;
#pragma unroll
    for (int r = 0; r < 16; ++r) { const int orow = crow(r, hi); const float rl = __builtin_amdgcn_rcpf(li_l[orow]);
#pragma unroll
        for (int d0 = 0; d0 < 4; ++d0) Ow[(size_t)orow * LDO + d0 * 32 + r32] = (bf16)f2bf(o[d0][r] * rl); }
}
__device__ __forceinline__ void attn_diff_unit(Frame& F, const bf16* P, bf16* O, int b, int qrow0, int h, int nloc, int loc0, float lam, float omli, const float* gsub) {
    using namespace att;
    int lane_ = F.lane; asm volatile("" : "+v"(lane_));
    int lane = lane_, wid = F.wave, r32 = lane & 31, hi = lane >> 5;
    constexpr float SCALE = 0.125f; constexpr float C = SCALE * 1.4426950408889634f;
    const size_t base = (size_t)b * TPB;
    const bf16* Qw = P + (base + qrow0 + wid * 32 + r32) * LDP + QB_ + h * 128 + hi * 8;
    const bf16* Kb = P + base * LDP + KB_ + h * 128; const bf16* Vb = P + base * LDP + VB_ + h * 128;
    ALAS float* li_l = (ALAS float*)((ALAS char*)F.lds + WSCR_OFF) + wid * 64;
    f32x16 o[4]; float m_reg, l_reg;
    attn_core<0, 4, 4>(o, m_reg, l_reg, Qw, Kb, Vb, nloc, loc0, 0, C, 8.f / SCALE, (ALAS char*)F.lds);
    asm volatile("" : "+v"(lane_)); lane = lane_; r32 = lane & 31; hi = lane >> 5;
    if (hi == 0) li_l[r32] = l_reg; asm volatile("s_waitcnt lgkmcnt(0)" ::: "memory");
    { float* stash = (float*)(F.ws + WS_STASH) + ((size_t)blockIdx.x * 8 + wid) * 4096 + lane;
#pragma unroll
    for (int d0 = 0; d0 < 4; ++d0) { float* sp = stash + d0 * 1024; asm volatile("" : "+v"(sp));
#pragma unroll
        for (int r = 0; r < 16; ++r) sp[r * 64] = o[d0][r] * __builtin_amdgcn_rcpf(li_l[crow(r, hi)]); } }
    __syncthreads();
    attn_core<0, 0, 4>(o, m_reg, l_reg, Qw, Kb, Vb, nloc, loc0, 0, C, 8.f / SCALE, (ALAS char*)F.lds);
    asm volatile("" : "+v"(lane_)); lane = lane_; r32 = lane & 31; hi = lane >> 5;
    if (hi == 0) li_l[r32] = l_reg; asm volatile("s_waitcnt lgkmcnt(0)" ::: "memory");
    float* stash = (float*)(F.ws + WS_STASH) + ((size_t)blockIdx.x * 8 + wid) * 4096 + lane;
    float g4[4];
#pragma unroll
    for (int d0 = 0; d0 < 4; ++d0) g4[d0] = gsub[d0 * 32 + r32] * omli;
    bf16* Ow = O + (base + qrow0 + wid * 32) * LDO + QB_ + h * 128;
#pragma unroll
    for (int r = 0; r < 16; ++r) { const int orow = crow(r, hi); const float rl = __builtin_amdgcn_rcpf(li_l[orow]);
        float v[4]; float ss = 0.f;
#pragma unroll
        for (int d0 = 0; d0 < 4; ++d0) { v[d0] = o[d0][r] * rl - lam * stash[(d0 * 16 + r) * 64]; ss += v[d0] * v[d0]; }
        ss += __shfl_xor(ss, 1); ss += __shfl_xor(ss, 2); ss += __shfl_xor(ss, 4); ss += __shfl_xor(ss, 8); ss += __shfl_xor(ss, 16);
        const float rstd = 1.f / sqrtf(ss * (1.f / 128.f) + EPS);
#pragma unroll
        for (int d0 = 0; d0 < 4; ++d0) Ow[(size_t)orow * LDO + d0 * 32 + r32] = (bf16)f2bf(v[d0] * rstd * g4[d0]); }
}

__device__ __forceinline__ void phase_attention(Frame& F, KArgs a, int l, bool last) {
    const bf16* P = (const bf16*)(F.ws + WS_P); bf16* O = (bf16*)(F.ws + WS_O);
    const float* lamv = (const float*)(F.ws + WS_TAB + 32768); const float lam = lamv[l * 2], omli = lamv[l * 2 + 1];
    const float* sinkv = a->in[19] + l * 8; const float* gsub = a->in[18] + l * 128; const float* nab = a->in[20] + (size_t)l * 8 * 15 * 31;
#ifndef ATT_MASK
#define ATT_MASK 15
#endif
    if (ATT_MASK & 1) for (int u = F.vcu; u < (last ? 256 : 272); u += F.G) {
        int b, h, qrow0, nloc;
        if (u < 256) { b = u >> 7; h = (u >> 4) & 7; qrow0 = (u & 15) * 256; nloc = 64; } else { const int e = u - 256; b = e >> 3; h = e & 7; qrow0 = SEQ; nloc = 0; }
        __syncthreads(); attn_diff_unit(F, P, O, b, qrow0, h, nloc, 0, lam, omli, gsub);
    }
    if (ATT_MASK & 2) for (int u = F.vcu; u < (last ? 256 : 304); u += F.G) {
        int b, qrow0, qcol, kcol, vcol, nloc; float sink = 0.f; bool has_sink = false;
        if (u < 256) { const int h = (u >> 4) & 7, qb = u & 15; b = u >> 7; qrow0 = qb * 256; qcol = QA + h * 128; kcol = KA + (h >> 2) * 128; vcol = VA + (h >> 2) * 128; nloc = 64; }
        else { const int e = u - 256, g = e >> 4, h = e & 7; b = (e >> 3) & 1; qrow0 = SEQ; nloc = 0;
            if (g == 0) { qcol = QA + h * 128; kcol = KA + (h >> 2) * 128; vcol = VA + (h >> 2) * 128; }
            else if (g == 1) { qcol = QC + h * 128; kcol = KC + (h >> 2) * 128; vcol = VC + (h >> 2) * 128; sink = sinkv[h]; has_sink = true; }
            else { qcol = QD + h * 128; kcol = KD + h * 128; vcol = VD + h * 128; } }
        __syncthreads(); attn_std_unit<0>(F, P, O, b, qrow0, qcol, kcol, vcol, qcol, nloc, 0, sink, has_sink);
    }
    if (ATT_MASK & 4) for (int u = F.vcu; u < 256; u += F.G) { const int b = u >> 7, h = (u >> 4) & 7, qb = u & 15;
        const int lo = max(qb * 256 - 128, 0), hiK = min(qb * 256 + 384, SEQ);
        __syncthreads(); attn_std_unit<2>(F, P, O, b, qb * 256, QC + h * 128, KC + (h >> 2) * 128, VC + (h >> 2) * 128, QC + h * 128, (hiK - lo) / 64, lo, sinkv[h], true); }
    if (ATT_MASK & 8) for (int u = F.vcu; u < 256; u += F.G) { const int b = u >> 7, h = (u >> 4) & 7, qb = u & 15;
        const int r0 = qb * 4; int rlo, nrow;
        if (r0 == 0) { rlo = 0; nrow = 8; } else if (r0 == 60) { rlo = 56; nrow = 8; } else { rlo = min(r0 - 4, 52); nrow = 12; }
        __syncthreads();
        { LAS float* bl = (LAS float*)(F.lds + att::BIAS_OFF); for (int e = F.tid; e < 15 * 31; e += NWAVES * 64) bl[e] = nab[h * 465 + e] * 11.313708498984761f; }
        attn_std_unit<3>(F, P, O, b, qb * 256, QD + h * 128, KD + h * 128, VD + h * 128, QD + h * 128, nrow, rlo * 64, 0.f, false); }
    __syncthreads();
}

__global__ void __launch_bounds__(NWAVES * 64, 2) fwd_kernel(Args args) {
    extern __shared__ __attribute__((aligned(16))) unsigned char lds[];
    Frame F;
    F.lds = (LAS unsigned char*)lds;
    volatile LAS unsigned* MISC = (volatile LAS unsigned*)(F.lds + MISC_OFF);
    F.tid = threadIdx.x; F.lane = F.tid & 63; F.wave = __builtin_amdgcn_readfirstlane(F.tid >> 6);
    F.G = gridDim.x; { const int bx = blockIdx.x; F.vcu = (F.G % 8 == 0) ? (bx % 8) * (F.G / 8) + bx / 8 : bx; }
    KArgs ap = (KArgs)__builtin_amdgcn_kernarg_segment_ptr();
    F.ws = ap->ws;
    gu32* ctl = (gu32*)(F.ws + WS_CTL);
    for (int u = F.tid; u < (LDS_BYTES - LDSCTL_OFF) / 4; u += NWAVES * 64) ((LAS unsigned*)(F.lds + LDSCTL_OFF))[u] = 0u;
    __syncthreads();
    const int lo = ap->ph_lo, hi = ap->ph_hi;
    XcdBarrier bar; bar.bar = (unsigned*)(ctl + CW_BAR); bar.x = 0; bar.st = nullptr;
    if (hi - lo > 1) bar = xcd_barrier_post((unsigned*)(ctl + CW_BAR), MISC + 8);
#ifndef PH_MASK
#define PH_MASK 0x7ff
#endif
#ifndef REP_PRO
#define REP_PRO 1
#endif
#ifndef REP_ATT
#define REP_ATT 1
#endif
#ifndef REP_GEMM
#define REP_GEMM 1
#endif
#ifndef REP_CONV
#define REP_CONV 1
#endif
#define IN(k) (lo <= (k) && (k) < hi)
#define FRESH() asm volatile("" : "+v"(F.tid), "+v"(F.lane), "+s"(ap))
#define EN(j) (((PH_MASK) >> (j)) & 1)
#define SEAM(k) do { if (IN(k) && IN((k) + 1)) xcd_barrier(bar); } while (0)

    if (EN(0) && IN(0)) { for (int rep = 0; rep < REP_PRO; ++rep) { FRESH(); phase_prologue(F, ap); __syncthreads(); } } SEAM(0);
    if (EN(1) && IN(1)) { FRESH(); phase_r0(F, ap); } SEAM(1);
    for (int l = 0; l < 2; ++l) {
        const bool last = (l == 1); const int pb = 2 + 8 * l;
        const pg8::bf16_t* HX = (const pg8::bf16_t*)(F.ws + WS_HX);
        if (EN(2) && IN(pb + 0)) {
            pg8::Gemm g{HX, (const pg8::bf16_t*)(F.ws + WS_WIN + (size_t)l * 72 * MiB), MROWS, NIN, DM};
            pg8::StaticOrder S; S.init(MROWS / 256, NIN, DM, F.G, fresh_bx(), 0);
            pg8::EpiInProj E{(pg8::bf16_t*)(F.ws + WS_P), NIN, (const float*)(F.ws + WS_TAB), (const float*)(F.ws + WS_TAB + 16384), ap->in[12] + l * 128, ap->in[13] + l * 128, (LAS float*)(F.lds + XCH_OFF)};
            pg8::gemm_phase<pg8::EpiInProj, pg8::StaticOrder, true>(F.lds + RING_OFF, g, S, E);
        } SEAM(pb + 0);
        if (EN(4) && IN(pb + 1)) { for (int rep = 0; rep < REP_ATT; ++rep) { FRESH(); phase_attention(F, ap, l, last); } } SEAM(pb + 1);
        if (EN(5) && IN(pb + 2)) {
            pg8::Gemm g{(const pg8::bf16_t*)(F.ws + WS_O), (const pg8::bf16_t*)(F.ws + WS_WOUT + (size_t)l * 32 * MiB), MROWS, DM, DM};
            pg8::SplitOrder S; S.init(DM, DM, F.G, fresh_bx()); if (last) S.ca = 0;
            pg8::EpiSplit E{(pg8::bf16_t*)(F.ws + WS_Y), (float*)(F.ws + WS_PART), DM};
            pg8::gemm_phase<pg8::EpiSplit, pg8::SplitOrder, true>(F.lds + RING_OFF, g, S, E);
        } SEAM(pb + 2);
        if (EN(6) && IN(pb + 3)) { FRESH(); phase_r1(F, ap, l, last); } SEAM(pb + 3);
        if (EN(7) && IN(pb + 4)) {
            pg8::Gemm g{HX, (const pg8::bf16_t*)(F.ws + WS_WUP + (size_t)l * 172 * MiB), MROWS, NUP, DM};
            pg8::StaticOrder S; S.init(last ? 32 : 34, NUP, DM, F.G, fresh_bx(), last ? 1 : 0);
            pg8::EpiUpConv E{(pg8::bf16_t*)(F.ws + WS_ACT), (float*)(F.ws + WS_U), ap->in[22] + (size_t)l * 3 * NUP, (LAS float*)(F.lds + XCH_OFF), DFF};
            pg8::gemm_phase<pg8::EpiUpConv, pg8::StaticOrder, true>(F.lds + RING_OFF, g, S, E);
        } SEAM(pb + 4);
        if (EN(8) && IN(pb + 5)) { for (int rep = 0; rep < REP_CONV; ++rep) { FRESH(); phase_fixup(F, ap, l, last); } } SEAM(pb + 5);
        if (EN(9) && IN(pb + 6)) {
            pg8::Gemm g{(const pg8::bf16_t*)(F.ws + WS_ACT), (const pg8::bf16_t*)(F.ws + WS_WDN + (size_t)l * 86 * MiB), MROWS, DM, DFF};
            pg8::SplitOrder S; S.init(DM, DFF, F.G, fresh_bx()); if (last) S.ca = 0;
            pg8::EpiSplit E{(pg8::bf16_t*)(F.ws + WS_Y), (float*)(F.ws + WS_PART), DM};
            pg8::gemm_phase<pg8::EpiSplit, pg8::SplitOrder, true>(F.lds + RING_OFF, g, S, E);
        } SEAM(pb + 6);
        if (EN(10) && IN(pb + 7)) { FRESH(); phase_r2(F, ap, l, last); } SEAM(pb + 7);
    }
#undef IN
#undef SEAM
}

extern "C" void kernel_launch(void* const* d_in, const int* in_sizes, int n_in, void* d_out, int out_size, void* d_ws, size_t ws_size, hipStream_t stream) {
    static int grid = 0;
    if (grid == 0) {
        if (n_in != 24 || in_sizes[0] != NB * SEQ * DM || out_size != NB * SEQ * DM || ws_size < WS_END) {
            fprintf(stderr, "kernel_launch: unexpected shapes: n_in %d in0 %d out %d ws %zu (need %zu); nothing launched\n", n_in, n_in > 0 ? in_sizes[0] : -1, out_size, ws_size, (size_t)WS_END); grid = -1; return; }
        int dev = 0, cus = 0, per_cu = 0;
        if (hipGetDevice(&dev) != hipSuccess || hipDeviceGetAttribute(&cus, hipDeviceAttributeMultiprocessorCount, dev) != hipSuccess) { grid = -1; return; }
        if (hipFuncSetAttribute((const void*)fwd_kernel, hipFuncAttributeMaxDynamicSharedMemorySize, LDS_BYTES) != hipSuccess) { fprintf(stderr, "kernel_launch: hipFuncSetAttribute failed\n"); grid = -1; return; }
        if (hipOccupancyMaxActiveBlocksPerMultiprocessor(&per_cu, (const void*)fwd_kernel, NWAVES * 64, LDS_BYTES) != hipSuccess || per_cu < 1)
            fprintf(stderr, "kernel_launch: note: occupancy query reports %d workgroups per CU\n", per_cu);
        (void)hipGetLastError();
        grid = cus;
    }
    if (grid < 0) return;
    if (hipMemsetAsync((char*)d_ws + WS_CTL, 0, CTL_ZERO_BYTES, stream) != hipSuccess) return;
    Args a{};
    for (int i = 0; i < 24; ++i) a.in[i] = (const float*)d_in[i];
    a.out = (float*)d_out; a.ws = (unsigned char*)d_ws;
#if MK_SINGLE
    a.ph_lo = 0; a.ph_hi = NPHASE;
    hipLaunchKernelGGL(fwd_kernel, dim3(grid), dim3(NWAVES * 64), LDS_BYTES, stream, a);
#else
    for (int p = 0; p < NPHASE; ++p) { a.ph_lo = p; a.ph_hi = p + 1; hipLaunchKernelGGL(fwd_kernel, dim3(grid), dim3(NWAVES * 64), LDS_BYTES, stream, a); }
#endif
    const hipError_t le = hipPeekAtLastError();
    if (le != hipSuccess) fprintf(stderr, "kernel_launch: launch failed: %s\n", hipGetErrorName(le));
}
```

```cpp
#include <hip/hip_runtime.h>
#include <cstdio>
#include <cstdint>

#ifndef MK_SINGLE
#define MK_SINGLE 1
#endif

namespace pg8 {
#define PG8_LAS __attribute__((address_space(3)))
typedef unsigned short bf16_t;
typedef short bf16x8 __attribute__((ext_vector_type(8)));
typedef float f32x4 __attribute__((ext_vector_type(4)));
typedef unsigned u32x4 __attribute__((ext_vector_type(4)));
constexpr int BM = 256, BK = 64, HALF = 128, HTB = HALF * BK * 2, STAGE_BYTES = 8 * HTB, NXCD = 8, WGM = 8;

__host__ __device__ __forceinline__ int lds_byte(int r, int c) { const int st = (r >> 4) * 2 + (c >> 5), rr = r & 15, cc = c & 31, ob = rr * 64 + cc * 2; return st * 1024 + (ob ^ (((ob >> 9) & 1) << 5)); }
__host__ __device__ __forceinline__ void stage_rc(int b, int& R, int& C) { const int st = b / 1024, sb = b % 1024, swz = sb ^ (((sb >> 9) & 1) << 5); R = (st >> 1) * 16 + swz / 64; C = (st & 1) * 32 + (swz % 64) / 2; }
__host__ __device__ __forceinline__ int perm32(int rho) { const int n = rho >> 4, i = rho & 15; return 8 * (i >> 2) + 4 * n + (i & 3); }

struct Unit { int pm, pn, kt0, nt, slab; };
struct Gemm { const bf16_t* A; const bf16_t* Bt; int M, N, K; };

struct StaticOrder {
    int nM, nN, nwg, G, c, skip, ntk;
    __host__ __device__ void init(int nM_, int N, int K, int G_, int c_, int skip_) { nM = nM_; nN = N / BM; nwg = nM * nN; G = G_; c = c_; skip = skip_; ntk = K / BK; }
    __host__ __device__ bool at(long L, Unit& u) const {
        if (L >= nwg) return false;
        int wgid = (int)L; { const int q = nwg / NXCD, r = nwg % NXCD, xcd = wgid % NXCD, off = wgid / NXCD; wgid = (xcd < r ? xcd * (q + 1) : r * (q + 1) + (xcd - r) * q) + off; }
        const int nig = WGM * nN, gid = wgid / nig, fm = gid * WGM, gsz = (nM - fm) < WGM ? (nM - fm) : WGM;
        u.pm = fm + ((wgid % nig) % gsz); u.pn = (wgid % nig) / gsz; u.kt0 = 0; u.nt = ntk; u.slab = -1;
        if (skip && u.pm >= 16) u.pm += 1;
        return true;
    }
    __host__ __device__ bool next(int i, Unit& u) const { return at((long)i * G + c, u); }
    __device__ __forceinline__ void a_ready(const Unit&) const {}
    __device__ __forceinline__ void done(const Unit&) const {}
};
struct SplitOrder {
    StaticOrder so; int ca, cb;
    __host__ __device__ void init(int N, int K, int G_, int c_) { so.init(32, N, K, G_, c_, 1); const int ntk = K / BK; ca = ((ntk / 8 + 1) / 2) * 2; cb = (ntk - 6 * ca) / 2; if (6 * ca + 2 * cb != ntk || (cb & 1) || cb <= 0) { ca = ntk / 8; cb = ca; } }
    __host__ __device__ bool next(int i, Unit& u) const {
        const long L = (long)i * so.G + so.c;
        if (L < so.nwg) return so.at(L, u);
        const int q = (int)(L - so.nwg); if (ca == 0 || q >= 256) return false;
        const int ch = q & 7, pn = (q >> 3) & 15, pp = q >> 7;
        u.pm = pp ? 33 : 16; u.pn = pn; u.slab = ch; u.kt0 = ch < 6 ? ca * ch : 6 * ca + cb * (ch - 6); u.nt = ch < 6 ? ca : cb;
        return true;
    }
    __device__ __forceinline__ void a_ready(const Unit&) const {}
    __device__ __forceinline__ void done(const Unit&) const {}
};

__device__ __forceinline__ unsigned cvt_pk_bf16(float lo, float hi) { unsigned r; asm volatile("v_cvt_pk_bf16_f32 %0, %1, %2" : "=v"(r) : "v"(lo), "v"(hi)); return r; }

struct EpiBf16 {
    static constexpr bool PERM = true, AFTER_DRAIN = false;
    bf16_t* O; int ldc;
    __device__ __forceinline__ void operator()(const f32x4 (&acc)[2][2][4][2], const Unit& u, int wr, int wc, int fr, int fq) const {
        const int row0 = u.pm * BM + wr * 64 + fr; const int col0 = u.pn * BM + wc * 32 + 8 * fq;
#pragma unroll
        for (int ai = 0; ai < 2; ++ai)
#pragma unroll
            for (int m = 0; m < 4; ++m) { bf16_t* rowp = O + (size_t)(row0 + ai * HALF + m * 16) * ldc + col0;
#pragma unroll
                for (int bj = 0; bj < 2; ++bj) { const f32x4 v0 = acc[ai][bj][m][0], v1 = acc[ai][bj][m][1];
                    u32x4 w; w.x = cvt_pk_bf16(v0[0], v0[1]); w.y = cvt_pk_bf16(v0[2], v0[3]); w.z = cvt_pk_bf16(v1[0], v1[1]); w.w = cvt_pk_bf16(v1[2], v1[3]);
                    *(u32x4*)(rowp + bj * HALF) = w; } }
    }
};

struct EpiSplit {
    static constexpr bool PERM = true, AFTER_DRAIN = false;
    bf16_t* O; float* part; int ldc;
    __device__ __forceinline__ void operator()(const f32x4 (&acc)[2][2][4][2], const Unit& u, int wr, int wc, int fr, int fq) const {
        const int col0 = u.pn * BM + wc * 32 + 8 * fq;
        if (u.slab < 0) {
            const int row0 = u.pm * BM + wr * 64 + fr;
#pragma unroll
            for (int ai = 0; ai < 2; ++ai)
#pragma unroll
                for (int m = 0; m < 4; ++m) { bf16_t* rowp = O + (size_t)(row0 + ai * HALF + m * 16) * ldc + col0;
#pragma unroll
                    for (int bj = 0; bj < 2; ++bj) { const f32x4 v0 = acc[ai][bj][m][0], v1 = acc[ai][bj][m][1];
                        u32x4 w; w.x = cvt_pk_bf16(v0[0], v0[1]); w.y = cvt_pk_bf16(v0[2], v0[3]); w.z = cvt_pk_bf16(v1[0], v1[1]); w.w = cvt_pk_bf16(v1[2], v1[3]);
                        *(u32x4*)(rowp + bj * HALF) = w; } }
        } else {
            const int row0 = (u.pm == 16 ? 0 : 256) + wr * 64 + fr; float* pb = part + (size_t)u.slab * 512 * ldc;
#pragma unroll
            for (int ai = 0; ai < 2; ++ai)
#pragma unroll
                for (int m = 0; m < 4; ++m) { float* rowp = pb + (size_t)(row0 + ai * HALF + m * 16) * ldc + col0;
#pragma unroll
                    for (int bj = 0; bj < 2; ++bj) { *(f32x4*)(rowp + bj * HALF) = acc[ai][bj][m][0]; *(f32x4*)(rowp + bj * HALF + 4) = acc[ai][bj][m][1]; } }
        }
    }
};

struct EpiInProj {
    static constexpr bool PERM = true, AFTER_DRAIN = false;
    bf16_t* O; int ldc; const float* thd; const float* tdh; const float* gq; const float* gk; PG8_LAS float* xch;
    __device__ __forceinline__ void operator()(f32x4 (&acc)[2][2][4][2], const Unit& u, int wr, int wc, int fr, int fq) const {
        const int pmb = u.pm % 17; const bool ctx = (pmb == 16); const int pn = u.pn;
        const int kind = pn < 4 ? 1 : pn < 8 ? 2 : pn < 12 ? 3 : pn < 16 ? 0 : pn == 16 ? 4 : pn < 18 ? 0 : pn < 22 ? 2 : pn == 26 ? 3 : 0;
        if (kind == 1 || kind == 4) {
            const float* g = (kind == 1 ? gq : gk) + wc * 32 + 8 * fq;
            const f32x4 g0 = *(const f32x4*)g, g1 = *(const f32x4*)(g + 4);
#pragma unroll
            for (int ai = 0; ai < 2; ++ai)
#pragma unroll
                for (int m = 0; m < 4; ++m)
#pragma unroll
                    for (int bj = 0; bj < 2; ++bj) { const f32x4 a = acc[ai][bj][m][0], b = acc[ai][bj][m][1];
                        float s = (a[0] * a[0] + a[1] * a[1]) + (a[2] * a[2] + a[3] * a[3]) + (b[0] * b[0] + b[1] * b[1]) + (b[2] * b[2] + b[3] * b[3]);
                        s += __shfl_xor(s, 16); s += __shfl_xor(s, 32);
                        if (fq == 0) xch[((ai * HALF + wr * 64 + m * 16 + fr) * 2 + bj) * 4 + wc] = s; }
            asm volatile("s_waitcnt lgkmcnt(0)" ::: "memory"); __builtin_amdgcn_s_barrier(); asm volatile("" ::: "memory");
#pragma unroll
            for (int ai = 0; ai < 2; ++ai)
#pragma unroll
                for (int m = 0; m < 4; ++m)
#pragma unroll
                    for (int bj = 0; bj < 2; ++bj) { const f32x4 p = *(const PG8_LAS f32x4*)(xch + ((ai * HALF + wr * 64 + m * 16 + fr) * 2 + bj) * 4);
                        const float rstd = __builtin_amdgcn_rsqf(((p[0] + p[1]) + (p[2] + p[3])) * (1.f / 128.f) + 1e-6f);
                        acc[ai][bj][m][0] = acc[ai][bj][m][0] * rstd * g0; acc[ai][bj][m][1] = acc[ai][bj][m][1] * rstd * g1; }
        }
        if (kind != 0 && !ctx) {
            const bool dh = (kind == 2);
#pragma unroll
            for (int ai = 0; ai < 2; ++ai)
#pragma unroll
                for (int m = 0; m < 4; ++m) { const int t = pmb * 256 + ai * HALF + wr * 64 + m * 16 + fr; const int grow = t >> 6, gcol = t & 63;
                    const float* tp = dh ? tdh + (size_t)((((wc & 1) == 0) ? grow : gcol) * 16 + 4 * fq) * 2 : thd + (size_t)(((wc < 2) ? grow : gcol) * 32 + 16 * (wc & 1) + 4 * fq) * 2;
                    const f32x4 c01 = *(const f32x4*)tp, c23 = *(const f32x4*)(tp + 4);
#pragma unroll
                    for (int bj = 0; bj < 2; ++bj) { f32x4 a = acc[ai][bj][m][0], b = acc[ai][bj][m][1];
                        acc[ai][bj][m][0] = (f32x4){a[0] * c01[0] - a[1] * c01[1], a[0] * c01[1] + a[1] * c01[0], a[2] * c01[2] - a[3] * c01[3], a[2] * c01[3] + a[3] * c01[2]};
                        acc[ai][bj][m][1] = (f32x4){b[0] * c23[0] - b[1] * c23[1], b[0] * c23[1] + b[1] * c23[0], b[2] * c23[2] - b[3] * c23[3], b[2] * c23[3] + b[3] * c23[2]}; } }
        }
        const int row0 = u.pm * BM + wr * 64 + fr; const int col0 = u.pn * BM + wc * 32 + 8 * fq;
#pragma unroll
        for (int ai = 0; ai < 2; ++ai)
#pragma unroll
            for (int m = 0; m < 4; ++m) { bf16_t* rowp = O + (size_t)(row0 + ai * HALF + m * 16) * ldc + col0;
#pragma unroll
                for (int bj = 0; bj < 2; ++bj) { const f32x4 v0 = acc[ai][bj][m][0], v1 = acc[ai][bj][m][1];
                    u32x4 w; w.x = cvt_pk_bf16(v0[0], v0[1]); w.y = cvt_pk_bf16(v0[2], v0[3]); w.z = cvt_pk_bf16(v1[0], v1[1]); w.w = cvt_pk_bf16(v1[2], v1[3]);
                    *(u32x4*)(rowp + bj * HALF) = w; } }
    }
};

struct EpiUpConv {
    static constexpr bool PERM = true, AFTER_DRAIN = false;
    bf16_t* ACT; float* side; const float* cw; PG8_LAS float* xb; int dff;
    static __device__ __forceinline__ float dppf(float old, float src, const int ctrl_sel) {
        const int o = __float_as_int(old), s = __float_as_int(src); int r;
        if (ctrl_sel == 0) r = __builtin_amdgcn_update_dpp(o, s, 0x111, 0xF, 0xF, false);
        else if (ctrl_sel == 1) r = __builtin_amdgcn_update_dpp(o, s, 0x101, 0xF, 0xF, false);
        else if (ctrl_sel == 2) r = __builtin_amdgcn_update_dpp(o, s, 0x121, 0xF, 0xF, false);
        else r = __builtin_amdgcn_update_dpp(o, s, 0x12F, 0xF, 0xF, false);
        return __int_as_float(r);
    }
    static __device__ __forceinline__ f32x4 dpp4(const f32x4 old, const f32x4 src, const int c) { return (f32x4){dppf(old[0], src[0], c), dppf(old[1], src[1], c), dppf(old[2], src[2], c), dppf(old[3], src[3], c)}; }
    static __device__ __forceinline__ int xidx(int ai, int wr, int wc, int which, int bj, int fq, int n) { return ((((((ai * 2 + wr) * 4 + wc) * 2 + which) * 2 + bj) * 4 + fq) * 2 + n) * 4; }
    __device__ __forceinline__ void operator()(const f32x4 (&acc)[2][2][4][2], const Unit& u, int wr, int wc, int fr, int fq) const {
        const int cbase = wc * 32 + 8 * fq;
#pragma unroll
        for (int ai = 0; ai < 2; ++ai)
#pragma unroll
            for (int bj = 0; bj < 2; ++bj)
#pragma unroll
                for (int n = 0; n < 2; ++n) {
                    if (fr == 0) *(PG8_LAS f32x4*)(xb + xidx(ai, wr, wc, 0, bj, fq, n)) = acc[ai][bj][0][n];
                    if (fr == 15) *(PG8_LAS f32x4*)(xb + xidx(ai, wr, wc, 1, bj, fq, n)) = acc[ai][bj][3][n]; }
        { float* sp = side + (size_t)u.pm * 4 * (2 * dff) + (size_t)u.pn * 256 + cbase;
          if (wr == 0 && fr < 2) {
#pragma unroll
              for (int bj = 0; bj < 2; ++bj)
#pragma unroll
                  for (int n = 0; n < 2; ++n) *(f32x4*)(sp + (size_t)fr * (2 * dff) + bj * 128 + 4 * n) = acc[0][bj][0][n]; }
          if (wr == 1 && fr >= 14) {
#pragma unroll
              for (int bj = 0; bj < 2; ++bj)
#pragma unroll
                  for (int n = 0; n < 2; ++n) *(f32x4*)(sp + (size_t)(fr - 12) * (2 * dff) + bj * 128 + 4 * n) = acc[1][bj][3][n]; } }
        asm volatile("s_waitcnt lgkmcnt(0)" ::: "memory"); __builtin_amdgcn_s_barrier(); asm volatile("" ::: "memory");
        const float* cwp = cw + u.pn * 128 + cbase;
        const f32x4 zero4 = {0.f, 0.f, 0.f, 0.f};
#pragma unroll
        for (int ai = 0; ai < 2; ++ai)
#pragma unroll
            for (int m = 0; m < 4; ++m) {
                const int beta = 2 * ai + wr;
                u32x4 w;
#pragma unroll
                for (int n = 0; n < 2; ++n) {
                    f32x4 res[2];
#pragma unroll
                    for (int bj = 0; bj < 2; ++bj) {
                        const f32x4 cur = acc[ai][bj][m][n];
                        f32x4 oldp, oldn;
                        if (m > 0) oldp = dpp4(zero4, acc[ai][bj][m - 1][n], 2);
                        else if (beta > 0) oldp = *(const PG8_LAS f32x4*)(xb + xidx((beta - 1) >> 1, (beta - 1) & 1, wc, 1, bj, fq, n));
                        else oldp = zero4;
                        if (m < 3) oldn = dpp4(zero4, acc[ai][bj][m + 1][n], 3);
                        else if (beta < 3) oldn = *(const PG8_LAS f32x4*)(xb + xidx((beta + 1) >> 1, (beta + 1) & 1, wc, 0, bj, fq, n));
                        else oldn = zero4;
                        const f32x4 prev = dpp4(oldp, cur, 0), next = dpp4(oldn, cur, 1);
                        const float* wp = cwp + bj * dff + 4 * n;
                        const f32x4 w0 = *(const f32x4*)wp, w1 = *(const f32x4*)(wp + 2 * dff), w2 = *(const f32x4*)(wp + 4 * dff);
                        res[bj] = prev * w0 + cur * w1 + next * w2;
                    }
                    f32x4 o;
#pragma unroll
                    for (int e = 0; e < 4; ++e) o[e] = res[0][e] * __builtin_amdgcn_rcpf(1.f + __expf(-res[0][e])) * res[1][e];
                    if (n == 0) { w.x = cvt_pk_bf16(o[0], o[1]); w.y = cvt_pk_bf16(o[2], o[3]); } else { w.z = cvt_pk_bf16(o[0], o[1]); w.w = cvt_pk_bf16(o[2], o[3]); }
                }
                *(u32x4*)(ACT + (size_t)(u.pm * BM + ai * HALF + wr * 64 + m * 16 + fr) * dff + u.pn * 128 + cbase) = w;
            }
    }
};

template <class Epi, class Sched, bool ALIGN_EPI = false>
__device__ __forceinline__ void gemm_phase(PG8_LAS unsigned char* lds, const Gemm g, const Sched& S, const Epi& E) {
    int tid_ = threadIdx.x; asm volatile("" : "+v"(tid_));
    const int tid = tid_, wid = __builtin_amdgcn_readfirstlane(tid >> 6), lane = tid & 63, wr = wid >> 2, wc = wid & 3, fr = lane & 15, fq = lane >> 4;
    const int K = g.K;
    unsigned voffA[2], voffB[2];
#pragma unroll
    for (int i = 0; i < 2; ++i) { int R, C; stage_rc(tid * 16 + i * 8192, R, C); const int Rb = Epi::PERM ? ((R & ~31) + perm32(R & 31)) : R;
        voffA[i] = (unsigned)(R * K + C) * 2u; voffB[i] = (unsigned)(Rb * K + C) * 2u; }
    const size_t kstep = (size_t)(BK * 2);
    const size_t hstep = (size_t)HALF * K * 2;
    const size_t tstep = 2 * hstep;
    const unsigned ldsw = (unsigned)wid * 1024u;
    const int aoff = lds_byte(wr * 64 + fr, fq * 8), boff = lds_byte(wc * 32 + fr, fq * 8);
#define PG8_SA(b, h) (((b) * 2 + (h)) * HTB)
#define PG8_SB(b, h) ((4 + (b) * 2 + (h)) * HTB)
#define PG8_STAGE(bufoff, gbase, voff) do { _Pragma("unroll") for (int _i = 0; _i < 2; ++_i) \
        __builtin_amdgcn_global_load_lds((const unsigned*)((const char*)(gbase) + (voff)[_i]), (PG8_LAS unsigned*)(lds + (bufoff) + ldsw + _i * 8192), 16, 0, 0); } while (0)
#define PG8_LDA(dst, b, h) do { _Pragma("unroll") for (int m = 0; m < 4; ++m) _Pragma("unroll") for (int k = 0; k < 2; ++k) dst[m][k] = *(const PG8_LAS bf16x8*)(lds + PG8_SA(b, h) + aoff + m * 2048 + k * 1024); } while (0)
#define PG8_LDB(dst, b, h) do { _Pragma("unroll") for (int n = 0; n < 2; ++n) _Pragma("unroll") for (int k = 0; k < 2; ++k) dst[n][k] = *(const PG8_LAS bf16x8*)(lds + PG8_SB(b, h) + boff + n * 2048 + k * 1024); } while (0)
#define PG8_MMA(ai, bj, At, Bt) do { __builtin_amdgcn_s_setprio(1); _Pragma("unroll") for (int m = 0; m < 4; ++m) _Pragma("unroll") for (int n = 0; n < 2; ++n) _Pragma("unroll") for (int k = 0; k < 2; ++k) \
        acc[ai][bj][m][n] = __builtin_amdgcn_mfma_f32_16x16x32_bf16(Bt[n][k], At[m][k], acc[ai][bj][m][n], 0, 0, 0); __builtin_amdgcn_s_setprio(0); } while (0)
#define PG8_WAIT_V(n) asm volatile("s_waitcnt vmcnt(" #n ")" ::: "memory")
#define PG8_WAIT_L(n) asm volatile("s_waitcnt lgkmcnt(" #n ")" ::: "memory")
#define PG8_BAR __builtin_amdgcn_s_barrier()
#define PG8_SCHED __builtin_amdgcn_sched_barrier(0)
    Unit cur, nxt; int ui = 0;
    if (!S.next(0, cur)) return;
    f32x4 acc[2][2][4][2];
#pragma unroll
    for (int a = 0; a < 2; ++a)
#pragma unroll
        for (int b = 0; b < 2; ++b)
#pragma unroll
            for (int m = 0; m < 4; ++m)
#pragma unroll
                for (int n = 0; n < 2; ++n) acc[a][b][m][n] = (f32x4){0.f, 0.f, 0.f, 0.f};
    bf16x8 At[4][2], B0[2][2], B1[2][2];
    const char* cA = (const char*)g.A + (size_t)cur.pm * tstep + (size_t)cur.kt0 * kstep; const char* cB = (const char*)g.Bt + (size_t)cur.pn * tstep + (size_t)cur.kt0 * kstep;
    S.a_ready(cur);
    PG8_STAGE(PG8_SB(0, 0), cB, voffB); PG8_STAGE(PG8_SB(0, 1), cB + hstep, voffB); PG8_STAGE(PG8_SA(0, 0), cA, voffA); PG8_STAGE(PG8_SA(0, 1), cA + hstep, voffA);
    if (wr == 1) PG8_BAR;
    PG8_WAIT_V(2); PG8_BAR;
    PG8_STAGE(PG8_SB(1, 0), cB + kstep, voffB); PG8_STAGE(PG8_SA(1, 0), cA + kstep, voffA); PG8_STAGE(PG8_SB(1, 1), cB + hstep + kstep, voffB);
    PG8_WAIT_V(6); PG8_BAR;
    for (;;) {
        const bool has_next = S.next(ui + 1, nxt);
        const char* nA = has_next ? (const char*)g.A + (size_t)nxt.pm * tstep + (size_t)nxt.kt0 * kstep : cA; const char* nB = has_next ? (const char*)g.Bt + (size_t)nxt.pn * tstep + (size_t)nxt.kt0 * kstep : cB;
        const int nt = cur.nt;
        for (int t = 0; t < nt; t += 2) {
            const bool last = (t == nt - 2);
            const char* a1 = cA + (size_t)(t + 1) * kstep;
            const char* a2 = last ? nA : cA + (size_t)(t + 2) * kstep; const char* b2 = last ? nB : cB + (size_t)(t + 2) * kstep;
            const char* a3 = a2 + kstep; const char* b3 = b2 + kstep;
            if (last && has_next) S.a_ready(nxt);
            PG8_LDB(B0, 0, 0); PG8_LDB(B1, 0, 1); PG8_SCHED; PG8_LDA(At, 0, 0); PG8_STAGE(PG8_SA(1, 1), a1 + hstep, voffA);
            PG8_WAIT_V(8); PG8_WAIT_L(0); PG8_BAR; PG8_MMA(0, 0, At, B0); PG8_MMA(0, 1, At, B1); PG8_BAR; PG8_SCHED;
            PG8_LDA(At, 0, 1); PG8_STAGE(PG8_SB(0, 0), b2, voffB); PG8_STAGE(PG8_SB(0, 1), b2 + hstep, voffB); PG8_STAGE(PG8_SA(0, 0), a2, voffA);
            PG8_WAIT_V(8); PG8_WAIT_L(0); PG8_BAR; PG8_MMA(1, 0, At, B0); PG8_MMA(1, 1, At, B1); PG8_BAR; PG8_SCHED;
            PG8_LDB(B0, 1, 0); PG8_LDB(B1, 1, 1); PG8_SCHED; PG8_LDA(At, 1, 0); PG8_STAGE(PG8_SA(0, 1), a2 + hstep, voffA);
            PG8_WAIT_V(8); PG8_WAIT_L(0); PG8_BAR; PG8_MMA(0, 0, At, B0); PG8_MMA(0, 1, At, B1); PG8_BAR; PG8_SCHED;
            PG8_LDA(At, 1, 1); PG8_STAGE(PG8_SB(1, 0), b3, voffB); PG8_STAGE(PG8_SB(1, 1), b3 + hstep, voffB); PG8_STAGE(PG8_SA(1, 0), a3, voffA);
            PG8_WAIT_V(8); PG8_WAIT_L(0); PG8_BAR; PG8_MMA(1, 0, At, B0); PG8_MMA(1, 1, At, B1); PG8_BAR; PG8_SCHED;
        }
        if constexpr (ALIGN_EPI) { if (wr == 0) PG8_BAR; }
        if constexpr (!Epi::AFTER_DRAIN) { E(acc, cur, wr, wc, fr, fq); S.done(cur); }
        if (!has_next) break;
#pragma unroll
        for (int a = 0; a < 2; ++a)
#pragma unroll
            for (int b = 0; b < 2; ++b)
#pragma unroll
                for (int m = 0; m < 4; ++m)
#pragma unroll
                    for (int n = 0; n < 2; ++n) acc[a][b][m][n] = (f32x4){0.f, 0.f, 0.f, 0.f};
        cur = nxt; cA = nA; cB = nB; ++ui;
        if constexpr (ALIGN_EPI) { if (wr == 1) PG8_BAR; }
    }
    PG8_WAIT_V(0);
    if constexpr (!ALIGN_EPI) { if (wr == 0) PG8_BAR; }
    PG8_BAR;
#undef PG8_SA
#undef PG8_SB
#undef PG8_STAGE
#undef PG8_LDA
#undef PG8_LDB
#undef PG8_MMA
#undef PG8_WAIT_V
#undef PG8_WAIT_L
#undef PG8_BAR
#undef PG8_SCHED
}
}

namespace att {
#define ALAS __attribute__((address_space(3)))
typedef unsigned short bf16;
typedef short bf16x8 __attribute__((ext_vector_type(8)));
typedef short s16x4 __attribute__((ext_vector_type(4)));
typedef float f32x16 __attribute__((ext_vector_type(16)));
typedef unsigned u32x4 __attribute__((ext_vector_type(4)));
constexpr int LDP = 9216, LDO = 4096;
constexpr int SLOT = 32768;
constexpr int WSCR_OFF = 131072 + 1024, BIAS_OFF = WSCR_OFF + 2048, SHM_END = BIAS_OFF + 2048;
constexpr int NCTX_T = 4;
#define KSWZ(row, colB) ((row) * 256 + ((colB) ^ (((row) & 7) << 4)))
#define SBAR() __builtin_amdgcn_sched_barrier(0)
__device__ __forceinline__ int crow(int r, int hi) { return (r & 3) + 8 * (r >> 2) + 4 * hi; }
__device__ __forceinline__ unsigned cvtpk(float lo, float hi) { unsigned r; asm volatile("v_cvt_pk_bf16_f32 %0, %1, %2" : "=v"(r) : "v"(lo), "v"(hi)); return r; }

__device__ __forceinline__ void partialSM(f32x16& p0, f32x16& p1, float& m_reg, float& mn, float& alpha, const float C, const float thr_raw) {
    float pmax = p0[0];
#pragma unroll
    for (int r = 1; r < 16; ++r) pmax = fmaxf(pmax, p0[r]);
#pragma unroll
    for (int r = 0; r < 16; ++r) pmax = fmaxf(pmax, p1[r]);
    { auto rr = __builtin_amdgcn_permlane32_swap(__float_as_uint(pmax), __float_as_uint(pmax), false, false);
      pmax = fmaxf(__uint_as_float(rr[0]), __uint_as_float(rr[1])); }
    if (__builtin_expect(__all(pmax - m_reg <= thr_raw), 1)) { mn = m_reg; alpha = 1.f; }
    else { mn = fmaxf(m_reg, pmax); alpha = __builtin_amdgcn_exp2f((m_reg - mn) * C); m_reg = mn; }
    const float mnC = -mn * C;
#pragma unroll
    for (int r = 0; r < 16; ++r) p0[r] = fmaf(p0[r], C, mnC);
#pragma unroll
    for (int r = 0; r < 16; ++r) p1[r] = fmaf(p1[r], C, mnC);
#pragma unroll
    for (int r = 0; r < 16; ++r) p0[r] = __builtin_amdgcn_exp2f(p0[r]);
}
__device__ __forceinline__ void finishSM(f32x16& p0, f32x16& p1, float alpha, float& l_reg, bf16x8& pa0, bf16x8& pa1, bf16x8& pa2, bf16x8& pa3) {
#pragma unroll
    for (int r = 0; r < 16; ++r) p1[r] = __builtin_amdgcn_exp2f(p1[r]);
    float ps = 0;
#pragma unroll
    for (int r = 0; r < 16; ++r) ps += p0[r];
#pragma unroll
    for (int r = 0; r < 16; ++r) ps += p1[r];
    { auto rr = __builtin_amdgcn_permlane32_swap(__float_as_uint(ps), __float_as_uint(ps), false, false);
      ps = __uint_as_float(rr[0]) + __uint_as_float(rr[1]); }
    l_reg = l_reg * alpha + ps;
#define PK4(P, BASE, OUT) do { unsigned a0 = cvtpk(P[BASE + 0], P[BASE + 1]), a1 = cvtpk(P[BASE + 2], P[BASE + 3]);   \
    unsigned b0 = cvtpk(P[BASE + 4], P[BASE + 5]), b1 = cvtpk(P[BASE + 6], P[BASE + 7]);                              \
    auto r0 = __builtin_amdgcn_permlane32_swap(a0, b0, false, false); auto r1 = __builtin_amdgcn_permlane32_swap(a1, b1, false, false); \
    u32x4 w = {r0[0], r1[0], r0[1], r1[1]}; OUT = __builtin_bit_cast(bf16x8, w); } while (0)
    PK4(p0, 0, pa0); PK4(p0, 8, pa1); PK4(p1, 0, pa2); PK4(p1, 8, pa3);
#undef PK4
}
template <int D0LO, int D0N>
__device__ __forceinline__ void qkt(f32x16& p0, f32x16& p1, const ALAS char* Ks, const bf16x8* qr, int r32, int hi) {
    p0 = f32x16{}; p1 = f32x16{};
#pragma unroll
    for (int d0 = D0LO; d0 < D0LO + D0N; ++d0) { const int cb = (d0 * 16 + hi * 8) * 2;
        const bf16x8 b0 = *(const ALAS bf16x8*)(Ks + KSWZ(r32, cb));
        const bf16x8 b1 = *(const ALAS bf16x8*)(Ks + KSWZ(32 + r32, cb));
        p0 = __builtin_amdgcn_mfma_f32_32x32x16_bf16(b0, qr[d0], p0, 0, 0, 0);
        p1 = __builtin_amdgcn_mfma_f32_32x32x16_bf16(b1, qr[d0], p1, 0, 0, 0); }
}
__device__ __forceinline__ int v_st(int k, int c) { const int kk = (k & ~0xC) | ((k & 4) << 1) | ((k & 8) >> 1); return ((kk >> 3) * 4 + (c >> 5)) * 512 + ((kk & 7) * 32 + (c & 31)) * 2; }
__device__ __forceinline__ int v_rd_base(int lane) { return ((lane & 3) << 3) | (((lane >> 2) & 3) << 6) | (((lane >> 4) & 1) << 5) | (((lane >> 5) & 1) << 8); }
constexpr int v_rd_off(int d0, int ks, int half) { return d0 * 512 + ks * 4096 + half * 2048; }
template <int OFF> __device__ __forceinline__ s16x4 tr_read(int vb) {
    s16x4 r; asm volatile("ds_read_b64_tr_b16 %0, %1 offset:%2" : "=&v"(r) : "v"(vb), "i"(OFF) : "memory"); return r;
}
template <int D0> __device__ __forceinline__ void pv_one(f32x16& od, int vb, bf16x8 pa0, bf16x8 pa1, bf16x8 pa2, bf16x8 pa3) {
    const s16x4 l0 = tr_read<v_rd_off(D0, 0, 0)>(vb), h0 = tr_read<v_rd_off(D0, 0, 1)>(vb), l1 = tr_read<v_rd_off(D0, 1, 0)>(vb), h1 = tr_read<v_rd_off(D0, 1, 1)>(vb);
    const s16x4 l2 = tr_read<v_rd_off(D0, 2, 0)>(vb), h2 = tr_read<v_rd_off(D0, 2, 1)>(vb), l3 = tr_read<v_rd_off(D0, 3, 0)>(vb), h3 = tr_read<v_rd_off(D0, 3, 1)>(vb);
    asm volatile("s_waitcnt lgkmcnt(0)" ::: "memory"); SBAR();
#define PK(L, H) (bf16x8){L[0], L[1], L[2], L[3], H[0], H[1], H[2], H[3]}
    od = __builtin_amdgcn_mfma_f32_32x32x16_bf16(pa0, PK(l0, h0), od, 0, 0, 0);
    od = __builtin_amdgcn_mfma_f32_32x32x16_bf16(pa1, PK(l1, h1), od, 0, 0, 0);
    od = __builtin_amdgcn_mfma_f32_32x32x16_bf16(pa2, PK(l2, h2), od, 0, 0, 0);
    od = __builtin_amdgcn_mfma_f32_32x32x16_bf16(pa3, PK(l3, h3), od, 0, 0, 0);
#undef PK
}
__device__ __forceinline__ void pv_d0(f32x16* o, int vb, bf16x8 pa0, bf16x8 pa1, bf16x8 pa2, bf16x8 pa3) {
    pv_one<0>(o[0], vb, pa0, pa1, pa2, pa3); pv_one<1>(o[1], vb, pa0, pa1, pa2, pa3); pv_one<2>(o[2], vb, pa0, pa1, pa2, pa3); pv_one<3>(o[3], vb, pa0, pa1, pa2, pa3);
}

template <int MASK>
__device__ __forceinline__ void apply_mask(f32x16& p0, f32x16& p1, int j, int loc0, int qp, int hi, const ALAS float* bias) {
    if constexpr (MASK == 2) {
        if (j >= NCTX_T) { const int kbase = loc0 + 64 * (j - NCTX_T);
#pragma unroll
            for (int r = 0; r < 16; ++r) { const int d0 = qp - (kbase + crow(r, hi)); const int d1 = d0 - 32;
                if (d0 > 128 || d0 < -128) p0[r] = -1e30f;
                if (d1 > 128 || d1 < -128) p1[r] = -1e30f; } }
    } else if constexpr (MASK == 3) {
        if (j >= NCTX_T) { const int kbase = loc0 + 64 * (j - NCTX_T);
            const int qrow = qp >> 6, qcol = qp & 63; const int rs = min(max(qrow - 4, 0), 56), cs = min(max(qcol - 8, 0), 48);
            const int kr = kbase >> 6; const int dr = kr - rs;
            if (dr < 0 || dr >= 8) {
#pragma unroll
                for (int r = 0; r < 16; ++r) { p0[r] = -1e30f; p1[r] = -1e30f; }
            } else {
                const ALAS float* brow = bias + (kr - qrow + 7) * 31 + 15 - qcol;
#pragma unroll
                for (int r = 0; r < 16; ++r) { const int kc0 = crow(r, hi), kc1 = kc0 + 32;
                    const bool ok0 = (unsigned)(kc0 - cs) < 16u, ok1 = (unsigned)(kc1 - cs) < 16u;
                    const float b0 = brow[ok0 ? kc0 : qcol], b1 = brow[ok1 ? kc1 : qcol];
                    p0[r] = ok0 ? p0[r] + b0 : -1e30f; p1[r] = ok1 ? p1[r] + b1 : -1e30f;
                    if ((r & 3) == 3) asm volatile("" ::: "memory"); }
            }
        }
    }
}

template <int MASK, int D0LO, int D0N>
__device__ __forceinline__ void attn_core(f32x16 (&o)[4], float& m_reg, float& l_reg, const bf16* __restrict__ Qw, const bf16* __restrict__ Kb, const bf16* __restrict__ Vb,
                                          const int nloc, const int loc0, const int qp, const float C, const float thr_raw, ALAS char* lds) {
    int tid_ = threadIdx.x; asm volatile("" : "+v"(tid_));
    const int tid = tid_, wid = __builtin_amdgcn_readfirstlane(tid >> 6), lane = tid & 63, r32 = lane & 31, hi = lane >> 5;
    ALAS float* ws = (ALAS float*)(lds + WSCR_OFF) + wid * 64; ALAS float* al_l = ws + 32;
    const ALAS float* bias = (const ALAS float*)(lds + BIAS_OFF);
    unsigned voffK[2], voffV[2];
#pragma unroll
    for (int i = 0; i < 2; ++i) { const int q = (wid + 8 * i) * 64 + lane;
        { const int row = q >> 4, cc = (q & 15) ^ (row & 7); voffK[i] = (unsigned)(row * (LDP * 2) + cc * 16); }
        { const int kk = (q >> 7) * 8 + ((q & 31) >> 2), c = ((q >> 5) & 3) * 32 + (q & 3) * 8; const int k = (kk & ~0xC) | ((kk & 4) << 1) | ((kk & 8) >> 1); voffV[i] = (unsigned)(k * (LDP * 2) + c * 2); } }
    const int NT = NCTX_T + nloc;
#define KOFF(j) ((j) < NCTX_T ? 4096 + 64 * (j) : loc0 + 64 * ((j) - NCTX_T))
#define ISSUE(j) do { const size_t _ro = (size_t)KOFF(j) * (LDP * 2); const char* _gk = (const char*)Kb + _ro; const char* _gv = (const char*)Vb + _ro; ALAS char* _sl = lds + ((j) & 3) * SLOT + wid * 1024; \
    _Pragma("unroll") for (int _i = 0; _i < 2; ++_i) __builtin_amdgcn_global_load_lds((const unsigned*)(_gk + voffK[_i]), (ALAS unsigned*)(_sl + _i * 8192), 16, 0, 0); \
    _Pragma("unroll") for (int _i = 0; _i < 2; ++_i) __builtin_amdgcn_global_load_lds((const unsigned*)(_gv + voffV[_i]), (ALAS unsigned*)(_sl + 16384 + _i * 8192), 16, 0, 0); } while (0)
#define WAITBAR(n) do { asm volatile("s_waitcnt vmcnt(" #n ") lgkmcnt(0)" ::: "memory"); __builtin_amdgcn_s_barrier(); asm volatile("" ::: "memory"); } while (0)
#define RESC(a) do { if (__any((a) < 1.f)) { if (hi == 0) al_l[r32] = (a); asm volatile("s_waitcnt lgkmcnt(0)" ::: "memory"); \
    _Pragma("unroll") for (int d = 0; d < 4; ++d) _Pragma("unroll") for (int r = 0; r < 16; ++r) o[d][r] *= al_l[crow(r, hi)]; } } while (0)
    asm volatile("s_waitcnt vmcnt(0)" ::: "memory");
    m_reg = -1e30f; l_reg = 0.f;
#pragma unroll
    for (int d = 0; d < 4; ++d) o[d] = f32x16{};
    bf16x8 qr[8];
#pragma unroll
    for (int d0 = 0; d0 < 8; ++d0) qr[d0] = *(const bf16x8*)(Qw + d0 * 16);
    ISSUE(0); ISSUE(1); ISSUE(2);
    const int vb0 = (int)(uintptr_t)lds + 16384 + v_rd_base(lane);
    f32x16 pA0, pA1, pB0, pB1; float mnA, mnB, alA, alB; bf16x8 pa0, pa1, pa2, pa3;
    WAITBAR(8);
    qkt<D0LO, D0N>(pA0, pA1, lds, qr, r32, hi); apply_mask<MASK>(pA0, pA1, 0, loc0, qp, hi, bias); partialSM(pA0, pA1, m_reg, mnA, alA, C, thr_raw);
    WAITBAR(4);
    ISSUE(3);
    for (int j = 1; j + 1 < NT; j += 2) {
        SBAR(); qkt<D0LO, D0N>(pB0, pB1, lds + (j & 3) * SLOT, qr, r32, hi);
        finishSM(pA0, pA1, alA, l_reg, pa0, pa1, pa2, pa3); SBAR();
        pv_d0(o, vb0 + ((j - 1) & 3) * SLOT, pa0, pa1, pa2, pa3); apply_mask<MASK>(pB0, pB1, j, loc0, qp, hi, bias); partialSM(pB0, pB1, m_reg, mnB, alB, C, thr_raw);
        if (j + 2 < NT) { WAITBAR(4); } else { WAITBAR(0); }
        if (j + 3 < NT) ISSUE(j + 3);
        RESC(alB);
        SBAR(); qkt<D0LO, D0N>(pA0, pA1, lds + ((j + 1) & 3) * SLOT, qr, r32, hi);
        finishSM(pB0, pB1, alB, l_reg, pa0, pa1, pa2, pa3); SBAR();
        pv_d0(o, vb0 + (j & 3) * SLOT, pa0, pa1, pa2, pa3); apply_mask<MASK>(pA0, pA1, j + 1, loc0, qp, hi, bias); partialSM(pA0, pA1, m_reg, mnA, alA, C, thr_raw);
        if (j + 3 < NT) { WAITBAR(4); } else { WAITBAR(0); }
        if (j + 4 < NT) ISSUE(j + 4);
        RESC(alA);
    }
    SBAR(); qkt<D0LO, D0N>(pB0, pB1, lds + ((NT - 1) & 3) * SLOT, qr, r32, hi);
    finishSM(pA0, pA1, alA, l_reg, pa0, pa1, pa2, pa3); SBAR();
    pv_d0(o, vb0 + ((NT - 2) & 3) * SLOT, pa0, pa1, pa2, pa3); apply_mask<MASK>(pB0, pB1, NT - 1, loc0, qp, hi, bias); partialSM(pB0, pB1, m_reg, mnB, alB, C, thr_raw);
    RESC(alB);
    finishSM(pB0, pB1, alB, l_reg, pa0, pa1, pa2, pa3); SBAR();
    pv_d0(o, vb0 + ((NT - 1) & 3) * SLOT, pa0, pa1, pa2, pa3);
#undef KOFF
#undef ISSUE
#undef WAITBAR
#undef RESC
}
}

constexpr int NWAVES = 8;
constexpr int DM = 4096, NB = 2, SEQ = 4096, CTXL = 256, TPB = SEQ + CTXL  , MROWS = NB * TPB  ;
constexpr int NIN = 9216, DFF = 11008, NUP = 2 * DFF, NADA = 6 * DM;
constexpr int QA = 0, QB_ = 1024, QC = 2048, QD = 3072, KA = 4096, VA = 4352, KB_ = 4608, VB_ = 5632, KC = 6656, VC = 6912, KD = 7168, VD = 8192;
constexpr float EPS = 1e-6f;
constexpr int NPHASE = 18;

constexpr size_t MiB = 1u << 20;
constexpr size_t WS_CTL = 0, CTL_ZERO_BYTES = 1 * MiB;
constexpr size_t WS_MOD = 1 * MiB;
constexpr size_t WS_TAB = 2 * MiB;
constexpr size_t WS_WIN = 4 * MiB;
constexpr size_t WS_WOUT = WS_WIN + 2 * 72 * MiB;
constexpr size_t WS_WUP = WS_WOUT + 2 * 32 * MiB;
constexpr size_t WS_WDN = WS_WUP + 2 * 172 * MiB;
constexpr size_t WS_XS = WS_WDN + 2 * 86 * MiB;
constexpr size_t WS_HX = WS_XS + 136 * MiB;
constexpr size_t WS_P = WS_HX + 68 * MiB;
constexpr size_t WS_O = WS_P + 153 * MiB;
constexpr size_t WS_Y = WS_O + 68 * MiB;
constexpr size_t WS_U = WS_Y + 68 * MiB;
constexpr size_t WS_ACT = WS_U + 366 * MiB;
constexpr size_t WS_STASH = WS_ACT + 183 * MiB;
constexpr size_t WS_PART = WS_STASH + 32 * MiB;
constexpr size_t WS_END = WS_PART + 64 * MiB;
static_assert((size_t)MROWS * NUP * 2 <= 366 * MiB && (size_t)MROWS * DFF * 2 <= 183 * MiB && (size_t)MROWS * NIN * 2 <= 153 * MiB, "ws map");
constexpr int CW_BAR = 4096;

constexpr int RING_OFF = 0, RING_BYTES = 131072;
constexpr int LDSCTL_OFF = RING_BYTES, MISC_OFF = LDSCTL_OFF + 320;
constexpr int LDS_BYTES = 147456;
constexpr int XCH_OFF = att::SHM_END;
static_assert(XCH_OFF + 8192 <= LDS_BYTES && att::WSCR_OFF >= MISC_OFF + 128, "LDS map");

#define GAS __attribute__((address_space(1)))
#define LAS __attribute__((address_space(3)))
typedef unsigned short bf16;
typedef unsigned v4u __attribute__((ext_vector_type(4)));
typedef unsigned v2u __attribute__((ext_vector_type(2)));
typedef float f32x4 __attribute__((ext_vector_type(4)));
typedef float f32x2 __attribute__((ext_vector_type(2)));
typedef GAS unsigned gu32;
#define RLX_AGENT __ATOMIC_RELAXED, __HIP_MEMORY_SCOPE_AGENT
#define LDS_WAIT() asm volatile("s_waitcnt lgkmcnt(0)" ::: "memory")
#define VM_WAIT() asm volatile("s_waitcnt vmcnt(0)" ::: "memory")
__device__ __forceinline__ unsigned f2bf(float f) { unsigned u = __builtin_bit_cast(unsigned, f); return (u + 0x7fffu + ((u >> 16) & 1u)) >> 16; }
__device__ __forceinline__ unsigned pk2(float lo, float hi) { return f2bf(lo) | (f2bf(hi) << 16); }
__device__ __forceinline__ float bf_lo(unsigned w) { return __uint_as_float(w << 16); }
__device__ __forceinline__ float bf_hi(unsigned w) { return __uint_as_float(w & 0xffff0000u); }

#define XB_TMO      128
#define XB_XCNT(j)  (256  + 64 * (j))
#define XB_XSUB(j)  (1280 + 64 * (j))
#define XB_XGEN(j)  (2304 + 64 * (j))
#define XB_TOP      3328
#define XB_TOPGEN   3392
#define XCD_BAR_WORDS 3456
#define XB_SPIN_CAP (1u << 24)

__device__ __forceinline__ unsigned xb_ld(unsigned* p)              { return __hip_atomic_load(p, __ATOMIC_RELAXED, __HIP_MEMORY_SCOPE_AGENT); }
__device__ __forceinline__ unsigned xb_add(unsigned* p, unsigned v) { return __hip_atomic_fetch_add(p, v, __ATOMIC_RELAXED, __HIP_MEMORY_SCOPE_AGENT); }
__device__ __forceinline__ unsigned xb_xcc_id() { return (unsigned)__builtin_amdgcn_s_getreg((3 << 11) | 20) & 0xFu; }
#define XB_SPIN(cond, bar) do { unsigned _sp = 0; while (cond) { __builtin_amdgcn_s_sleep(1); \
    if ((++_sp & 255u) == 0u) { if (xb_ld(&(bar)[XB_TMO])) break; if (_sp > XB_SPIN_CAP) { atomicAdd(&(bar)[XB_TMO], 1u); break; } } } } while (0)

struct XcdBarrier { unsigned* bar; unsigned x; volatile LAS unsigned* st; };

__device__ __forceinline__ XcdBarrier xcd_barrier_post(unsigned* bar, volatile LAS unsigned* st) {
    XcdBarrier b; b.bar = bar; b.x = xb_xcc_id(); b.st = st;
    if (threadIdx.x == 0) (void)xb_add(&bar[XB_XCNT(b.x)], 1u);
    return b;
}
__device__ __forceinline__ void xcd_barrier_complete(unsigned* bar, unsigned x, unsigned& nloc, unsigned& nx) {
    const unsigned G = gridDim.x * gridDim.y * gridDim.z;
    unsigned sum, cnt, mine, sp = 0u;
    for (;;) {
        sum = 0u; cnt = 0u; mine = 0u;
#pragma unroll
        for (unsigned j = 0; j < 16; ++j) { const unsigned c = xb_ld(&bar[XB_XCNT(j)]); sum += c; cnt += (c > 0u) ? 1u : 0u; mine = (j == x) ? c : mine; }
        if (sum == G) break;
        __builtin_amdgcn_s_sleep(1);
        if ((++sp & 255u) == 0u) { if (xb_ld(&bar[XB_TMO])) break; if (sp > XB_SPIN_CAP) { atomicAdd(&bar[XB_TMO], 1u); break; } }
    }
    nloc = mine > 0u ? mine : 1u; nx = cnt > 0u ? cnt : 1u;
}
__device__ __forceinline__ void xcd_barrier(const XcdBarrier& b) {
    asm volatile("s_waitcnt vmcnt(0)" ::: "memory");
    __syncthreads();
    if (threadIdx.x == 0) {
        unsigned* bar = b.bar;
        __builtin_amdgcn_s_waitcnt(0);
        unsigned nloc = b.st[0], nx = b.st[1];
        if (nloc == 0u) { xcd_barrier_complete(bar, b.x, nloc, nx); b.st[0] = nloc; b.st[1] = nx; }
        const unsigned old = xb_add(&bar[XB_XSUB(b.x)], 1u);
        const unsigned gen = old / nloc;
        if (old + 1u == (gen + 1u) * nloc) {
            __builtin_amdgcn_fence(__ATOMIC_RELEASE, "agent");
            asm volatile("s_waitcnt vmcnt(0)" ::: "memory");
            const unsigned og = xb_add(&bar[XB_TOP], 1u);
            const unsigned tg = og / nx;
            if (og + 1u == (tg + 1u) * nx) xb_add(&bar[XB_TOPGEN], 1u);
            else XB_SPIN(xb_ld(&bar[XB_TOPGEN]) == tg, bar);
            __builtin_amdgcn_fence(__ATOMIC_ACQUIRE, "agent");
            xb_add(&bar[XB_XGEN(b.x)], 1u);
            asm volatile("s_waitcnt vmcnt(0)" ::: "memory");
        } else {
            XB_SPIN(xb_ld(&bar[XB_XGEN(b.x)]) == gen, bar);
            __builtin_amdgcn_fence(__ATOMIC_ACQUIRE, "agent");
            asm volatile("s_waitcnt vmcnt(0)" ::: "memory");
        }
    }
    __syncthreads();
}

struct Args {
    const float* in[24]; float* out; unsigned char* ws; int ph_lo, ph_hi;
};
typedef __attribute__((address_space(4))) const Args* KArgs;
struct Frame {
    LAS unsigned char* lds;
    int tid, lane, wave, vcu, G;
    unsigned char* ws;
};

__device__ __forceinline__ int fresh_bx() { int bx = blockIdx.x; asm volatile("" : "+s"(bx)); return bx; }
__device__ __forceinline__ float wave_sum(float v) {
#pragma unroll
    for (int o = 1; o < 64; o <<= 1) v += __shfl_xor(v, o);
    return v;
}

__device__ const float INV32[32] = {
    1.0f, 0.74989420933f, 0.56234132519f, 0.42169650343f, 0.31622776602f, 0.23713737057f, 0.17782794100f, 0.13335214322f,
    0.1f, 0.074989420933f, 0.056234132519f, 0.042169650343f, 0.031622776602f, 0.023713737057f, 0.017782794100f, 0.013335214322f,
    0.01f, 0.0074989420933f, 0.0056234132519f, 0.0042169650343f, 0.0031622776602f, 0.0023713737057f, 0.0017782794100f, 0.0013335214322f,
    0.001f, 0.00074989420933f, 0.00056234132519f, 0.00042169650343f, 0.00031622776602f, 0.00023713737057f, 0.00017782794100f, 0.00013335214322f };
__device__ const float INV16[16] = {
    1.0f, 0.56234132519f, 0.31622776602f, 0.17782794100f, 0.1f, 0.056234132519f, 0.031622776602f, 0.017782794100f,
    0.01f, 0.0056234132519f, 0.0031622776602f, 0.0017782794100f, 0.001f, 0.00056234132519f, 0.00031622776602f, 0.00017782794100f };

__device__ __forceinline__ void sincos_acc(float af, float& c, float& s) {
    const double a = (double)af; const double kd = __builtin_rint(a * 0.63661977236758134308); const int k = (int)kd;
    const double r = (a - kd * 1.57079632679489655800) - kd * 6.12323399573676603587e-17; const double r2 = r * r;
    const double sn = r * (1.0 + r2 * (-1.0 / 6 + r2 * (1.0 / 120 + r2 * (-1.0 / 5040 + r2 * (1.0 / 362880 + r2 * (-1.0 / 39916800 + r2 * (1.0 / 6227020800.0)))))));
    const double cs = 1.0 + r2 * (-0.5 + r2 * (1.0 / 24 + r2 * (-1.0 / 720 + r2 * (1.0 / 40320 + r2 * (-1.0 / 3628800 + r2 * (1.0 / 479001600.0 + r2 * (-1.0 / 87178291200.0)))))));
    double cc, ss;
    switch (k & 3) { case 0: cc = cs; ss = sn; break; case 1: cc = -sn; ss = cs; break; case 2: cc = -cs; ss = -sn; break; default: cc = sn; ss = -cs; break; }
    c = (float)cc; s = (float)ss;
}

__device__ __forceinline__ unsigned cvtpk_bf16(float lo, float hi) { unsigned r; asm volatile("v_cvt_pk_bf16_f32 %0, %1, %2" : "=v"(r) : "v"(lo), "v"(hi)); return r; }
__device__ __forceinline__ void p0_transpose_item(const float* W, int K, int N, bf16* WT, int item, int lane, bool gv) {
    const int nblk = N / 64, kb = item / nblk, nb = item % nblk, k0 = 64 * kb, n0 = 64 * nb;
    const int v0 = !gv ? n0 : (n0 < DFF ? (n0 >> 7) * 256 + (n0 & 127) : ((n0 - DFF) >> 7) * 256 + 128 + ((n0 - DFF) & 127));
    const int kr = lane >> 4, c4 = lane & 15;
    const GAS float* src = (const GAS float*)W + (size_t)(k0 + 16 * kr) * N + n0 + 4 * c4;
    f32x4 v[16];
#pragma unroll
    for (int i = 0; i < 16; ++i) v[i] = *(const GAS f32x4*)(src + (size_t)i * N);
    GAS bf16* dst = (GAS bf16*)WT + (size_t)(v0 + 4 * c4) * K + k0 + 16 * kr;
#pragma unroll
    for (int e = 0; e < 4; ++e) {
        v4u o0, o1;
        o0.x = cvtpk_bf16(v[0][e], v[1][e]); o0.y = cvtpk_bf16(v[2][e], v[3][e]); o0.z = cvtpk_bf16(v[4][e], v[5][e]); o0.w = cvtpk_bf16(v[6][e], v[7][e]);
        o1.x = cvtpk_bf16(v[8][e], v[9][e]); o1.y = cvtpk_bf16(v[10][e], v[11][e]); o1.z = cvtpk_bf16(v[12][e], v[13][e]); o1.w = cvtpk_bf16(v[14][e], v[15][e]);
        *(GAS v4u*)(dst + (size_t)e * K) = o0; *(GAS v4u*)(dst + (size_t)e * K + 8) = o1;
    }
}

__device__ __forceinline__ void convert_matrix(Frame& F, KArgs a, int mat, int l, int gw, int ngw) {
    const float* W; bf16* WT; int K, N;
    if (mat == 0) { W = a->in[10] + (size_t)l * DM * NIN; WT = (bf16*)(F.ws + WS_WIN + (size_t)l * 72 * MiB); K = DM; N = NIN; }
    else if (mat == 1) { W = a->in[11] + (size_t)l * DM * DM; WT = (bf16*)(F.ws + WS_WOUT + (size_t)l * 32 * MiB); K = DM; N = DM; }
    else if (mat == 2) { W = a->in[21] + (size_t)l * DM * NUP; WT = (bf16*)(F.ws + WS_WUP + (size_t)l * 172 * MiB); K = DM; N = NUP; }
    else { W = a->in[23] + (size_t)l * DFF * DM; WT = (bf16*)(F.ws + WS_WDN + (size_t)l * 86 * MiB); K = DFF; N = DM; }
    const int nitems = (K / 64) * (N / 64);
    for (int it = gw; it < nitems; it += ngw) p0_transpose_item(W, K, N, WT, it, F.lane, mat == 2);
}
__device__ __forceinline__ void tail_convert(Frame& F, KArgs a, int nbusy, int mat0, int l0, int mat1, int l1) {
    const int bx = fresh_bx(); if (bx < nbusy || nbusy >= F.G) return;
    const int gw = (bx - nbusy) * NWAVES + F.wave, ngw = (F.G - nbusy) * NWAVES;
    convert_matrix(F, a, mat0, l0, gw, ngw);
    if (mat1 >= 0) convert_matrix(F, a, mat1, l1, gw, ngw);
}
__device__ __forceinline__ float silu_f(float x) { return x / (1.f + __expf(-x)); }

__device__ __forceinline__ void phase_prologue(Frame& F, KArgs a) {
    const float* c_in = a->in[1]; const float* cctx = a->in[3]; const float* w_ada = a->in[4]; const float* b_ada = a->in[5];
    float* mod = (float*)(F.ws + WS_MOD);
    if (F.vcu == 0) {
        f32x2* thd = (f32x2*)(F.ws + WS_TAB);
        for (int e = F.tid; e < 64 * 32; e += NWAVES * 64) { const int pos = e >> 5, i = e & 31; float c, s; sincos_acc((float)pos * INV32[i], c, s); thd[e] = (f32x2){c, s}; }
        f32x2* tdh = (f32x2*)(F.ws + WS_TAB + 16384);
        for (int e = F.tid; e < 64 * 16; e += NWAVES * 64) { const int pos = e >> 4, i = e & 15; float c, s; sincos_acc((float)pos * INV16[i], c, s); tdh[e] = (f32x2){c, s}; }
        if (F.tid < 2) { const int l = F.tid; float s1 = 0.f, s2 = 0.f;
            for (int i = 0; i < 64; ++i) { s1 += a->in[14][l * 64 + i] * a->in[15][l * 64 + i]; s2 += a->in[16][l * 64 + i] * a->in[17][l * 64 + i]; }
            const float lam_init = 0.8f - 0.6f * expf(-0.3f * (float)l);
            float* lam = (float*)(F.ws + WS_TAB + 32768); lam[l * 2 + 0] = expf(s1) - expf(s2) + lam_init; lam[l * 2 + 1] = 1.f - lam_init; }
    }
    {
        LAS float* sv = (LAS float*)(F.lds + RING_OFF);
        LAS float* red = (LAS float*)(F.lds + RING_OFF + 49152);
        for (int e = F.tid; e < 3 * DM; e += NWAVES * 64) { const int v = e / DM, k = e % DM; const float x = v < 2 ? c_in[v * DM + k] : cctx[k]; sv[e] = silu_f(x); }
        __syncthreads();
        const int cg = F.lane & 15, kq = F.lane >> 4;
        for (int it = F.vcu; it < 2 * (NADA / 64); it += F.G) {
            const int l = it / (NADA / 64), ch = it % (NADA / 64);
            const float* W = w_ada + (size_t)l * DM * NADA + ch * 64 + cg * 4;
            f32x4 a0 = {0.f, 0.f, 0.f, 0.f}, a1 = a0, a2 = a0;
#pragma unroll 8
            for (int s = 0; s < DM / 32; ++s) { const int k = s * 32 + F.wave * 4 + kq; const f32x4 w = *(const GAS f32x4*)(W + (size_t)k * NADA);
                a0 += w * sv[k]; a1 += w * sv[DM + k]; a2 += w * sv[2 * DM + k]; }
#pragma unroll
            for (int e = 0; e < 4; ++e) { a0[e] += __shfl_xor(a0[e], 16); a0[e] += __shfl_xor(a0[e], 32); a1[e] += __shfl_xor(a1[e], 16); a1[e] += __shfl_xor(a1[e], 32); a2[e] += __shfl_xor(a2[e], 16); a2[e] += __shfl_xor(a2[e], 32); }
            if (kq == 0) {
#pragma unroll
                for (int e = 0; e < 4; ++e) { red[(F.wave * 3 + 0) * 64 + cg * 4 + e] = a0[e]; red[(F.wave * 3 + 1) * 64 + cg * 4 + e] = a1[e]; red[(F.wave * 3 + 2) * 64 + cg * 4 + e] = a2[e]; } }
            __syncthreads();
            if (F.tid < 192) { const int v = F.tid / 64, cidx = F.tid % 64; float s = 0.f;
#pragma unroll
                for (int w = 0; w < 8; ++w) s += red[(w * 3 + v) * 64 + cidx];
                const int col = ch * 64 + cidx; mod[((size_t)l * 3 + v) * NADA + col] = s + b_ada[(size_t)l * NADA + col]; }
            __syncthreads();
        }
    }
    {
        const int gw = F.vcu * NWAVES + F.wave, NGW = F.G * NWAVES;
        convert_matrix(F, a, 0, 0, gw, NGW); convert_matrix(F, a, 2, 0, gw, NGW); convert_matrix(F, a, 2, 1, gw, NGW);
        if (F.G != 256) { convert_matrix(F, a, 1, 0, gw, NGW); convert_matrix(F, a, 3, 0, gw, NGW); convert_matrix(F, a, 0, 1, gw, NGW); convert_matrix(F, a, 1, 1, gw, NGW); convert_matrix(F, a, 3, 1, gw, NGW); }
    }
}

struct RowRegs { f32x4 v[16]; };
__device__ __forceinline__ float row_sumsq(const RowRegs& r) {
    float s = 0.f;
#pragma unroll
    for (int j = 0; j < 16; ++j) s += (r.v[j].x * r.v[j].x + r.v[j].y * r.v[j].y) + (r.v[j].z * r.v[j].z + r.v[j].w * r.v[j].w);
    return wave_sum(s);
}
__device__ __forceinline__ void row_load_f32(RowRegs& r, const float* p, int lane) {
    const GAS f32x4* q = (const GAS f32x4*)p + lane;
#pragma unroll
    for (int j = 0; j < 16; ++j) r.v[j] = q[64 * j];
}
__device__ __forceinline__ void row_load_bf16(RowRegs& r, const bf16* p, int lane) {
    const GAS v2u* q = (const GAS v2u*)p + lane;
#pragma unroll
    for (int j = 0; j < 16; ++j) { const v2u w = q[64 * j]; r.v[j] = (f32x4){bf_lo(w.x), bf_hi(w.x), bf_lo(w.y), bf_hi(w.y)}; }
}
__device__ __forceinline__ void row_store_f32(const RowRegs& r, float* p, int lane) {
    GAS f32x4* q = (GAS f32x4*)p + lane;
#pragma unroll
    for (int j = 0; j < 16; ++j) q[64 * j] = r.v[j];
}
__device__ __forceinline__ void row_store_bf16(const RowRegs& r, bf16* p, int lane) {
    GAS v2u* q = (GAS v2u*)p + lane;
#pragma unroll
    for (int j = 0; j < 16; ++j) { v2u w; w.x = pk2(r.v[j].x, r.v[j].y); w.y = pk2(r.v[j].z, r.v[j].w); q[64 * j] = w; }
}
__device__ __forceinline__ void row_modnorm_store(const RowRegs& x, float rstd, const float* g, const float* sc, const float* sh, bf16* out, int lane) {
    GAS v2u* q = (GAS v2u*)out + lane;
#pragma unroll
    for (int j = 0; j < 16; ++j) { const int c = 4 * lane + 256 * j;
        const f32x4 gv = *(const GAS f32x4*)(g + c), sv = *(const GAS f32x4*)(sc + c), hv = *(const GAS f32x4*)(sh + c);
        const f32x4 y = (x.v[j] * rstd) * gv * (sv + 1.f) + hv;
        v2u w; w.x = pk2(y.x, y.y); w.y = pk2(y.z, y.w); q[64 * j] = w; }
}
__device__ __forceinline__ void row_residual(RowRegs& x, const RowRegs& y, float rstd, const float* g, const float* gate, int lane) {
#pragma unroll
    for (int j = 0; j < 16; ++j) { const int c = 4 * lane + 256 * j;
        const f32x4 gv = *(const GAS f32x4*)(g + c), tv = *(const GAS f32x4*)(gate + c);
        x.v[j] = x.v[j] + tv * ((y.v[j] * rstd) * gv); }
}

__device__ __forceinline__ void row_load_part(RowRegs& r, const float* part, int lrow, int lane) {
#pragma unroll
    for (int j = 0; j < 16; ++j) r.v[j] = (f32x4){0.f, 0.f, 0.f, 0.f};
#pragma unroll 2
    for (int c = 0; c < 8; ++c) { const GAS f32x4* q = (const GAS f32x4*)(part + ((size_t)c * 512 + lrow) * DM) + lane;
#pragma unroll
        for (int j = 0; j < 16; ++j) r.v[j] += q[64 * j]; }
}

__device__ __forceinline__ void phase_r0(Frame& F, KArgs a) {
    const float* mod = (const float*)(F.ws + WS_MOD); bf16* hx = (bf16*)(F.ws + WS_HX);
    const int gw = F.vcu * NWAVES + F.wave, NGW = F.G * NWAVES;
    for (int m = gw; m < MROWS; m += NGW) {
        const int b = m / TPB, t = m % TPB; const bool lat = t < SEQ;
        const float* src = lat ? a->in[0] + ((size_t)b * SEQ + t) * DM : a->in[2] + ((size_t)b * CTXL + (t - SEQ)) * DM;
        RowRegs x; row_load_f32(x, src, F.lane);
        const float rstd = 1.f / sqrtf(row_sumsq(x) * (1.f / DM) + EPS);
        const float* mv = mod + (size_t)(0 * 3 + (lat ? b : 2)) * NADA;
        row_modnorm_store(x, rstd, a->in[6]  , mv + DM, mv, hx + (size_t)m * DM, F.lane);
    }
}
__device__ __forceinline__ void phase_r1(Frame& F, KArgs a, int l, bool last) {
    const float* mod = (const float*)(F.ws + WS_MOD); bf16* xs = (bf16*)(F.ws + WS_XS); bf16* hx = (bf16*)(F.ws + WS_HX); const bf16* yb = (const bf16*)(F.ws + WS_Y);
    const int gw = F.vcu * NWAVES + F.wave, NGW = F.G * NWAVES;
    for (int m = gw; m < MROWS; m += NGW) {
        const int b = m / TPB, t = m % TPB; const bool lat = t < SEQ;
        if (last && !lat) continue;
        const float* mv = mod + (size_t)(l * 3 + (lat ? b : 2)) * NADA;
        RowRegs x, y;
        if (l == 0) row_load_f32(x, lat ? a->in[0] + ((size_t)b * SEQ + t) * DM : a->in[2] + ((size_t)b * CTXL + (t - SEQ)) * DM, F.lane);
        else row_load_bf16(x, xs + (size_t)m * DM, F.lane);
        if (lat) row_load_bf16(y, yb + (size_t)m * DM, F.lane); else row_load_part(y, (const float*)(F.ws + WS_PART), b * 256 + (t - SEQ), F.lane);
        const float rstd_y = 1.f / sqrtf(row_sumsq(y) * (1.f / DM) + EPS);
        row_residual(x, y, rstd_y, a->in[7] + (size_t)l * DM, mv + 2 * DM, F.lane);
        row_store_bf16(x, xs + (size_t)m * DM, F.lane);
        const float rstd = 1.f / sqrtf(row_sumsq(x) * (1.f / DM) + EPS);
        row_modnorm_store(x, rstd, a->in[8] + (size_t)l * DM, mv + 4 * DM, mv + 3 * DM, hx + (size_t)m * DM, F.lane);
    }
}
__device__ __forceinline__ void phase_r2(Frame& F, KArgs a, int l, bool last) {
    const float* mod = (const float*)(F.ws + WS_MOD); bf16* xs = (bf16*)(F.ws + WS_XS); bf16* hx = (bf16*)(F.ws + WS_HX); const bf16* yb = (const bf16*)(F.ws + WS_Y);
    const int gw = F.vcu * NWAVES + F.wave, NGW = F.G * NWAVES;
    for (int m = gw; m < MROWS; m += NGW) {
        const int b = m / TPB, t = m % TPB; const bool lat = t < SEQ;
        if (last && !lat) continue;
        const float* mv = mod + (size_t)(l * 3 + (lat ? b : 2)) * NADA;
        RowRegs x, y; row_load_bf16(x, xs + (size_t)m * DM, F.lane);
        if (lat) row_load_bf16(y, yb + (size_t)m * DM, F.lane); else row_load_part(y, (const float*)(F.ws + WS_PART), b * 256 + (t - SEQ), F.lane);
        const float rstd_y = 1.f / sqrtf(row_sumsq(y) * (1.f / DM) + EPS);
        row_residual(x, y, rstd_y, a->in[9] + (size_t)l * DM, mv + 5 * DM, F.lane);
        if (last) { row_store_f32(x, a->out + ((size_t)b * SEQ + t) * DM, F.lane); continue; }
        row_store_bf16(x, xs + (size_t)m * DM, F.lane);
        const float rstd = 1.f / sqrtf(row_sumsq(x) * (1.f / DM) + EPS);
        const float* mn = mod + (size_t)((l + 1) * 3 + (lat ? b : 2)) * NADA;
        row_modnorm_store(x, rstd, a->in[6] + (size_t)(l + 1) * DM, mn + DM, mn, hx + (size_t)m * DM, F.lane);
    }
}

__device__ __forceinline__ void phase_fixup(Frame& F, KArgs a, int l, bool last) {
    const float* side = (const float*)(F.ws + WS_U); bf16* ACT = (bf16*)(F.ws + WS_ACT);
    const float* cw = a->in[22] + (size_t)l * 3 * NUP;
    constexpr int CG = DFF / 4;
    const int ntile = last ? 32 : 34;
    for (int idx = F.vcu * NWAVES * 64 + F.tid; idx < ntile * 2 * CG; idx += F.G * NWAVES * 64) {
        const int cg = idx % CG, e = (idx / CG) & 1, pmi = idx / (2 * CG); const int pm = (last && pmi >= 16) ? pmi + 1 : pmi; const int pmb = pm % 17;
        const int col = cg * 4, vg = (col >> 7) * 256 + (col & 127);
        const float* sb = side + (size_t)pm * 4 * NUP;
        const f32x4 zero4 = {0.f, 0.f, 0.f, 0.f};
        f32x4 pg, pv, cg_, cv, ng, nv;
        if (e == 0) {
            cg_ = *(const GAS f32x4*)(sb + vg); cv = *(const GAS f32x4*)(sb + vg + 128); ng = *(const GAS f32x4*)(sb + NUP + vg); nv = *(const GAS f32x4*)(sb + NUP + vg + 128);
            if (pmb == 0 || pmb == 16) { pg = zero4; pv = zero4; } else { pg = *(const GAS f32x4*)(sb - NUP + vg); pv = *(const GAS f32x4*)(sb - NUP + vg + 128); }
        } else {
            cg_ = *(const GAS f32x4*)(sb + 3 * (size_t)NUP + vg); cv = *(const GAS f32x4*)(sb + 3 * (size_t)NUP + vg + 128); pg = *(const GAS f32x4*)(sb + 2 * (size_t)NUP + vg); pv = *(const GAS f32x4*)(sb + 2 * (size_t)NUP + vg + 128);
            if (pmb >= 15) { ng = zero4; nv = zero4; } else { ng = *(const GAS f32x4*)(sb + 4 * (size_t)NUP + vg); nv = *(const GAS f32x4*)(sb + 4 * (size_t)NUP + vg + 128); }
        }
        const f32x4 g = pg * *(const GAS f32x4*)(cw + col) + cg_ * *(const GAS f32x4*)(cw + NUP + col) + ng * *(const GAS f32x4*)(cw + 2 * NUP + col);
        const f32x4 v = pv * *(const GAS f32x4*)(cw + DFF + col) + cv * *(const GAS f32x4*)(cw + NUP + DFF + col) + nv * *(const GAS f32x4*)(cw + 2 * NUP + DFF + col);
        f32x4 o;
#pragma unroll
        for (int k = 0; k < 4; ++k) o[k] = g[k] / (1.f + __expf(-g[k])) * v[k];
        v2u w; w.x = pk2(o.x, o.y); w.y = pk2(o.z, o.w);
        *(GAS v2u*)(ACT + (size_t)(pm * 256 + (e ? 255 : 0)) * DFF + col) = w;
    }
}

template <int MASK>
__device__ __forceinline__ void attn_std_unit(Frame& F, const bf16* P, bf16* O, int b, int qrow0  , int qcol, int kcol, int vcol, int ocol,
                                              int nloc, int loc0, float sink, bool has_sink) {
    using namespace att;
    int lane_ = F.lane; asm volatile("" : "+v"(lane_));
    int lane = lane_, wid = F.wave, r32 = lane & 31, hi = lane >> 5;
    constexpr float SCALE = 0.088388347648318440f; constexpr float C = SCALE * 1.4426950408889634f;
    const size_t base = (size_t)b * TPB;
    const bf16* Qw = P + (base + qrow0 + wid * 32 + r32) * LDP + qcol + hi * 8;
    f32x16 o[4]; float m_reg, l_reg;
    attn_core<MASK, 0, 8>(o, m_reg, l_reg, Qw, P + base * LDP + kcol, P + base * LDP + vcol, nloc, loc0, qrow0 + wid * 32 + r32, C, 8.f / SCALE, (ALAS char*)F.lds);
    if (has_sink) l_reg += __builtin_amdgcn_exp2f(sink * 1.4426950408889634f - m_reg * C);
    asm volatile("" : "+v"(lane_)); lane = lane_; r32 = lane & 31; hi = lane >> 5;
    ALAS float* li_l = (ALAS float*)((ALAS char*)F.lds + WSCR_OFF) + wid * 64;
    if (hi == 0) li_l[r32] = l_reg; asm volatile("s_waitcnt lgkmcnt(0)" ::: "memory");
    bf16* Ow = O + (base + qrow0 + wid * 32) * LDO + ocol;
#pragma unroll
    for (int r = 0; r < 16; ++r) { const int orow = crow(r, hi); const float rl = __builtin_amdgcn_rcpf(li_l[orow]);
#pragma unroll
        for (int d0 = 0; d0 < 4; ++d0) Ow[(size_t)orow * LDO + d0 * 32 + r32] = (bf16)f2bf(o[d0][r] * rl); }
}
__device__ __forceinline__ void attn_diff_unit(Frame& F, const bf16* P, bf16* O, int b, int qrow0, int h, int nloc, int loc0, float lam, float omli, const float* gsub) {
    using namespace att;
    int lane_ = F.lane; asm volatile("" : "+v"(lane_));
    int lane = lane_, wid = F.wave, r32 = lane & 31, hi = lane >> 5;
    constexpr float SCALE = 0.125f; constexpr float C = SCALE * 1.4426950408889634f;
    const size_t base = (size_t)b * TPB;
    const bf16* Qw = P + (base + qrow0 + wid * 32 + r32) * LDP + QB_ + h * 128 + hi * 8;
    const bf16* Kb = P + base * LDP + KB_ + h * 128; const bf16* Vb = P + base * LDP + VB_ + h * 128;
    ALAS float* li_l = (ALAS float*)((ALAS char*)F.lds + WSCR_OFF) + wid * 64;
    f32x16 o[4]; float m_reg, l_reg;
    attn_core<0, 4, 4>(o, m_reg, l_reg, Qw, Kb, Vb, nloc, loc0, 0, C, 8.f / SCALE, (ALAS char*)F.lds);
    asm volatile("" : "+v"(lane_)); lane = lane_; r32 = lane & 31; hi = lane >> 5;
    if (hi == 0) li_l[r32] = l_reg; asm volatile("s_waitcnt lgkmcnt(0)" ::: "memory");
    { float* stash = (float*)(F.ws + WS_STASH) + ((size_t)blockIdx.x * 8 + wid) * 4096 + lane;
#pragma unroll
    for (int d0 = 0; d0 < 4; ++d0) { float* sp = stash + d0 * 1024; asm volatile("" : "+v"(sp));
#pragma unroll
        for (int r = 0; r < 16; ++r) sp[r * 64] = o[d0][r] * __builtin_amdgcn_rcpf(li_l[crow(r, hi)]); } }
    __syncthreads();
    attn_core<0, 0, 4>(o, m_reg, l_reg, Qw, Kb, Vb, nloc, loc0, 0, C, 8.f / SCALE, (ALAS char*)F.lds);
    asm volatile("" : "+v"(lane_)); lane = lane_; r32 = lane & 31; hi = lane >> 5;
    if (hi == 0) li_l[r32] = l_reg; asm volatile("s_waitcnt lgkmcnt(0)" ::: "memory");
    float* stash = (float*)(F.ws + WS_STASH) + ((size_t)blockIdx.x * 8 + wid) * 4096 + lane;
    float g4[4];
#pragma unroll
    for (int d0 = 0; d0 < 4; ++d0) g4[d0] = gsub[d0 * 32 + r32] * omli;
    bf16* Ow = O + (base + qrow0 + wid * 32) * LDO + QB_ + h * 128;
#pragma unroll
    for (int r = 0; r < 16; ++r) { const int orow = crow(r, hi); const float rl = __builtin_amdgcn_rcpf(li_l[orow]);
        float v[4]; float ss = 0.f;
#pragma unroll
        for (int d0 = 0; d0 < 4; ++d0) { v[d0] = o[d0][r] * rl - lam * stash[(d0 * 16 + r) * 64]; ss += v[d0] * v[d0]; }
        ss += __shfl_xor(ss, 1); ss += __shfl_xor(ss, 2); ss += __shfl_xor(ss, 4); ss += __shfl_xor(ss, 8); ss += __shfl_xor(ss, 16);
        const float rstd = 1.f / sqrtf(ss * (1.f / 128.f) + EPS);
#pragma unroll
        for (int d0 = 0; d0 < 4; ++d0) Ow[(size_t)orow * LDO + d0 * 32 + r32] = (bf16)f2bf(v[d0] * rstd * g4[d0]); }
}

__device__ __forceinline__ void phase_attention(Frame& F, KArgs a, int l, bool last) {
    const bf16* P = (const bf16*)(F.ws + WS_P); bf16* O = (bf16*)(F.ws + WS_O);
    const float* lamv = (const float*)(F.ws + WS_TAB + 32768); const float lam = lamv[l * 2], omli = lamv[l * 2 + 1];
    const float* sinkv = a->in[19] + l * 8; const float* gsub = a->in[18] + l * 128; const float* nab = a->in[20] + (size_t)l * 8 * 15 * 31;
#ifndef ATT_MASK
#define ATT_MASK 15
#endif
    if (ATT_MASK & 1) for (int u = F.vcu; u < (last ? 256 : 272); u += F.G) {
        int b, h, qrow0, nloc;
        if (u < 256) { b = u >> 7; h = (u >> 4) & 7; qrow0 = (u & 15) * 256; nloc = 64; } else { const int e = u - 256; b = e >> 3; h = e & 7; qrow0 = SEQ; nloc = 0; }
        __syncthreads(); attn_diff_unit(F, P, O, b, qrow0, h, nloc, 0, lam, omli, gsub);
    }
    if (ATT_MASK & 2) for (int u = F.vcu; u < (last ? 256 : 304); u += F.G) {
        int b, qrow0, qcol, kcol, vcol, nloc; float sink = 0.f; bool has_sink = false;
        if (u < 256) { const int h = (u >> 4) & 7, qb = u & 15; b = u >> 7; qrow0 = qb * 256; qcol = QA + h * 128; kcol = KA + (h >> 2) * 128; vcol = VA + (h >> 2) * 128; nloc = 64; }
        else { const int e = u - 256, g = e >> 4, h = e & 7; b = (e >> 3) & 1; qrow0 = SEQ; nloc = 0;
            if (g == 0) { qcol = QA + h * 128; kcol = KA + (h >> 2) * 128; vcol = VA + (h >> 2) * 128; }
            else if (g == 1) { qcol = QC + h * 128; kcol = KC + (h >> 2) * 128; vcol = VC + (h >> 2) * 128; sink = sinkv[h]; has_sink = true; }
            else { qcol = QD + h * 128; kcol = KD + h * 128; vcol = VD + h * 128; } }
        __syncthreads(); attn_std_unit<0>(F, P, O, b, qrow0, qcol, kcol, vcol, qcol, nloc, 0, sink, has_sink);
    }
    if (ATT_MASK & 4) for (int u = F.vcu; u < 256; u += F.G) { const int b = u >> 7, h = (u >> 4) & 7, qb = u & 15;
        const int lo = max(qb * 256 - 128, 0), hiK = min(qb * 256 + 384, SEQ);
        __syncthreads(); attn_std_unit<2>(F, P, O, b, qb * 256, QC + h * 128, KC + (h >> 2) * 128, VC + (h >> 2) * 128, QC + h * 128, (hiK - lo) / 64, lo, sinkv[h], true); }
    if (ATT_MASK & 8) for (int u = F.vcu; u < 256; u += F.G) { const int b = u >> 7, h = (u >> 4) & 7, qb = u & 15;
        const int r0 = qb * 4; int rlo, nrow;
        if (r0 == 0) { rlo = 0; nrow = 8; } else if (r0 == 60) { rlo = 56; nrow = 8; } else { rlo = min(r0 - 4, 52); nrow = 12; }
        __syncthreads();
        { LAS float* bl = (LAS float*)(F.lds + att::BIAS_OFF); for (int e = F.tid; e < 15 * 31; e += NWAVES * 64) bl[e] = nab[h * 465 + e] * 11.313708498984761f; }
        attn_std_unit<3>(F, P, O, b, qb * 256, QD + h * 128, KD + h * 128, VD + h * 128, QD + h * 128, nrow, rlo * 64, 0.f, false); }
    __syncthreads();
}

__global__ void __launch_bounds__(NWAVES * 64, 2) fwd_kernel(Args args) {
    extern __shared__ __attribute__((aligned(16))) unsigned char lds[];
    Frame F;
    F.lds = (LAS unsigned char*)lds;
    volatile LAS unsigned* MISC = (volatile LAS unsigned*)(F.lds + MISC_OFF);
    F.tid = threadIdx.x; F.lane = F.tid & 63; F.wave = __builtin_amdgcn_readfirstlane(F.tid >> 6);
    F.G = gridDim.x; { const int bx = blockIdx.x; F.vcu = (F.G % 8 == 0) ? (bx % 8) * (F.G / 8) + bx / 8 : bx; }
    KArgs ap = (KArgs)__builtin_amdgcn_kernarg_segment_ptr();
    F.ws = ap->ws;
    gu32* ctl = (gu32*)(F.ws + WS_CTL);
    for (int u = F.tid; u < (LDS_BYTES - LDSCTL_OFF) / 4; u += NWAVES * 64) ((LAS unsigned*)(F.lds + LDSCTL_OFF))[u] = 0u;
    __syncthreads();
    const int lo = ap->ph_lo, hi = ap->ph_hi;
    XcdBarrier bar; bar.bar = (unsigned*)(ctl + CW_BAR); bar.x = 0; bar.st = nullptr;
    if (hi - lo > 1) bar = xcd_barrier_post((unsigned*)(ctl + CW_BAR), MISC + 8);
#ifndef PH_MASK
#define PH_MASK 0x7ff
#endif
#ifndef REP_PRO
#define REP_PRO 1
#endif
#ifndef REP_ATT
#define REP_ATT 1
#endif
#ifndef REP_GEMM
#define REP_GEMM 1
#endif
#ifndef REP_CONV
#define REP_CONV 1
#endif
#define IN(k) (lo <= (k) && (k) < hi)
#define FRESH() asm volatile("" : "+v"(F.tid), "+v"(F.lane), "+s"(ap))
#define EN(j) (((PH_MASK) >> (j)) & 1)
#define SEAM(k) do { if (IN(k) && IN((k) + 1)) xcd_barrier(bar); } while (0)

    if (EN(0) && IN(0)) { for (int rep = 0; rep < REP_PRO; ++rep) { FRESH(); phase_prologue(F, ap); __syncthreads(); } } SEAM(0);
    if (EN(1) && IN(1)) { FRESH(); phase_r0(F, ap); } SEAM(1);
    for (int l = 0; l < 2; ++l) {
        const bool last = (l == 1); const int pb = 2 + 8 * l;
        const pg8::bf16_t* HX = (const pg8::bf16_t*)(F.ws + WS_HX);
        if (EN(2) && IN(pb + 0)) {
            pg8::Gemm g{HX, (const pg8::bf16_t*)(F.ws + WS_WIN + (size_t)l * 72 * MiB), MROWS, NIN, DM};
            pg8::StaticOrder S; S.init(MROWS / 256, NIN, DM, F.G, fresh_bx(), 0);
            pg8::EpiInProj E{(pg8::bf16_t*)(F.ws + WS_P), NIN, (const float*)(F.ws + WS_TAB), (const float*)(F.ws + WS_TAB + 16384), ap->in[12] + l * 128, ap->in[13] + l * 128, (LAS float*)(F.lds + XCH_OFF)};
            pg8::gemm_phase<pg8::EpiInProj, pg8::StaticOrder, true>(F.lds + RING_OFF, g, S, E);
            if (F.G == 256) tail_convert(F, ap, (34 * 36) % 256, 1, l, -1, 0);
        } SEAM(pb + 0);
        if (EN(4) && IN(pb + 1)) { for (int rep = 0; rep < REP_ATT; ++rep) { FRESH(); phase_attention(F, ap, l, last); } } SEAM(pb + 1);
        if (EN(5) && IN(pb + 2)) {
            pg8::Gemm g{(const pg8::bf16_t*)(F.ws + WS_O), (const pg8::bf16_t*)(F.ws + WS_WOUT + (size_t)l * 32 * MiB), MROWS, DM, DM};
            pg8::SplitOrder S; S.init(DM, DM, F.G, fresh_bx()); if (last) S.ca = 0;
            pg8::EpiSplit E{(pg8::bf16_t*)(F.ws + WS_Y), (float*)(F.ws + WS_PART), DM};
            pg8::gemm_phase<pg8::EpiSplit, pg8::SplitOrder, true>(F.lds + RING_OFF, g, S, E);
        } SEAM(pb + 2);
        if (EN(6) && IN(pb + 3)) { FRESH(); phase_r1(F, ap, l, last); } SEAM(pb + 3);
        if (EN(7) && IN(pb + 4)) {
            pg8::Gemm g{HX, (const pg8::bf16_t*)(F.ws + WS_WUP + (size_t)l * 172 * MiB), MROWS, NUP, DM};
            pg8::StaticOrder S; S.init(last ? 32 : 34, NUP, DM, F.G, fresh_bx(), last ? 1 : 0);
            pg8::EpiUpConv E{(pg8::bf16_t*)(F.ws + WS_ACT), (float*)(F.ws + WS_U), ap->in[22] + (size_t)l * 3 * NUP, (LAS float*)(F.lds + XCH_OFF), DFF};
            pg8::gemm_phase<pg8::EpiUpConv, pg8::StaticOrder, true>(F.lds + RING_OFF, g, S, E);
            if (F.G == 256) { if (!last) tail_convert(F, ap, (34 * 86) % 256, 3, 0, 0, 1); else tail_convert(F, ap, (32 * 86) % 256, 3, 1, -1, 0); }
        } SEAM(pb + 4);
        if (EN(8) && IN(pb + 5)) { for (int rep = 0; rep < REP_CONV; ++rep) { FRESH(); phase_fixup(F, ap, l, last); } } SEAM(pb + 5);
        if (EN(9) && IN(pb + 6)) {
            pg8::Gemm g{(const pg8::bf16_t*)(F.ws + WS_ACT), (const pg8::bf16_t*)(F.ws + WS_WDN + (size_t)l * 86 * MiB), MROWS, DM, DFF};
            pg8::SplitOrder S; S.init(DM, DFF, F.G, fresh_bx()); if (last) S.ca = 0;
            pg8::EpiSplit E{(pg8::bf16_t*)(F.ws + WS_Y), (float*)(F.ws + WS_PART), DM};
            pg8::gemm_phase<pg8::EpiSplit, pg8::SplitOrder, true>(F.lds + RING_OFF, g, S, E);
        } SEAM(pb + 6);
        if (EN(10) && IN(pb + 7)) { FRESH(); phase_r2(F, ap, l, last); } SEAM(pb + 7);
    }
#undef IN
#undef SEAM
}

extern "C" void kernel_launch(void* const* d_in, const int* in_sizes, int n_in, void* d_out, int out_size, void* d_ws, size_t ws_size, hipStream_t stream) {
    static int grid = 0;
    if (grid == 0) {
        if (n_in != 24 || in_sizes[0] != NB * SEQ * DM || out_size != NB * SEQ * DM || ws_size < WS_END) {
            fprintf(stderr, "kernel_launch: unexpected shapes: n_in %d in0 %d out %d ws %zu (need %zu); nothing launched\n", n_in, n_in > 0 ? in_sizes[0] : -1, out_size, ws_size, (size_t)WS_END); grid = -1; return; }
        int dev = 0, cus = 0, per_cu = 0;
        if (hipGetDevice(&dev) != hipSuccess || hipDeviceGetAttribute(&cus, hipDeviceAttributeMultiprocessorCount, dev) != hipSuccess) { grid = -1; return; }
        if (hipFuncSetAttribute((const void*)fwd_kernel, hipFuncAttributeMaxDynamicSharedMemorySize, LDS_BYTES) != hipSuccess) { fprintf(stderr, "kernel_launch: hipFuncSetAttribute failed\n"); grid = -1; return; }
        if (hipOccupancyMaxActiveBlocksPerMultiprocessor(&per_cu, (const void*)fwd_kernel, NWAVES * 64, LDS_BYTES) != hipSuccess || per_cu < 1)
            fprintf(stderr, "kernel_launch: note: occupancy query reports %d workgroups per CU\n", per_cu);
        (void)hipGetLastError();
        grid = cus;
    }
    if (grid < 0) return;
    if (hipMemsetAsync((char*)d_ws + WS_CTL, 0, CTL_ZERO_BYTES, stream) != hipSuccess) return;
    Args a{};
    for (int i = 0; i < 24; ++i) a.in[i] = (const float*)d_in[i];
    a.out = (float*)d_out; a.ws = (unsigned char*)d_ws;
#if MK_SINGLE
    a.ph_lo = 0; a.ph_hi = NPHASE;
    hipLaunchKernelGGL(fwd_kernel, dim3(grid), dim3(NWAVES * 64), LDS_BYTES, stream, a);
#else
    for (int p = 0; p < NPHASE; ++p) { a.ph_lo = p; a.ph_hi = p + 1; hipLaunchKernelGGL(fwd_kernel, dim3(grid), dim3(NWAVES * 64), LDS_BYTES, stream, a); }
#endif
    const hipError_t le = hipPeekAtLastError();
    if (le != hipSuccess) fprintf(stderr, "kernel_launch: launch failed: %s\n", hipGetErrorName(le));
}
```

```cpp
#include <hip/hip_runtime.h>
#include <cstdio>
#include <cstdint>

#ifndef MK_SINGLE
#define MK_SINGLE 1
#endif

namespace pg8 {
#define PG8_LAS __attribute__((address_space(3)))
typedef unsigned short bf16_t;
typedef short bf16x8 __attribute__((ext_vector_type(8)));
typedef float f32x4 __attribute__((ext_vector_type(4)));
typedef unsigned u32x4 __attribute__((ext_vector_type(4)));
constexpr int BM = 256, BK = 64, HALF = 128, HTB = HALF * BK * 2, STAGE_BYTES = 8 * HTB, NXCD = 8, WGM = 8;

__host__ __device__ __forceinline__ int lds_byte(int r, int c) { const int st = (r >> 4) * 2 + (c >> 5), rr = r & 15, cc = c & 31, ob = rr * 64 + cc * 2; return st * 1024 + (ob ^ (((ob >> 9) & 1) << 5)); }
__host__ __device__ __forceinline__ void stage_rc(int b, int& R, int& C) { const int st = b / 1024, sb = b % 1024, swz = sb ^ (((sb >> 9) & 1) << 5); R = (st >> 1) * 16 + swz / 64; C = (st & 1) * 32 + (swz % 64) / 2; }
__host__ __device__ __forceinline__ int perm32(int rho) { const int n = rho >> 4, i = rho & 15; return 8 * (i >> 2) + 4 * n + (i & 3); }

struct Unit { int pm, pn, kt0, nt, slab; };
struct Gemm { const bf16_t* A; const bf16_t* Bt; int M, N, K; };

struct StaticOrder {
    int nM, nN, nwg, G, c, skip, ntk;
    __host__ __device__ void init(int nM_, int N, int K, int G_, int c_, int skip_) { nM = nM_; nN = N / BM; nwg = nM * nN; G = G_; c = c_; skip = skip_; ntk = K / BK; }
    __host__ __device__ bool at(long L, Unit& u) const {
        if (L >= nwg) return false;
        int wgid = (int)L; { const int q = nwg / NXCD, r = nwg % NXCD, xcd = wgid % NXCD, off = wgid / NXCD; wgid = (xcd < r ? xcd * (q + 1) : r * (q + 1) + (xcd - r) * q) + off; }
        const int nig = WGM * nN, gid = wgid / nig, fm = gid * WGM, gsz = (nM - fm) < WGM ? (nM - fm) : WGM;
        u.pm = fm + ((wgid % nig) % gsz); u.pn = (wgid % nig) / gsz; u.kt0 = 0; u.nt = ntk; u.slab = -1;
        if (skip && u.pm >= 16) u.pm += 1;
        return true;
    }
    __host__ __device__ bool next(int i, Unit& u) const { return at((long)i * G + c, u); }
    __device__ __forceinline__ void a_ready(const Unit&) const {}
    __device__ __forceinline__ void done(const Unit&) const {}
};
struct SplitOrder {
    StaticOrder so; int ca, cb;
    __host__ __device__ void init(int N, int K, int G_, int c_) { so.init(32, N, K, G_, c_, 1); const int ntk = K / BK; ca = ((ntk / 8 + 1) / 2) * 2; cb = (ntk - 6 * ca) / 2; if (6 * ca + 2 * cb != ntk || (cb & 1) || cb <= 0) { ca = ntk / 8; cb = ca; } }
    __host__ __device__ bool next(int i, Unit& u) const {
        const long L = (long)i * so.G + so.c;
        if (L < so.nwg) return so.at(L, u);
        const int q = (int)(L - so.nwg); if (ca == 0 || q >= 256) return false;
        const int ch = q & 7, pn = (q >> 3) & 15, pp = q >> 7;
        u.pm = pp ? 33 : 16; u.pn = pn; u.slab = ch; u.kt0 = ch < 6 ? ca * ch : 6 * ca + cb * (ch - 6); u.nt = ch < 6 ? ca : cb;
        return true;
    }
    __device__ __forceinline__ void a_ready(const Unit&) const {}
    __device__ __forceinline__ void done(const Unit&) const {}
};

__device__ __forceinline__ unsigned cvt_pk_bf16(float lo, float hi) { unsigned r; asm volatile("v_cvt_pk_bf16_f32 %0, %1, %2" : "=v"(r) : "v"(lo), "v"(hi)); return r; }

struct EpiBf16 {
    static constexpr bool PERM = true, AFTER_DRAIN = false, PREFETCH = false;
    bf16_t* O; int ldc;
    __device__ __forceinline__ void operator()(const f32x4 (&acc)[2][2][4][2], const Unit& u, int wr, int wc, int fr, int fq) const {
        const int row0 = u.pm * BM + wr * 64 + fr; const int col0 = u.pn * BM + wc * 32 + 8 * fq;
#pragma unroll
        for (int ai = 0; ai < 2; ++ai)
#pragma unroll
            for (int m = 0; m < 4; ++m) { bf16_t* rowp = O + (size_t)(row0 + ai * HALF + m * 16) * ldc + col0;
#pragma unroll
                for (int bj = 0; bj < 2; ++bj) { const f32x4 v0 = acc[ai][bj][m][0], v1 = acc[ai][bj][m][1];
                    u32x4 w; w.x = cvt_pk_bf16(v0[0], v0[1]); w.y = cvt_pk_bf16(v0[2], v0[3]); w.z = cvt_pk_bf16(v1[0], v1[1]); w.w = cvt_pk_bf16(v1[2], v1[3]);
                    *(u32x4*)(rowp + bj * HALF) = w; } }
    }
};

struct EpiSplit {
    static constexpr bool PERM = true, AFTER_DRAIN = false, PREFETCH = false;
    bf16_t* O; float* part; int ldc;
    __device__ __forceinline__ void operator()(const f32x4 (&acc)[2][2][4][2], const Unit& u, int wr, int wc, int fr, int fq) const {
        const int col0 = u.pn * BM + wc * 32 + 8 * fq;
        if (u.slab < 0) {
            const int row0 = u.pm * BM + wr * 64 + fr;
#pragma unroll
            for (int ai = 0; ai < 2; ++ai)
#pragma unroll
                for (int m = 0; m < 4; ++m) { bf16_t* rowp = O + (size_t)(row0 + ai * HALF + m * 16) * ldc + col0;
#pragma unroll
                    for (int bj = 0; bj < 2; ++bj) { const f32x4 v0 = acc[ai][bj][m][0], v1 = acc[ai][bj][m][1];
                        u32x4 w; w.x = cvt_pk_bf16(v0[0], v0[1]); w.y = cvt_pk_bf16(v0[2], v0[3]); w.z = cvt_pk_bf16(v1[0], v1[1]); w.w = cvt_pk_bf16(v1[2], v1[3]);
                        *(u32x4*)(rowp + bj * HALF) = w; } }
        } else {
            const int row0 = (u.pm == 16 ? 0 : 256) + wr * 64 + fr; float* pb = part + (size_t)u.slab * 512 * ldc;
#pragma unroll
            for (int ai = 0; ai < 2; ++ai)
#pragma unroll
                for (int m = 0; m < 4; ++m) { float* rowp = pb + (size_t)(row0 + ai * HALF + m * 16) * ldc + col0;
#pragma unroll
                    for (int bj = 0; bj < 2; ++bj) { *(f32x4*)(rowp + bj * HALF) = acc[ai][bj][m][0]; *(f32x4*)(rowp + bj * HALF + 4) = acc[ai][bj][m][1]; } }
        }
    }
};

struct EpiInProj {
    static constexpr bool PERM = true, AFTER_DRAIN = false, PREFETCH = false;
    bf16_t* O; int ldc; const PG8_LAS float* thd; const PG8_LAS float* gains; PG8_LAS float* xch;
    __device__ __forceinline__ void operator()(f32x4 (&acc)[2][2][4][2], const Unit& u, int wr, int wc, int fr, int fq) const {
        const int pmb = u.pm % 17; const bool ctx = (pmb == 16); const int pn = u.pn;
        const int kind = pn < 4 ? 1 : pn < 8 ? 2 : pn < 12 ? 3 : pn < 16 ? 0 : pn == 16 ? 4 : pn < 18 ? 0 : pn < 22 ? 2 : pn == 26 ? 3 : 0;
        if (kind == 1 || kind == 4) {
            const PG8_LAS float* g = gains + (kind == 1 ? 0 : 128) + wc * 32 + 8 * fq;
            const f32x4 g0 = *(const PG8_LAS f32x4*)g, g1 = *(const PG8_LAS f32x4*)(g + 4);
#pragma unroll
            for (int ai = 0; ai < 2; ++ai)
#pragma unroll
                for (int m = 0; m < 4; ++m)
#pragma unroll
                    for (int bj = 0; bj < 2; ++bj) { const f32x4 a = acc[ai][bj][m][0], b = acc[ai][bj][m][1];
                        float s = (a[0] * a[0] + a[1] * a[1]) + (a[2] * a[2] + a[3] * a[3]) + (b[0] * b[0] + b[1] * b[1]) + (b[2] * b[2] + b[3] * b[3]);
                        s += __shfl_xor(s, 16); s += __shfl_xor(s, 32);
                        if (fq == 0) xch[((ai * HALF + wr * 64 + m * 16 + fr) * 2 + bj) * 4 + wc] = s; }
            asm volatile("s_waitcnt lgkmcnt(0)" ::: "memory"); __builtin_amdgcn_s_barrier(); asm volatile("" ::: "memory");
#pragma unroll
            for (int ai = 0; ai < 2; ++ai)
#pragma unroll
                for (int m = 0; m < 4; ++m)
#pragma unroll
                    for (int bj = 0; bj < 2; ++bj) { const f32x4 p = *(const PG8_LAS f32x4*)(xch + ((ai * HALF + wr * 64 + m * 16 + fr) * 2 + bj) * 4);
                        const float rstd = __builtin_amdgcn_rsqf(((p[0] + p[1]) + (p[2] + p[3])) * (1.f / 128.f) + 1e-6f);
                        acc[ai][bj][m][0] = acc[ai][bj][m][0] * rstd * g0; acc[ai][bj][m][1] = acc[ai][bj][m][1] * rstd * g1; }
        }
        if (kind != 0 && !ctx) {
            const bool dh = (kind == 2);
#pragma unroll
            for (int ai = 0; ai < 2; ++ai)
#pragma unroll
                for (int m = 0; m < 4; ++m) { const int t = pmb * 256 + ai * HALF + wr * 64 + m * 16 + fr; const int grow = t >> 6, gcol = t & 63;
                    f32x4 c01, c23;
                    if (!dh) { const PG8_LAS float* tp = thd + (((wc < 2) ? grow : gcol) * 32 + 16 * (wc & 1) + 4 * fq) * 2; c01 = *(const PG8_LAS f32x4*)tp; c23 = *(const PG8_LAS f32x4*)(tp + 4); }
                    else { typedef float f32x2_ __attribute__((ext_vector_type(2))); const PG8_LAS float* tp = thd + ((((wc & 1) == 0) ? grow : gcol) * 32 + 8 * fq) * 2;
                        const f32x2_ e0 = *(const PG8_LAS f32x2_*)tp, e1 = *(const PG8_LAS f32x2_*)(tp + 4), e2 = *(const PG8_LAS f32x2_*)(tp + 8), e3 = *(const PG8_LAS f32x2_*)(tp + 12);
                        c01 = (f32x4){e0.x, e0.y, e1.x, e1.y}; c23 = (f32x4){e2.x, e2.y, e3.x, e3.y}; }
#pragma unroll
                    for (int bj = 0; bj < 2; ++bj) { f32x4 a = acc[ai][bj][m][0], b = acc[ai][bj][m][1];
                        acc[ai][bj][m][0] = (f32x4){a[0] * c01[0] - a[1] * c01[1], a[0] * c01[1] + a[1] * c01[0], a[2] * c01[2] - a[3] * c01[3], a[2] * c01[3] + a[3] * c01[2]};
                        acc[ai][bj][m][1] = (f32x4){b[0] * c23[0] - b[1] * c23[1], b[0] * c23[1] + b[1] * c23[0], b[2] * c23[2] - b[3] * c23[3], b[2] * c23[3] + b[3] * c23[2]}; } }
        }
        const int row0 = u.pm * BM + wr * 64 + fr; const int col0 = u.pn * BM + wc * 32 + 8 * fq;
#pragma unroll
        for (int ai = 0; ai < 2; ++ai)
#pragma unroll
            for (int m = 0; m < 4; ++m) { bf16_t* rowp = O + (size_t)(row0 + ai * HALF + m * 16) * ldc + col0;
#pragma unroll
                for (int bj = 0; bj < 2; ++bj) { const f32x4 v0 = acc[ai][bj][m][0], v1 = acc[ai][bj][m][1];
                    u32x4 w; w.x = cvt_pk_bf16(v0[0], v0[1]); w.y = cvt_pk_bf16(v0[2], v0[3]); w.z = cvt_pk_bf16(v1[0], v1[1]); w.w = cvt_pk_bf16(v1[2], v1[3]);
                    *(u32x4*)(rowp + bj * HALF) = w; } }
    }
};

struct EpiUpConv {
    static constexpr bool PERM = true, AFTER_DRAIN = false, PREFETCH = true;
    bf16_t* ACT; float* side; const float* cw; PG8_LAS float* xb; int dff; PG8_LAS float* wl0; PG8_LAS float* wl1; mutable int par;
    __device__ __forceinline__ void prefetch(const Unit& u, int parity, int wid, int lane) const {
        if (wid == 0) { PG8_LAS float* wl = parity ? wl1 : wl0;
#pragma unroll
            for (int i = 0; i < 3; ++i) { const int q = 64 * i + lane, bt = q >> 5, c4 = q & 31, bj = bt / 3, tap = bt - 3 * bj;
                __builtin_amdgcn_global_load_lds((const unsigned*)(cw + (size_t)tap * 2 * dff + bj * dff + u.pn * 128 + 4 * c4), (PG8_LAS unsigned*)(wl + 256 * i), 16, 0, 0); } }
    }
    static __device__ __forceinline__ float dppf(float old, float src, const int ctrl_sel) {
        const int o = __float_as_int(old), s = __float_as_int(src); int r;
        if (ctrl_sel == 0) r = __builtin_amdgcn_update_dpp(o, s, 0x111, 0xF, 0xF, false);
        else if (ctrl_sel == 1) r = __builtin_amdgcn_update_dpp(o, s, 0x101, 0xF, 0xF, false);
        else if (ctrl_sel == 2) r = __builtin_amdgcn_update_dpp(o, s, 0x121, 0xF, 0xF, false);
        else r = __builtin_amdgcn_update_dpp(o, s, 0x12F, 0xF, 0xF, false);
        return __int_as_float(r);
    }
    static __device__ __forceinline__ f32x4 dpp4(const f32x4 old, const f32x4 src, const int c) { return (f32x4){dppf(old[0], src[0], c), dppf(old[1], src[1], c), dppf(old[2], src[2], c), dppf(old[3], src[3], c)}; }
    static __device__ __forceinline__ int xidx(int ai, int wr, int wc, int which, int bj, int fq, int n) { return ((((((ai * 2 + wr) * 4 + wc) * 2 + which) * 2 + bj) * 4 + fq) * 2 + n) * 4; }
    __device__ __forceinline__ void operator()(const f32x4 (&acc)[2][2][4][2], const Unit& u, int wr, int wc, int fr, int fq) const {
        const int cbase = wc * 32 + 8 * fq;
        f32x4 wts[2][2][3];
#pragma unroll
        for (int bj = 0; bj < 2; ++bj)
#pragma unroll
            for (int n = 0; n < 2; ++n)
#pragma unroll
                for (int j = 0; j < 3; ++j) wts[bj][n][j] = *(const PG8_LAS f32x4*)((par ? wl1 : wl0) + (bj * 3 + j) * 128 + cbase + 4 * n);
#pragma unroll
        for (int ai = 0; ai < 2; ++ai)
#pragma unroll
            for (int bj = 0; bj < 2; ++bj)
#pragma unroll
                for (int n = 0; n < 2; ++n) {
                    if (fr == 0) *(PG8_LAS f32x4*)(xb + xidx(ai, wr, wc, 0, bj, fq, n)) = acc[ai][bj][0][n];
                    if (fr == 15) *(PG8_LAS f32x4*)(xb + xidx(ai, wr, wc, 1, bj, fq, n)) = acc[ai][bj][3][n]; }
        { float* sp = side + (size_t)u.pm * 4 * (2 * dff) + (size_t)u.pn * 256 + cbase;
          if (wr == 0 && fr < 2) {
#pragma unroll
              for (int bj = 0; bj < 2; ++bj)
#pragma unroll
                  for (int n = 0; n < 2; ++n) *(f32x4*)(sp + (size_t)fr * (2 * dff) + bj * 128 + 4 * n) = acc[0][bj][0][n]; }
          if (wr == 1 && fr >= 14) {
#pragma unroll
              for (int bj = 0; bj < 2; ++bj)
#pragma unroll
                  for (int n = 0; n < 2; ++n) *(f32x4*)(sp + (size_t)(fr - 12) * (2 * dff) + bj * 128 + 4 * n) = acc[1][bj][3][n]; } }
        asm volatile("s_waitcnt lgkmcnt(0)" ::: "memory"); __builtin_amdgcn_s_barrier(); asm volatile("" ::: "memory");
        const f32x4 zero4 = {0.f, 0.f, 0.f, 0.f};
#pragma unroll
        for (int ai = 0; ai < 2; ++ai)
#pragma unroll
            for (int m = 0; m < 4; ++m) {
                const int beta = 2 * ai + wr;
                u32x4 w;
#pragma unroll
                for (int n = 0; n < 2; ++n) {
                    f32x4 res[2];
#pragma unroll
                    for (int bj = 0; bj < 2; ++bj) {
                        const f32x4 cur = acc[ai][bj][m][n];
                        f32x4 oldp, oldn;
                        if (m > 0) oldp = dpp4(zero4, acc[ai][bj][m - 1][n], 2);
                        else if (beta > 0) oldp = *(const PG8_LAS f32x4*)(xb + xidx((beta - 1) >> 1, (beta - 1) & 1, wc, 1, bj, fq, n));
                        else oldp = zero4;
                        if (m < 3) oldn = dpp4(zero4, acc[ai][bj][m + 1][n], 3);
                        else if (beta < 3) oldn = *(const PG8_LAS f32x4*)(xb + xidx((beta + 1) >> 1, (beta + 1) & 1, wc, 0, bj, fq, n));
                        else oldn = zero4;
                        const f32x4 prev = dpp4(oldp, cur, 0), next = dpp4(oldn, cur, 1);
                        res[bj] = prev * wts[bj][n][0] + cur * wts[bj][n][1] + next * wts[bj][n][2];
                    }
                    f32x4 o;
#pragma unroll
                    for (int e = 0; e < 4; ++e) o[e] = res[0][e] * __builtin_amdgcn_rcpf(1.f + __expf(-res[0][e])) * res[1][e];
                    if (n == 0) { w.x = cvt_pk_bf16(o[0], o[1]); w.y = cvt_pk_bf16(o[2], o[3]); } else { w.z = cvt_pk_bf16(o[0], o[1]); w.w = cvt_pk_bf16(o[2], o[3]); }
                }
                *(u32x4*)(ACT + (size_t)(u.pm * BM + ai * HALF + wr * 64 + m * 16 + fr) * dff + u.pn * 128 + cbase) = w;
            }
    }
};

template <class Epi, class Sched, bool ALIGN_EPI = false>
__device__ __forceinline__ void gemm_phase(PG8_LAS unsigned char* lds, const Gemm g, const Sched& S, const Epi& E) {
    int tid_ = threadIdx.x; asm volatile("" : "+v"(tid_));
    const int tid = tid_, wid = __builtin_amdgcn_readfirstlane(tid >> 6), lane = tid & 63, wr = wid >> 2, wc = wid & 3, fr = lane & 15, fq = lane >> 4;
    const int K = g.K;
    unsigned voffA[2], voffB[2];
#pragma unroll
    for (int i = 0; i < 2; ++i) { int R, C; stage_rc(tid * 16 + i * 8192, R, C); const int Rb = Epi::PERM ? ((R & ~31) + perm32(R & 31)) : R;
        voffA[i] = (unsigned)(R * K + C) * 2u; voffB[i] = (unsigned)(Rb * K + C) * 2u; }
    const size_t kstep = (size_t)(BK * 2);
    const size_t hstep = (size_t)HALF * K * 2;
    const size_t tstep = 2 * hstep;
    const unsigned ldsw = (unsigned)wid * 1024u;
    const int aoff = lds_byte(wr * 64 + fr, fq * 8), boff = lds_byte(wc * 32 + fr, fq * 8);
#define PG8_SA(b, h) (((b) * 2 + (h)) * HTB)
#define PG8_SB(b, h) ((4 + (b) * 2 + (h)) * HTB)
#define PG8_STAGE(bufoff, gbase, voff) do { _Pragma("unroll") for (int _i = 0; _i < 2; ++_i) \
        __builtin_amdgcn_global_load_lds((const unsigned*)((const char*)(gbase) + (voff)[_i]), (PG8_LAS unsigned*)(lds + (bufoff) + ldsw + _i * 8192), 16, 0, 0); } while (0)
#define PG8_LDA(dst, b, h) do { _Pragma("unroll") for (int m = 0; m < 4; ++m) _Pragma("unroll") for (int k = 0; k < 2; ++k) dst[m][k] = *(const PG8_LAS bf16x8*)(lds + PG8_SA(b, h) + aoff + m * 2048 + k * 1024); } while (0)
#define PG8_LDB(dst, b, h) do { _Pragma("unroll") for (int n = 0; n < 2; ++n) _Pragma("unroll") for (int k = 0; k < 2; ++k) dst[n][k] = *(const PG8_LAS bf16x8*)(lds + PG8_SB(b, h) + boff + n * 2048 + k * 1024); } while (0)
#define PG8_MMA(ai, bj, At, Bt) do { __builtin_amdgcn_s_setprio(1); _Pragma("unroll") for (int m = 0; m < 4; ++m) _Pragma("unroll") for (int n = 0; n < 2; ++n) _Pragma("unroll") for (int k = 0; k < 2; ++k) \
        acc[ai][bj][m][n] = __builtin_amdgcn_mfma_f32_16x16x32_bf16(Bt[n][k], At[m][k], acc[ai][bj][m][n], 0, 0, 0); __builtin_amdgcn_s_setprio(0); } while (0)
#define PG8_WAIT_V(n) asm volatile("s_waitcnt vmcnt(" #n ")" ::: "memory")
#define PG8_WAIT_L(n) asm volatile("s_waitcnt lgkmcnt(" #n ")" ::: "memory")
#define PG8_BAR __builtin_amdgcn_s_barrier()
#define PG8_SCHED __builtin_amdgcn_sched_barrier(0)
    Unit cur, nxt; int ui = 0;
    if (!S.next(0, cur)) return;
    f32x4 acc[2][2][4][2];
#pragma unroll
    for (int a = 0; a < 2; ++a)
#pragma unroll
        for (int b = 0; b < 2; ++b)
#pragma unroll
            for (int m = 0; m < 4; ++m)
#pragma unroll
                for (int n = 0; n < 2; ++n) acc[a][b][m][n] = (f32x4){0.f, 0.f, 0.f, 0.f};
    bf16x8 At[4][2], B0[2][2], B1[2][2];
    const char* cA = (const char*)g.A + (size_t)cur.pm * tstep + (size_t)cur.kt0 * kstep; const char* cB = (const char*)g.Bt + (size_t)cur.pn * tstep + (size_t)cur.kt0 * kstep;
    S.a_ready(cur);
    if constexpr (Epi::PREFETCH) E.prefetch(cur, 0, wid, lane);
    PG8_STAGE(PG8_SB(0, 0), cB, voffB); PG8_STAGE(PG8_SB(0, 1), cB + hstep, voffB); PG8_STAGE(PG8_SA(0, 0), cA, voffA); PG8_STAGE(PG8_SA(0, 1), cA + hstep, voffA);
    if (wr == 1) PG8_BAR;
    PG8_WAIT_V(2); PG8_BAR;
    PG8_STAGE(PG8_SB(1, 0), cB + kstep, voffB); PG8_STAGE(PG8_SA(1, 0), cA + kstep, voffA); PG8_STAGE(PG8_SB(1, 1), cB + hstep + kstep, voffB);
    PG8_WAIT_V(6); PG8_BAR;
    for (;;) {
        const bool has_next = S.next(ui + 1, nxt);
        const char* nA = has_next ? (const char*)g.A + (size_t)nxt.pm * tstep + (size_t)nxt.kt0 * kstep : cA; const char* nB = has_next ? (const char*)g.Bt + (size_t)nxt.pn * tstep + (size_t)nxt.kt0 * kstep : cB;
        const int nt = cur.nt;
        for (int t = 0; t < nt; t += 2) {
            const bool last = (t == nt - 2);
            const char* a1 = cA + (size_t)(t + 1) * kstep;
            const char* a2 = last ? nA : cA + (size_t)(t + 2) * kstep; const char* b2 = last ? nB : cB + (size_t)(t + 2) * kstep;
            const char* a3 = a2 + kstep; const char* b3 = b2 + kstep;
            if (last && has_next) S.a_ready(nxt);
            PG8_LDB(B0, 0, 0); PG8_LDB(B1, 0, 1); PG8_SCHED; PG8_LDA(At, 0, 0); PG8_STAGE(PG8_SA(1, 1), a1 + hstep, voffA);
            PG8_WAIT_V(8); PG8_WAIT_L(0); PG8_BAR; PG8_MMA(0, 0, At, B0); PG8_MMA(0, 1, At, B1); PG8_BAR; PG8_SCHED;
            PG8_LDA(At, 0, 1); PG8_STAGE(PG8_SB(0, 0), b2, voffB); PG8_STAGE(PG8_SB(0, 1), b2 + hstep, voffB); PG8_STAGE(PG8_SA(0, 0), a2, voffA);
            PG8_WAIT_V(8); PG8_WAIT_L(0); PG8_BAR; PG8_MMA(1, 0, At, B0); PG8_MMA(1, 1, At, B1); PG8_BAR; PG8_SCHED;
            PG8_LDB(B0, 1, 0); PG8_LDB(B1, 1, 1); PG8_SCHED; PG8_LDA(At, 1, 0); PG8_STAGE(PG8_SA(0, 1), a2 + hstep, voffA);
            PG8_WAIT_V(8); PG8_WAIT_L(0); PG8_BAR; PG8_MMA(0, 0, At, B0); PG8_MMA(0, 1, At, B1); PG8_BAR; PG8_SCHED;
            PG8_LDA(At, 1, 1); PG8_STAGE(PG8_SB(1, 0), b3, voffB); PG8_STAGE(PG8_SB(1, 1), b3 + hstep, voffB); PG8_STAGE(PG8_SA(1, 0), a3, voffA);
            PG8_WAIT_V(8); PG8_WAIT_L(0); PG8_BAR; PG8_MMA(1, 0, At, B0); PG8_MMA(1, 1, At, B1); PG8_BAR; PG8_SCHED;
        }
        if constexpr (ALIGN_EPI) { if (wr == 0) PG8_BAR; }
        if constexpr (Epi::PREFETCH) { if (has_next) E.prefetch(nxt, (ui + 1) & 1, wid, lane); }
        if constexpr (!Epi::AFTER_DRAIN) { if constexpr (Epi::PREFETCH) E.par = ui & 1; E(acc, cur, wr, wc, fr, fq); S.done(cur); }
        if (!has_next) break;
#pragma unroll
        for (int a = 0; a < 2; ++a)
#pragma unroll
            for (int b = 0; b < 2; ++b)
#pragma unroll
                for (int m = 0; m < 4; ++m)
#pragma unroll
                    for (int n = 0; n < 2; ++n) acc[a][b][m][n] = (f32x4){0.f, 0.f, 0.f, 0.f};
        cur = nxt; cA = nA; cB = nB; ++ui;
        if constexpr (ALIGN_EPI) { if (wr == 1) PG8_BAR; }
    }
    PG8_WAIT_V(0);
    if constexpr (!ALIGN_EPI) { if (wr == 0) PG8_BAR; }
    PG8_BAR;
#undef PG8_SA
#undef PG8_SB
#undef PG8_STAGE
#undef PG8_LDA
#undef PG8_LDB
#undef PG8_MMA
#undef PG8_WAIT_V
#undef PG8_WAIT_L
#undef PG8_BAR
#undef PG8_SCHED
}
}

namespace att {
#define ALAS __attribute__((address_space(3)))
typedef unsigned short bf16;
typedef short bf16x8 __attribute__((ext_vector_type(8)));
typedef short s16x4 __attribute__((ext_vector_type(4)));
typedef float f32x16 __attribute__((ext_vector_type(16)));
typedef unsigned u32x4 __attribute__((ext_vector_type(4)));
constexpr int LDP = 9216, LDO = 4096;
constexpr int SLOT = 32768;
constexpr int WSCR_OFF = 131072 + 1024, BIAS_OFF = WSCR_OFF + 2048, SHM_END = BIAS_OFF + 2048;
constexpr int NCTX_T = 4;
#define KSWZ(row, colB) ((row) * 256 + ((colB) ^ (((row) & 7) << 4)))
#define SBAR() __builtin_amdgcn_sched_barrier(0)
__device__ __forceinline__ int crow(int r, int hi) { return (r & 3) + 8 * (r >> 2) + 4 * hi; }
__device__ __forceinline__ unsigned cvtpk(float lo, float hi) { unsigned r; asm volatile("v_cvt_pk_bf16_f32 %0, %1, %2" : "=v"(r) : "v"(lo), "v"(hi)); return r; }

__device__ __forceinline__ void partialSM(f32x16& p0, f32x16& p1, float& m_reg, float& mn, float& alpha, const float C, const float thr_raw) {
    float pmax = p0[0];
#pragma unroll
    for (int r = 1; r < 16; ++r) pmax = fmaxf(pmax, p0[r]);
#pragma unroll
    for (int r = 0; r < 16; ++r) pmax = fmaxf(pmax, p1[r]);
    { auto rr = __builtin_amdgcn_permlane32_swap(__float_as_uint(pmax), __float_as_uint(pmax), false, false);
      pmax = fmaxf(__uint_as_float(rr[0]), __uint_as_float(rr[1])); }
    if (__builtin_expect(__all(pmax - m_reg <= thr_raw), 1)) { mn = m_reg; alpha = 1.f; }
    else { mn = fmaxf(m_reg, pmax); alpha = __builtin_amdgcn_exp2f((m_reg - mn) * C); m_reg = mn; }
    const float mnC = -mn * C;
#pragma unroll
    for (int r = 0; r < 16; ++r) p0[r] = fmaf(p0[r], C, mnC);
#pragma unroll
    for (int r = 0; r < 16; ++r) p1[r] = fmaf(p1[r], C, mnC);
#pragma unroll
    for (int r = 0; r < 16; ++r) p0[r] = __builtin_amdgcn_exp2f(p0[r]);
}
__device__ __forceinline__ void finishSM(f32x16& p0, f32x16& p1, float alpha, float& l_reg, bf16x8& pa0, bf16x8& pa1, bf16x8& pa2, bf16x8& pa3) {
#pragma unroll
    for (int r = 0; r < 16; ++r) p1[r] = __builtin_amdgcn_exp2f(p1[r]);
    float ps = 0;
#pragma unroll
    for (int r = 0; r < 16; ++r) ps += p0[r];
#pragma unroll
    for (int r = 0; r < 16; ++r) ps += p1[r];
    { auto rr = __builtin_amdgcn_permlane32_swap(__float_as_uint(ps), __float_as_uint(ps), false, false);
      ps = __uint_as_float(rr[0]) + __uint_as_float(rr[1]); }
    l_reg = l_reg * alpha + ps;
#define PK4(P, BASE, OUT) do { unsigned a0 = cvtpk(P[BASE + 0], P[BASE + 1]), a1 = cvtpk(P[BASE + 2], P[BASE + 3]);   \
    unsigned b0 = cvtpk(P[BASE + 4], P[BASE + 5]), b1 = cvtpk(P[BASE + 6], P[BASE + 7]);                              \
    auto r0 = __builtin_amdgcn_permlane32_swap(a0, b0, false, false); auto r1 = __builtin_amdgcn_permlane32_swap(a1, b1, false, false); \
    u32x4 w = {r0[0], r1[0], r0[1], r1[1]}; OUT = __builtin_bit_cast(bf16x8, w); } while (0)
    PK4(p0, 0, pa0); PK4(p0, 8, pa1); PK4(p1, 0, pa2); PK4(p1, 8, pa3);
#undef PK4
}
template <int D0LO, int D0N>
__device__ __forceinline__ void qkt(f32x16& p0, f32x16& p1, const ALAS char* Ks, const bf16x8* qr, int r32, int hi) {
    p0 = f32x16{}; p1 = f32x16{};
#pragma unroll
    for (int d0 = D0LO; d0 < D0LO + D0N; ++d0) { const int cb = (d0 * 16 + hi * 8) * 2;
        const bf16x8 b0 = *(const ALAS bf16x8*)(Ks + KSWZ(r32, cb));
        const bf16x8 b1 = *(const ALAS bf16x8*)(Ks + KSWZ(32 + r32, cb));
        p0 = __builtin_amdgcn_mfma_f32_32x32x16_bf16(b0, qr[d0], p0, 0, 0, 0);
        p1 = __builtin_amdgcn_mfma_f32_32x32x16_bf16(b1, qr[d0], p1, 0, 0, 0); }
}
__device__ __forceinline__ int v_st(int k, int c) { const int kk = (k & ~0xC) | ((k & 4) << 1) | ((k & 8) >> 1); return ((kk >> 3) * 4 + (c >> 5)) * 512 + ((kk & 7) * 32 + (c & 31)) * 2; }
__device__ __forceinline__ int v_rd_base(int lane) { return ((lane & 3) << 3) | (((lane >> 2) & 3) << 6) | (((lane >> 4) & 1) << 5) | (((lane >> 5) & 1) << 8); }
constexpr int v_rd_off(int d0, int ks, int half) { return d0 * 512 + ks * 4096 + half * 2048; }
template <int OFF> __device__ __forceinline__ s16x4 tr_read(int vb) {
    s16x4 r; asm volatile("ds_read_b64_tr_b16 %0, %1 offset:%2" : "=&v"(r) : "v"(vb), "i"(OFF) : "memory"); return r;
}
template <int D0> __device__ __forceinline__ void pv_one(f32x16& od, int vb, bf16x8 pa0, bf16x8 pa1, bf16x8 pa2, bf16x8 pa3) {
    const s16x4 l0 = tr_read<v_rd_off(D0, 0, 0)>(vb), h0 = tr_read<v_rd_off(D0, 0, 1)>(vb), l1 = tr_read<v_rd_off(D0, 1, 0)>(vb), h1 = tr_read<v_rd_off(D0, 1, 1)>(vb);
    const s16x4 l2 = tr_read<v_rd_off(D0, 2, 0)>(vb), h2 = tr_read<v_rd_off(D0, 2, 1)>(vb), l3 = tr_read<v_rd_off(D0, 3, 0)>(vb), h3 = tr_read<v_rd_off(D0, 3, 1)>(vb);
    asm volatile("s_waitcnt lgkmcnt(0)" ::: "memory"); SBAR();
#define PK(L, H) (bf16x8){L[0], L[1], L[2], L[3], H[0], H[1], H[2], H[3]}
    od = __builtin_amdgcn_mfma_f32_32x32x16_bf16(pa0, PK(l0, h0), od, 0, 0, 0);
    od = __builtin_amdgcn_mfma_f32_32x32x16_bf16(pa1, PK(l1, h1), od, 0, 0, 0);
    od = __builtin_amdgcn_mfma_f32_32x32x16_bf16(pa2, PK(l2, h2), od, 0, 0, 0);
    od = __builtin_amdgcn_mfma_f32_32x32x16_bf16(pa3, PK(l3, h3), od, 0, 0, 0);
#undef PK
}
__device__ __forceinline__ void pv_d0(f32x16* o, int vb, bf16x8 pa0, bf16x8 pa1, bf16x8 pa2, bf16x8 pa3) {
    pv_one<0>(o[0], vb, pa0, pa1, pa2, pa3); pv_one<1>(o[1], vb, pa0, pa1, pa2, pa3); pv_one<2>(o[2], vb, pa0, pa1, pa2, pa3); pv_one<3>(o[3], vb, pa0, pa1, pa2, pa3);
}

template <int MASK>
__device__ __forceinline__ void apply_mask(f32x16& p0, f32x16& p1, int j, int loc0, int qp, int hi, const ALAS float* bias) {
    if constexpr (MASK == 2) {
        if (j >= NCTX_T) { const int kbase = loc0 + 64 * (j - NCTX_T);
#pragma unroll
            for (int r = 0; r < 16; ++r) { const int d0 = qp - (kbase + crow(r, hi)); const int d1 = d0 - 32;
                if (d0 > 128 || d0 < -128) p0[r] = -1e30f;
                if (d1 > 128 || d1 < -128) p1[r] = -1e30f; } }
    } else if constexpr (MASK == 3) {
        if (j >= NCTX_T) { const int kbase = loc0 + 64 * (j - NCTX_T);
            const int qrow = qp >> 6, qcol = qp & 63; const int rs = min(max(qrow - 4, 0), 56), cs = min(max(qcol - 8, 0), 48);
            const int kr = kbase >> 6; const int dr = kr - rs;
            if (dr < 0 || dr >= 8) {
#pragma unroll
                for (int r = 0; r < 16; ++r) { p0[r] = -1e30f; p1[r] = -1e30f; }
            } else {
                const ALAS float* brow = bias + (kr - qrow + 7) * 31 + 15 - qcol;
#pragma unroll
                for (int r = 0; r < 16; ++r) { const int kc0 = crow(r, hi), kc1 = kc0 + 32;
                    const bool ok0 = (unsigned)(kc0 - cs) < 16u, ok1 = (unsigned)(kc1 - cs) < 16u;
                    const float b0 = brow[ok0 ? kc0 : qcol], b1 = brow[ok1 ? kc1 : qcol];
                    p0[r] = ok0 ? p0[r] + b0 : -1e30f; p1[r] = ok1 ? p1[r] + b1 : -1e30f;
                    if ((r & 3) == 3) asm volatile("" ::: "memory"); }
            }
        }
    }
}

template <int MASK, int D0LO, int D0N>
__device__ __forceinline__ void attn_core(f32x16 (&o)[4], float& m_reg, float& l_reg, const bf16* __restrict__ Qw, const bf16* __restrict__ Kb, const bf16* __restrict__ Vb,
                                          const int nloc, const int loc0, const int qp, const float C, const float thr_raw, ALAS char* lds) {
    int tid_ = threadIdx.x; asm volatile("" : "+v"(tid_));
    const int tid = tid_, wid = __builtin_amdgcn_readfirstlane(tid >> 6), lane = tid & 63, r32 = lane & 31, hi = lane >> 5;
    ALAS float* ws = (ALAS float*)(lds + WSCR_OFF) + wid * 64; ALAS float* al_l = ws + 32;
    const ALAS float* bias = (const ALAS float*)(lds + BIAS_OFF);
    unsigned voffK[2], voffV[2];
#pragma unroll
    for (int i = 0; i < 2; ++i) { const int q = (wid + 8 * i) * 64 + lane;
        { const int row = q >> 4, cc = (q & 15) ^ (row & 7); voffK[i] = (unsigned)(row * (LDP * 2) + cc * 16); }
        { const int kk = (q >> 7) * 8 + ((q & 31) >> 2), c = ((q >> 5) & 3) * 32 + (q & 3) * 8; const int k = (kk & ~0xC) | ((kk & 4) << 1) | ((kk & 8) >> 1); voffV[i] = (unsigned)(k * (LDP * 2) + c * 2); } }
    const int NT = NCTX_T + nloc;
#define KOFF(j) ((j) < NCTX_T ? 4096 + 64 * (j) : loc0 + 64 * ((j) - NCTX_T))
#define ISSUE(j) do { const size_t _ro = (size_t)KOFF(j) * (LDP * 2); const char* _gk = (const char*)Kb + _ro; const char* _gv = (const char*)Vb + _ro; ALAS char* _sl = lds + ((j) & 3) * SLOT + wid * 1024; \
    _Pragma("unroll") for (int _i = 0; _i < 2; ++_i) __builtin_amdgcn_global_load_lds((const unsigned*)(_gk + voffK[_i]), (ALAS unsigned*)(_sl + _i * 8192), 16, 0, 0); \
    _Pragma("unroll") for (int _i = 0; _i < 2; ++_i) __builtin_amdgcn_global_load_lds((const unsigned*)(_gv + voffV[_i]), (ALAS unsigned*)(_sl + 16384 + _i * 8192), 16, 0, 0); } while (0)
#define WAITBAR(n) do { asm volatile("s_waitcnt vmcnt(" #n ") lgkmcnt(0)" ::: "memory"); __builtin_amdgcn_s_barrier(); asm volatile("" ::: "memory"); } while (0)
#define RESC(a) do { if (__any((a) < 1.f)) { if (hi == 0) al_l[r32] = (a); asm volatile("s_waitcnt lgkmcnt(0)" ::: "memory"); \
    _Pragma("unroll") for (int d = 0; d < 4; ++d) _Pragma("unroll") for (int r = 0; r < 16; ++r) o[d][r] *= al_l[crow(r, hi)]; } } while (0)
    asm volatile("s_waitcnt vmcnt(0)" ::: "memory");
    m_reg = -1e30f; l_reg = 0.f;
#pragma unroll
    for (int d = 0; d < 4; ++d) o[d] = f32x16{};
    bf16x8 qr[8];
#pragma unroll
    for (int d0 = 0; d0 < 8; ++d0) qr[d0] = *(const bf16x8*)(Qw + d0 * 16);
    ISSUE(0); ISSUE(1); ISSUE(2);
    const int vb0 = (int)(uintptr_t)lds + 16384 + v_rd_base(lane);
    f32x16 pA0, pA1, pB0, pB1; float mnA, mnB, alA, alB; bf16x8 pa0, pa1, pa2, pa3;
    WAITBAR(8);
    qkt<D0LO, D0N>(pA0, pA1, lds, qr, r32, hi); apply_mask<MASK>(pA0, pA1, 0, loc0, qp, hi, bias); partialSM(pA0, pA1, m_reg, mnA, alA, C, thr_raw);
    WAITBAR(4);
    ISSUE(3);
    for (int j = 1; j + 1 < NT; j += 2) {
        SBAR(); qkt<D0LO, D0N>(pB0, pB1, lds + (j & 3) * SLOT, qr, r32, hi);
        finishSM(pA0, pA1, alA, l_reg, pa0, pa1, pa2, pa3); SBAR();
        pv_d0(o, vb0 + ((j - 1) & 3) * SLOT, pa0, pa1, pa2, pa3); apply_mask<MASK>(pB0, pB1, j, loc0, qp, hi, bias); partialSM(pB0, pB1, m_reg, mnB, alB, C, thr_raw);
        if (j + 2 < NT) { WAITBAR(4); } else { WAITBAR(0); }
        if (j + 3 < NT) ISSUE(j + 3);
        RESC(alB);
        SBAR(); qkt<D0LO, D0N>(pA0, pA1, lds + ((j + 1) & 3) * SLOT, qr, r32, hi);
        finishSM(pB0, pB1, alB, l_reg, pa0, pa1, pa2, pa3); SBAR();
        pv_d0(o, vb0 + (j & 3) * SLOT, pa0, pa1, pa2, pa3); apply_mask<MASK>(pA0, pA1, j + 1, loc0, qp, hi, bias); partialSM(pA0, pA1, m_reg, mnA, alA, C, thr_raw);
        if (j + 3 < NT) { WAITBAR(4); } else { WAITBAR(0); }
        if (j + 4 < NT) ISSUE(j + 4);
        RESC(alA);
    }
    SBAR(); qkt<D0LO, D0N>(pB0, pB1, lds + ((NT - 1) & 3) * SLOT, qr, r32, hi);
    finishSM(pA0, pA1, alA, l_reg, pa0, pa1, pa2, pa3); SBAR();
    pv_d0(o, vb0 + ((NT - 2) & 3) * SLOT, pa0, pa1, pa2, pa3); apply_mask<MASK>(pB0, pB1, NT - 1, loc0, qp, hi, bias); partialSM(pB0, pB1, m_reg, mnB, alB, C, thr_raw);
    RESC(alB);
    finishSM(pB0, pB1, alB, l_reg, pa0, pa1, pa2, pa3); SBAR();
    pv_d0(o, vb0 + ((NT - 1) & 3) * SLOT, pa0, pa1, pa2, pa3);
#undef KOFF
#undef ISSUE
#undef WAITBAR
#undef RESC
}
}

constexpr int NWAVES = 8;
constexpr int DM = 4096, NB = 2, SEQ = 4096, CTXL = 256, TPB = SEQ + CTXL  , MROWS = NB * TPB  ;
constexpr int NIN = 9216, DFF = 11008, NUP = 2 * DFF, NADA = 6 * DM;
constexpr int QA = 0, QB_ = 1024, QC = 2048, QD = 3072, KA = 4096, VA = 4352, KB_ = 4608, VB_ = 5632, KC = 6656, VC = 6912, KD = 7168, VD = 8192;
constexpr float EPS = 1e-6f;
constexpr int NPHASE = 18;

constexpr size_t MiB = 1u << 20;
constexpr size_t WS_CTL = 0, CTL_ZERO_BYTES = 1 * MiB;
constexpr size_t WS_MOD = 1 * MiB;
constexpr size_t WS_TAB = 2 * MiB;
constexpr size_t WS_WIN = 4 * MiB;
constexpr size_t WS_WOUT = WS_WIN + 2 * 72 * MiB;
constexpr size_t WS_WUP = WS_WOUT + 2 * 32 * MiB;
constexpr size_t WS_WDN = WS_WUP + 2 * 172 * MiB;
constexpr size_t WS_XS = WS_WDN + 2 * 86 * MiB;
constexpr size_t WS_HX = WS_XS + 136 * MiB;
constexpr size_t WS_P = WS_HX + 68 * MiB;
constexpr size_t WS_O = WS_P + 153 * MiB;
constexpr size_t WS_Y = WS_O + 68 * MiB;
constexpr size_t WS_U = WS_Y + 68 * MiB;
constexpr size_t WS_ACT = WS_U + 366 * MiB;
constexpr size_t WS_STASH = WS_ACT + 183 * MiB;
constexpr size_t WS_PART = WS_STASH + 32 * MiB;
constexpr size_t WS_END = WS_PART + 64 * MiB;
static_assert((size_t)MROWS * NUP * 2 <= 366 * MiB && (size_t)MROWS * DFF * 2 <= 183 * MiB && (size_t)MROWS * NIN * 2 <= 153 * MiB, "ws map");
constexpr int CW_BAR = 4096;

constexpr int RING_OFF = 0, RING_BYTES = 131072;
constexpr int LDSCTL_OFF = RING_BYTES, MISC_OFF = LDSCTL_OFF + 320;
constexpr int LDS_BYTES = 163840;
constexpr int WL_OFF = att::SHM_END + 8192, THD_OFF = WL_OFF + 3072, GAINS_OFF = att::WSCR_OFF;
static_assert(THD_OFF + 16384 <= LDS_BYTES, "LDS map");
constexpr int XCH_OFF = att::SHM_END;
static_assert(XCH_OFF + 8192 <= LDS_BYTES && att::WSCR_OFF >= MISC_OFF + 128, "LDS map");

#define GAS __attribute__((address_space(1)))
#define LAS __attribute__((address_space(3)))
typedef unsigned short bf16;
typedef unsigned v4u __attribute__((ext_vector_type(4)));
typedef unsigned v2u __attribute__((ext_vector_type(2)));
typedef float f32x4 __attribute__((ext_vector_type(4)));
typedef float f32x2 __attribute__((ext_vector_type(2)));
typedef GAS unsigned gu32;
#define RLX_AGENT __ATOMIC_RELAXED, __HIP_MEMORY_SCOPE_AGENT
#define LDS_WAIT() asm volatile("s_waitcnt lgkmcnt(0)" ::: "memory")
#define VM_WAIT() asm volatile("s_waitcnt vmcnt(0)" ::: "memory")
__device__ __forceinline__ unsigned f2bf(float f) { unsigned u = __builtin_bit_cast(unsigned, f); return (u + 0x7fffu + ((u >> 16) & 1u)) >> 16; }
__device__ __forceinline__ unsigned pk2(float lo, float hi) { return f2bf(lo) | (f2bf(hi) << 16); }
__device__ __forceinline__ float bf_lo(unsigned w) { return __uint_as_float(w << 16); }
__device__ __forceinline__ float bf_hi(unsigned w) { return __uint_as_float(w & 0xffff0000u); }

#define XB_TMO      128
#define XB_XCNT(j)  (256  + 64 * (j))
#define XB_XSUB(j)  (1280 + 64 * (j))
#define XB_XGEN(j)  (2304 + 64 * (j))
#define XB_TOP      3328
#define XB_TOPGEN   3392
#define XCD_BAR_WORDS 3456
#define XB_SPIN_CAP (1u << 24)

__device__ __forceinline__ unsigned xb_ld(unsigned* p)              { return __hip_atomic_load(p, __ATOMIC_RELAXED, __HIP_MEMORY_SCOPE_AGENT); }
__device__ __forceinline__ unsigned xb_add(unsigned* p, unsigned v) { return __hip_atomic_fetch_add(p, v, __ATOMIC_RELAXED, __HIP_MEMORY_SCOPE_AGENT); }
__device__ __forceinline__ unsigned xb_xcc_id() { return (unsigned)__builtin_amdgcn_s_getreg((3 << 11) | 20) & 0xFu; }
#define XB_SPIN(cond, bar) do { unsigned _sp = 0; while (cond) { __builtin_amdgcn_s_sleep(1); \
    if ((++_sp & 255u) == 0u) { if (xb_ld(&(bar)[XB_TMO])) break; if (_sp > XB_SPIN_CAP) { atomicAdd(&(bar)[XB_TMO], 1u); break; } } } } while (0)

struct XcdBarrier { unsigned* bar; unsigned x; volatile LAS unsigned* st; };

__device__ __forceinline__ XcdBarrier xcd_barrier_post(unsigned* bar, volatile LAS unsigned* st) {
    XcdBarrier b; b.bar = bar; b.x = xb_xcc_id(); b.st = st;
    if (threadIdx.x == 0) (void)xb_add(&bar[XB_XCNT(b.x)], 1u);
    return b;
}
__device__ __forceinline__ void xcd_barrier_complete(unsigned* bar, unsigned x, unsigned& nloc, unsigned& nx) {
    const unsigned G = gridDim.x * gridDim.y * gridDim.z;
    unsigned sum, cnt, mine, sp = 0u;
    for (;;) {
        sum = 0u; cnt = 0u; mine = 0u;
#pragma unroll
        for (unsigned j = 0; j < 16; ++j) { const unsigned c = xb_ld(&bar[XB_XCNT(j)]); sum += c; cnt += (c > 0u) ? 1u : 0u; mine = (j == x) ? c : mine; }
        if (sum == G) break;
        __builtin_amdgcn_s_sleep(1);
        if ((++sp & 255u) == 0u) { if (xb_ld(&bar[XB_TMO])) break; if (sp > XB_SPIN_CAP) { atomicAdd(&bar[XB_TMO], 1u); break; } }
    }
    nloc = mine > 0u ? mine : 1u; nx = cnt > 0u ? cnt : 1u;
}
__device__ __forceinline__ void xcd_barrier(const XcdBarrier& b) {
    asm volatile("s_waitcnt vmcnt(0)" ::: "memory");
    __syncthreads();
    if (threadIdx.x == 0) {
        unsigned* bar = b.bar;
        __builtin_amdgcn_s_waitcnt(0);
        unsigned nloc = b.st[0], nx = b.st[1];
        if (nloc == 0u) { xcd_barrier_complete(bar, b.x, nloc, nx); b.st[0] = nloc; b.st[1] = nx; }
        const unsigned old = xb_add(&bar[XB_XSUB(b.x)], 1u);
        const unsigned gen = old / nloc;
        if (old + 1u == (gen + 1u) * nloc) {
            __builtin_amdgcn_fence(__ATOMIC_RELEASE, "agent");
            asm volatile("s_waitcnt vmcnt(0)" ::: "memory");
            const unsigned og = xb_add(&bar[XB_TOP], 1u);
            const unsigned tg = og / nx;
            if (og + 1u == (tg + 1u) * nx) xb_add(&bar[XB_TOPGEN], 1u);
            else XB_SPIN(xb_ld(&bar[XB_TOPGEN]) == tg, bar);
            __builtin_amdgcn_fence(__ATOMIC_ACQUIRE, "agent");
            xb_add(&bar[XB_XGEN(b.x)], 1u);
            asm volatile("s_waitcnt vmcnt(0)" ::: "memory");
        } else {
            XB_SPIN(xb_ld(&bar[XB_XGEN(b.x)]) == gen, bar);
            __builtin_amdgcn_fence(__ATOMIC_ACQUIRE, "agent");
            asm volatile("s_waitcnt vmcnt(0)" ::: "memory");
        }
    }
    __syncthreads();
}

struct Args {
    const float* in[24]; float* out; unsigned char* ws; int ph_lo, ph_hi;
};
typedef __attribute__((address_space(4))) const Args* KArgs;
struct Frame {
    LAS unsigned char* lds;
    int tid, lane, wave, vcu, G;
    unsigned char* ws;
};

__device__ __forceinline__ int fresh_bx() { int bx = blockIdx.x; asm volatile("" : "+s"(bx)); return bx; }
__device__ __forceinline__ float wave_sum(float v) {
#pragma unroll
    for (int o = 1; o < 64; o <<= 1) v += __shfl_xor(v, o);
    return v;
}

__device__ const float INV32[32] = {
    1.0f, 0.74989420933f, 0.56234132519f, 0.42169650343f, 0.31622776602f, 0.23713737057f, 0.17782794100f, 0.13335214322f,
    0.1f, 0.074989420933f, 0.056234132519f, 0.042169650343f, 0.031622776602f, 0.023713737057f, 0.017782794100f, 0.013335214322f,
    0.01f, 0.0074989420933f, 0.0056234132519f, 0.0042169650343f, 0.0031622776602f, 0.0023713737057f, 0.0017782794100f, 0.0013335214322f,
    0.001f, 0.00074989420933f, 0.00056234132519f, 0.00042169650343f, 0.00031622776602f, 0.00023713737057f, 0.00017782794100f, 0.00013335214322f };
__device__ const float INV16[16] = {
    1.0f, 0.56234132519f, 0.31622776602f, 0.17782794100f, 0.1f, 0.056234132519f, 0.031622776602f, 0.017782794100f,
    0.01f, 0.0056234132519f, 0.0031622776602f, 0.0017782794100f, 0.001f, 0.00056234132519f, 0.00031622776602f, 0.00017782794100f };

__device__ __forceinline__ void sincos_acc(float af, float& c, float& s) {
    const double a = (double)af; const double kd = __builtin_rint(a * 0.63661977236758134308); const int k = (int)kd;
    const double r = (a - kd * 1.57079632679489655800) - kd * 6.12323399573676603587e-17; const double r2 = r * r;
    const double sn = r * (1.0 + r2 * (-1.0 / 6 + r2 * (1.0 / 120 + r2 * (-1.0 / 5040 + r2 * (1.0 / 362880 + r2 * (-1.0 / 39916800 + r2 * (1.0 / 6227020800.0)))))));
    const double cs = 1.0 + r2 * (-0.5 + r2 * (1.0 / 24 + r2 * (-1.0 / 720 + r2 * (1.0 / 40320 + r2 * (-1.0 / 3628800 + r2 * (1.0 / 479001600.0 + r2 * (-1.0 / 87178291200.0)))))));
    double cc, ss;
    switch (k & 3) { case 0: cc = cs; ss = sn; break; case 1: cc = -sn; ss = cs; break; case 2: cc = -cs; ss = -sn; break; default: cc = sn; ss = -cs; break; }
    c = (float)cc; s = (float)ss;
}

__device__ __forceinline__ unsigned cvtpk_bf16(float lo, float hi) { unsigned r; asm volatile("v_cvt_pk_bf16_f32 %0, %1, %2" : "=v"(r) : "v"(lo), "v"(hi)); return r; }
__device__ __forceinline__ void p0_transpose_item(const float* W, int K, int N, bf16* WT, int item, int lane, bool gv) {
    const int nblk = N / 64, kb = item / nblk, nb = item % nblk, k0 = 64 * kb, n0 = 64 * nb;
    const int v0 = !gv ? n0 : (n0 < DFF ? (n0 >> 7) * 256 + (n0 & 127) : ((n0 - DFF) >> 7) * 256 + 128 + ((n0 - DFF) & 127));
    const int kr = lane >> 4, c4 = lane & 15;
    const GAS float* src = (const GAS float*)W + (size_t)(k0 + 16 * kr) * N + n0 + 4 * c4;
    f32x4 v[16];
#pragma unroll
    for (int i = 0; i < 16; ++i) v[i] = __builtin_nontemporal_load((const GAS f32x4*)(src + (size_t)i * N));
    GAS bf16* dst = (GAS bf16*)WT + (size_t)(v0 + 4 * c4) * K + k0 + 16 * kr;
#pragma unroll
    for (int e = 0; e < 4; ++e) {
        v4u o0, o1;
        o0.x = cvtpk_bf16(v[0][e], v[1][e]); o0.y = cvtpk_bf16(v[2][e], v[3][e]); o0.z = cvtpk_bf16(v[4][e], v[5][e]); o0.w = cvtpk_bf16(v[6][e], v[7][e]);
        o1.x = cvtpk_bf16(v[8][e], v[9][e]); o1.y = cvtpk_bf16(v[10][e], v[11][e]); o1.z = cvtpk_bf16(v[12][e], v[13][e]); o1.w = cvtpk_bf16(v[14][e], v[15][e]);
        *(GAS v4u*)(dst + (size_t)e * K) = o0; *(GAS v4u*)(dst + (size_t)e * K + 8) = o1;
    }
}

__device__ __forceinline__ void convert_matrix(Frame& F, KArgs a, int mat, int l, int gw, int ngw) {
    const float* W; bf16* WT; int K, N;
    if (mat == 0) { W = a->in[10] + (size_t)l * DM * NIN; WT = (bf16*)(F.ws + WS_WIN + (size_t)l * 72 * MiB); K = DM; N = NIN; }
    else if (mat == 1) { W = a->in[11] + (size_t)l * DM * DM; WT = (bf16*)(F.ws + WS_WOUT + (size_t)l * 32 * MiB); K = DM; N = DM; }
    else if (mat == 2) { W = a->in[21] + (size_t)l * DM * NUP; WT = (bf16*)(F.ws + WS_WUP + (size_t)l * 172 * MiB); K = DM; N = NUP; }
    else { W = a->in[23] + (size_t)l * DFF * DM; WT = (bf16*)(F.ws + WS_WDN + (size_t)l * 86 * MiB); K = DFF; N = DM; }
    const int nitems = (K / 64) * (N / 64);
    for (int it = gw; it < nitems; it += ngw) p0_transpose_item(W, K, N, WT, it, F.lane, mat == 2);
}
__device__ __forceinline__ void tail_convert(Frame& F, KArgs a, int nbusy, int mat0, int l0, int mat1, int l1) {
    const int bx = fresh_bx(); if (bx < nbusy || nbusy >= F.G) return;
    const int gw = (bx - nbusy) * NWAVES + F.wave, ngw = (F.G - nbusy) * NWAVES;
    convert_matrix(F, a, mat0, l0, gw, ngw);
    if (mat1 >= 0) convert_matrix(F, a, mat1, l1, gw, ngw);
}
__device__ __forceinline__ float silu_f(float x) { return x / (1.f + __expf(-x)); }

__device__ __forceinline__ void phase_prologue(Frame& F, KArgs a) {
    const float* c_in = a->in[1]; const float* cctx = a->in[3]; const float* w_ada = a->in[4]; const float* b_ada = a->in[5];
    float* mod = (float*)(F.ws + WS_MOD);
    if (F.vcu == 0) {
        f32x2* thd = (f32x2*)(F.ws + WS_TAB);
        for (int e = F.tid; e < 64 * 32; e += NWAVES * 64) { const int pos = e >> 5, i = e & 31; float c, s; sincos_acc((float)pos * INV32[i], c, s); thd[e] = (f32x2){c, s}; }
        f32x2* tdh = (f32x2*)(F.ws + WS_TAB + 16384);
        for (int e = F.tid; e < 64 * 16; e += NWAVES * 64) { const int pos = e >> 4, i = e & 15; float c, s; sincos_acc((float)pos * INV16[i], c, s); tdh[e] = (f32x2){c, s}; }
        if (F.tid < 2) { const int l = F.tid; float s1 = 0.f, s2 = 0.f;
            for (int i = 0; i < 64; ++i) { s1 += a->in[14][l * 64 + i] * a->in[15][l * 64 + i]; s2 += a->in[16][l * 64 + i] * a->in[17][l * 64 + i]; }
            const float lam_init = 0.8f - 0.6f * expf(-0.3f * (float)l);
            float* lam = (float*)(F.ws + WS_TAB + 32768); lam[l * 2 + 0] = expf(s1) - expf(s2) + lam_init; lam[l * 2 + 1] = 1.f - lam_init; }
    }
    {
        LAS float* sv = (LAS float*)(F.lds + RING_OFF);
        LAS float* red = (LAS float*)(F.lds + RING_OFF + 49152);
        for (int e = F.tid; e < 3 * DM; e += NWAVES * 64) { const int v = e / DM, k = e % DM; const float x = v < 2 ? c_in[v * DM + k] : cctx[k]; sv[e] = silu_f(x); }
        __syncthreads();
        const int cg = F.lane & 15, kq = F.lane >> 4;
        for (int it = F.vcu; it < 2 * (NADA / 64); it += F.G) {
            const int l = it / (NADA / 64), ch = it % (NADA / 64);
            const float* W = w_ada + (size_t)l * DM * NADA + ch * 64 + cg * 4;
            f32x4 a0 = {0.f, 0.f, 0.f, 0.f}, a1 = a0, a2 = a0;
#pragma unroll 8
            for (int s = 0; s < DM / 32; ++s) { const int k = s * 32 + F.wave * 4 + kq; const f32x4 w = __builtin_nontemporal_load((const GAS f32x4*)(W + (size_t)k * NADA));
                a0 += w * sv[k]; a1 += w * sv[DM + k]; a2 += w * sv[2 * DM + k]; }
#pragma unroll
            for (int e = 0; e < 4; ++e) { a0[e] += __shfl_xor(a0[e], 16); a0[e] += __shfl_xor(a0[e], 32); a1[e] += __shfl_xor(a1[e], 16); a1[e] += __shfl_xor(a1[e], 32); a2[e] += __shfl_xor(a2[e], 16); a2[e] += __shfl_xor(a2[e], 32); }
            if (kq == 0) {
#pragma unroll
                for (int e = 0; e < 4; ++e) { red[(F.wave * 3 + 0) * 64 + cg * 4 + e] = a0[e]; red[(F.wave * 3 + 1) * 64 + cg * 4 + e] = a1[e]; red[(F.wave * 3 + 2) * 64 + cg * 4 + e] = a2[e]; } }
            __syncthreads();
            if (F.tid < 192) { const int v = F.tid / 64, cidx = F.tid % 64; float s = 0.f;
#pragma unroll
                for (int w = 0; w < 8; ++w) s += red[(w * 3 + v) * 64 + cidx];
                const int col = ch * 64 + cidx; mod[((size_t)l * 3 + v) * NADA + col] = s + b_ada[(size_t)l * NADA + col]; }
            __syncthreads();
        }
    }
    {
        const int gw = F.vcu * NWAVES + F.wave, NGW = F.G * NWAVES;
        convert_matrix(F, a, 0, 0, gw, NGW); convert_matrix(F, a, 2, 0, gw, NGW); convert_matrix(F, a, 2, 1, gw, NGW);
        if (F.G != 256) { convert_matrix(F, a, 1, 0, gw, NGW); convert_matrix(F, a, 3, 0, gw, NGW); convert_matrix(F, a, 0, 1, gw, NGW); convert_matrix(F, a, 1, 1, gw, NGW); convert_matrix(F, a, 3, 1, gw, NGW); }
    }
}

struct RowRegs { f32x4 v[16]; };
__device__ __forceinline__ float row_sumsq(const RowRegs& r) {
    float s = 0.f;
#pragma unroll
    for (int j = 0; j < 16; ++j) s += (r.v[j].x * r.v[j].x + r.v[j].y * r.v[j].y) + (r.v[j].z * r.v[j].z + r.v[j].w * r.v[j].w);
    return wave_sum(s);
}
__device__ __forceinline__ void row_load_f32(RowRegs& r, const float* p, int lane) {
    const GAS f32x4* q = (const GAS f32x4*)p + lane;
#pragma unroll
    for (int j = 0; j < 16; ++j) r.v[j] = q[64 * j];
}
__device__ __forceinline__ void row_load_bf16(RowRegs& r, const bf16* p, int lane) {
    const GAS v2u* q = (const GAS v2u*)p + lane;
#pragma unroll
    for (int j = 0; j < 16; ++j) { const v2u w = q[64 * j]; r.v[j] = (f32x4){bf_lo(w.x), bf_hi(w.x), bf_lo(w.y), bf_hi(w.y)}; }
}
__device__ __forceinline__ void row_store_f32(const RowRegs& r, float* p, int lane) {
    GAS f32x4* q = (GAS f32x4*)p + lane;
#pragma unroll
    for (int j = 0; j < 16; ++j) q[64 * j] = r.v[j];
}
__device__ __forceinline__ void row_store_bf16(const RowRegs& r, bf16* p, int lane) {
    GAS v2u* q = (GAS v2u*)p + lane;
#pragma unroll
    for (int j = 0; j < 16; ++j) { v2u w; w.x = pk2(r.v[j].x, r.v[j].y); w.y = pk2(r.v[j].z, r.v[j].w); q[64 * j] = w; }
}
__device__ __forceinline__ void row_modnorm_store(const RowRegs& x, float rstd, const float* g, const float* sc, const float* sh, bf16* out, int lane) {
    GAS v2u* q = (GAS v2u*)out + lane;
#pragma unroll
    for (int j = 0; j < 16; ++j) { const int c = 4 * lane + 256 * j;
        const f32x4 gv = *(const GAS f32x4*)(g + c), sv = *(const GAS f32x4*)(sc + c), hv = *(const GAS f32x4*)(sh + c);
        const f32x4 y = (x.v[j] * rstd) * gv * (sv + 1.f) + hv;
        v2u w; w.x = pk2(y.x, y.y); w.y = pk2(y.z, y.w); q[64 * j] = w; }
}
__device__ __forceinline__ void row_residual(RowRegs& x, const RowRegs& y, float rstd, const float* g, const float* gate, int lane) {
#pragma unroll
    for (int j = 0; j < 16; ++j) { const int c = 4 * lane + 256 * j;
        const f32x4 gv = *(const GAS f32x4*)(g + c), tv = *(const GAS f32x4*)(gate + c);
        x.v[j] = x.v[j] + tv * ((y.v[j] * rstd) * gv); }
}

__device__ __forceinline__ void row_load_part(RowRegs& r, const float* part, int lrow, int lane) {
#pragma unroll
    for (int j = 0; j < 16; ++j) r.v[j] = (f32x4){0.f, 0.f, 0.f, 0.f};
#pragma unroll 2
    for (int c = 0; c < 8; ++c) { const GAS f32x4* q = (const GAS f32x4*)(part + ((size_t)c * 512 + lrow) * DM) + lane;
#pragma unroll
        for (int j = 0; j < 16; ++j) r.v[j] += q[64 * j]; }
}

__device__ __forceinline__ void phase_r0(Frame& F, KArgs a) {
    const float* mod = (const float*)(F.ws + WS_MOD); bf16* hx = (bf16*)(F.ws + WS_HX);
    const int gw = F.vcu * NWAVES + F.wave, NGW = F.G * NWAVES;
    for (int m = gw; m < MROWS; m += NGW) {
        const int b = m / TPB, t = m % TPB; const bool lat = t < SEQ;
        const float* src = lat ? a->in[0] + ((size_t)b * SEQ + t) * DM : a->in[2] + ((size_t)b * CTXL + (t - SEQ)) * DM;
        RowRegs x; row_load_f32(x, src, F.lane);
        const float rstd = 1.f / sqrtf(row_sumsq(x) * (1.f / DM) + EPS);
        const float* mv = mod + (size_t)(0 * 3 + (lat ? b : 2)) * NADA;
        row_modnorm_store(x, rstd, a->in[6]  , mv + DM, mv, hx + (size_t)m * DM, F.lane);
    }
}
__device__ __forceinline__ void phase_r1(Frame& F, KArgs a, int l, bool last) {
    const float* mod = (const float*)(F.ws + WS_MOD); bf16* xs = (bf16*)(F.ws + WS_XS); bf16* hx = (bf16*)(F.ws + WS_HX); const bf16* yb = (const bf16*)(F.ws + WS_Y);
    const int gw = F.vcu * NWAVES + F.wave, NGW = F.G * NWAVES;
    for (int m = gw; m < MROWS; m += NGW) {
        const int b = m / TPB, t = m % TPB; const bool lat = t < SEQ;
        if (last && !lat) continue;
        const float* mv = mod + (size_t)(l * 3 + (lat ? b : 2)) * NADA;
        RowRegs x, y;
        if (l == 0) row_load_f32(x, lat ? a->in[0] + ((size_t)b * SEQ + t) * DM : a->in[2] + ((size_t)b * CTXL + (t - SEQ)) * DM, F.lane);
        else row_load_bf16(x, xs + (size_t)m * DM, F.lane);
        if (lat) row_load_bf16(y, yb + (size_t)m * DM, F.lane); else row_load_part(y, (const float*)(F.ws + WS_PART), b * 256 + (t - SEQ), F.lane);
        const float rstd_y = 1.f / sqrtf(row_sumsq(y) * (1.f / DM) + EPS);
        row_residual(x, y, rstd_y, a->in[7] + (size_t)l * DM, mv + 2 * DM, F.lane);
        row_store_bf16(x, xs + (size_t)m * DM, F.lane);
        const float rstd = 1.f / sqrtf(row_sumsq(x) * (1.f / DM) + EPS);
        row_modnorm_store(x, rstd, a->in[8] + (size_t)l * DM, mv + 4 * DM, mv + 3 * DM, hx + (size_t)m * DM, F.lane);
    }
}
__device__ __forceinline__ void phase_r2(Frame& F, KArgs a, int l, bool last) {
    const float* mod = (const float*)(F.ws + WS_MOD); bf16* xs = (bf16*)(F.ws + WS_XS); bf16* hx = (bf16*)(F.ws + WS_HX); const bf16* yb = (const bf16*)(F.ws + WS_Y);
    const int gw = F.vcu * NWAVES + F.wave, NGW = F.G * NWAVES;
    for (int m = gw; m < MROWS; m += NGW) {
        const int b = m / TPB, t = m % TPB; const bool lat = t < SEQ;
        if (last && !lat) continue;
        const float* mv = mod + (size_t)(l * 3 + (lat ? b : 2)) * NADA;
        RowRegs x, y; row_load_bf16(x, xs + (size_t)m * DM, F.lane);
        if (lat) row_load_bf16(y, yb + (size_t)m * DM, F.lane); else row_load_part(y, (const float*)(F.ws + WS_PART), b * 256 + (t - SEQ), F.lane);
        const float rstd_y = 1.f / sqrtf(row_sumsq(y) * (1.f / DM) + EPS);
        row_residual(x, y, rstd_y, a->in[9] + (size_t)l * DM, mv + 5 * DM, F.lane);
        if (last) { row_store_f32(x, a->out + ((size_t)b * SEQ + t) * DM, F.lane); continue; }
        row_store_bf16(x, xs + (size_t)m * DM, F.lane);
        const float rstd = 1.f / sqrtf(row_sumsq(x) * (1.f / DM) + EPS);
        const float* mn = mod + (size_t)((l + 1) * 3 + (lat ? b : 2)) * NADA;
        row_modnorm_store(x, rstd, a->in[6] + (size_t)(l + 1) * DM, mn + DM, mn, hx + (size_t)m * DM, F.lane);
    }
}

__device__ __forceinline__ void phase_fixup(Frame& F, KArgs a, int l, bool last) {
    const float* side = (const float*)(F.ws + WS_U); bf16* ACT = (bf16*)(F.ws + WS_ACT);
    const float* cw = a->in[22] + (size_t)l * 3 * NUP;
    constexpr int CG = DFF / 4;
    const int ntile = last ? 32 : 34;
    for (int idx = F.vcu * NWAVES * 64 + F.tid; idx < ntile * 2 * CG; idx += F.G * NWAVES * 64) {
        const int cg = idx % CG, e = (idx / CG) & 1, pmi = idx / (2 * CG); const int pm = (last && pmi >= 16) ? pmi + 1 : pmi; const int pmb = pm % 17;
        const int col = cg * 4, vg = (col >> 7) * 256 + (col & 127);
        const float* sb = side + (size_t)pm * 4 * NUP;
        const f32x4 zero4 = {0.f, 0.f, 0.f, 0.f};
        f32x4 pg, pv, cg_, cv, ng, nv;
        if (e == 0) {
            cg_ = *(const GAS f32x4*)(sb + vg); cv = *(const GAS f32x4*)(sb + vg + 128); ng = *(const GAS f32x4*)(sb + NUP + vg); nv = *(const GAS f32x4*)(sb + NUP + vg + 128);
            if (pmb == 0 || pmb == 16) { pg = zero4; pv = zero4; } else { pg = *(const GAS f32x4*)(sb - NUP + vg); pv = *(const GAS f32x4*)(sb - NUP + vg + 128); }
        } else {
            cg_ = *(const GAS f32x4*)(sb + 3 * (size_t)NUP + vg); cv = *(const GAS f32x4*)(sb + 3 * (size_t)NUP + vg + 128); pg = *(const GAS f32x4*)(sb + 2 * (size_t)NUP + vg); pv = *(const GAS f32x4*)(sb + 2 * (size_t)NUP + vg + 128);
            if (pmb >= 15) { ng = zero4; nv = zero4; } else { ng = *(const GAS f32x4*)(sb + 4 * (size_t)NUP + vg); nv = *(const GAS f32x4*)(sb + 4 * (size_t)NUP + vg + 128); }
        }
        const f32x4 g = pg * *(const GAS f32x4*)(cw + col) + cg_ * *(const GAS f32x4*)(cw + NUP + col) + ng * *(const GAS f32x4*)(cw + 2 * NUP + col);
        const f32x4 v = pv * *(const GAS f32x4*)(cw + DFF + col) + cv * *(const GAS f32x4*)(cw + NUP + DFF + col) + nv * *(const GAS f32x4*)(cw + 2 * NUP + DFF + col);
        f32x4 o;
#pragma unroll
        for (int k = 0; k < 4; ++k) o[k] = g[k] / (1.f + __expf(-g[k])) * v[k];
        v2u w; w.x = pk2(o.x, o.y); w.y = pk2(o.z, o.w);
        *(GAS v2u*)(ACT + (size_t)(pm * 256 + (e ? 255 : 0)) * DFF + col) = w;
    }
}

template <int MASK>
__device__ __forceinline__ void attn_std_unit(Frame& F, const bf16* P, bf16* O, int b, int qrow0  , int qcol, int kcol, int vcol, int ocol,
                                              int nloc, int loc0, float sink, bool has_sink) {
    using namespace att;
    int lane_ = F.lane; asm volatile("" : "+v"(lane_));
    int lane = lane_, wid = F.wave, r32 = lane & 31, hi = lane >> 5;
    constexpr float SCALE = 0.088388347648318440f; constexpr float C = SCALE * 1.4426950408889634f;
    const size_t base = (size_t)b * TPB;
    const bf16* Qw = P + (base + qrow0 + wid * 32 + r32) * LDP + qcol + hi * 8;
    f32x16 o[4]; float m_reg, l_reg;
    attn_core<MASK, 0, 8>(o, m_reg, l_reg, Qw, P + base * LDP + kcol, P + base * LDP + vcol, nloc, loc0, qrow0 + wid * 32 + r32, C, 8.f / SCALE, (ALAS char*)F.lds);
    if (has_sink) l_reg += __builtin_amdgcn_exp2f(sink * 1.4426950408889634f - m_reg * C);
    asm volatile("" : "+v"(lane_)); lane = lane_; r32 = lane & 31; hi = lane >> 5;
    ALAS float* li_l = (ALAS float*)((ALAS char*)F.lds + WSCR_OFF) + wid * 64;
    if (hi == 0) li_l[r32] = l_reg; asm volatile("s_waitcnt lgkmcnt(0)" ::: "memory");
    bf16* Ow = O + (base + qrow0 + wid * 32) * LDO + ocol;
#pragma unroll
    for (int r = 0; r < 16; ++r) { const int orow = crow(r, hi); const float rl = __builtin_amdgcn_rcpf(li_l[orow]);
#pragma unroll
        for (int d0 = 0; d0 < 4; ++d0) Ow[(size_t)orow * LDO + d0 * 32 + r32] = (bf16)f2bf(o[d0][r] * rl); }
}
__device__ __forceinline__ void attn_diff_unit(Frame& F, const bf16* P, bf16* O, int b, int qrow0, int h, int nloc, int loc0, float lam, float omli, const float* gsub) {
    using namespace att;
    int lane_ = F.lane; asm volatile("" : "+v"(lane_));
    int lane = lane_, wid = F.wave, r32 = lane & 31, hi = lane >> 5;
    constexpr float SCALE = 0.125f; constexpr float C = SCALE * 1.4426950408889634f;
    const size_t base = (size_t)b * TPB;
    const bf16* Qw = P + (base + qrow0 + wid * 32 + r32) * LDP + QB_ + h * 128 + hi * 8;
    const bf16* Kb = P + base * LDP + KB_ + h * 128; const bf16* Vb = P + base * LDP + VB_ + h * 128;
    ALAS float* li_l = (ALAS float*)((ALAS char*)F.lds + WSCR_OFF) + wid * 64;
    f32x16 o[4]; float m_reg, l_reg;
    attn_core<0, 4, 4>(o, m_reg, l_reg, Qw, Kb, Vb, nloc, loc0, 0, C, 8.f / SCALE, (ALAS char*)F.lds);
    asm volatile("" : "+v"(lane_)); lane = lane_; r32 = lane & 31; hi = lane >> 5;
    if (hi == 0) li_l[r32] = l_reg; asm volatile("s_waitcnt lgkmcnt(0)" ::: "memory");
    { float* stash = (float*)(F.ws + WS_STASH) + ((size_t)blockIdx.x * 8 + wid) * 4096 + lane;
#pragma unroll
    for (int d0 = 0; d0 < 4; ++d0) { float* sp = stash + d0 * 1024; asm volatile("" : "+v"(sp));
#pragma unroll
        for (int r = 0; r < 16; ++r) sp[r * 64] = o[d0][r] * __builtin_amdgcn_rcpf(li_l[crow(r, hi)]); } }
    __syncthreads();
    attn_core<0, 0, 4>(o, m_reg, l_reg, Qw, Kb, Vb, nloc, loc0, 0, C, 8.f / SCALE, (ALAS char*)F.lds);
    asm volatile("" : "+v"(lane_)); lane = lane_; r32 = lane & 31; hi = lane >> 5;
    if (hi == 0) li_l[r32] = l_reg; asm volatile("s_waitcnt lgkmcnt(0)" ::: "memory");
    float* stash = (float*)(F.ws + WS_STASH) + ((size_t)blockIdx.x * 8 + wid) * 4096 + lane;
    float g4[4];
#pragma unroll
    for (int d0 = 0; d0 < 4; ++d0) g4[d0] = gsub[d0 * 32 + r32] * omli;
    bf16* Ow = O + (base + qrow0 + wid * 32) * LDO + QB_ + h * 128;
#pragma unroll
    for (int r = 0; r < 16; ++r) { const int orow = crow(r, hi); const float rl = __builtin_amdgcn_rcpf(li_l[orow]);
        float v[4]; float ss = 0.f;
#pragma unroll
        for (int d0 = 0; d0 < 4; ++d0) { v[d0] = o[d0][r] * rl - lam * stash[(d0 * 16 + r) * 64]; ss += v[d0] * v[d0]; }
        ss += __shfl_xor(ss, 1); ss += __shfl_xor(ss, 2); ss += __shfl_xor(ss, 4); ss += __shfl_xor(ss, 8); ss += __shfl_xor(ss, 16);
        const float rstd = 1.f / sqrtf(ss * (1.f / 128.f) + EPS);
#pragma unroll
        for (int d0 = 0; d0 < 4; ++d0) Ow[(size_t)orow * LDO + d0 * 32 + r32] = (bf16)f2bf(v[d0] * rstd * g4[d0]); }
}

__device__ __forceinline__ void phase_attention(Frame& F, KArgs a, int l, bool last) {
    const bf16* P = (const bf16*)(F.ws + WS_P); bf16* O = (bf16*)(F.ws + WS_O);
    const float* lamv = (const float*)(F.ws + WS_TAB + 32768); const float lam = lamv[l * 2], omli = lamv[l * 2 + 1];
    const float* sinkv = a->in[19] + l * 8; const float* gsub = a->in[18] + l * 128; const float* nab = a->in[20] + (size_t)l * 8 * 15 * 31;
#ifndef ATT_MASK
#define ATT_MASK 15
#endif
    if (ATT_MASK & 1) for (int u = F.vcu; u < (last ? 256 : 272); u += F.G) {
        int b, h, qrow0, nloc;
        if (u < 256) { b = u >> 7; h = (u >> 4) & 7; qrow0 = (u & 15) * 256; nloc = 64; } else { const int e = u - 256; b = e >> 3; h = e & 7; qrow0 = SEQ; nloc = 0; }
        __syncthreads(); attn_diff_unit(F, P, O, b, qrow0, h, nloc, 0, lam, omli, gsub);
    }
    if (ATT_MASK & 2) for (int u = F.vcu; u < (last ? 256 : 304); u += F.G) {
        int b, qrow0, qcol, kcol, vcol, nloc; float sink = 0.f; bool has_sink = false;
        if (u < 256) { const int h = (u >> 4) & 7, qb = u & 15; b = u >> 7; qrow0 = qb * 256; qcol = QA + h * 128; kcol = KA + (h >> 2) * 128; vcol = VA + (h >> 2) * 128; nloc = 64; }
        else { const int e = u - 256, g = e >> 4, h = e & 7; b = (e >> 3) & 1; qrow0 = SEQ; nloc = 0;
            if (g == 0) { qcol = QA + h * 128; kcol = KA + (h >> 2) * 128; vcol = VA + (h >> 2) * 128; }
            else if (g == 1) { qcol = QC + h * 128; kcol = KC + (h >> 2) * 128; vcol = VC + (h >> 2) * 128; sink = sinkv[h]; has_sink = true; }
            else { qcol = QD + h * 128; kcol = KD + h * 128; vcol = VD + h * 128; } }
        __syncthreads(); attn_std_unit<0>(F, P, O, b, qrow0, qcol, kcol, vcol, qcol, nloc, 0, sink, has_sink);
    }
    if (ATT_MASK & 4) for (int u = F.vcu; u < 256; u += F.G) { const int b = u >> 7, h = (u >> 4) & 7, qb = u & 15;
        const int lo = max(qb * 256 - 128, 0), hiK = min(qb * 256 + 384, SEQ);
        __syncthreads(); attn_std_unit<2>(F, P, O, b, qb * 256, QC + h * 128, KC + (h >> 2) * 128, VC + (h >> 2) * 128, QC + h * 128, (hiK - lo) / 64, lo, sinkv[h], true); }
    if (ATT_MASK & 8) for (int u = F.vcu; u < 256; u += F.G) { const int b = u >> 7, h = (u >> 4) & 7, qb = u & 15;
        const int r0 = qb * 4; int rlo, nrow;
        if (r0 == 0) { rlo = 0; nrow = 8; } else if (r0 == 60) { rlo = 56; nrow = 8; } else { rlo = min(r0 - 4, 52); nrow = 12; }
        __syncthreads();
        { LAS float* bl = (LAS float*)(F.lds + att::BIAS_OFF); for (int e = F.tid; e < 15 * 31; e += NWAVES * 64) bl[e] = nab[h * 465 + e] * 11.313708498984761f; }
        attn_std_unit<3>(F, P, O, b, qb * 256, QD + h * 128, KD + h * 128, VD + h * 128, QD + h * 128, nrow, rlo * 64, 0.f, false); }
    __syncthreads();
}

__global__ void __launch_bounds__(NWAVES * 64, 2) fwd_kernel(Args args) {
    extern __shared__ __attribute__((aligned(16))) unsigned char lds[];
    Frame F;
    F.lds = (LAS unsigned char*)lds;
    volatile LAS unsigned* MISC = (volatile LAS unsigned*)(F.lds + MISC_OFF);
    F.tid = threadIdx.x; F.lane = F.tid & 63; F.wave = __builtin_amdgcn_readfirstlane(F.tid >> 6);
    F.G = gridDim.x; { const int bx = blockIdx.x; F.vcu = (F.G % 8 == 0) ? (bx % 8) * (F.G / 8) + bx / 8 : bx; }
    KArgs ap = (KArgs)__builtin_amdgcn_kernarg_segment_ptr();
    F.ws = ap->ws;
    gu32* ctl = (gu32*)(F.ws + WS_CTL);
    for (int u = F.tid; u < (LDS_BYTES - LDSCTL_OFF) / 4; u += NWAVES * 64) ((LAS unsigned*)(F.lds + LDSCTL_OFF))[u] = 0u;
    __syncthreads();
    const int lo = ap->ph_lo, hi = ap->ph_hi;
    XcdBarrier bar; bar.bar = (unsigned*)(ctl + CW_BAR); bar.x = 0; bar.st = nullptr;
    if (hi - lo > 1) bar = xcd_barrier_post((unsigned*)(ctl + CW_BAR), MISC + 8);
#ifndef PH_MASK
#define PH_MASK 0x7ff
#endif
#ifndef REP_PRO
#define REP_PRO 1
#endif
#ifndef REP_ATT
#define REP_ATT 1
#endif
#ifndef REP_GEMM
#define REP_GEMM 1
#endif
#ifndef REP_CONV
#define REP_CONV 1
#endif
#define IN(k) (lo <= (k) && (k) < hi)
#define FRESH() asm volatile("" : "+v"(F.tid), "+v"(F.lane), "+s"(ap))
#define EN(j) (((PH_MASK) >> (j)) & 1)
#define SEAM(k) do { if (IN(k) && IN((k) + 1)) xcd_barrier(bar); } while (0)

    if (EN(0) && IN(0)) { for (int rep = 0; rep < REP_PRO; ++rep) { FRESH(); phase_prologue(F, ap); __syncthreads(); } } SEAM(0);
    if (EN(1) && IN(1)) { FRESH(); phase_r0(F, ap); } SEAM(1);
    for (int l = 0; l < 2; ++l) {
        const bool last = (l == 1); const int pb = 2 + 8 * l;
        const pg8::bf16_t* HX = (const pg8::bf16_t*)(F.ws + WS_HX);
        if (EN(2) && IN(pb + 0)) {
            pg8::Gemm g{HX, (const pg8::bf16_t*)(F.ws + WS_WIN + (size_t)l * 72 * MiB), MROWS, NIN, DM};
            pg8::StaticOrder S; S.init(MROWS / 256, NIN, DM, F.G, fresh_bx(), 0);
            { FRESH(); const f32x4* tg = (const f32x4*)(F.ws + WS_TAB); LAS f32x4* tl = (LAS f32x4*)(F.lds + THD_OFF);
              for (int e = F.tid; e < 1024; e += NWAVES * 64) tl[e] = tg[e];
              LAS float* gl = (LAS float*)(F.lds + GAINS_OFF); if (F.tid < 256) gl[F.tid] = (F.tid < 128 ? ap->in[12] + l * 128 : ap->in[13] + l * 128 - 128)[F.tid];
              __syncthreads(); }
            pg8::EpiInProj E{(pg8::bf16_t*)(F.ws + WS_P), NIN, (const LAS float*)(F.lds + THD_OFF), (const LAS float*)(F.lds + GAINS_OFF), (LAS float*)(F.lds + XCH_OFF)};
            pg8::gemm_phase<pg8::EpiInProj, pg8::StaticOrder, true>(F.lds + RING_OFF, g, S, E);
            if (F.G == 256) tail_convert(F, ap, (34 * 36) % 256, 1, l, -1, 0);
        } SEAM(pb + 0);
        if (EN(4) && IN(pb + 1)) { for (int rep = 0; rep < REP_ATT; ++rep) { FRESH(); phase_attention(F, ap, l, last); } } SEAM(pb + 1);
        if (EN(5) && IN(pb + 2)) {
            pg8::Gemm g{(const pg8::bf16_t*)(F.ws + WS_O), (const pg8::bf16_t*)(F.ws + WS_WOUT + (size_t)l * 32 * MiB), MROWS, DM, DM};
            pg8::SplitOrder S; S.init(DM, DM, F.G, fresh_bx()); if (last) S.ca = 0;
            pg8::EpiSplit E{(pg8::bf16_t*)(F.ws + WS_Y), (float*)(F.ws + WS_PART), DM};
            pg8::gemm_phase<pg8::EpiSplit, pg8::SplitOrder, true>(F.lds + RING_OFF, g, S, E);
        } SEAM(pb + 2);
        if (EN(6) && IN(pb + 3)) { FRESH(); phase_r1(F, ap, l, last); } SEAM(pb + 3);
        if (EN(7) && IN(pb + 4)) {
            pg8::Gemm g{HX, (const pg8::bf16_t*)(F.ws + WS_WUP + (size_t)l * 172 * MiB), MROWS, NUP, DM};
            pg8::StaticOrder S; S.init(last ? 32 : 34, NUP, DM, F.G, fresh_bx(), last ? 1 : 0);
            pg8::EpiUpConv E{(pg8::bf16_t*)(F.ws + WS_ACT), (float*)(F.ws + WS_U), ap->in[22] + (size_t)l * 3 * NUP, (LAS float*)(F.lds + XCH_OFF), DFF, (LAS float*)(F.lds + WL_OFF), (LAS float*)(F.lds + GAINS_OFF), 0};
            pg8::gemm_phase<pg8::EpiUpConv, pg8::StaticOrder, true>(F.lds + RING_OFF, g, S, E);
            if (F.G == 256) { if (!last) tail_convert(F, ap, (34 * 86) % 256, 3, 0, 0, 1); else tail_convert(F, ap, (32 * 86) % 256, 3, 1, -1, 0); }
        } SEAM(pb + 4);
        if (EN(8) && IN(pb + 5)) { for (int rep = 0; rep < REP_CONV; ++rep) { FRESH(); phase_fixup(F, ap, l, last); } } SEAM(pb + 5);
        if (EN(9) && IN(pb + 6)) {
            pg8::Gemm g{(const pg8::bf16_t*)(F.ws + WS_ACT), (const pg8::bf16_t*)(F.ws + WS_WDN + (size_t)l * 86 * MiB), MROWS, DM, DFF};
            pg8::SplitOrder S; S.init(DM, DFF, F.G, fresh_bx()); if (last) S.ca = 0;
            pg8::EpiSplit E{(pg8::bf16_t*)(F.ws + WS_Y), (float*)(F.ws + WS_PART), DM};
            pg8::gemm_phase<pg8::EpiSplit, pg8::SplitOrder, true>(F.lds + RING_OFF, g, S, E);
        } SEAM(pb + 6);
        if (EN(10) && IN(pb + 7)) { FRESH(); phase_r2(F, ap, l, last); } SEAM(pb + 7);
    }
#undef IN
#undef SEAM
}

extern "C" void kernel_launch(void* const* d_in, const int* in_sizes, int n_in, void* d_out, int out_size, void* d_ws, size_t ws_size, hipStream_t stream) {
    static int grid = 0;
    if (grid == 0) {
        if (n_in != 24 || in_sizes[0] != NB * SEQ * DM || out_size != NB * SEQ * DM || ws_size < WS_END) {
            fprintf(stderr, "kernel_launch: unexpected shapes: n_in %d in0 %d out %d ws %zu (need %zu); nothing launched\n", n_in, n_in > 0 ? in_sizes[0] : -1, out_size, ws_size, (size_t)WS_END); grid = -1; return; }
        int dev = 0, cus = 0, per_cu = 0;
        if (hipGetDevice(&dev) != hipSuccess || hipDeviceGetAttribute(&cus, hipDeviceAttributeMultiprocessorCount, dev) != hipSuccess) { grid = -1; return; }
        if (hipFuncSetAttribute((const void*)fwd_kernel, hipFuncAttributeMaxDynamicSharedMemorySize, LDS_BYTES) != hipSuccess) { fprintf(stderr, "kernel_launch: hipFuncSetAttribute failed\n"); grid = -1; return; }
        if (hipOccupancyMaxActiveBlocksPerMultiprocessor(&per_cu, (const void*)fwd_kernel, NWAVES * 64, LDS_BYTES) != hipSuccess || per_cu < 1)
            fprintf(stderr, "kernel_launch: note: occupancy query reports %d workgroups per CU\n", per_cu);
        (void)hipGetLastError();
        grid = cus;
    }
    if (grid < 0) return;
    if (hipMemsetAsync((char*)d_ws + WS_CTL, 0, CTL_ZERO_BYTES, stream) != hipSuccess) return;
    Args a{};
    for (int i = 0; i < 24; ++i) a.in[i] = (const float*)d_in[i];
    a.out = (float*)d_out; a.ws = (unsigned char*)d_ws;
#if MK_SINGLE
    a.ph_lo = 0; a.ph_hi = NPHASE;
    hipLaunchKernelGGL(fwd_kernel, dim3(grid), dim3(NWAVES * 64), LDS_BYTES, stream, a);
#else
    for (int p = 0; p < NPHASE; ++p) { a.ph_lo = p; a.ph_hi = p + 1; hipLaunchKernelGGL(fwd_kernel, dim3(grid), dim3(NWAVES * 64), LDS_BYTES, stream, a); }
#endif
    const hipError_t le = hipPeekAtLastError();
    if (le != hipSuccess) fprintf(stderr, "kernel_launch: launch failed: %s\n", hipGetErrorName(le));
}
```

```cpp
#include <hip/hip_runtime.h>
#include <cstdio>
#include <cstdint>

#ifndef MK_SINGLE
#define MK_SINGLE 1
#endif

namespace pg8 {
#define PG8_LAS __attribute__((address_space(3)))
typedef unsigned short bf16_t;
typedef short bf16x8 __attribute__((ext_vector_type(8)));
typedef float f32x4 __attribute__((ext_vector_type(4)));
typedef unsigned u32x4 __attribute__((ext_vector_type(4)));
constexpr int BM = 256, BK = 64, HALF = 128, HTB = HALF * BK * 2, STAGE_BYTES = 8 * HTB, NXCD = 8, WGM = 8;

__host__ __device__ __forceinline__ int lds_byte(int r, int c) { const int st = (r >> 4) * 2 + (c >> 5), rr = r & 15, cc = c & 31, ob = rr * 64 + cc * 2; return st * 1024 + (ob ^ (((ob >> 9) & 1) << 5)); }
__host__ __device__ __forceinline__ void stage_rc(int b, int& R, int& C) { const int st = b / 1024, sb = b % 1024, swz = sb ^ (((sb >> 9) & 1) << 5); R = (st >> 1) * 16 + swz / 64; C = (st & 1) * 32 + (swz % 64) / 2; }
__host__ __device__ __forceinline__ int perm32(int rho) { const int n = rho >> 4, i = rho & 15; return 8 * (i >> 2) + 4 * n + (i & 3); }

struct Unit { int pm, pn, kt0, nt, slab; };
struct Gemm { const bf16_t* A; const bf16_t* Bt; int M, N, K; };

struct StaticOrder {
    int nM, nN, nwg, G, c, skip, ntk;
    __host__ __device__ void init(int nM_, int N, int K, int G_, int c_, int skip_) { nM = nM_; nN = N / BM; nwg = nM * nN; G = G_; c = c_; skip = skip_; ntk = K / BK; }
    __host__ __device__ bool at(long L, Unit& u) const {
        if (L >= nwg) return false;
        int wgid = (int)L; { const int q = nwg / NXCD, r = nwg % NXCD, xcd = wgid % NXCD, off = wgid / NXCD; wgid = (xcd < r ? xcd * (q + 1) : r * (q + 1) + (xcd - r) * q) + off; }
        const int nig = WGM * nN, gid = wgid / nig, fm = gid * WGM, gsz = (nM - fm) < WGM ? (nM - fm) : WGM;
        u.pm = fm + ((wgid % nig) % gsz); u.pn = (wgid % nig) / gsz; u.kt0 = 0; u.nt = ntk; u.slab = -1;
        if (skip && u.pm >= 16) u.pm += 1;
        return true;
    }
    __host__ __device__ bool next(int i, Unit& u) const { return at((long)i * G + c, u); }
    __device__ __forceinline__ void a_ready(const Unit&) const {}
    __device__ __forceinline__ void done(const Unit&) const {}
};
struct SplitOrder {
    StaticOrder so; int ca, cb;
    __host__ __device__ void init(int N, int K, int G_, int c_) { so.init(32, N, K, G_, c_, 1); const int ntk = K / BK; ca = ((ntk / 8 + 1) / 2) * 2; cb = (ntk - 6 * ca) / 2; if (6 * ca + 2 * cb != ntk || (cb & 1) || cb <= 0) { ca = ntk / 8; cb = ca; } }
    __host__ __device__ bool next(int i, Unit& u) const {
        const long L = (long)i * so.G + so.c;
        if (L < so.nwg) return so.at(L, u);
        const int q = (int)(L - so.nwg); if (ca == 0 || q >= 256) return false;
        const int ch = q & 7, pn = (q >> 3) & 15, pp = q >> 7;
        u.pm = pp ? 33 : 16; u.pn = pn; u.slab = ch; u.kt0 = ch < 6 ? ca * ch : 6 * ca + cb * (ch - 6); u.nt = ch < 6 ? ca : cb;
        return true;
    }
    __device__ __forceinline__ void a_ready(const Unit&) const {}
    __device__ __forceinline__ void done(const Unit&) const {}
};

__device__ __forceinline__ unsigned cvt_pk_bf16(float lo, float hi) { unsigned r; asm volatile("v_cvt_pk_bf16_f32 %0, %1, %2" : "=v"(r) : "v"(lo), "v"(hi)); return r; }

struct EpiBf16 {
    static constexpr bool PERM = true, AFTER_DRAIN = false, PREFETCH = false;
    bf16_t* O; int ldc;
    __device__ __forceinline__ void operator()(const f32x4 (&acc)[2][2][4][2], const Unit& u, int wr, int wc, int fr, int fq) const {
        const int row0 = u.pm * BM + wr * 64 + fr; const int col0 = u.pn * BM + wc * 32 + 8 * fq;
#pragma unroll
        for (int ai = 0; ai < 2; ++ai)
#pragma unroll
            for (int m = 0; m < 4; ++m) { bf16_t* rowp = O + (size_t)(row0 + ai * HALF + m * 16) * ldc + col0;
#pragma unroll
                for (int bj = 0; bj < 2; ++bj) { const f32x4 v0 = acc[ai][bj][m][0], v1 = acc[ai][bj][m][1];
                    u32x4 w; w.x = cvt_pk_bf16(v0[0], v0[1]); w.y = cvt_pk_bf16(v0[2], v0[3]); w.z = cvt_pk_bf16(v1[0], v1[1]); w.w = cvt_pk_bf16(v1[2], v1[3]);
                    *(u32x4*)(rowp + bj * HALF) = w; } }
    }
};

struct EpiSplit {
    static constexpr bool PERM = true, AFTER_DRAIN = false, PREFETCH = false;
    bf16_t* O; float* part; int ldc;
    __device__ __forceinline__ void operator()(const f32x4 (&acc)[2][2][4][2], const Unit& u, int wr, int wc, int fr, int fq) const {
        const int col0 = u.pn * BM + wc * 32 + 8 * fq;
        if (u.slab < 0) {
            const int row0 = u.pm * BM + wr * 64 + fr;
#pragma unroll
            for (int ai = 0; ai < 2; ++ai)
#pragma unroll
                for (int m = 0; m < 4; ++m) { bf16_t* rowp = O + (size_t)(row0 + ai * HALF + m * 16) * ldc + col0;
#pragma unroll
                    for (int bj = 0; bj < 2; ++bj) { const f32x4 v0 = acc[ai][bj][m][0], v1 = acc[ai][bj][m][1];
                        u32x4 w; w.x = cvt_pk_bf16(v0[0], v0[1]); w.y = cvt_pk_bf16(v0[2], v0[3]); w.z = cvt_pk_bf16(v1[0], v1[1]); w.w = cvt_pk_bf16(v1[2], v1[3]);
                        *(u32x4*)(rowp + bj * HALF) = w; } }
        } else {
            const int row0 = (u.pm == 16 ? 0 : 256) + wr * 64 + fr; float* pb = part + (size_t)u.slab * 512 * ldc;
#pragma unroll
            for (int ai = 0; ai < 2; ++ai)
#pragma unroll
                for (int m = 0; m < 4; ++m) { float* rowp = pb + (size_t)(row0 + ai * HALF + m * 16) * ldc + col0;
#pragma unroll
                    for (int bj = 0; bj < 2; ++bj) { *(f32x4*)(rowp + bj * HALF) = acc[ai][bj][m][0]; *(f32x4*)(rowp + bj * HALF + 4) = acc[ai][bj][m][1]; } }
        }
    }
};

struct EpiInProj {
    static constexpr bool PERM = true, AFTER_DRAIN = false, PREFETCH = false;
    bf16_t* O; int ldc; const PG8_LAS float* thd; const PG8_LAS float* gains; PG8_LAS float* xch;
    __device__ __forceinline__ void operator()(f32x4 (&acc)[2][2][4][2], const Unit& u, int wr, int wc, int fr, int fq) const {
        const int pmb = u.pm % 17; const bool ctx = (pmb == 16); const int pn = u.pn;
        const int kind = pn < 4 ? 1 : pn < 8 ? 2 : pn < 12 ? 3 : pn < 16 ? 0 : pn == 16 ? 4 : pn < 18 ? 0 : pn < 22 ? 2 : pn == 26 ? 3 : 0;
        if (kind == 1 || kind == 4) {
            const PG8_LAS float* g = gains + (kind == 1 ? 0 : 128) + wc * 32 + 8 * fq;
            const f32x4 g0 = *(const PG8_LAS f32x4*)g, g1 = *(const PG8_LAS f32x4*)(g + 4);
#pragma unroll
            for (int ai = 0; ai < 2; ++ai)
#pragma unroll
                for (int m = 0; m < 4; ++m)
#pragma unroll
                    for (int bj = 0; bj < 2; ++bj) { const f32x4 a = acc[ai][bj][m][0], b = acc[ai][bj][m][1];
                        float s = (a[0] * a[0] + a[1] * a[1]) + (a[2] * a[2] + a[3] * a[3]) + (b[0] * b[0] + b[1] * b[1]) + (b[2] * b[2] + b[3] * b[3]);
                        s += __shfl_xor(s, 16); s += __shfl_xor(s, 32);
                        if (fq == 0) xch[((ai * HALF + wr * 64 + m * 16 + fr) * 2 + bj) * 4 + wc] = s; }
            asm volatile("s_waitcnt lgkmcnt(0)" ::: "memory"); __builtin_amdgcn_s_barrier(); asm volatile("" ::: "memory");
#pragma unroll
            for (int ai = 0; ai < 2; ++ai)
#pragma unroll
                for (int m = 0; m < 4; ++m)
#pragma unroll
                    for (int bj = 0; bj < 2; ++bj) { const f32x4 p = *(const PG8_LAS f32x4*)(xch + ((ai * HALF + wr * 64 + m * 16 + fr) * 2 + bj) * 4);
                        const float rstd = __builtin_amdgcn_rsqf(((p[0] + p[1]) + (p[2] + p[3])) * (1.f / 128.f) + 1e-6f);
                        acc[ai][bj][m][0] = acc[ai][bj][m][0] * rstd * g0; acc[ai][bj][m][1] = acc[ai][bj][m][1] * rstd * g1; }
        }
        if (kind != 0 && !ctx) {
            const bool dh = (kind == 2);
#pragma unroll
            for (int ai = 0; ai < 2; ++ai)
#pragma unroll
                for (int m = 0; m < 4; ++m) { const int t = pmb * 256 + ai * HALF + wr * 64 + m * 16 + fr; const int grow = t >> 6, gcol = t & 63;
                    f32x4 c01, c23;
                    if (!dh) { const PG8_LAS float* tp = thd + (((wc < 2) ? grow : gcol) * 32 + 16 * (wc & 1) + 4 * fq) * 2; c01 = *(const PG8_LAS f32x4*)tp; c23 = *(const PG8_LAS f32x4*)(tp + 4); }
                    else { typedef float f32x2_ __attribute__((ext_vector_type(2))); const PG8_LAS float* tp = thd + ((((wc & 1) == 0) ? grow : gcol) * 32 + 8 * fq) * 2;
                        const f32x2_ e0 = *(const PG8_LAS f32x2_*)tp, e1 = *(const PG8_LAS f32x2_*)(tp + 4), e2 = *(const PG8_LAS f32x2_*)(tp + 8), e3 = *(const PG8_LAS f32x2_*)(tp + 12);
                        c01 = (f32x4){e0.x, e0.y, e1.x, e1.y}; c23 = (f32x4){e2.x, e2.y, e3.x, e3.y}; }
#pragma unroll
                    for (int bj = 0; bj < 2; ++bj) { f32x4 a = acc[ai][bj][m][0], b = acc[ai][bj][m][1];
                        acc[ai][bj][m][0] = (f32x4){a[0] * c01[0] - a[1] * c01[1], a[0] * c01[1] + a[1] * c01[0], a[2] * c01[2] - a[3] * c01[3], a[2] * c01[3] + a[3] * c01[2]};
                        acc[ai][bj][m][1] = (f32x4){b[0] * c23[0] - b[1] * c23[1], b[0] * c23[1] + b[1] * c23[0], b[2] * c23[2] - b[3] * c23[3], b[2] * c23[3] + b[3] * c23[2]}; } }
        }
        const int row0 = u.pm * BM + wr * 64 + fr; const int col0 = u.pn * BM + wc * 32 + 8 * fq;
#pragma unroll
        for (int ai = 0; ai < 2; ++ai)
#pragma unroll
            for (int m = 0; m < 4; ++m) { bf16_t* rowp = O + (size_t)(row0 + ai * HALF + m * 16) * ldc + col0;
#pragma unroll
                for (int bj = 0; bj < 2; ++bj) { const f32x4 v0 = acc[ai][bj][m][0], v1 = acc[ai][bj][m][1];
                    u32x4 w; w.x = cvt_pk_bf16(v0[0], v0[1]); w.y = cvt_pk_bf16(v0[2], v0[3]); w.z = cvt_pk_bf16(v1[0], v1[1]); w.w = cvt_pk_bf16(v1[2], v1[3]);
                    *(u32x4*)(rowp + bj * HALF) = w; } }
    }
};

struct EpiUpConv {
    static constexpr bool PERM = true, AFTER_DRAIN = false, PREFETCH = true;
    bf16_t* ACT; float* side; const float* cw; PG8_LAS float* xb; int dff; PG8_LAS float* wl0; PG8_LAS float* wl1; mutable int par;
    __device__ __forceinline__ void prefetch(const Unit& u, int parity, int wid, int lane) const {
        if (wid == 0) { PG8_LAS float* wl = parity ? wl1 : wl0;
#pragma unroll
            for (int i = 0; i < 3; ++i) { const int q = 64 * i + lane, bt = q >> 5, c4 = q & 31, bj = bt / 3, tap = bt - 3 * bj;
                __builtin_amdgcn_global_load_lds((const unsigned*)(cw + (size_t)tap * 2 * dff + bj * dff + u.pn * 128 + 4 * c4), (PG8_LAS unsigned*)(wl + 256 * i), 16, 0, 0); } }
    }
    static __device__ __forceinline__ float dppf(float old, float src, const int ctrl_sel) {
        const int o = __float_as_int(old), s = __float_as_int(src); int r;
        if (ctrl_sel == 0) r = __builtin_amdgcn_update_dpp(o, s, 0x111, 0xF, 0xF, false);
        else if (ctrl_sel == 1) r = __builtin_amdgcn_update_dpp(o, s, 0x101, 0xF, 0xF, false);
        else if (ctrl_sel == 2) r = __builtin_amdgcn_update_dpp(o, s, 0x121, 0xF, 0xF, false);
        else r = __builtin_amdgcn_update_dpp(o, s, 0x12F, 0xF, 0xF, false);
        return __int_as_float(r);
    }
    static __device__ __forceinline__ f32x4 dpp4(const f32x4 old, const f32x4 src, const int c) { return (f32x4){dppf(old[0], src[0], c), dppf(old[1], src[1], c), dppf(old[2], src[2], c), dppf(old[3], src[3], c)}; }
    static __device__ __forceinline__ int xidx(int ai, int wr, int wc, int which, int bj, int fq, int n) { return ((((((ai * 2 + wr) * 4 + wc) * 2 + which) * 2 + bj) * 4 + fq) * 2 + n) * 4; }
    __device__ __forceinline__ void operator()(const f32x4 (&acc)[2][2][4][2], const Unit& u, int wr, int wc, int fr, int fq) const {
        const int cbase = wc * 32 + 8 * fq;
        f32x4 wts[2][2][3];
#pragma unroll
        for (int bj = 0; bj < 2; ++bj)
#pragma unroll
            for (int n = 0; n < 2; ++n)
#pragma unroll
                for (int j = 0; j < 3; ++j) wts[bj][n][j] = *(const PG8_LAS f32x4*)((par ? wl1 : wl0) + (bj * 3 + j) * 128 + cbase + 4 * n);
#pragma unroll
        for (int ai = 0; ai < 2; ++ai)
#pragma unroll
            for (int bj = 0; bj < 2; ++bj)
#pragma unroll
                for (int n = 0; n < 2; ++n) {
                    if (fr == 0) *(PG8_LAS f32x4*)(xb + xidx(ai, wr, wc, 0, bj, fq, n)) = acc[ai][bj][0][n];
                    if (fr == 15) *(PG8_LAS f32x4*)(xb + xidx(ai, wr, wc, 1, bj, fq, n)) = acc[ai][bj][3][n]; }
        { float* sp = side + (size_t)u.pm * 4 * (2 * dff) + (size_t)u.pn * 256 + cbase;
          if (wr == 0 && fr < 2) {
#pragma unroll
              for (int bj = 0; bj < 2; ++bj)
#pragma unroll
                  for (int n = 0; n < 2; ++n) *(f32x4*)(sp + (size_t)fr * (2 * dff) + bj * 128 + 4 * n) = acc[0][bj][0][n]; }
          if (wr == 1 && fr >= 14) {
#pragma unroll
              for (int bj = 0; bj < 2; ++bj)
#pragma unroll
                  for (int n = 0; n < 2; ++n) *(f32x4*)(sp + (size_t)(fr - 12) * (2 * dff) + bj * 128 + 4 * n) = acc[1][bj][3][n]; } }
        asm volatile("s_waitcnt lgkmcnt(0)" ::: "memory"); __builtin_amdgcn_s_barrier(); asm volatile("" ::: "memory");
        const f32x4 zero4 = {0.f, 0.f, 0.f, 0.f};
#pragma unroll
        for (int ai = 0; ai < 2; ++ai)
#pragma unroll
            for (int m = 0; m < 4; ++m) {
                const int beta = 2 * ai + wr;
                u32x4 w;
#pragma unroll
                for (int n = 0; n < 2; ++n) {
                    f32x4 res[2];
#pragma unroll
                    for (int bj = 0; bj < 2; ++bj) {
                        const f32x4 cur = acc[ai][bj][m][n];
                        f32x4 oldp, oldn;
                        if (m > 0) oldp = dpp4(zero4, acc[ai][bj][m - 1][n], 2);
                        else if (beta > 0) oldp = *(const PG8_LAS f32x4*)(xb + xidx((beta - 1) >> 1, (beta - 1) & 1, wc, 1, bj, fq, n));
                        else oldp = zero4;
                        if (m < 3) oldn = dpp4(zero4, acc[ai][bj][m + 1][n], 3);
                        else if (beta < 3) oldn = *(const PG8_LAS f32x4*)(xb + xidx((beta + 1) >> 1, (beta + 1) & 1, wc, 0, bj, fq, n));
                        else oldn = zero4;
                        const f32x4 prev = dpp4(oldp, cur, 0), next = dpp4(oldn, cur, 1);
                        res[bj] = prev * wts[bj][n][0] + cur * wts[bj][n][1] + next * wts[bj][n][2];
                    }
                    f32x4 o;
#pragma unroll
                    for (int e = 0; e < 4; ++e) o[e] = res[0][e] * __builtin_amdgcn_rcpf(1.f + __expf(-res[0][e])) * res[1][e];
                    if (n == 0) { w.x = cvt_pk_bf16(o[0], o[1]); w.y = cvt_pk_bf16(o[2], o[3]); } else { w.z = cvt_pk_bf16(o[0], o[1]); w.w = cvt_pk_bf16(o[2], o[3]); }
                }
                *(u32x4*)(ACT + (size_t)(u.pm * BM + ai * HALF + wr * 64 + m * 16 + fr) * dff + u.pn * 128 + cbase) = w;
            }
    }
};

template <class Epi, class Sched, bool ALIGN_EPI = false>
__device__ __forceinline__ void gemm_phase(PG8_LAS unsigned char* lds, const Gemm g, const Sched& S, const Epi& E) {
    int tid_ = threadIdx.x; asm volatile("" : "+v"(tid_));
    const int tid = tid_, wid = __builtin_amdgcn_readfirstlane(tid >> 6), lane = tid & 63, wr = wid >> 2, wc = wid & 3, fr = lane & 15, fq = lane >> 4;
    const int K = g.K;
    unsigned voffA[2], voffB[2];
#pragma unroll
    for (int i = 0; i < 2; ++i) { int R, C; stage_rc(tid * 16 + i * 8192, R, C); const int Rb = Epi::PERM ? ((R & ~31) + perm32(R & 31)) : R;
        voffA[i] = (unsigned)(R * K + C) * 2u; voffB[i] = (unsigned)(Rb * K + C) * 2u; }
    const size_t kstep = (size_t)(BK * 2);
    const size_t hstep = (size_t)HALF * K * 2;
    const size_t tstep = 2 * hstep;
    const unsigned ldsw = (unsigned)wid * 1024u;
    const int aoff = lds_byte(wr * 64 + fr, fq * 8), boff = lds_byte(wc * 32 + fr, fq * 8);
#define PG8_SA(b, h) (((b) * 2 + (h)) * HTB)
#define PG8_SB(b, h) ((4 + (b) * 2 + (h)) * HTB)
#define PG8_STAGE(bufoff, gbase, voff) do { _Pragma("unroll") for (int _i = 0; _i < 2; ++_i) \
        __builtin_amdgcn_global_load_lds((const unsigned*)((const char*)(gbase) + (voff)[_i]), (PG8_LAS unsigned*)(lds + (bufoff) + ldsw + _i * 8192), 16, 0, 0); } while (0)
#define PG8_LDA(dst, b, h) do { _Pragma("unroll") for (int m = 0; m < 4; ++m) _Pragma("unroll") for (int k = 0; k < 2; ++k) dst[m][k] = *(const PG8_LAS bf16x8*)(lds + PG8_SA(b, h) + aoff + m * 2048 + k * 1024); } while (0)
#define PG8_LDB(dst, b, h) do { _Pragma("unroll") for (int n = 0; n < 2; ++n) _Pragma("unroll") for (int k = 0; k < 2; ++k) dst[n][k] = *(const PG8_LAS bf16x8*)(lds + PG8_SB(b, h) + boff + n * 2048 + k * 1024); } while (0)
#define PG8_MMA(ai, bj, At, Bt) do { __builtin_amdgcn_s_setprio(1); _Pragma("unroll") for (int m = 0; m < 4; ++m) _Pragma("unroll") for (int n = 0; n < 2; ++n) _Pragma("unroll") for (int k = 0; k < 2; ++k) \
        acc[ai][bj][m][n] = __builtin_amdgcn_mfma_f32_16x16x32_bf16(Bt[n][k], At[m][k], acc[ai][bj][m][n], 0, 0, 0); __builtin_amdgcn_s_setprio(0); } while (0)
#define PG8_WAIT_V(n) asm volatile("s_waitcnt vmcnt(" #n ")" ::: "memory")
#define PG8_WAIT_L(n) asm volatile("s_waitcnt lgkmcnt(" #n ")" ::: "memory")
#define PG8_BAR __builtin_amdgcn_s_barrier()
#define PG8_SCHED __builtin_amdgcn_sched_barrier(0)
    Unit cur, nxt; int ui = 0;
    if (!S.next(0, cur)) return;
    f32x4 acc[2][2][4][2];
#pragma unroll
    for (int a = 0; a < 2; ++a)
#pragma unroll
        for (int b = 0; b < 2; ++b)
#pragma unroll
            for (int m = 0; m < 4; ++m)
#pragma unroll
                for (int n = 0; n < 2; ++n) acc[a][b][m][n] = (f32x4){0.f, 0.f, 0.f, 0.f};
    bf16x8 At[4][2], B0[2][2], B1[2][2];
    const char* cA = (const char*)g.A + (size_t)cur.pm * tstep + (size_t)cur.kt0 * kstep; const char* cB = (const char*)g.Bt + (size_t)cur.pn * tstep + (size_t)cur.kt0 * kstep;
    S.a_ready(cur);
    if constexpr (Epi::PREFETCH) E.prefetch(cur, 0, wid, lane);
    PG8_STAGE(PG8_SB(0, 0), cB, voffB); PG8_STAGE(PG8_SB(0, 1), cB + hstep, voffB); PG8_STAGE(PG8_SA(0, 0), cA, voffA); PG8_STAGE(PG8_SA(0, 1), cA + hstep, voffA);
    if (wr == 1) PG8_BAR;
    PG8_WAIT_V(2); PG8_BAR;
    PG8_STAGE(PG8_SB(1, 0), cB + kstep, voffB); PG8_STAGE(PG8_SA(1, 0), cA + kstep, voffA); PG8_STAGE(PG8_SB(1, 1), cB + hstep + kstep, voffB);
    PG8_WAIT_V(6); PG8_BAR;
    for (;;) {
        const bool has_next = S.next(ui + 1, nxt);
        const char* nA = has_next ? (const char*)g.A + (size_t)nxt.pm * tstep + (size_t)nxt.kt0 * kstep : cA; const char* nB = has_next ? (const char*)g.Bt + (size_t)nxt.pn * tstep + (size_t)nxt.kt0 * kstep : cB;
        const int nt = cur.nt;
        for (int t = 0; t < nt; t += 2) {
            const bool last = (t == nt - 2);
            const char* a1 = cA + (size_t)(t + 1) * kstep;
            const char* a2 = last ? nA : cA + (size_t)(t + 2) * kstep; const char* b2 = last ? nB : cB + (size_t)(t + 2) * kstep;
            const char* a3 = a2 + kstep; const char* b3 = b2 + kstep;
            if (last && has_next) S.a_ready(nxt);
            PG8_LDB(B0, 0, 0); PG8_LDB(B1, 0, 1); PG8_SCHED; PG8_LDA(At, 0, 0); PG8_STAGE(PG8_SA(1, 1), a1 + hstep, voffA);
            PG8_WAIT_V(8); PG8_WAIT_L(0); PG8_BAR; PG8_MMA(0, 0, At, B0); PG8_MMA(0, 1, At, B1); PG8_BAR; PG8_SCHED;
            PG8_LDA(At, 0, 1); PG8_STAGE(PG8_SB(0, 0), b2, voffB); PG8_STAGE(PG8_SB(0, 1), b2 + hstep, voffB); PG8_STAGE(PG8_SA(0, 0), a2, voffA);
            PG8_WAIT_V(8); PG8_WAIT_L(0); PG8_BAR; PG8_MMA(1, 0, At, B0); PG8_MMA(1, 1, At, B1); PG8_BAR; PG8_SCHED;
            PG8_LDB(B0, 1, 0); PG8_LDB(B1, 1, 1); PG8_SCHED; PG8_LDA(At, 1, 0); PG8_STAGE(PG8_SA(0, 1), a2 + hstep, voffA);
            PG8_WAIT_V(8); PG8_WAIT_L(0); PG8_BAR; PG8_MMA(0, 0, At, B0); PG8_MMA(0, 1, At, B1); PG8_BAR; PG8_SCHED;
            PG8_LDA(At, 1, 1); PG8_STAGE(PG8_SB(1, 0), b3, voffB); PG8_STAGE(PG8_SB(1, 1), b3 + hstep, voffB); PG8_STAGE(PG8_SA(1, 0), a3, voffA);
            PG8_WAIT_V(8); PG8_WAIT_L(0); PG8_BAR; PG8_MMA(1, 0, At, B0); PG8_MMA(1, 1, At, B1); PG8_BAR; PG8_SCHED;
        }
        if constexpr (ALIGN_EPI) { if (wr == 0) PG8_BAR; }
        if constexpr (Epi::PREFETCH) { if (has_next) E.prefetch(nxt, (ui + 1) & 1, wid, lane); }
        if constexpr (!Epi::AFTER_DRAIN) { if constexpr (Epi::PREFETCH) E.par = ui & 1; E(acc, cur, wr, wc, fr, fq); S.done(cur); }
        if (!has_next) break;
#pragma unroll
        for (int a = 0; a < 2; ++a)
#pragma unroll
            for (int b = 0; b < 2; ++b)
#pragma unroll
                for (int m = 0; m < 4; ++m)
#pragma unroll
                    for (int n = 0; n < 2; ++n) acc[a][b][m][n] = (f32x4){0.f, 0.f, 0.f, 0.f};
        cur = nxt; cA = nA; cB = nB; ++ui;
        if constexpr (ALIGN_EPI) { if (wr == 1) PG8_BAR; }
    }
    PG8_WAIT_V(0);
    if constexpr (!ALIGN_EPI) { if (wr == 0) PG8_BAR; }
    PG8_BAR;
#undef PG8_SA
#undef PG8_SB
#undef PG8_STAGE
#undef PG8_LDA
#undef PG8_LDB
#undef PG8_MMA
#undef PG8_WAIT_V
#undef PG8_WAIT_L
#undef PG8_BAR
#undef PG8_SCHED
}
}

namespace att {
#define ALAS __attribute__((address_space(3)))
typedef unsigned short bf16;
typedef short bf16x8 __attribute__((ext_vector_type(8)));
typedef short s16x4 __attribute__((ext_vector_type(4)));
typedef float f32x16 __attribute__((ext_vector_type(16)));
typedef unsigned u32x4 __attribute__((ext_vector_type(4)));
constexpr int LDP = 9216, LDO = 4096;
constexpr int SLOT = 32768;
constexpr int WSCR_OFF = 131072 + 1024, BIAS_OFF = WSCR_OFF + 2048, SHM_END = BIAS_OFF + 2048;
constexpr int NCTX_T = 4;
#define KSWZ(row, colB) ((row) * 256 + ((colB) ^ (((row) & 7) << 4)))
#define SBAR() __builtin_amdgcn_sched_barrier(0)
__device__ __forceinline__ int crow(int r, int hi) { return (r & 3) + 8 * (r >> 2) + 4 * hi; }
__device__ __forceinline__ unsigned cvtpk(float lo, float hi) { unsigned r; asm volatile("v_cvt_pk_bf16_f32 %0, %1, %2" : "=v"(r) : "v"(lo), "v"(hi)); return r; }

__device__ __forceinline__ void partialSM(f32x16& p0, f32x16& p1, float& m_reg, float& mn, float& alpha, const float C, const float thr_raw) {
    float pmax = p0[0];
#pragma unroll
    for (int r = 1; r < 16; ++r) pmax = fmaxf(pmax, p0[r]);
#pragma unroll
    for (int r = 0; r < 16; ++r) pmax = fmaxf(pmax, p1[r]);
    { auto rr = __builtin_amdgcn_permlane32_swap(__float_as_uint(pmax), __float_as_uint(pmax), false, false);
      pmax = fmaxf(__uint_as_float(rr[0]), __uint_as_float(rr[1])); }
    if (__builtin_expect(__all(pmax - m_reg <= thr_raw), 1)) { mn = m_reg; alpha = 1.f; }
    else { mn = fmaxf(m_reg, pmax); alpha = __builtin_amdgcn_exp2f((m_reg - mn) * C); m_reg = mn; }
    const float mnC = -mn * C;
#pragma unroll
    for (int r = 0; r < 16; ++r) p0[r] = fmaf(p0[r], C, mnC);
#pragma unroll
    for (int r = 0; r < 16; ++r) p1[r] = fmaf(p1[r], C, mnC);
#pragma unroll
    for (int r = 0; r < 16; ++r) p0[r] = __builtin_amdgcn_exp2f(p0[r]);
}
__device__ __forceinline__ void finishSM(f32x16& p0, f32x16& p1, float alpha, float& l_reg, bf16x8& pa0, bf16x8& pa1, bf16x8& pa2, bf16x8& pa3) {
#pragma unroll
    for (int r = 0; r < 16; ++r) p1[r] = __builtin_amdgcn_exp2f(p1[r]);
    float ps = 0;
#pragma unroll
    for (int r = 0; r < 16; ++r) ps += p0[r];
#pragma unroll
    for (int r = 0; r < 16; ++r) ps += p1[r];
    { auto rr = __builtin_amdgcn_permlane32_swap(__float_as_uint(ps), __float_as_uint(ps), false, false);
      ps = __uint_as_float(rr[0]) + __uint_as_float(rr[1]); }
    l_reg = l_reg * alpha + ps;
#define PK4(P, BASE, OUT) do { unsigned a0 = cvtpk(P[BASE + 0], P[BASE + 1]), a1 = cvtpk(P[BASE + 2], P[BASE + 3]);   \
    unsigned b0 = cvtpk(P[BASE + 4], P[BASE + 5]), b1 = cvtpk(P[BASE + 6], P[BASE + 7]);                              \
    auto r0 = __builtin_amdgcn_permlane32_swap(a0, b0, false, false); auto r1 = __builtin_amdgcn_permlane32_swap(a1, b1, false, false); \
    u32x4 w = {r0[0], r1[0], r0[1], r1[1]}; OUT = __builtin_bit_cast(bf16x8, w); } while (0)
    PK4(p0, 0, pa0); PK4(p0, 8, pa1); PK4(p1, 0, pa2); PK4(p1, 8, pa3);
#undef PK4
}
template <int D0LO, int D0N>
__device__ __forceinline__ void qkt(f32x16& p0, f32x16& p1, const ALAS char* Ks, const bf16x8* qr, int r32, int hi) {
    p0 = f32x16{}; p1 = f32x16{};
    __builtin_amdgcn_s_setprio(1);
#pragma unroll
    for (int d0 = D0LO; d0 < D0LO + D0N; ++d0) { const int cb = (d0 * 16 + hi * 8) * 2;
        const bf16x8 b0 = *(const ALAS bf16x8*)(Ks + KSWZ(r32, cb));
        const bf16x8 b1 = *(const ALAS bf16x8*)(Ks + KSWZ(32 + r32, cb));
        p0 = __builtin_amdgcn_mfma_f32_32x32x16_bf16(b0, qr[d0], p0, 0, 0, 0);
        p1 = __builtin_amdgcn_mfma_f32_32x32x16_bf16(b1, qr[d0], p1, 0, 0, 0); }
    __builtin_amdgcn_s_setprio(0);
}
__device__ __forceinline__ int v_st(int k, int c) { const int kk = (k & ~0xC) | ((k & 4) << 1) | ((k & 8) >> 1); return ((kk >> 3) * 4 + (c >> 5)) * 512 + ((kk & 7) * 32 + (c & 31)) * 2; }
__device__ __forceinline__ int v_rd_base(int lane) { return ((lane & 3) << 3) | (((lane >> 2) & 3) << 6) | (((lane >> 4) & 1) << 5) | (((lane >> 5) & 1) << 8); }
constexpr int v_rd_off(int d0, int ks, int half) { return d0 * 512 + ks * 4096 + half * 2048; }
template <int OFF> __device__ __forceinline__ s16x4 tr_read(int vb) {
    s16x4 r; asm volatile("ds_read_b64_tr_b16 %0, %1 offset:%2" : "=&v"(r) : "v"(vb), "i"(OFF) : "memory"); return r;
}
template <int D0> __device__ __forceinline__ void pv_one(f32x16& od, int vb, bf16x8 pa0, bf16x8 pa1, bf16x8 pa2, bf16x8 pa3) {
    const s16x4 l0 = tr_read<v_rd_off(D0, 0, 0)>(vb), h0 = tr_read<v_rd_off(D0, 0, 1)>(vb), l1 = tr_read<v_rd_off(D0, 1, 0)>(vb), h1 = tr_read<v_rd_off(D0, 1, 1)>(vb);
    const s16x4 l2 = tr_read<v_rd_off(D0, 2, 0)>(vb), h2 = tr_read<v_rd_off(D0, 2, 1)>(vb), l3 = tr_read<v_rd_off(D0, 3, 0)>(vb), h3 = tr_read<v_rd_off(D0, 3, 1)>(vb);
    asm volatile("s_waitcnt lgkmcnt(0)" ::: "memory"); SBAR();
#define PK(L, H) (bf16x8){L[0], L[1], L[2], L[3], H[0], H[1], H[2], H[3]}
    od = __builtin_amdgcn_mfma_f32_32x32x16_bf16(pa0, PK(l0, h0), od, 0, 0, 0);
    od = __builtin_amdgcn_mfma_f32_32x32x16_bf16(pa1, PK(l1, h1), od, 0, 0, 0);
    od = __builtin_amdgcn_mfma_f32_32x32x16_bf16(pa2, PK(l2, h2), od, 0, 0, 0);
    od = __builtin_amdgcn_mfma_f32_32x32x16_bf16(pa3, PK(l3, h3), od, 0, 0, 0);
#undef PK
}
__device__ __forceinline__ void pv_d0(f32x16* o, int vb, bf16x8 pa0, bf16x8 pa1, bf16x8 pa2, bf16x8 pa3) {
    __builtin_amdgcn_s_setprio(1);
    pv_one<0>(o[0], vb, pa0, pa1, pa2, pa3); pv_one<1>(o[1], vb, pa0, pa1, pa2, pa3); pv_one<2>(o[2], vb, pa0, pa1, pa2, pa3); pv_one<3>(o[3], vb, pa0, pa1, pa2, pa3);
    __builtin_amdgcn_s_setprio(0);
}

template <int MASK>
__device__ __forceinline__ void apply_mask(f32x16& p0, f32x16& p1, int j, int loc0, int qp, int hi, const ALAS float* bias) {
    if constexpr (MASK == 2) {
        if (j >= NCTX_T) { const int kbase = loc0 + 64 * (j - NCTX_T);
#pragma unroll
            for (int r = 0; r < 16; ++r) { const int d0 = qp - (kbase + crow(r, hi)); const int d1 = d0 - 32;
                if (d0 > 128 || d0 < -128) p0[r] = -1e30f;
                if (d1 > 128 || d1 < -128) p1[r] = -1e30f; } }
    } else if constexpr (MASK == 3) {
        if (j >= NCTX_T) { const int kbase = loc0 + 64 * (j - NCTX_T);
            const int qrow = qp >> 6, qcol = qp & 63; const int rs = min(max(qrow - 4, 0), 56), cs = min(max(qcol - 8, 0), 48);
            const int kr = kbase >> 6; const int dr = kr - rs;
            if (dr < 0 || dr >= 8) {
#pragma unroll
                for (int r = 0; r < 16; ++r) { p0[r] = -1e30f; p1[r] = -1e30f; }
            } else {
                const ALAS float* brow = bias + (kr - qrow + 7) * 31 + 15 - qcol;
#pragma unroll
                for (int r = 0; r < 16; ++r) { const int kc0 = crow(r, hi), kc1 = kc0 + 32;
                    const bool ok0 = (unsigned)(kc0 - cs) < 16u, ok1 = (unsigned)(kc1 - cs) < 16u;
                    const float b0 = brow[ok0 ? kc0 : qcol], b1 = brow[ok1 ? kc1 : qcol];
                    p0[r] = ok0 ? p0[r] + b0 : -1e30f; p1[r] = ok1 ? p1[r] + b1 : -1e30f;
                    if ((r & 3) == 3) asm volatile("" ::: "memory"); }
            }
        }
    }
}

template <int MASK, int D0LO, int D0N>
__device__ __forceinline__ void attn_core(f32x16 (&o)[4], float& m_reg, float& l_reg, const bf16* __restrict__ Qw, const bf16* __restrict__ Kb, const bf16* __restrict__ Vb,
                                          const int nloc, const int loc0, const int qp, const float C, const float thr_raw, ALAS char* lds) {
    int tid_ = threadIdx.x; asm volatile("" : "+v"(tid_));
    const int tid = tid_, wid = __builtin_amdgcn_readfirstlane(tid >> 6), lane = tid & 63, r32 = lane & 31, hi = lane >> 5;
    ALAS float* ws = (ALAS float*)(lds + WSCR_OFF) + wid * 64; ALAS float* al_l = ws + 32;
    const ALAS float* bias = (const ALAS float*)(lds + BIAS_OFF);
    unsigned voffK[2], voffV[2];
#pragma unroll
    for (int i = 0; i < 2; ++i) { const int q = (wid + 8 * i) * 64 + lane;
        { const int row = q >> 4, cc = (q & 15) ^ (row & 7); voffK[i] = (unsigned)(row * (LDP * 2) + cc * 16); }
        { const int kk = (q >> 7) * 8 + ((q & 31) >> 2), c = ((q >> 5) & 3) * 32 + (q & 3) * 8; const int k = (kk & ~0xC) | ((kk & 4) << 1) | ((kk & 8) >> 1); voffV[i] = (unsigned)(k * (LDP * 2) + c * 2); } }
    const int NT = NCTX_T + nloc;
#define KOFF(j) ((j) < NCTX_T ? 4096 + 64 * (j) : loc0 + 64 * ((j) - NCTX_T))
#define ISSUE(j) do { const size_t _ro = (size_t)KOFF(j) * (LDP * 2); const char* _gk = (const char*)Kb + _ro; const char* _gv = (const char*)Vb + _ro; ALAS char* _sl = lds + ((j) & 3) * SLOT + wid * 1024; \
    _Pragma("unroll") for (int _i = 0; _i < 2; ++_i) __builtin_amdgcn_global_load_lds((const unsigned*)(_gk + voffK[_i]), (ALAS unsigned*)(_sl + _i * 8192), 16, 0, 0); \
    _Pragma("unroll") for (int _i = 0; _i < 2; ++_i) __builtin_amdgcn_global_load_lds((const unsigned*)(_gv + voffV[_i]), (ALAS unsigned*)(_sl + 16384 + _i * 8192), 16, 0, 0); } while (0)
#define WAITBAR(n) do { asm volatile("s_waitcnt vmcnt(" #n ") lgkmcnt(0)" ::: "memory"); __builtin_amdgcn_s_barrier(); asm volatile("" ::: "memory"); } while (0)
#define RESC(a) do { if (__any((a) < 1.f)) { if (hi == 0) al_l[r32] = (a); asm volatile("s_waitcnt lgkmcnt(0)" ::: "memory"); \
    _Pragma("unroll") for (int d = 0; d < 4; ++d) _Pragma("unroll") for (int r = 0; r < 16; ++r) o[d][r] *= al_l[crow(r, hi)]; } } while (0)
    asm volatile("s_waitcnt vmcnt(0)" ::: "memory");
    m_reg = -1e30f; l_reg = 0.f;
#pragma unroll
    for (int d = 0; d < 4; ++d) o[d] = f32x16{};
    bf16x8 qr[8];
#pragma unroll
    for (int d0 = 0; d0 < 8; ++d0) qr[d0] = *(const bf16x8*)(Qw + d0 * 16);
    ISSUE(0); ISSUE(1); ISSUE(2);
    const int vb0 = (int)(uintptr_t)lds + 16384 + v_rd_base(lane);
    f32x16 pA0, pA1, pB0, pB1; float mnA, mnB, alA, alB; bf16x8 pa0, pa1, pa2, pa3;
    WAITBAR(8);
    qkt<D0LO, D0N>(pA0, pA1, lds, qr, r32, hi); apply_mask<MASK>(pA0, pA1, 0, loc0, qp, hi, bias); partialSM(pA0, pA1, m_reg, mnA, alA, C, thr_raw);
    WAITBAR(4);
    ISSUE(3);
    for (int j = 1; j + 1 < NT; j += 2) {
        SBAR(); qkt<D0LO, D0N>(pB0, pB1, lds + (j & 3) * SLOT, qr, r32, hi);
        finishSM(pA0, pA1, alA, l_reg, pa0, pa1, pa2, pa3); SBAR();
        pv_d0(o, vb0 + ((j - 1) & 3) * SLOT, pa0, pa1, pa2, pa3); apply_mask<MASK>(pB0, pB1, j, loc0, qp, hi, bias); partialSM(pB0, pB1, m_reg, mnB, alB, C, thr_raw);
        if (j + 2 < NT) { WAITBAR(4); } else { WAITBAR(0); }
        if (j + 3 < NT) ISSUE(j + 3);
        RESC(alB);
        SBAR(); qkt<D0LO, D0N>(pA0, pA1, lds + ((j + 1) & 3) * SLOT, qr, r32, hi);
        finishSM(pB0, pB1, alB, l_reg, pa0, pa1, pa2, pa3); SBAR();
        pv_d0(o, vb0 + (j & 3) * SLOT, pa0, pa1, pa2, pa3); apply_mask<MASK>(pA0, pA1, j + 1, loc0, qp, hi, bias); partialSM(pA0, pA1, m_reg, mnA, alA, C, thr_raw);
        if (j + 3 < NT) { WAITBAR(4); } else { WAITBAR(0); }
        if (j + 4 < NT) ISSUE(j + 4);
        RESC(alA);
    }
    SBAR(); qkt<D0LO, D0N>(pB0, pB1, lds + ((NT - 1) & 3) * SLOT, qr, r32, hi);
    finishSM(pA0, pA1, alA, l_reg, pa0, pa1, pa2, pa3); SBAR();
    pv_d0(o, vb0 + ((NT - 2) & 3) * SLOT, pa0, pa1, pa2, pa3); apply_mask<MASK>(pB0, pB1, NT - 1, loc0, qp, hi, bias); partialSM(pB0, pB1, m_reg, mnB, alB, C, thr_raw);
    RESC(alB);
    finishSM(pB0, pB1, alB, l_reg, pa0, pa1, pa2, pa3); SBAR();
    pv_d0(o, vb0 + ((NT - 1) & 3) * SLOT, pa0, pa1, pa2, pa3);
#undef KOFF
#undef ISSUE
#undef WAITBAR
#undef RESC
}
}

constexpr int NWAVES = 8;
constexpr int DM = 4096, NB = 2, SEQ = 4096, CTXL = 256, TPB = SEQ + CTXL  , MROWS = NB * TPB  ;
constexpr int NIN = 9216, DFF = 11008, NUP = 2 * DFF, NADA = 6 * DM;
constexpr int QA = 0, QB_ = 1024, QC = 2048, QD = 3072, KA = 4096, VA = 4352, KB_ = 4608, VB_ = 5632, KC = 6656, VC = 6912, KD = 7168, VD = 8192;
constexpr float EPS = 1e-6f;
constexpr int NPHASE = 18;

constexpr size_t MiB = 1u << 20;
constexpr size_t WS_CTL = 0, CTL_ZERO_BYTES = 1 * MiB;
constexpr size_t WS_MOD = 1 * MiB;
constexpr size_t WS_TAB = 2 * MiB;
constexpr size_t WS_WIN = 4 * MiB;
constexpr size_t WS_WOUT = WS_WIN + 2 * 72 * MiB;
constexpr size_t WS_WUP = WS_WOUT + 2 * 32 * MiB;
constexpr size_t WS_WDN = WS_WUP + 2 * 172 * MiB;
constexpr size_t WS_XS = WS_WDN + 2 * 86 * MiB;
constexpr size_t WS_HX = WS_XS + 136 * MiB;
constexpr size_t WS_P = WS_HX + 68 * MiB;
constexpr size_t WS_O = WS_P + 153 * MiB;
constexpr size_t WS_Y = WS_O + 68 * MiB;
constexpr size_t WS_U = WS_Y + 68 * MiB;
constexpr size_t WS_ACT = WS_U + 366 * MiB;
constexpr size_t WS_STASH = WS_ACT + 183 * MiB;
constexpr size_t WS_PART = WS_STASH + 32 * MiB;
constexpr size_t WS_END = WS_PART + 64 * MiB;
static_assert((size_t)MROWS * NUP * 2 <= 366 * MiB && (size_t)MROWS * DFF * 2 <= 183 * MiB && (size_t)MROWS * NIN * 2 <= 153 * MiB, "ws map");
constexpr int CW_BAR = 4096;

constexpr int RING_OFF = 0, RING_BYTES = 131072;
constexpr int LDSCTL_OFF = RING_BYTES, MISC_OFF = LDSCTL_OFF + 320;
constexpr int LDS_BYTES = 163840;
constexpr int WL_OFF = att::SHM_END + 8192, THD_OFF = WL_OFF + 3072, GAINS_OFF = att::WSCR_OFF;
static_assert(THD_OFF + 16384 <= LDS_BYTES, "LDS map");
constexpr int XCH_OFF = att::SHM_END;
static_assert(XCH_OFF + 8192 <= LDS_BYTES && att::WSCR_OFF >= MISC_OFF + 128, "LDS map");

#define GAS __attribute__((address_space(1)))
#define LAS __attribute__((address_space(3)))
typedef unsigned short bf16;
typedef unsigned v4u __attribute__((ext_vector_type(4)));
typedef unsigned v2u __attribute__((ext_vector_type(2)));
typedef float f32x4 __attribute__((ext_vector_type(4)));
typedef float f32x2 __attribute__((ext_vector_type(2)));
typedef GAS unsigned gu32;
#define RLX_AGENT __ATOMIC_RELAXED, __HIP_MEMORY_SCOPE_AGENT
#define LDS_WAIT() asm volatile("s_waitcnt lgkmcnt(0)" ::: "memory")
#define VM_WAIT() asm volatile("s_waitcnt vmcnt(0)" ::: "memory")
__device__ __forceinline__ unsigned f2bf(float f) { unsigned u = __builtin_bit_cast(unsigned, f); return (u + 0x7fffu + ((u >> 16) & 1u)) >> 16; }
__device__ __forceinline__ unsigned pk2(float lo, float hi) { return f2bf(lo) | (f2bf(hi) << 16); }
__device__ __forceinline__ float bf_lo(unsigned w) { return __uint_as_float(w << 16); }
__device__ __forceinline__ float bf_hi(unsigned w) { return __uint_as_float(w & 0xffff0000u); }

#define XB_TMO      128
#define XB_XCNT(j)  (256  + 64 * (j))
#define XB_XSUB(j)  (1280 + 64 * (j))
#define XB_XGEN(j)  (2304 + 64 * (j))
#define XB_TOP      3328
#define XB_TOPGEN   3392
#define XCD_BAR_WORDS 3456
#define XB_SPIN_CAP (1u << 24)

__device__ __forceinline__ unsigned xb_ld(unsigned* p)              { return __hip_atomic_load(p, __ATOMIC_RELAXED, __HIP_MEMORY_SCOPE_AGENT); }
__device__ __forceinline__ unsigned xb_add(unsigned* p, unsigned v) { return __hip_atomic_fetch_add(p, v, __ATOMIC_RELAXED, __HIP_MEMORY_SCOPE_AGENT); }
__device__ __forceinline__ unsigned xb_xcc_id() { return (unsigned)__builtin_amdgcn_s_getreg((3 << 11) | 20) & 0xFu; }
#define XB_SPIN(cond, bar) do { unsigned _sp = 0; while (cond) { __builtin_amdgcn_s_sleep(1); \
    if ((++_sp & 255u) == 0u) { if (xb_ld(&(bar)[XB_TMO])) break; if (_sp > XB_SPIN_CAP) { atomicAdd(&(bar)[XB_TMO], 1u); break; } } } } while (0)

struct XcdBarrier { unsigned* bar; unsigned x; volatile LAS unsigned* st; };

__device__ __forceinline__ XcdBarrier xcd_barrier_post(unsigned* bar, volatile LAS unsigned* st) {
    XcdBarrier b; b.bar = bar; b.x = xb_xcc_id(); b.st = st;
    if (threadIdx.x == 0) (void)xb_add(&bar[XB_XCNT(b.x)], 1u);
    return b;
}
__device__ __forceinline__ void xcd_barrier_complete(unsigned* bar, unsigned x, unsigned& nloc, unsigned& nx) {
    const unsigned G = gridDim.x * gridDim.y * gridDim.z;
    unsigned sum, cnt, mine, sp = 0u;
    for (;;) {
        sum = 0u; cnt = 0u; mine = 0u;
#pragma unroll
        for (unsigned j = 0; j < 16; ++j) { const unsigned c = xb_ld(&bar[XB_XCNT(j)]); sum += c; cnt += (c > 0u) ? 1u : 0u; mine = (j == x) ? c : mine; }
        if (sum == G) break;
        __builtin_amdgcn_s_sleep(1);
        if ((++sp & 255u) == 0u) { if (xb_ld(&bar[XB_TMO])) break; if (sp > XB_SPIN_CAP) { atomicAdd(&bar[XB_TMO], 1u); break; } }
    }
    nloc = mine > 0u ? mine : 1u; nx = cnt > 0u ? cnt : 1u;
}
__device__ __forceinline__ void xcd_barrier(const XcdBarrier& b) {
    asm volatile("s_waitcnt vmcnt(0)" ::: "memory");
    __syncthreads();
    if (threadIdx.x == 0) {
        unsigned* bar = b.bar;
        __builtin_amdgcn_s_waitcnt(0);
        unsigned nloc = b.st[0], nx = b.st[1];
        if (nloc == 0u) { xcd_barrier_complete(bar, b.x, nloc, nx); b.st[0] = nloc; b.st[1] = nx; }
        const unsigned old = xb_add(&bar[XB_XSUB(b.x)], 1u);
        const unsigned gen = old / nloc;
        if (old + 1u == (gen + 1u) * nloc) {
            __builtin_amdgcn_fence(__ATOMIC_RELEASE, "agent");
            asm volatile("s_waitcnt vmcnt(0)" ::: "memory");
            const unsigned og = xb_add(&bar[XB_TOP], 1u);
            const unsigned tg = og / nx;
            if (og + 1u == (tg + 1u) * nx) xb_add(&bar[XB_TOPGEN], 1u);
            else XB_SPIN(xb_ld(&bar[XB_TOPGEN]) == tg, bar);
            __builtin_amdgcn_fence(__ATOMIC_ACQUIRE, "agent");
            xb_add(&bar[XB_XGEN(b.x)], 1u);
            asm volatile("s_waitcnt vmcnt(0)" ::: "memory");
        } else {
            XB_SPIN(xb_ld(&bar[XB_XGEN(b.x)]) == gen, bar);
            __builtin_amdgcn_fence(__ATOMIC_ACQUIRE, "agent");
            asm volatile("s_waitcnt vmcnt(0)" ::: "memory");
        }
    }
    __syncthreads();
}

struct Args {
    const float* in[24]; float* out; unsigned char* ws; int ph_lo, ph_hi;
};
typedef __attribute__((address_space(4))) const Args* KArgs;
struct Frame {
    LAS unsigned char* lds;
    int tid, lane, wave, vcu, G;
    unsigned char* ws;
};

__device__ __forceinline__ int fresh_bx() { int bx = blockIdx.x; asm volatile("" : "+s"(bx)); return bx; }
__device__ __forceinline__ float wave_sum(float v) {
#pragma unroll
    for (int o = 1; o < 64; o <<= 1) v += __shfl_xor(v, o);
    return v;
}

__device__ const float INV32[32] = {
    1.0f, 0.74989420933f, 0.56234132519f, 0.42169650343f, 0.31622776602f, 0.23713737057f, 0.17782794100f, 0.13335214322f,
    0.1f, 0.074989420933f, 0.056234132519f, 0.042169650343f, 0.031622776602f, 0.023713737057f, 0.017782794100f, 0.013335214322f,
    0.01f, 0.0074989420933f, 0.0056234132519f, 0.0042169650343f, 0.0031622776602f, 0.0023713737057f, 0.0017782794100f, 0.0013335214322f,
    0.001f, 0.00074989420933f, 0.00056234132519f, 0.00042169650343f, 0.00031622776602f, 0.00023713737057f, 0.00017782794100f, 0.00013335214322f };
__device__ const float INV16[16] = {
    1.0f, 0.56234132519f, 0.31622776602f, 0.17782794100f, 0.1f, 0.056234132519f, 0.031622776602f, 0.017782794100f,
    0.01f, 0.0056234132519f, 0.0031622776602f, 0.0017782794100f, 0.001f, 0.00056234132519f, 0.00031622776602f, 0.00017782794100f };

__device__ __forceinline__ void sincos_acc(float af, float& c, float& s) {
    const double a = (double)af; const double kd = __builtin_rint(a * 0.63661977236758134308); const int k = (int)kd;
    const double r = (a - kd * 1.57079632679489655800) - kd * 6.12323399573676603587e-17; const double r2 = r * r;
    const double sn = r * (1.0 + r2 * (-1.0 / 6 + r2 * (1.0 / 120 + r2 * (-1.0 / 5040 + r2 * (1.0 / 362880 + r2 * (-1.0 / 39916800 + r2 * (1.0 / 6227020800.0)))))));
    const double cs = 1.0 + r2 * (-0.5 + r2 * (1.0 / 24 + r2 * (-1.0 / 720 + r2 * (1.0 / 40320 + r2 * (-1.0 / 3628800 + r2 * (1.0 / 479001600.0 + r2 * (-1.0 / 87178291200.0)))))));
    double cc, ss;
    switch (k & 3) { case 0: cc = cs; ss = sn; break; case 1: cc = -sn; ss = cs; break; case 2: cc = -cs; ss = -sn; break; default: cc = sn; ss = -cs; break; }
    c = (float)cc; s = (float)ss;
}

__device__ __forceinline__ unsigned cvtpk_bf16(float lo, float hi) { unsigned r; asm volatile("v_cvt_pk_bf16_f32 %0, %1, %2" : "=v"(r) : "v"(lo), "v"(hi)); return r; }
__device__ __forceinline__ void p0_transpose_item(const float* W, int K, int N, bf16* WT, int item, int lane, bool gv) {
    const int nblk = N / 64, kb = item / nblk, nb = item % nblk, k0 = 64 * kb, n0 = 64 * nb;
    const int v0 = !gv ? n0 : (n0 < DFF ? (n0 >> 7) * 256 + (n0 & 127) : ((n0 - DFF) >> 7) * 256 + 128 + ((n0 - DFF) & 127));
    const int kr = lane >> 4, c4 = lane & 15;
    const GAS float* src = (const GAS float*)W + (size_t)(k0 + 16 * kr) * N + n0 + 4 * c4;
    f32x4 v[16];
#pragma unroll
    for (int i = 0; i < 16; ++i) v[i] = __builtin_nontemporal_load((const GAS f32x4*)(src + (size_t)i * N));
    GAS bf16* dst = (GAS bf16*)WT + (size_t)(v0 + 4 * c4) * K + k0 + 16 * kr;
#pragma unroll
    for (int e = 0; e < 4; ++e) {
        v4u o0, o1;
        o0.x = cvtpk_bf16(v[0][e], v[1][e]); o0.y = cvtpk_bf16(v[2][e], v[3][e]); o0.z = cvtpk_bf16(v[4][e], v[5][e]); o0.w = cvtpk_bf16(v[6][e], v[7][e]);
        o1.x = cvtpk_bf16(v[8][e], v[9][e]); o1.y = cvtpk_bf16(v[10][e], v[11][e]); o1.z = cvtpk_bf16(v[12][e], v[13][e]); o1.w = cvtpk_bf16(v[14][e], v[15][e]);
        *(GAS v4u*)(dst + (size_t)e * K) = o0; *(GAS v4u*)(dst + (size_t)e * K + 8) = o1;
    }
}

__device__ __forceinline__ void convert_matrix(Frame& F, KArgs a, int mat, int l, int gw, int ngw, int part = 0) {
    const float* W; bf16* WT; int K, N;
    if (mat == 0) { W = a->in[10] + (size_t)l * DM * NIN; WT = (bf16*)(F.ws + WS_WIN + (size_t)l * 72 * MiB); K = DM; N = NIN; }
    else if (mat == 1) { W = a->in[11] + (size_t)l * DM * DM; WT = (bf16*)(F.ws + WS_WOUT + (size_t)l * 32 * MiB); K = DM; N = DM; }
    else if (mat == 2) { W = a->in[21] + (size_t)l * DM * NUP; WT = (bf16*)(F.ws + WS_WUP + (size_t)l * 172 * MiB); K = DM; N = NUP; }
    else { W = a->in[23] + (size_t)l * DFF * DM; WT = (bf16*)(F.ws + WS_WDN + (size_t)l * 86 * MiB); K = DFF; N = DM; }
    const int nitems = (K / 64) * (N / 64); const int lo = part == 2 ? nitems / 2 : 0, hi = part == 1 ? nitems / 2 : nitems;
    for (int it = lo + gw; it < hi; it += ngw) p0_transpose_item(W, K, N, WT, it, F.lane, mat == 2);
}
__device__ __forceinline__ void tail_convert(Frame& F, KArgs a, int nbusy, int mat0, int l0, int part0, int mat1, int l1, int part1) {
    const int bx = fresh_bx(); if (bx < nbusy || nbusy >= F.G) return;
    const int gw = (bx - nbusy) * NWAVES + F.wave, ngw = (F.G - nbusy) * NWAVES;
    convert_matrix(F, a, mat0, l0, gw, ngw, part0);
    if (mat1 >= 0) convert_matrix(F, a, mat1, l1, gw, ngw, part1);
}
__device__ __forceinline__ float silu_f(float x) { return x / (1.f + __expf(-x)); }

__device__ __forceinline__ void phase_prologue(Frame& F, KArgs a) {
    const float* c_in = a->in[1]; const float* cctx = a->in[3]; const float* w_ada = a->in[4]; const float* b_ada = a->in[5];
    float* mod = (float*)(F.ws + WS_MOD);
    if (F.vcu == 0) {
        f32x2* thd = (f32x2*)(F.ws + WS_TAB);
        for (int e = F.tid; e < 64 * 32; e += NWAVES * 64) { const int pos = e >> 5, i = e & 31; float c, s; sincos_acc((float)pos * INV32[i], c, s); thd[e] = (f32x2){c, s}; }
        f32x2* tdh = (f32x2*)(F.ws + WS_TAB + 16384);
        for (int e = F.tid; e < 64 * 16; e += NWAVES * 64) { const int pos = e >> 4, i = e & 15; float c, s; sincos_acc((float)pos * INV16[i], c, s); tdh[e] = (f32x2){c, s}; }
        if (F.tid < 2) { const int l = F.tid; float s1 = 0.f, s2 = 0.f;
            for (int i = 0; i < 64; ++i) { s1 += a->in[14][l * 64 + i] * a->in[15][l * 64 + i]; s2 += a->in[16][l * 64 + i] * a->in[17][l * 64 + i]; }
            const float lam_init = 0.8f - 0.6f * expf(-0.3f * (float)l);
            float* lam = (float*)(F.ws + WS_TAB + 32768); lam[l * 2 + 0] = expf(s1) - expf(s2) + lam_init; lam[l * 2 + 1] = 1.f - lam_init; }
    }
    {
        LAS float* sv = (LAS float*)(F.lds + RING_OFF);
        LAS float* red = (LAS float*)(F.lds + RING_OFF + 49152);
        for (int e = F.tid; e < 3 * DM; e += NWAVES * 64) { const int v = e / DM, k = e % DM; const float x = v < 2 ? c_in[v * DM + k] : cctx[k]; sv[e] = silu_f(x); }
        __syncthreads();
        const int cg = F.lane & 15, kq = F.lane >> 4;
        for (int it = F.vcu; it < 2 * (NADA / 64); it += F.G) {
            const int l = it / (NADA / 64), ch = it % (NADA / 64);
            const float* W = w_ada + (size_t)l * DM * NADA + ch * 64 + cg * 4;
            f32x4 a0 = {0.f, 0.f, 0.f, 0.f}, a1 = a0, a2 = a0;
#pragma unroll 8
            for (int s = 0; s < DM / 32; ++s) { const int k = s * 32 + F.wave * 4 + kq; const f32x4 w = __builtin_nontemporal_load((const GAS f32x4*)(W + (size_t)k * NADA));
                a0 += w * sv[k]; a1 += w * sv[DM + k]; a2 += w * sv[2 * DM + k]; }
#pragma unroll
            for (int e = 0; e < 4; ++e) { a0[e] += __shfl_xor(a0[e], 16); a0[e] += __shfl_xor(a0[e], 32); a1[e] += __shfl_xor(a1[e], 16); a1[e] += __shfl_xor(a1[e], 32); a2[e] += __shfl_xor(a2[e], 16); a2[e] += __shfl_xor(a2[e], 32); }
            if (kq == 0) {
#pragma unroll
                for (int e = 0; e < 4; ++e) { red[(F.wave * 3 + 0) * 64 + cg * 4 + e] = a0[e]; red[(F.wave * 3 + 1) * 64 + cg * 4 + e] = a1[e]; red[(F.wave * 3 + 2) * 64 + cg * 4 + e] = a2[e]; } }
            __syncthreads();
            if (F.tid < 192) { const int v = F.tid / 64, cidx = F.tid % 64; float s = 0.f;
#pragma unroll
                for (int w = 0; w < 8; ++w) s += red[(w * 3 + v) * 64 + cidx];
                const int col = ch * 64 + cidx; mod[((size_t)l * 3 + v) * NADA + col] = s + b_ada[(size_t)l * NADA + col]; }
            __syncthreads();
        }
    }
    {
        const int gw = F.vcu * NWAVES + F.wave, NGW = F.G * NWAVES;
        convert_matrix(F, a, 0, 0, gw, NGW); convert_matrix(F, a, 2, 0, gw, NGW); convert_matrix(F, a, 2, 1, gw, NGW);
        if (F.G != 256) { convert_matrix(F, a, 1, 0, gw, NGW); convert_matrix(F, a, 3, 0, gw, NGW); convert_matrix(F, a, 0, 1, gw, NGW); convert_matrix(F, a, 1, 1, gw, NGW); convert_matrix(F, a, 3, 1, gw, NGW); }
    }
}

struct RowRegs { f32x4 v[16]; };
__device__ __forceinline__ float row_sumsq(const RowRegs& r) {
    float s = 0.f;
#pragma unroll
    for (int j = 0; j < 16; ++j) s += (r.v[j].x * r.v[j].x + r.v[j].y * r.v[j].y) + (r.v[j].z * r.v[j].z + r.v[j].w * r.v[j].w);
    return wave_sum(s);
}
__device__ __forceinline__ void row_load_f32(RowRegs& r, const float* p, int lane) {
    const GAS f32x4* q = (const GAS f32x4*)p + lane;
#pragma unroll
    for (int j = 0; j < 16; ++j) r.v[j] = __builtin_nontemporal_load(q + 64 * j);
}
__device__ __forceinline__ void row_load_bf16(RowRegs& r, const bf16* p, int lane) {
    const GAS v2u* q = (const GAS v2u*)p + lane;
#pragma unroll
    for (int j = 0; j < 16; ++j) { const v2u w = __builtin_nontemporal_load(q + 64 * j); r.v[j] = (f32x4){bf_lo(w.x), bf_hi(w.x), bf_lo(w.y), bf_hi(w.y)}; }
}
__device__ __forceinline__ void row_store_f32(const RowRegs& r, float* p, int lane) {
    GAS f32x4* q = (GAS f32x4*)p + lane;
#pragma unroll
    for (int j = 0; j < 16; ++j) __builtin_nontemporal_store(r.v[j], q + 64 * j);
}
__device__ __forceinline__ void row_store_bf16(const RowRegs& r, bf16* p, int lane) {
    GAS v2u* q = (GAS v2u*)p + lane;
#pragma unroll
    for (int j = 0; j < 16; ++j) { v2u w; w.x = pk2(r.v[j].x, r.v[j].y); w.y = pk2(r.v[j].z, r.v[j].w); __builtin_nontemporal_store(w, q + 64 * j); }
}
__device__ __forceinline__ void row_modnorm_store(const RowRegs& x, float rstd, const float* g, const float* sc, const float* sh, bf16* out, int lane) {
    GAS v2u* q = (GAS v2u*)out + lane;
#pragma unroll
    for (int j = 0; j < 16; ++j) { const int c = 4 * lane + 256 * j;
        const f32x4 gv = *(const GAS f32x4*)(g + c), sv = *(const GAS f32x4*)(sc + c), hv = *(const GAS f32x4*)(sh + c);
        const f32x4 y = (x.v[j] * rstd) * gv * (sv + 1.f) + hv;
        v2u w; w.x = pk2(y.x, y.y); w.y = pk2(y.z, y.w); q[64 * j] = w; }
}
__device__ __forceinline__ void row_residual(RowRegs& x, const RowRegs& y, float rstd, const float* g, const float* gate, int lane) {
#pragma unroll
    for (int j = 0; j < 16; ++j) { const int c = 4 * lane + 256 * j;
        const f32x4 gv = *(const GAS f32x4*)(g + c), tv = *(const GAS f32x4*)(gate + c);
        x.v[j] = x.v[j] + tv * ((y.v[j] * rstd) * gv); }
}

__device__ __forceinline__ void row_load_part(RowRegs& r, const float* part, int lrow, int lane) {
#pragma unroll
    for (int j = 0; j < 16; ++j) r.v[j] = (f32x4){0.f, 0.f, 0.f, 0.f};
#pragma unroll 2
    for (int c = 0; c < 8; ++c) { const GAS f32x4* q = (const GAS f32x4*)(part + ((size_t)c * 512 + lrow) * DM) + lane;
#pragma unroll
        for (int j = 0; j < 16; ++j) r.v[j] += q[64 * j]; }
}

__device__ __forceinline__ void phase_r0(Frame& F, KArgs a) {
    const float* mod = (const float*)(F.ws + WS_MOD); bf16* hx = (bf16*)(F.ws + WS_HX);
    const int gw = F.vcu * NWAVES + F.wave, NGW = F.G * NWAVES;
    for (int m = gw; m < MROWS; m += NGW) {
        const int b = m / TPB, t = m % TPB; const bool lat = t < SEQ;
        const float* src = lat ? a->in[0] + ((size_t)b * SEQ + t) * DM : a->in[2] + ((size_t)b * CTXL + (t - SEQ)) * DM;
        RowRegs x; row_load_f32(x, src, F.lane);
        const float rstd = 1.f / sqrtf(row_sumsq(x) * (1.f / DM) + EPS);
        const float* mv = mod + (size_t)(0 * 3 + (lat ? b : 2)) * NADA;
        row_modnorm_store(x, rstd, a->in[6]  , mv + DM, mv, hx + (size_t)m * DM, F.lane);
    }
}
__device__ __forceinline__ void phase_r1(Frame& F, KArgs a, int l, bool last) {
    const float* mod = (const float*)(F.ws + WS_MOD); bf16* xs = (bf16*)(F.ws + WS_XS); bf16* hx = (bf16*)(F.ws + WS_HX); const bf16* yb = (const bf16*)(F.ws + WS_Y);
    const int gw = F.vcu * NWAVES + F.wave, NGW = F.G * NWAVES;
    for (int m = gw; m < MROWS; m += NGW) {
        const int b = m / TPB, t = m % TPB; const bool lat = t < SEQ;
        if (last && !lat) continue;
        const float* mv = mod + (size_t)(l * 3 + (lat ? b : 2)) * NADA;
        RowRegs x, y;
        if (l == 0) row_load_f32(x, lat ? a->in[0] + ((size_t)b * SEQ + t) * DM : a->in[2] + ((size_t)b * CTXL + (t - SEQ)) * DM, F.lane);
        else row_load_bf16(x, xs + (size_t)m * DM, F.lane);
        if (lat) row_load_bf16(y, yb + (size_t)m * DM, F.lane); else row_load_part(y, (const float*)(F.ws + WS_PART), b * 256 + (t - SEQ), F.lane);
        const float rstd_y = 1.f / sqrtf(row_sumsq(y) * (1.f / DM) + EPS);
        row_residual(x, y, rstd_y, a->in[7] + (size_t)l * DM, mv + 2 * DM, F.lane);
        row_store_bf16(x, xs + (size_t)m * DM, F.lane);
        const float rstd = 1.f / sqrtf(row_sumsq(x) * (1.f / DM) + EPS);
        row_modnorm_store(x, rstd, a->in[8] + (size_t)l * DM, mv + 4 * DM, mv + 3 * DM, hx + (size_t)m * DM, F.lane);
    }
}
__device__ __forceinline__ void phase_r2(Frame& F, KArgs a, int l, bool last) {
    const float* mod = (const float*)(F.ws + WS_MOD); bf16* xs = (bf16*)(F.ws + WS_XS); bf16* hx = (bf16*)(F.ws + WS_HX); const bf16* yb = (const bf16*)(F.ws + WS_Y);
    const int gw = F.vcu * NWAVES + F.wave, NGW = F.G * NWAVES;
    for (int m = gw; m < MROWS; m += NGW) {
        const int b = m / TPB, t = m % TPB; const bool lat = t < SEQ;
        if (last && !lat) continue;
        const float* mv = mod + (size_t)(l * 3 + (lat ? b : 2)) * NADA;
        RowRegs x, y; row_load_bf16(x, xs + (size_t)m * DM, F.lane);
        if (lat) row_load_bf16(y, yb + (size_t)m * DM, F.lane); else row_load_part(y, (const float*)(F.ws + WS_PART), b * 256 + (t - SEQ), F.lane);
        const float rstd_y = 1.f / sqrtf(row_sumsq(y) * (1.f / DM) + EPS);
        row_residual(x, y, rstd_y, a->in[9] + (size_t)l * DM, mv + 5 * DM, F.lane);
        if (last) { row_store_f32(x, a->out + ((size_t)b * SEQ + t) * DM, F.lane); continue; }
        row_store_bf16(x, xs + (size_t)m * DM, F.lane);
        const float rstd = 1.f / sqrtf(row_sumsq(x) * (1.f / DM) + EPS);
        const float* mn = mod + (size_t)((l + 1) * 3 + (lat ? b : 2)) * NADA;
        row_modnorm_store(x, rstd, a->in[6] + (size_t)(l + 1) * DM, mn + DM, mn, hx + (size_t)m * DM, F.lane);
    }
}

__device__ __forceinline__ void phase_fixup(Frame& F, KArgs a, int l, bool last) {
    const float* side = (const float*)(F.ws + WS_U); bf16* ACT = (bf16*)(F.ws + WS_ACT);
    const float* cw = a->in[22] + (size_t)l * 3 * NUP;
    constexpr int CG = DFF / 4;
    const int ntile = last ? 32 : 34;
    for (int idx = F.vcu * NWAVES * 64 + F.tid; idx < ntile * 2 * CG; idx += F.G * NWAVES * 64) {
        const int cg = idx % CG, e = (idx / CG) & 1, pmi = idx / (2 * CG); const int pm = (last && pmi >= 16) ? pmi + 1 : pmi; const int pmb = pm % 17;
        const int col = cg * 4, vg = (col >> 7) * 256 + (col & 127);
        const float* sb = side + (size_t)pm * 4 * NUP;
        const f32x4 zero4 = {0.f, 0.f, 0.f, 0.f};
        f32x4 pg, pv, cg_, cv, ng, nv;
        if (e == 0) {
            cg_ = *(const GAS f32x4*)(sb + vg); cv = *(const GAS f32x4*)(sb + vg + 128); ng = *(const GAS f32x4*)(sb + NUP + vg); nv = *(const GAS f32x4*)(sb + NUP + vg + 128);
            if (pmb == 0 || pmb == 16) { pg = zero4; pv = zero4; } else { pg = *(const GAS f32x4*)(sb - NUP + vg); pv = *(const GAS f32x4*)(sb - NUP + vg + 128); }
        } else {
            cg_ = *(const GAS f32x4*)(sb + 3 * (size_t)NUP + vg); cv = *(const GAS f32x4*)(sb + 3 * (size_t)NUP + vg + 128); pg = *(const GAS f32x4*)(sb + 2 * (size_t)NUP + vg); pv = *(const GAS f32x4*)(sb + 2 * (size_t)NUP + vg + 128);
            if (pmb >= 15) { ng = zero4; nv = zero4; } else { ng = *(const GAS f32x4*)(sb + 4 * (size_t)NUP + vg); nv = *(const GAS f32x4*)(sb + 4 * (size_t)NUP + vg + 128); }
        }
        const f32x4 g = pg * *(const GAS f32x4*)(cw + col) + cg_ * *(const GAS f32x4*)(cw + NUP + col) + ng * *(const GAS f32x4*)(cw + 2 * NUP + col);
        const f32x4 v = pv * *(const GAS f32x4*)(cw + DFF + col) + cv * *(const GAS f32x4*)(cw + NUP + DFF + col) + nv * *(const GAS f32x4*)(cw + 2 * NUP + DFF + col);
        f32x4 o;
#pragma unroll
        for (int k = 0; k < 4; ++k) o[k] = g[k] / (1.f + __expf(-g[k])) * v[k];
        v2u w; w.x = pk2(o.x, o.y); w.y = pk2(o.z, o.w);
        *(GAS v2u*)(ACT + (size_t)(pm * 256 + (e ? 255 : 0)) * DFF + col) = w;
    }
}

template <int MASK>
__device__ __forceinline__ void attn_std_unit(Frame& F, const bf16* P, bf16* O, int b, int qrow0  , int qcol, int kcol, int vcol, int ocol,
                                              int nloc, int loc0, float sink, bool has_sink) {
    using namespace att;
    int lane_ = F.lane; asm volatile("" : "+v"(lane_));
    int lane = lane_, wid = F.wave, r32 = lane & 31, hi = lane >> 5;
    constexpr float SCALE = 0.088388347648318440f; constexpr float C = SCALE * 1.4426950408889634f;
    const size_t base = (size_t)b * TPB;
    const bf16* Qw = P + (base + qrow0 + wid * 32 + r32) * LDP + qcol + hi * 8;
    f32x16 o[4]; float m_reg, l_reg;
    attn_core<MASK, 0, 8>(o, m_reg, l_reg, Qw, P + base * LDP + kcol, P + base * LDP + vcol, nloc, loc0, qrow0 + wid * 32 + r32, C, 8.f / SCALE, (ALAS char*)F.lds);
    if (has_sink) l_reg += __builtin_amdgcn_exp2f(sink * 1.4426950408889634f - m_reg * C);
    asm volatile("" : "+v"(lane_)); lane = lane_; r32 = lane & 31; hi = lane >> 5;
    ALAS float* li_l = (ALAS float*)((ALAS char*)F.lds + WSCR_OFF) + wid * 64;
    if (hi == 0) li_l[r32] = l_reg; asm volatile("s_waitcnt lgkmcnt(0)" ::: "memory");
    bf16* Ow = O + (base + qrow0 + wid * 32) * LDO + ocol;
#pragma unroll
    for (int r = 0; r < 16; ++r) { const int orow = crow(r, hi); const float rl = __builtin_amdgcn_rcpf(li_l[orow]);
#pragma unroll
        for (int d0 = 0; d0 < 4; ++d0) Ow[(size_t)orow * LDO + d0 * 32 + r32] = (bf16)f2bf(o[d0][r] * rl); }
}
__device__ __forceinline__ void attn_diff_unit(Frame& F, const bf16* P, bf16* O, int b, int qrow0, int h, int nloc, int loc0, float lam, float omli, const float* gsub) {
    using namespace att;
    int lane_ = F.lane; asm volatile("" : "+v"(lane_));
    int lane = lane_, wid = F.wave, r32 = lane & 31, hi = lane >> 5;
    constexpr float SCALE = 0.125f; constexpr float C = SCALE * 1.4426950408889634f;
    const size_t base = (size_t)b * TPB;
    const bf16* Qw = P + (base + qrow0 + wid * 32 + r32) * LDP + QB_ + h * 128 + hi * 8;
    const bf16* Kb = P + base * LDP + KB_ + h * 128; const bf16* Vb = P + base * LDP + VB_ + h * 128;
    ALAS float* li_l = (ALAS float*)((ALAS char*)F.lds + WSCR_OFF) + wid * 64;
    f32x16 o[4]; float m_reg, l_reg;
    attn_core<0, 4, 4>(o, m_reg, l_reg, Qw, Kb, Vb, nloc, loc0, 0, C, 8.f / SCALE, (ALAS char*)F.lds);
    asm volatile("" : "+v"(lane_)); lane = lane_; r32 = lane & 31; hi = lane >> 5;
    if (hi == 0) li_l[r32] = l_reg; asm volatile("s_waitcnt lgkmcnt(0)" ::: "memory");
    { float* stash = (float*)(F.ws + WS_STASH) + ((size_t)blockIdx.x * 8 + wid) * 4096 + lane;
#pragma unroll
    for (int d0 = 0; d0 < 4; ++d0) { float* sp = stash + d0 * 1024; asm volatile("" : "+v"(sp));
#pragma unroll
        for (int r = 0; r < 16; ++r) sp[r * 64] = o[d0][r] * __builtin_amdgcn_rcpf(li_l[crow(r, hi)]); } }
    __syncthreads();
    attn_core<0, 0, 4>(o, m_reg, l_reg, Qw, Kb, Vb, nloc, loc0, 0, C, 8.f / SCALE, (ALAS char*)F.lds);
    asm volatile("" : "+v"(lane_)); lane = lane_; r32 = lane & 31; hi = lane >> 5;
    if (hi == 0) li_l[r32] = l_reg; asm volatile("s_waitcnt lgkmcnt(0)" ::: "memory");
    float* stash = (float*)(F.ws + WS_STASH) + ((size_t)blockIdx.x * 8 + wid) * 4096 + lane;
    float g4[4];
#pragma unroll
    for (int d0 = 0; d0 < 4; ++d0) g4[d0] = gsub[d0 * 32 + r32] * omli;
    bf16* Ow = O + (base + qrow0 + wid * 32) * LDO + QB_ + h * 128;
#pragma unroll
    for (int r = 0; r < 16; ++r) { const int orow = crow(r, hi); const float rl = __builtin_amdgcn_rcpf(li_l[orow]);
        float v[4]; float ss = 0.f;
#pragma unroll
        for (int d0 = 0; d0 < 4; ++d0) { v[d0] = o[d0][r] * rl - lam * stash[(d0 * 16 + r) * 64]; ss += v[d0] * v[d0]; }
        ss += __shfl_xor(ss, 1); ss += __shfl_xor(ss, 2); ss += __shfl_xor(ss, 4); ss += __shfl_xor(ss, 8); ss += __shfl_xor(ss, 16);
        const float rstd = 1.f / sqrtf(ss * (1.f / 128.f) + EPS);
#pragma unroll
        for (int d0 = 0; d0 < 4; ++d0) Ow[(size_t)orow * LDO + d0 * 32 + r32] = (bf16)f2bf(v[d0] * rstd * g4[d0]); }
}

__device__ __forceinline__ void phase_attention(Frame& F, KArgs a, int l, bool last) {
    const bf16* P = (const bf16*)(F.ws + WS_P); bf16* O = (bf16*)(F.ws + WS_O);
    const float* lamv = (const float*)(F.ws + WS_TAB + 32768); const float lam = lamv[l * 2], omli = lamv[l * 2 + 1];
    const float* sinkv = a->in[19] + l * 8; const float* gsub = a->in[18] + l * 128; const float* nab = a->in[20] + (size_t)l * 8 * 15 * 31;
#ifndef ATT_MASK
#define ATT_MASK 15
#endif
    if (ATT_MASK & 1) for (int it = 0;; ++it) { int u;
        if (F.G == 256) { if (it == 0) u = F.vcu; else if (it == 1 && !last && F.vcu >= 192 && F.vcu < 208) u = 256 + (F.vcu - 192); else break; }
        else { u = F.vcu + it * F.G; if (u >= (last ? 256 : 272)) break; }
        int b, h, qrow0, nloc;
        if (u < 256) { b = u >> 7; h = (u >> 4) & 7; qrow0 = (u & 15) * 256; nloc = 64; } else { const int e = u - 256; b = e >> 3; h = e & 7; qrow0 = SEQ; nloc = 0; }
        __syncthreads(); attn_diff_unit(F, P, O, b, qrow0, h, nloc, 0, lam, omli, gsub);
    }
    if (ATT_MASK & 2) for (int it = 0;; ++it) { int u;
        if (F.G == 256) { if (it == 0) u = F.vcu; else if (it == 1 && !last && F.vcu >= 208) u = 256 + (F.vcu - 208); else break; }
        else { u = F.vcu + it * F.G; if (u >= (last ? 256 : 304)) break; }
        int b, qrow0, qcol, kcol, vcol, nloc; float sink = 0.f; bool has_sink = false;
        if (u < 256) { const int h = (u >> 4) & 7, qb = u & 15; b = u >> 7; qrow0 = qb * 256; qcol = QA + h * 128; kcol = KA + (h >> 2) * 128; vcol = VA + (h >> 2) * 128; nloc = 64; }
        else { const int e = u - 256, g = e >> 4, h = e & 7; b = (e >> 3) & 1; qrow0 = SEQ; nloc = 0;
            if (g == 0) { qcol = QA + h * 128; kcol = KA + (h >> 2) * 128; vcol = VA + (h >> 2) * 128; }
            else if (g == 1) { qcol = QC + h * 128; kcol = KC + (h >> 2) * 128; vcol = VC + (h >> 2) * 128; sink = sinkv[h]; has_sink = true; }
            else { qcol = QD + h * 128; kcol = KD + h * 128; vcol = VD + h * 128; } }
        __syncthreads(); attn_std_unit<0>(F, P, O, b, qrow0, qcol, kcol, vcol, qcol, nloc, 0, sink, has_sink);
    }
    if (ATT_MASK & 4) for (int u = F.vcu; u < 256; u += F.G) { const int b = u >> 7, h = (u >> 4) & 7, qb = u & 15;
        const int lo = max(qb * 256 - 128, 0), hiK = min(qb * 256 + 384, SEQ);
        __syncthreads(); attn_std_unit<2>(F, P, O, b, qb * 256, QC + h * 128, KC + (h >> 2) * 128, VC + (h >> 2) * 128, QC + h * 128, (hiK - lo) / 64, lo, sinkv[h], true); }
    if (ATT_MASK & 8) for (int u = F.vcu; u < 256; u += F.G) { const int b = u >> 7, h = (u >> 4) & 7, qb = u & 15;
        const int r0 = qb * 4; int rlo, nrow;
        if (r0 == 0) { rlo = 0; nrow = 8; } else if (r0 == 60) { rlo = 56; nrow = 8; } else { rlo = min(r0 - 4, 52); nrow = 12; }
        __syncthreads();
        { LAS float* bl = (LAS float*)(F.lds + att::BIAS_OFF); for (int e = F.tid; e < 15 * 31; e += NWAVES * 64) bl[e] = nab[h * 465 + e] * 11.313708498984761f; }
        attn_std_unit<3>(F, P, O, b, qb * 256, QD + h * 128, KD + h * 128, VD + h * 128, QD + h * 128, nrow, rlo * 64, 0.f, false); }
    __syncthreads();
}

__global__ void __launch_bounds__(NWAVES * 64, 2) fwd_kernel(Args args) {
    extern __shared__ __attribute__((aligned(16))) unsigned char lds[];
    Frame F;
    F.lds = (LAS unsigned char*)lds;
    volatile LAS unsigned* MISC = (volatile LAS unsigned*)(F.lds + MISC_OFF);
    F.tid = threadIdx.x; F.lane = F.tid & 63; F.wave = __builtin_amdgcn_readfirstlane(F.tid >> 6);
    F.G = gridDim.x; { const int bx = blockIdx.x; F.vcu = (F.G % 8 == 0) ? (bx % 8) * (F.G / 8) + bx / 8 : bx; }
    KArgs ap = (KArgs)__builtin_amdgcn_kernarg_segment_ptr();
    F.ws = ap->ws;
    gu32* ctl = (gu32*)(F.ws + WS_CTL);
    for (int u = F.tid; u < (LDS_BYTES - LDSCTL_OFF) / 4; u += NWAVES * 64) ((LAS unsigned*)(F.lds + LDSCTL_OFF))[u] = 0u;
    __syncthreads();
    const int lo = ap->ph_lo, hi = ap->ph_hi;
    XcdBarrier bar; bar.bar = (unsigned*)(ctl + CW_BAR); bar.x = 0; bar.st = nullptr;
    if (hi - lo > 1) bar = xcd_barrier_post((unsigned*)(ctl + CW_BAR), MISC + 8);
#ifndef PH_MASK
#define PH_MASK 0x7ff
#endif
#ifndef REP_PRO
#define REP_PRO 1
#endif
#ifndef REP_ATT
#define REP_ATT 1
#endif
#ifndef REP_GEMM
#define REP_GEMM 1
#endif
#ifndef REP_CONV
#define REP_CONV 1
#endif
#define IN(k) (lo <= (k) && (k) < hi)
#define FRESH() asm volatile("" : "+v"(F.tid), "+v"(F.lane), "+s"(ap))
#define EN(j) (((PH_MASK) >> (j)) & 1)
#define SEAM(k) do { if (IN(k) && IN((k) + 1)) xcd_barrier(bar); } while (0)

    if (EN(0) && IN(0)) { for (int rep = 0; rep < REP_PRO; ++rep) { FRESH(); phase_prologue(F, ap); __syncthreads(); } } SEAM(0);
    if (EN(1) && IN(1)) { FRESH(); phase_r0(F, ap); } SEAM(1);
    for (int l = 0; l < 2; ++l) {
        const bool last = (l == 1); const int pb = 2 + 8 * l;
        const pg8::bf16_t* HX = (const pg8::bf16_t*)(F.ws + WS_HX);
        if (EN(2) && IN(pb + 0)) {
            pg8::Gemm g{HX, (const pg8::bf16_t*)(F.ws + WS_WIN + (size_t)l * 72 * MiB), MROWS, NIN, DM};
            pg8::StaticOrder S; S.init(MROWS / 256, NIN, DM, F.G, fresh_bx(), 0);
            { FRESH(); const f32x4* tg = (const f32x4*)(F.ws + WS_TAB); LAS f32x4* tl = (LAS f32x4*)(F.lds + THD_OFF);
              for (int e = F.tid; e < 1024; e += NWAVES * 64) tl[e] = tg[e];
              LAS float* gl = (LAS float*)(F.lds + GAINS_OFF); if (F.tid < 256) gl[F.tid] = (F.tid < 128 ? ap->in[12] + l * 128 : ap->in[13] + l * 128 - 128)[F.tid];
              __syncthreads(); }
            pg8::EpiInProj E{(pg8::bf16_t*)(F.ws + WS_P), NIN, (const LAS float*)(F.lds + THD_OFF), (const LAS float*)(F.lds + GAINS_OFF), (LAS float*)(F.lds + XCH_OFF)};
            pg8::gemm_phase<pg8::EpiInProj, pg8::StaticOrder, true>(F.lds + RING_OFF, g, S, E);
            if (F.G == 256) { if (!last) tail_convert(F, ap, (34 * 36) % 256, 1, 0, 0, -1, 0, 0); else tail_convert(F, ap, (34 * 36) % 256, 1, 1, 0, 3, 1, 1); }
        } SEAM(pb + 0);
        if (EN(4) && IN(pb + 1)) { for (int rep = 0; rep < REP_ATT; ++rep) { FRESH(); phase_attention(F, ap, l, last); } } SEAM(pb + 1);
        if (EN(5) && IN(pb + 2)) {
            pg8::Gemm g{(const pg8::bf16_t*)(F.ws + WS_O), (const pg8::bf16_t*)(F.ws + WS_WOUT + (size_t)l * 32 * MiB), MROWS, DM, DM};
            pg8::SplitOrder S; S.init(DM, DM, F.G, fresh_bx()); if (last) S.ca = 0;
            pg8::EpiSplit E{(pg8::bf16_t*)(F.ws + WS_Y), (float*)(F.ws + WS_PART), DM};
            pg8::gemm_phase<pg8::EpiSplit, pg8::SplitOrder, true>(F.lds + RING_OFF, g, S, E);
        } SEAM(pb + 2);
        if (EN(6) && IN(pb + 3)) { FRESH(); phase_r1(F, ap, l, last); } SEAM(pb + 3);
        if (EN(7) && IN(pb + 4)) {
            pg8::Gemm g{HX, (const pg8::bf16_t*)(F.ws + WS_WUP + (size_t)l * 172 * MiB), MROWS, NUP, DM};
            pg8::StaticOrder S; S.init(last ? 32 : 34, NUP, DM, F.G, fresh_bx(), last ? 1 : 0);
            pg8::EpiUpConv E{(pg8::bf16_t*)(F.ws + WS_ACT), (float*)(F.ws + WS_U), ap->in[22] + (size_t)l * 3 * NUP, (LAS float*)(F.lds + XCH_OFF), DFF, (LAS float*)(F.lds + WL_OFF), (LAS float*)(F.lds + GAINS_OFF), 0};
            pg8::gemm_phase<pg8::EpiUpConv, pg8::StaticOrder, true>(F.lds + RING_OFF, g, S, E);
            if (F.G == 256) { if (!last) tail_convert(F, ap, (34 * 86) % 256, 3, 0, 0, 0, 1, 0); else tail_convert(F, ap, (32 * 86) % 256, 3, 1, 2, -1, 0, 0); }
        } SEAM(pb + 4);
        if (EN(8) && IN(pb + 5)) { for (int rep = 0; rep < REP_CONV; ++rep) { FRESH(); phase_fixup(F, ap, l, last); } } SEAM(pb + 5);
        if (EN(9) && IN(pb + 6)) {
            pg8::Gemm g{(const pg8::bf16_t*)(F.ws + WS_ACT), (const pg8::bf16_t*)(F.ws + WS_WDN + (size_t)l * 86 * MiB), MROWS, DM, DFF};
            pg8::SplitOrder S; S.init(DM, DFF, F.G, fresh_bx()); if (last) S.ca = 0;
            pg8::EpiSplit E{(pg8::bf16_t*)(F.ws + WS_Y), (float*)(F.ws + WS_PART), DM};
            pg8::gemm_phase<pg8::EpiSplit, pg8::SplitOrder, true>(F.lds + RING_OFF, g, S, E);
        } SEAM(pb + 6);
        if (EN(10) && IN(pb + 7)) { FRESH(); phase_r2(F, ap, l, last); } SEAM(pb + 7);
    }
#undef IN
#undef SEAM
}

extern "C" void kernel_launch(void* const* d_in, const int* in_sizes, int n_in, void* d_out, int out_size, void* d_ws, size_t ws_size, hipStream_t stream) {
    static int grid = 0;
    if (grid == 0) {
        if (n_in != 24 || in_sizes[0] != NB * SEQ * DM || out_size != NB * SEQ * DM || ws_size < WS_END) {
            fprintf(stderr, "kernel_launch: unexpected shapes: n_in %d in0 %d out %d ws %zu (need %zu); nothing launched\n", n_in, n_in > 0 ? in_sizes[0] : -1, out_size, ws_size, (size_t)WS_END); grid = -1; return; }
        int dev = 0, cus = 0, per_cu = 0;
        if (hipGetDevice(&dev) != hipSuccess || hipDeviceGetAttribute(&cus, hipDeviceAttributeMultiprocessorCount, dev) != hipSuccess) { grid = -1; return; }
        if (hipFuncSetAttribute((const void*)fwd_kernel, hipFuncAttributeMaxDynamicSharedMemorySize, LDS_BYTES) != hipSuccess) { fprintf(stderr, "kernel_launch: hipFuncSetAttribute failed\n"); grid = -1; return; }
        if (hipOccupancyMaxActiveBlocksPerMultiprocessor(&per_cu, (const void*)fwd_kernel, NWAVES * 64, LDS_BYTES) != hipSuccess || per_cu < 1)
            fprintf(stderr, "kernel_launch: note: occupancy query reports %d workgroups per CU\n", per_cu);
        (void)hipGetLastError();
        grid = cus;
    }
    if (grid < 0) return;
    if (hipMemsetAsync((char*)d_ws + WS_CTL, 0, CTL_ZERO_BYTES, stream) != hipSuccess) return;
    Args a{};
    for (int i = 0; i < 24; ++i) a.in[i] = (const float*)d_in[i];
    a.out = (float*)d_out; a.ws = (unsigned char*)d_ws;
#if MK_SINGLE
    a.ph_lo = 0; a.ph_hi = NPHASE;
    hipLaunchKernelGGL(fwd_kernel, dim3(grid), dim3(NWAVES * 64), LDS_BYTES, stream, a);
#else
    for (int p = 0; p < NPHASE; ++p) { a.ph_lo = p; a.ph_hi = p + 1; hipLaunchKernelGGL(fwd_kernel, dim3(grid), dim3(NWAVES * 64), LDS_BYTES, stream, a); }
#endif
    const hipError_t le = hipPeekAtLastError();
    if (le != hipSuccess) fprintf(stderr, "kernel_launch: launch failed: %s\n", hipGetErrorName(le));
}
```

```cpp
#include <hip/hip_runtime.h>
#include <cstdio>
#include <cstdint>

#ifndef MK_SINGLE
#define MK_SINGLE 1
#endif

namespace pg8 {
#define PG8_LAS __attribute__((address_space(3)))
typedef unsigned short bf16_t;
typedef short bf16x8 __attribute__((ext_vector_type(8)));
typedef float f32x4 __attribute__((ext_vector_type(4)));
typedef unsigned u32x4 __attribute__((ext_vector_type(4)));
constexpr int BM = 256, BK = 64, HALF = 128, HTB = HALF * BK * 2, STAGE_BYTES = 8 * HTB, NXCD = 8, WGM = 8;

__host__ __device__ __forceinline__ int lds_byte(int r, int c) { const int st = (r >> 4) * 2 + (c >> 5), rr = r & 15, cc = c & 31, ob = rr * 64 + cc * 2; return st * 1024 + (ob ^ (((ob >> 9) & 1) << 5)); }
__host__ __device__ __forceinline__ void stage_rc(int b, int& R, int& C) { const int st = b / 1024, sb = b % 1024, swz = sb ^ (((sb >> 9) & 1) << 5); R = (st >> 1) * 16 + swz / 64; C = (st & 1) * 32 + (swz % 64) / 2; }
__host__ __device__ __forceinline__ int perm32(int rho) { const int n = rho >> 4, i = rho & 15; return 8 * (i >> 2) + 4 * n + (i & 3); }

struct Unit { int pm, pn, kt0, nt, slab; };
struct Gemm { const bf16_t* A; const bf16_t* Bt; int M, N, K; };

struct StaticOrder {
    int nM, nN, nwg, G, c, skip, ntk;
    __host__ __device__ __forceinline__ void init(int nM_, int N, int K, int G_, int c_, int skip_) { nM = nM_; nN = N / BM; nwg = nM * nN; G = G_; c = c_; skip = skip_; ntk = K / BK; }
    __host__ __device__ __forceinline__ bool at(long L, Unit& u) const {
        if (L >= nwg) return false;
        int wgid = (int)L; { const int q = nwg / NXCD, r = nwg % NXCD, xcd = wgid % NXCD, off = wgid / NXCD; wgid = (xcd < r ? xcd * (q + 1) : r * (q + 1) + (xcd - r) * q) + off; }
        const int nig = WGM * nN, gid = wgid / nig, fm = gid * WGM, gsz = (nM - fm) < WGM ? (nM - fm) : WGM;
        u.pm = fm + ((wgid % nig) % gsz); u.pn = (wgid % nig) / gsz; u.kt0 = 0; u.nt = ntk; u.slab = -1;
        if (skip && u.pm >= 16) u.pm += 1;
        return true;
    }
    __host__ __device__ __forceinline__ bool next(int i, Unit& u) const { return at((long)i * G + c, u); }
    __device__ __forceinline__ void a_ready(const Unit&) const {}
    __device__ __forceinline__ void done(const Unit&) const {}
};
struct SplitOrder {
    StaticOrder so; int ca, cb;
    __host__ __device__ __forceinline__ void init(int N, int K, int G_, int c_) { so.init(32, N, K, G_, c_, 1); const int ntk = K / BK; ca = ((ntk / 8 + 1) / 2) * 2; cb = (ntk - 6 * ca) / 2; if (6 * ca + 2 * cb != ntk || (cb & 1) || cb <= 0) { ca = ntk / 8; cb = ca; } }
    __host__ __device__ __forceinline__ bool next(int i, Unit& u) const {
        const long L = (long)i * so.G + so.c;
        if (L < so.nwg) return so.at(L, u);
        const int q = (int)(L - so.nwg); if (ca == 0 || q >= 256) return false;
        const int ch = q & 7, pn = (q >> 3) & 15, pp = q >> 7;
        u.pm = pp ? 33 : 16; u.pn = pn; u.slab = ch; u.kt0 = ch < 6 ? ca * ch : 6 * ca + cb * (ch - 6); u.nt = ch < 6 ? ca : cb;
        return true;
    }
    __device__ __forceinline__ void a_ready(const Unit&) const {}
    __device__ __forceinline__ void done(const Unit&) const {}
};

__device__ __forceinline__ unsigned cvt_pk_bf16(float lo, float hi) { unsigned r; asm volatile("v_cvt_pk_bf16_f32 %0, %1, %2" : "=v"(r) : "v"(lo), "v"(hi)); return r; }

struct EpiBf16 {
    static constexpr bool PERM = true, AFTER_DRAIN = false, PREFETCH = false;
    bf16_t* O; int ldc;
    __device__ __forceinline__ void operator()(const f32x4 (&acc)[2][2][4][2], const Unit& u, int wr, int wc, int fr, int fq) const {
        const int row0 = u.pm * BM + wr * 64 + fr; const int col0 = u.pn * BM + wc * 32 + 8 * fq;
#pragma unroll
        for (int ai = 0; ai < 2; ++ai)
#pragma unroll
            for (int m = 0; m < 4; ++m) { bf16_t* rowp = O + (size_t)(row0 + ai * HALF + m * 16) * ldc + col0;
#pragma unroll
                for (int bj = 0; bj < 2; ++bj) { const f32x4 v0 = acc[ai][bj][m][0], v1 = acc[ai][bj][m][1];
                    u32x4 w; w.x = cvt_pk_bf16(v0[0], v0[1]); w.y = cvt_pk_bf16(v0[2], v0[3]); w.z = cvt_pk_bf16(v1[0], v1[1]); w.w = cvt_pk_bf16(v1[2], v1[3]);
                    *(u32x4*)(rowp + bj * HALF) = w; } }
    }
};

struct EpiSplit {
    static constexpr bool PERM = true, AFTER_DRAIN = false, PREFETCH = false;
    bf16_t* O; float* part; int ldc;
    __device__ __forceinline__ void operator()(const f32x4 (&acc)[2][2][4][2], const Unit& u, int wr, int wc, int fr, int fq) const {
        const int col0 = u.pn * BM + wc * 32 + 8 * fq;
        if (u.slab < 0) {
            const int row0 = u.pm * BM + wr * 64 + fr;
#pragma unroll
            for (int ai = 0; ai < 2; ++ai)
#pragma unroll
                for (int m = 0; m < 4; ++m) { bf16_t* rowp = O + (size_t)(row0 + ai * HALF + m * 16) * ldc + col0;
#pragma unroll
                    for (int bj = 0; bj < 2; ++bj) { const f32x4 v0 = acc[ai][bj][m][0], v1 = acc[ai][bj][m][1];
                        u32x4 w; w.x = cvt_pk_bf16(v0[0], v0[1]); w.y = cvt_pk_bf16(v0[2], v0[3]); w.z = cvt_pk_bf16(v1[0], v1[1]); w.w = cvt_pk_bf16(v1[2], v1[3]);
                        *(u32x4*)(rowp + bj * HALF) = w; } }
        } else {
            const int row0 = (u.pm == 16 ? 0 : 256) + wr * 64 + fr; float* pb = part + (size_t)u.slab * 512 * ldc;
#pragma unroll
            for (int ai = 0; ai < 2; ++ai)
#pragma unroll
                for (int m = 0; m < 4; ++m) { float* rowp = pb + (size_t)(row0 + ai * HALF + m * 16) * ldc + col0;
#pragma unroll
                    for (int bj = 0; bj < 2; ++bj) { *(f32x4*)(rowp + bj * HALF) = acc[ai][bj][m][0]; *(f32x4*)(rowp + bj * HALF + 4) = acc[ai][bj][m][1]; } }
        }
    }
};

struct EpiInProj {
    static constexpr bool PERM = true, AFTER_DRAIN = false, PREFETCH = false;
    bf16_t* O; int ldc; const PG8_LAS float* thd; const PG8_LAS float* gains; PG8_LAS float* xch;
    __device__ __forceinline__ void operator()(f32x4 (&acc)[2][2][4][2], const Unit& u, int wr, int wc, int fr, int fq) const {
        const int pmb = u.pm % 17; const bool ctx = (pmb == 16); const int pn = u.pn;
        const int kind = pn < 4 ? 1 : pn < 8 ? 2 : pn < 12 ? 3 : pn < 16 ? 0 : pn == 16 ? 4 : pn < 18 ? 0 : pn < 22 ? 2 : pn == 26 ? 3 : 0;
        if (kind == 1 || kind == 4) {
            const PG8_LAS float* g = gains + (kind == 1 ? 0 : 128) + wc * 32 + 8 * fq;
            const f32x4 g0 = *(const PG8_LAS f32x4*)g, g1 = *(const PG8_LAS f32x4*)(g + 4);
#pragma unroll
            for (int ai = 0; ai < 2; ++ai)
#pragma unroll
                for (int m = 0; m < 4; ++m)
#pragma unroll
                    for (int bj = 0; bj < 2; ++bj) { const f32x4 a = acc[ai][bj][m][0], b = acc[ai][bj][m][1];
                        float s = (a[0] * a[0] + a[1] * a[1]) + (a[2] * a[2] + a[3] * a[3]) + (b[0] * b[0] + b[1] * b[1]) + (b[2] * b[2] + b[3] * b[3]);
                        s += __shfl_xor(s, 16); s += __shfl_xor(s, 32);
                        if (fq == 0) xch[((ai * HALF + wr * 64 + m * 16 + fr) * 2 + bj) * 4 + wc] = s; }
            asm volatile("s_waitcnt lgkmcnt(0)" ::: "memory"); __builtin_amdgcn_s_barrier(); asm volatile("" ::: "memory");
#pragma unroll
            for (int ai = 0; ai < 2; ++ai)
#pragma unroll
                for (int m = 0; m < 4; ++m)
#pragma unroll
                    for (int bj = 0; bj < 2; ++bj) { const f32x4 p = *(const PG8_LAS f32x4*)(xch + ((ai * HALF + wr * 64 + m * 16 + fr) * 2 + bj) * 4);
                        const float rstd = __builtin_amdgcn_rsqf(((p[0] + p[1]) + (p[2] + p[3])) * (1.f / 128.f) + 1e-6f);
                        acc[ai][bj][m][0] = acc[ai][bj][m][0] * rstd * g0; acc[ai][bj][m][1] = acc[ai][bj][m][1] * rstd * g1; }
        }
        if (kind != 0 && !ctx) {
            const bool dh = (kind == 2);
#pragma unroll
            for (int ai = 0; ai < 2; ++ai)
#pragma unroll
                for (int m = 0; m < 4; ++m) { const int t = pmb * 256 + ai * HALF + wr * 64 + m * 16 + fr; const int grow = t >> 6, gcol = t & 63;
                    f32x4 c01, c23;
                    if (!dh) { const PG8_LAS float* tp = thd + (((wc < 2) ? grow : gcol) * 32 + 16 * (wc & 1) + 4 * fq) * 2; c01 = *(const PG8_LAS f32x4*)tp; c23 = *(const PG8_LAS f32x4*)(tp + 4); }
                    else { typedef float f32x2_ __attribute__((ext_vector_type(2))); const PG8_LAS float* tp = thd + ((((wc & 1) == 0) ? grow : gcol) * 32 + 8 * fq) * 2;
                        const f32x2_ e0 = *(const PG8_LAS f32x2_*)tp, e1 = *(const PG8_LAS f32x2_*)(tp + 4), e2 = *(const PG8_LAS f32x2_*)(tp + 8), e3 = *(const PG8_LAS f32x2_*)(tp + 12);
                        c01 = (f32x4){e0.x, e0.y, e1.x, e1.y}; c23 = (f32x4){e2.x, e2.y, e3.x, e3.y}; }
#pragma unroll
                    for (int bj = 0; bj < 2; ++bj) { f32x4 a = acc[ai][bj][m][0], b = acc[ai][bj][m][1];
                        acc[ai][bj][m][0] = (f32x4){a[0] * c01[0] - a[1] * c01[1], a[0] * c01[1] + a[1] * c01[0], a[2] * c01[2] - a[3] * c01[3], a[2] * c01[3] + a[3] * c01[2]};
                        acc[ai][bj][m][1] = (f32x4){b[0] * c23[0] - b[1] * c23[1], b[0] * c23[1] + b[1] * c23[0], b[2] * c23[2] - b[3] * c23[3], b[2] * c23[3] + b[3] * c23[2]}; } }
        }
        const int row0 = u.pm * BM + wr * 64 + fr; const int col0 = u.pn * BM + wc * 32 + 8 * fq;
#pragma unroll
        for (int ai = 0; ai < 2; ++ai)
#pragma unroll
            for (int m = 0; m < 4; ++m) { bf16_t* rowp = O + (size_t)(row0 + ai * HALF + m * 16) * ldc + col0;
#pragma unroll
                for (int bj = 0; bj < 2; ++bj) { const f32x4 v0 = acc[ai][bj][m][0], v1 = acc[ai][bj][m][1];
                    u32x4 w; w.x = cvt_pk_bf16(v0[0], v0[1]); w.y = cvt_pk_bf16(v0[2], v0[3]); w.z = cvt_pk_bf16(v1[0], v1[1]); w.w = cvt_pk_bf16(v1[2], v1[3]);
                    *(u32x4*)(rowp + bj * HALF) = w; } }
    }
};

struct EpiUpConv {
    static constexpr bool PERM = true, AFTER_DRAIN = false, PREFETCH = true;
    bf16_t* ACT; float* side; const float* cw; PG8_LAS float* xb; int dff; PG8_LAS float* wl0; PG8_LAS float* wl1; mutable int par;
    __device__ __forceinline__ void prefetch(const Unit& u, int parity, int wid, int lane) const {
        if (wid == 0) { PG8_LAS float* wl = parity ? wl1 : wl0;
#pragma unroll
            for (int i = 0; i < 3; ++i) { const int q = 64 * i + lane, bt = q >> 5, c4 = q & 31, bj = bt / 3, tap = bt - 3 * bj;
                __builtin_amdgcn_global_load_lds((const unsigned*)(cw + (size_t)tap * 2 * dff + bj * dff + u.pn * 128 + 4 * c4), (PG8_LAS unsigned*)(wl + 256 * i), 16, 0, 0); } }
    }
    static __device__ __forceinline__ float dppf(float old, float src, const int ctrl_sel) {
        const int o = __float_as_int(old), s = __float_as_int(src); int r;
        if (ctrl_sel == 0) r = __builtin_amdgcn_update_dpp(o, s, 0x111, 0xF, 0xF, false);
        else if (ctrl_sel == 1) r = __builtin_amdgcn_update_dpp(o, s, 0x101, 0xF, 0xF, false);
        else if (ctrl_sel == 2) r = __builtin_amdgcn_update_dpp(o, s, 0x121, 0xF, 0xF, false);
        else r = __builtin_amdgcn_update_dpp(o, s, 0x12F, 0xF, 0xF, false);
        return __int_as_float(r);
    }
    static __device__ __forceinline__ f32x4 dpp4(const f32x4 old, const f32x4 src, const int c) { return (f32x4){dppf(old[0], src[0], c), dppf(old[1], src[1], c), dppf(old[2], src[2], c), dppf(old[3], src[3], c)}; }
    static __device__ __forceinline__ int xidx(int ai, int wr, int wc, int which, int bj, int fq, int n) { return ((((((ai * 2 + wr) * 4 + wc) * 2 + which) * 2 + bj) * 4 + fq) * 2 + n) * 4; }
    __device__ __forceinline__ void operator()(const f32x4 (&acc)[2][2][4][2], const Unit& u, int wr, int wc, int fr, int fq) const {
        const int cbase = wc * 32 + 8 * fq;
        f32x4 wts[2][2][3];
#pragma unroll
        for (int bj = 0; bj < 2; ++bj)
#pragma unroll
            for (int n = 0; n < 2; ++n)
#pragma unroll
                for (int j = 0; j < 3; ++j) wts[bj][n][j] = *(const PG8_LAS f32x4*)((par ? wl1 : wl0) + (bj * 3 + j) * 128 + cbase + 4 * n);
#pragma unroll
        for (int ai = 0; ai < 2; ++ai)
#pragma unroll
            for (int bj = 0; bj < 2; ++bj)
#pragma unroll
                for (int n = 0; n < 2; ++n) {
                    if (fr == 0) *(PG8_LAS f32x4*)(xb + xidx(ai, wr, wc, 0, bj, fq, n)) = acc[ai][bj][0][n];
                    if (fr == 15) *(PG8_LAS f32x4*)(xb + xidx(ai, wr, wc, 1, bj, fq, n)) = acc[ai][bj][3][n]; }
        { float* sp = side + (size_t)u.pm * 4 * (2 * dff) + (size_t)u.pn * 256 + cbase;
          if (wr == 0 && fr < 2) {
#pragma unroll
              for (int bj = 0; bj < 2; ++bj)
#pragma unroll
                  for (int n = 0; n < 2; ++n) *(f32x4*)(sp + (size_t)fr * (2 * dff) + bj * 128 + 4 * n) = acc[0][bj][0][n]; }
          if (wr == 1 && fr >= 14) {
#pragma unroll
              for (int bj = 0; bj < 2; ++bj)
#pragma unroll
                  for (int n = 0; n < 2; ++n) *(f32x4*)(sp + (size_t)(fr - 12) * (2 * dff) + bj * 128 + 4 * n) = acc[1][bj][3][n]; } }
        asm volatile("s_waitcnt lgkmcnt(0)" ::: "memory"); __builtin_amdgcn_s_barrier(); asm volatile("" ::: "memory");
        const f32x4 zero4 = {0.f, 0.f, 0.f, 0.f};
#pragma unroll
        for (int ai = 0; ai < 2; ++ai)
#pragma unroll
            for (int m = 0; m < 4; ++m) {
                const int beta = 2 * ai + wr;
                u32x4 w;
#pragma unroll
                for (int n = 0; n < 2; ++n) {
                    f32x4 res[2];
#pragma unroll
                    for (int bj = 0; bj < 2; ++bj) {
                        const f32x4 cur = acc[ai][bj][m][n];
                        f32x4 oldp, oldn;
                        if (m > 0) oldp = dpp4(zero4, acc[ai][bj][m - 1][n], 2);
                        else if (beta > 0) oldp = *(const PG8_LAS f32x4*)(xb + xidx((beta - 1) >> 1, (beta - 1) & 1, wc, 1, bj, fq, n));
                        else oldp = zero4;
                        if (m < 3) oldn = dpp4(zero4, acc[ai][bj][m + 1][n], 3);
                        else if (beta < 3) oldn = *(const PG8_LAS f32x4*)(xb + xidx((beta + 1) >> 1, (beta + 1) & 1, wc, 0, bj, fq, n));
                        else oldn = zero4;
                        const f32x4 prev = dpp4(oldp, cur, 0), next = dpp4(oldn, cur, 1);
                        res[bj] = prev * wts[bj][n][0] + cur * wts[bj][n][1] + next * wts[bj][n][2];
                    }
                    f32x4 o;
#pragma unroll
                    for (int e = 0; e < 4; ++e) o[e] = res[0][e] * __builtin_amdgcn_rcpf(1.f + __expf(-res[0][e])) * res[1][e];
                    if (n == 0) { w.x = cvt_pk_bf16(o[0], o[1]); w.y = cvt_pk_bf16(o[2], o[3]); } else { w.z = cvt_pk_bf16(o[0], o[1]); w.w = cvt_pk_bf16(o[2], o[3]); }
                }
                *(u32x4*)(ACT + (size_t)(u.pm * BM + ai * HALF + wr * 64 + m * 16 + fr) * dff + u.pn * 128 + cbase) = w;
            }
    }
};

template <class Epi, class Sched, bool ALIGN_EPI = false>
__device__ __forceinline__ void gemm_phase(PG8_LAS unsigned char* lds, const Gemm g, const Sched& S, const Epi& E) {
    int tid_ = threadIdx.x; asm volatile("" : "+v"(tid_));
    const int tid = tid_, wid = __builtin_amdgcn_readfirstlane(tid >> 6), lane = tid & 63, wr = wid >> 2, wc = wid & 3, fr = lane & 15, fq = lane >> 4;
    const int K = g.K;
    unsigned voffA[2], voffB[2];
#pragma unroll
    for (int i = 0; i < 2; ++i) { int R, C; stage_rc(tid * 16 + i * 8192, R, C); const int Rb = Epi::PERM ? ((R & ~31) + perm32(R & 31)) : R;
        voffA[i] = (unsigned)(R * K + C) * 2u; voffB[i] = (unsigned)(Rb * K + C) * 2u; }
    const size_t kstep = (size_t)(BK * 2);
    const size_t hstep = (size_t)HALF * K * 2;
    const size_t tstep = 2 * hstep;
    const unsigned ldsw = (unsigned)wid * 1024u;
    const int aoff = lds_byte(wr * 64 + fr, fq * 8), boff = lds_byte(wc * 32 + fr, fq * 8);
#define PG8_SA(b, h) (((b) * 2 + (h)) * HTB)
#define PG8_SB(b, h) ((4 + (b) * 2 + (h)) * HTB)
#define PG8_STAGE(bufoff, gbase, voff) do { _Pragma("unroll") for (int _i = 0; _i < 2; ++_i) \
        __builtin_amdgcn_global_load_lds((const unsigned*)((const char*)(gbase) + (voff)[_i]), (PG8_LAS unsigned*)(lds + (bufoff) + ldsw + _i * 8192), 16, 0, 0); } while (0)
#define PG8_LDA(dst, b, h) do { _Pragma("unroll") for (int m = 0; m < 4; ++m) _Pragma("unroll") for (int k = 0; k < 2; ++k) dst[m][k] = *(const PG8_LAS bf16x8*)(lds + PG8_SA(b, h) + aoff + m * 2048 + k * 1024); } while (0)
#define PG8_LDB(dst, b, h) do { _Pragma("unroll") for (int n = 0; n < 2; ++n) _Pragma("unroll") for (int k = 0; k < 2; ++k) dst[n][k] = *(const PG8_LAS bf16x8*)(lds + PG8_SB(b, h) + boff + n * 2048 + k * 1024); } while (0)
#define PG8_MMA(ai, bj, At, Bt) do { __builtin_amdgcn_s_setprio(1); _Pragma("unroll") for (int m = 0; m < 4; ++m) _Pragma("unroll") for (int n = 0; n < 2; ++n) _Pragma("unroll") for (int k = 0; k < 2; ++k) \
        acc[ai][bj][m][n] = __builtin_amdgcn_mfma_f32_16x16x32_bf16(Bt[n][k], At[m][k], acc[ai][bj][m][n], 0, 0, 0); __builtin_amdgcn_s_setprio(0); } while (0)
#define PG8_WAIT_V(n) asm volatile("s_waitcnt vmcnt(" #n ")" ::: "memory")
#define PG8_WAIT_L(n) asm volatile("s_waitcnt lgkmcnt(" #n ")" ::: "memory")
#define PG8_BAR __builtin_amdgcn_s_barrier()
#define PG8_SCHED __builtin_amdgcn_sched_barrier(0)
    Unit cur, nxt; int ui = 0;
    if (!S.next(0, cur)) return;
    f32x4 acc[2][2][4][2];
#pragma unroll
    for (int a = 0; a < 2; ++a)
#pragma unroll
        for (int b = 0; b < 2; ++b)
#pragma unroll
            for (int m = 0; m < 4; ++m)
#pragma unroll
                for (int n = 0; n < 2; ++n) acc[a][b][m][n] = (f32x4){0.f, 0.f, 0.f, 0.f};
    bf16x8 At[4][2], B0[2][2], B1[2][2];
    const char* cA = (const char*)g.A + (size_t)cur.pm * tstep + (size_t)cur.kt0 * kstep; const char* cB = (const char*)g.Bt + (size_t)cur.pn * tstep + (size_t)cur.kt0 * kstep;
    S.a_ready(cur);
    if constexpr (Epi::PREFETCH) E.prefetch(cur, 0, wid, lane);
    PG8_STAGE(PG8_SB(0, 0), cB, voffB); PG8_STAGE(PG8_SB(0, 1), cB + hstep, voffB); PG8_STAGE(PG8_SA(0, 0), cA, voffA); PG8_STAGE(PG8_SA(0, 1), cA + hstep, voffA);
    if (wr == 1) PG8_BAR;
    PG8_WAIT_V(2); PG8_BAR;
    PG8_STAGE(PG8_SB(1, 0), cB + kstep, voffB); PG8_STAGE(PG8_SA(1, 0), cA + kstep, voffA); PG8_STAGE(PG8_SB(1, 1), cB + hstep + kstep, voffB);
    PG8_WAIT_V(6); PG8_BAR;
    for (;;) {
        const bool has_next = S.next(ui + 1, nxt);
        const char* nA = has_next ? (const char*)g.A + (size_t)nxt.pm * tstep + (size_t)nxt.kt0 * kstep : cA; const char* nB = has_next ? (const char*)g.Bt + (size_t)nxt.pn * tstep + (size_t)nxt.kt0 * kstep : cB;
        const int nt = cur.nt;
        for (int t = 0; t < nt; t += 2) {
            const bool last = (t == nt - 2);
            const char* a1 = cA + (size_t)(t + 1) * kstep;
            const char* a2 = last ? nA : cA + (size_t)(t + 2) * kstep; const char* b2 = last ? nB : cB + (size_t)(t + 2) * kstep;
            const char* a3 = a2 + kstep; const char* b3 = b2 + kstep;
            if (last && has_next) S.a_ready(nxt);
            PG8_LDB(B0, 0, 0); PG8_LDB(B1, 0, 1); PG8_SCHED; PG8_LDA(At, 0, 0); PG8_STAGE(PG8_SA(1, 1), a1 + hstep, voffA);
            PG8_WAIT_V(8); PG8_WAIT_L(0); PG8_BAR; PG8_MMA(0, 0, At, B0); PG8_MMA(0, 1, At, B1); PG8_BAR; PG8_SCHED;
            PG8_LDA(At, 0, 1); PG8_STAGE(PG8_SB(0, 0), b2, voffB); PG8_STAGE(PG8_SB(0, 1), b2 + hstep, voffB); PG8_STAGE(PG8_SA(0, 0), a2, voffA);
            PG8_WAIT_V(8); PG8_WAIT_L(0); PG8_BAR; PG8_MMA(1, 0, At, B0); PG8_MMA(1, 1, At, B1); PG8_BAR; PG8_SCHED;
            PG8_LDB(B0, 1, 0); PG8_LDB(B1, 1, 1); PG8_SCHED; PG8_LDA(At, 1, 0); PG8_STAGE(PG8_SA(0, 1), a2 + hstep, voffA);
            PG8_WAIT_V(8); PG8_WAIT_L(0); PG8_BAR; PG8_MMA(0, 0, At, B0); PG8_MMA(0, 1, At, B1); PG8_BAR; PG8_SCHED;
            PG8_LDA(At, 1, 1); PG8_STAGE(PG8_SB(1, 0), b3, voffB); PG8_STAGE(PG8_SB(1, 1), b3 + hstep, voffB); PG8_STAGE(PG8_SA(1, 0), a3, voffA);
            PG8_WAIT_V(8); PG8_WAIT_L(0); PG8_BAR; PG8_MMA(1, 0, At, B0); PG8_MMA(1, 1, At, B1); PG8_BAR; PG8_SCHED;
        }
        if constexpr (ALIGN_EPI) { if (wr == 0) PG8_BAR; }
        if constexpr (Epi::PREFETCH) { if (has_next) E.prefetch(nxt, (ui + 1) & 1, wid, lane); }
        if constexpr (!Epi::AFTER_DRAIN) { if constexpr (Epi::PREFETCH) E.par = ui & 1; E(acc, cur, wr, wc, fr, fq); S.done(cur); }
        if (!has_next) break;
#pragma unroll
        for (int a = 0; a < 2; ++a)
#pragma unroll
            for (int b = 0; b < 2; ++b)
#pragma unroll
                for (int m = 0; m < 4; ++m)
#pragma unroll
                    for (int n = 0; n < 2; ++n) acc[a][b][m][n] = (f32x4){0.f, 0.f, 0.f, 0.f};
        cur = nxt; cA = nA; cB = nB; ++ui;
        if constexpr (ALIGN_EPI) { if (wr == 1) PG8_BAR; }
    }
    PG8_WAIT_V(0);
    if constexpr (!ALIGN_EPI) { if (wr == 0) PG8_BAR; }
    PG8_BAR;
#undef PG8_SA
#undef PG8_SB
#undef PG8_STAGE
#undef PG8_LDA
#undef PG8_LDB
#undef PG8_MMA
#undef PG8_WAIT_V
#undef PG8_WAIT_L
#undef PG8_BAR
#undef PG8_SCHED
}
}

namespace att {
#define ALAS __attribute__((address_space(3)))
typedef unsigned short bf16;
typedef short bf16x8 __attribute__((ext_vector_type(8)));
typedef short s16x4 __attribute__((ext_vector_type(4)));
typedef float f32x16 __attribute__((ext_vector_type(16)));
typedef unsigned u32x4 __attribute__((ext_vector_type(4)));
constexpr int LDP = 9216, LDO = 4096;
constexpr int SLOT = 32768;
constexpr int WSCR_OFF = 131072 + 1024, BIAS_OFF = WSCR_OFF + 2048, SHM_END = BIAS_OFF + 2048;
constexpr int NCTX_T = 4;
#define KSWZ(row, colB) ((row) * 256 + ((colB) ^ (((row) & 7) << 4)))
#define SBAR() __builtin_amdgcn_sched_barrier(0)
__device__ __forceinline__ int crow(int r, int hi) { return (r & 3) + 8 * (r >> 2) + 4 * hi; }
__device__ __forceinline__ unsigned cvtpk(float lo, float hi) { unsigned r; asm volatile("v_cvt_pk_bf16_f32 %0, %1, %2" : "=v"(r) : "v"(lo), "v"(hi)); return r; }

__device__ __forceinline__ void partialSM(f32x16& p0, f32x16& p1, float& m_reg, float& mn, float& alpha, const float C, const float thr_raw) {
    float pmax = p0[0];
#pragma unroll
    for (int r = 1; r < 16; ++r) pmax = fmaxf(pmax, p0[r]);
#pragma unroll
    for (int r = 0; r < 16; ++r) pmax = fmaxf(pmax, p1[r]);
    { auto rr = __builtin_amdgcn_permlane32_swap(__float_as_uint(pmax), __float_as_uint(pmax), false, false);
      pmax = fmaxf(__uint_as_float(rr[0]), __uint_as_float(rr[1])); }
    if (__builtin_expect(__all(pmax - m_reg <= thr_raw), 1)) { mn = m_reg; alpha = 1.f; }
    else { mn = fmaxf(m_reg, pmax); alpha = __builtin_amdgcn_exp2f((m_reg - mn) * C); m_reg = mn; }
    const float mnC = -mn * C;
#pragma unroll
    for (int r = 0; r < 16; ++r) p0[r] = fmaf(p0[r], C, mnC);
#pragma unroll
    for (int r = 0; r < 16; ++r) p1[r] = fmaf(p1[r], C, mnC);
#pragma unroll
    for (int r = 0; r < 16; ++r) p0[r] = __builtin_amdgcn_exp2f(p0[r]);
}
__device__ __forceinline__ void finishSM(f32x16& p0, f32x16& p1, float alpha, float& l_reg, bf16x8& pa0, bf16x8& pa1, bf16x8& pa2, bf16x8& pa3) {
#pragma unroll
    for (int r = 0; r < 16; ++r) p1[r] = __builtin_amdgcn_exp2f(p1[r]);
    float ps = 0;
#pragma unroll
    for (int r = 0; r < 16; ++r) ps += p0[r];
#pragma unroll
    for (int r = 0; r < 16; ++r) ps += p1[r];
    { auto rr = __builtin_amdgcn_permlane32_swap(__float_as_uint(ps), __float_as_uint(ps), false, false);
      ps = __uint_as_float(rr[0]) + __uint_as_float(rr[1]); }
    l_reg = l_reg * alpha + ps;
#define PK4(P, BASE, OUT) do { unsigned a0 = cvtpk(P[BASE + 0], P[BASE + 1]), a1 = cvtpk(P[BASE + 2], P[BASE + 3]);   \
    unsigned b0 = cvtpk(P[BASE + 4], P[BASE + 5]), b1 = cvtpk(P[BASE + 6], P[BASE + 7]);                              \
    auto r0 = __builtin_amdgcn_permlane32_swap(a0, b0, false, false); auto r1 = __builtin_amdgcn_permlane32_swap(a1, b1, false, false); \
    u32x4 w = {r0[0], r1[0], r0[1], r1[1]}; OUT = __builtin_bit_cast(bf16x8, w); } while (0)
    PK4(p0, 0, pa0); PK4(p0, 8, pa1); PK4(p1, 0, pa2); PK4(p1, 8, pa3);
#undef PK4
}
template <int D0LO, int D0N>
__device__ __forceinline__ void qkt(f32x16& p0, f32x16& p1, const ALAS char* Ks, const bf16x8* qr, int r32, int hi) {
    p0 = f32x16{}; p1 = f32x16{};
    __builtin_amdgcn_s_setprio(1);
#pragma unroll
    for (int d0 = D0LO; d0 < D0LO + D0N; ++d0) { const int cb = (d0 * 16 + hi * 8) * 2;
        const bf16x8 b0 = *(const ALAS bf16x8*)(Ks + KSWZ(r32, cb));
        const bf16x8 b1 = *(const ALAS bf16x8*)(Ks + KSWZ(32 + r32, cb));
        p0 = __builtin_amdgcn_mfma_f32_32x32x16_bf16(b0, qr[d0], p0, 0, 0, 0);
        p1 = __builtin_amdgcn_mfma_f32_32x32x16_bf16(b1, qr[d0], p1, 0, 0, 0); }
    __builtin_amdgcn_s_setprio(0);
}
__device__ __forceinline__ int v_st(int k, int c) { const int kk = (k & ~0xC) | ((k & 4) << 1) | ((k & 8) >> 1); return ((kk >> 3) * 4 + (c >> 5)) * 512 + ((kk & 7) * 32 + (c & 31)) * 2; }
__device__ __forceinline__ int v_rd_base(int lane) { return ((lane & 3) << 3) | (((lane >> 2) & 3) << 6) | (((lane >> 4) & 1) << 5) | (((lane >> 5) & 1) << 8); }
constexpr int v_rd_off(int d0, int ks, int half) { return d0 * 512 + ks * 4096 + half * 2048; }
template <int OFF> __device__ __forceinline__ s16x4 tr_read(int vb) {
    s16x4 r; asm volatile("ds_read_b64_tr_b16 %0, %1 offset:%2" : "=&v"(r) : "v"(vb), "i"(OFF) : "memory"); return r;
}
template <int D0> __device__ __forceinline__ void pv_one(f32x16& od, int vb, bf16x8 pa0, bf16x8 pa1, bf16x8 pa2, bf16x8 pa3) {
    const s16x4 l0 = tr_read<v_rd_off(D0, 0, 0)>(vb), h0 = tr_read<v_rd_off(D0, 0, 1)>(vb), l1 = tr_read<v_rd_off(D0, 1, 0)>(vb), h1 = tr_read<v_rd_off(D0, 1, 1)>(vb);
    const s16x4 l2 = tr_read<v_rd_off(D0, 2, 0)>(vb), h2 = tr_read<v_rd_off(D0, 2, 1)>(vb), l3 = tr_read<v_rd_off(D0, 3, 0)>(vb), h3 = tr_read<v_rd_off(D0, 3, 1)>(vb);
    asm volatile("s_waitcnt lgkmcnt(0)" ::: "memory"); SBAR();
#define PK(L, H) (bf16x8){L[0], L[1], L[2], L[3], H[0], H[1], H[2], H[3]}
    od = __builtin_amdgcn_mfma_f32_32x32x16_bf16(pa0, PK(l0, h0), od, 0, 0, 0);
    od = __builtin_amdgcn_mfma_f32_32x32x16_bf16(pa1, PK(l1, h1), od, 0, 0, 0);
    od = __builtin_amdgcn_mfma_f32_32x32x16_bf16(pa2, PK(l2, h2), od, 0, 0, 0);
    od = __builtin_amdgcn_mfma_f32_32x32x16_bf16(pa3, PK(l3, h3), od, 0, 0, 0);
#undef PK
}
__device__ __forceinline__ void pv_d0(f32x16* o, int vb, bf16x8 pa0, bf16x8 pa1, bf16x8 pa2, bf16x8 pa3) {
    __builtin_amdgcn_s_setprio(1);
    pv_one<0>(o[0], vb, pa0, pa1, pa2, pa3); pv_one<1>(o[1], vb, pa0, pa1, pa2, pa3); pv_one<2>(o[2], vb, pa0, pa1, pa2, pa3); pv_one<3>(o[3], vb, pa0, pa1, pa2, pa3);
    __builtin_amdgcn_s_setprio(0);
}

template <int MASK>
__device__ __forceinline__ void apply_mask(f32x16& p0, f32x16& p1, int j, int loc0, int qp, int hi, const ALAS float* bias) {
    if constexpr (MASK == 2) {
        if (j >= NCTX_T) { const int kbase = loc0 + 64 * (j - NCTX_T);
#pragma unroll
            for (int r = 0; r < 16; ++r) { const int d0 = qp - (kbase + crow(r, hi)); const int d1 = d0 - 32;
                if (d0 > 128 || d0 < -128) p0[r] = -1e30f;
                if (d1 > 128 || d1 < -128) p1[r] = -1e30f; } }
    } else if constexpr (MASK == 3) {
        if (j >= NCTX_T) { const int kbase = loc0 + 64 * (j - NCTX_T);
            const int qrow = qp >> 6, qcol = qp & 63; const int rs = min(max(qrow - 4, 0), 56), cs = min(max(qcol - 8, 0), 48);
            const int kr = kbase >> 6; const int dr = kr - rs;
            if (dr < 0 || dr >= 8) {
#pragma unroll
                for (int r = 0; r < 16; ++r) { p0[r] = -1e30f; p1[r] = -1e30f; }
            } else {
                const ALAS float* brow = bias + (kr - qrow + 7) * 31 + 15 - qcol;
#pragma unroll
                for (int r = 0; r < 16; ++r) { const int kc0 = crow(r, hi), kc1 = kc0 + 32;
                    const bool ok0 = (unsigned)(kc0 - cs) < 16u, ok1 = (unsigned)(kc1 - cs) < 16u;
                    const float b0 = brow[ok0 ? kc0 : qcol], b1 = brow[ok1 ? kc1 : qcol];
                    p0[r] = ok0 ? p0[r] + b0 : -1e30f; p1[r] = ok1 ? p1[r] + b1 : -1e30f;
                    if ((r & 3) == 3) asm volatile("" ::: "memory"); }
            }
        }
    }
}

template <int MASK, int D0LO, int D0N>
__device__ __forceinline__ void attn_core(f32x16 (&o)[4], float& m_reg, float& l_reg, const bf16* __restrict__ Qw, const bf16* __restrict__ Kb, const bf16* __restrict__ Vb,
                                          const int nloc, const int loc0, const int qp, const float C, const float thr_raw, ALAS char* lds) {
    int tid_ = threadIdx.x; asm volatile("" : "+v"(tid_));
    const int tid = tid_, wid = __builtin_amdgcn_readfirstlane(tid >> 6), lane = tid & 63, r32 = lane & 31, hi = lane >> 5;
    ALAS float* ws = (ALAS float*)(lds + WSCR_OFF) + wid * 64; ALAS float* al_l = ws + 32;
    const ALAS float* bias = (const ALAS float*)(lds + BIAS_OFF);
    unsigned voffK[2], voffV[2];
#pragma unroll
    for (int i = 0; i < 2; ++i) { const int q = (wid + 8 * i) * 64 + lane;
        { const int row = q >> 4, cc = (q & 15) ^ (row & 7); voffK[i] = (unsigned)(row * (LDP * 2) + cc * 16); }
        { const int kk = (q >> 7) * 8 + ((q & 31) >> 2), c = ((q >> 5) & 3) * 32 + (q & 3) * 8; const int k = (kk & ~0xC) | ((kk & 4) << 1) | ((kk & 8) >> 1); voffV[i] = (unsigned)(k * (LDP * 2) + c * 2); } }
    const int NT = NCTX_T + nloc;
#define KOFF(j) ((j) < NCTX_T ? 4096 + 64 * (j) : loc0 + 64 * ((j) - NCTX_T))
#define ISSUE(j) do { const size_t _ro = (size_t)KOFF(j) * (LDP * 2); const char* _gk = (const char*)Kb + _ro; const char* _gv = (const char*)Vb + _ro; ALAS char* _sl = lds + ((j) & 3) * SLOT + wid * 1024; \
    _Pragma("unroll") for (int _i = 0; _i < 2; ++_i) __builtin_amdgcn_global_load_lds((const unsigned*)(_gk + voffK[_i]), (ALAS unsigned*)(_sl + _i * 8192), 16, 0, 0); \
    _Pragma("unroll") for (int _i = 0; _i < 2; ++_i) __builtin_amdgcn_global_load_lds((const unsigned*)(_gv + voffV[_i]), (ALAS unsigned*)(_sl + 16384 + _i * 8192), 16, 0, 0); } while (0)
#define WAITBAR(n) do { asm volatile("s_waitcnt vmcnt(" #n ") lgkmcnt(0)" ::: "memory"); __builtin_amdgcn_s_barrier(); asm volatile("" ::: "memory"); } while (0)
#define RESC(a) do { if (__any((a) < 1.f)) { if (hi == 0) al_l[r32] = (a); asm volatile("s_waitcnt lgkmcnt(0)" ::: "memory"); \
    _Pragma("unroll") for (int d = 0; d < 4; ++d) _Pragma("unroll") for (int r = 0; r < 16; ++r) o[d][r] *= al_l[crow(r, hi)]; } } while (0)
    asm volatile("s_waitcnt vmcnt(0)" ::: "memory");
    m_reg = -1e30f; l_reg = 0.f;
#pragma unroll
    for (int d = 0; d < 4; ++d) o[d] = f32x16{};
    bf16x8 qr[8];
#pragma unroll
    for (int d0 = 0; d0 < 8; ++d0) qr[d0] = *(const bf16x8*)(Qw + d0 * 16);
    ISSUE(0); ISSUE(1); ISSUE(2);
    const int vb0 = (int)(uintptr_t)lds + 16384 + v_rd_base(lane);
    f32x16 pA0, pA1, pB0, pB1; float mnA, mnB, alA, alB; bf16x8 pa0, pa1, pa2, pa3;
    WAITBAR(8);
    qkt<D0LO, D0N>(pA0, pA1, lds, qr, r32, hi); apply_mask<MASK>(pA0, pA1, 0, loc0, qp, hi, bias); partialSM(pA0, pA1, m_reg, mnA, alA, C, thr_raw);
    WAITBAR(4);
    ISSUE(3);
    for (int j = 1; j + 1 < NT; j += 2) {
        SBAR(); qkt<D0LO, D0N>(pB0, pB1, lds + (j & 3) * SLOT, qr, r32, hi);
        finishSM(pA0, pA1, alA, l_reg, pa0, pa1, pa2, pa3); SBAR();
        pv_d0(o, vb0 + ((j - 1) & 3) * SLOT, pa0, pa1, pa2, pa3); apply_mask<MASK>(pB0, pB1, j, loc0, qp, hi, bias); partialSM(pB0, pB1, m_reg, mnB, alB, C, thr_raw);
        if (j + 2 < NT) { WAITBAR(4); } else { WAITBAR(0); }
        if (j + 3 < NT) ISSUE(j + 3);
        RESC(alB);
        SBAR(); qkt<D0LO, D0N>(pA0, pA1, lds + ((j + 1) & 3) * SLOT, qr, r32, hi);
        finishSM(pB0, pB1, alB, l_reg, pa0, pa1, pa2, pa3); SBAR();
        pv_d0(o, vb0 + (j & 3) * SLOT, pa0, pa1, pa2, pa3); apply_mask<MASK>(pA0, pA1, j + 1, loc0, qp, hi, bias); partialSM(pA0, pA1, m_reg, mnA, alA, C, thr_raw);
        if (j + 3 < NT) { WAITBAR(4); } else { WAITBAR(0); }
        if (j + 4 < NT) ISSUE(j + 4);
        RESC(alA);
    }
    SBAR(); qkt<D0LO, D0N>(pB0, pB1, lds + ((NT - 1) & 3) * SLOT, qr, r32, hi);
    finishSM(pA0, pA1, alA, l_reg, pa0, pa1, pa2, pa3); SBAR();
    pv_d0(o, vb0 + ((NT - 2) & 3) * SLOT, pa0, pa1, pa2, pa3); apply_mask<MASK>(pB0, pB1, NT - 1, loc0, qp, hi, bias); partialSM(pB0, pB1, m_reg, mnB, alB, C, thr_raw);
    RESC(alB);
    finishSM(pB0, pB1, alB, l_reg, pa0, pa1, pa2, pa3); SBAR();
    pv_d0(o, vb0 + ((NT - 1) & 3) * SLOT, pa0, pa1, pa2, pa3);
#undef KOFF
#undef ISSUE
#undef WAITBAR
#undef RESC
}
}

constexpr int NWAVES = 8;
constexpr int DM = 4096, NB = 2, SEQ = 4096, CTXL = 256, TPB = SEQ + CTXL  , MROWS = NB * TPB  ;
constexpr int NIN = 9216, DFF = 11008, NUP = 2 * DFF, NADA = 6 * DM;
constexpr int QA = 0, QB_ = 1024, QC = 2048, QD = 3072, KA = 4096, VA = 4352, KB_ = 4608, VB_ = 5632, KC = 6656, VC = 6912, KD = 7168, VD = 8192;
constexpr float EPS = 1e-6f;
constexpr int NPHASE = 18;

constexpr size_t MiB = 1u << 20;
constexpr size_t WS_CTL = 0, CTL_ZERO_BYTES = 1 * MiB;
constexpr size_t WS_MOD = 1 * MiB;
constexpr size_t WS_TAB = 2 * MiB;
constexpr size_t WS_WIN = 4 * MiB;
constexpr size_t WS_WOUT = WS_WIN + 2 * 72 * MiB;
constexpr size_t WS_WUP = WS_WOUT + 2 * 32 * MiB;
constexpr size_t WS_WDN = WS_WUP + 2 * 172 * MiB;
constexpr size_t WS_XS = WS_WDN + 2 * 86 * MiB;
constexpr size_t WS_HX = WS_XS + 136 * MiB;
constexpr size_t WS_P = WS_HX + 68 * MiB;
constexpr size_t WS_O = WS_P + 153 * MiB;
constexpr size_t WS_Y = WS_O + 68 * MiB;
constexpr size_t WS_U = WS_Y + 68 * MiB;
constexpr size_t WS_ACT = WS_U + 366 * MiB;
constexpr size_t WS_STASH = WS_ACT + 183 * MiB;
constexpr size_t WS_PART = WS_STASH + 32 * MiB;
constexpr size_t WS_END = WS_PART + 64 * MiB;
static_assert((size_t)MROWS * NUP * 2 <= 366 * MiB && (size_t)MROWS * DFF * 2 <= 183 * MiB && (size_t)MROWS * NIN * 2 <= 153 * MiB, "ws map");
constexpr int CW_BAR = 4096;

constexpr int RING_OFF = 0, RING_BYTES = 131072;
constexpr int LDSCTL_OFF = RING_BYTES, MISC_OFF = LDSCTL_OFF + 320;
constexpr int LDS_BYTES = 163840;
constexpr int WL_OFF = att::SHM_END + 8192, THD_OFF = WL_OFF + 3072, GAINS_OFF = att::WSCR_OFF;
static_assert(THD_OFF + 16384 <= LDS_BYTES, "LDS map");
constexpr int XCH_OFF = att::SHM_END;
static_assert(XCH_OFF + 8192 <= LDS_BYTES && att::WSCR_OFF >= MISC_OFF + 128, "LDS map");

#define GAS __attribute__((address_space(1)))
#define LAS __attribute__((address_space(3)))
typedef unsigned short bf16;
typedef unsigned v4u __attribute__((ext_vector_type(4)));
typedef unsigned v2u __attribute__((ext_vector_type(2)));
typedef float f32x4 __attribute__((ext_vector_type(4)));
typedef float f32x2 __attribute__((ext_vector_type(2)));
typedef GAS unsigned gu32;
#define RLX_AGENT __ATOMIC_RELAXED, __HIP_MEMORY_SCOPE_AGENT
#define LDS_WAIT() asm volatile("s_waitcnt lgkmcnt(0)" ::: "memory")
#define VM_WAIT() asm volatile("s_waitcnt vmcnt(0)" ::: "memory")
__device__ __forceinline__ unsigned f2bf(float f) { unsigned u = __builtin_bit_cast(unsigned, f); return (u + 0x7fffu + ((u >> 16) & 1u)) >> 16; }
__device__ __forceinline__ unsigned pk2(float lo, float hi) { return f2bf(lo) | (f2bf(hi) << 16); }
__device__ __forceinline__ float bf_lo(unsigned w) { return __uint_as_float(w << 16); }
__device__ __forceinline__ float bf_hi(unsigned w) { return __uint_as_float(w & 0xffff0000u); }

#define XB_TMO      128
#define XB_XCNT(j)  (256  + 64 * (j))
#define XB_XSUB(j)  (1280 + 64 * (j))
#define XB_XGEN(j)  (2304 + 64 * (j))
#define XB_TOP      3328
#define XB_TOPGEN   3392
#define XCD_BAR_WORDS 3456
#define XB_SPIN_CAP (1u << 24)

__device__ __forceinline__ unsigned xb_ld(unsigned* p)              { return __hip_atomic_load(p, __ATOMIC_RELAXED, __HIP_MEMORY_SCOPE_AGENT); }
__device__ __forceinline__ unsigned xb_add(unsigned* p, unsigned v) { return __hip_atomic_fetch_add(p, v, __ATOMIC_RELAXED, __HIP_MEMORY_SCOPE_AGENT); }
__device__ __forceinline__ unsigned xb_xcc_id() { return (unsigned)__builtin_amdgcn_s_getreg((3 << 11) | 20) & 0xFu; }
#define XB_SPIN(cond, bar) do { unsigned _sp = 0; while (cond) { __builtin_amdgcn_s_sleep(1); \
    if ((++_sp & 255u) == 0u) { if (xb_ld(&(bar)[XB_TMO])) break; if (_sp > XB_SPIN_CAP) { atomicAdd(&(bar)[XB_TMO], 1u); break; } } } } while (0)

struct XcdBarrier { unsigned* bar; unsigned x; volatile LAS unsigned* st; };

__device__ __forceinline__ XcdBarrier xcd_barrier_post(unsigned* bar, volatile LAS unsigned* st) {
    XcdBarrier b; b.bar = bar; b.x = xb_xcc_id(); b.st = st;
    if (threadIdx.x == 0) (void)xb_add(&bar[XB_XCNT(b.x)], 1u);
    return b;
}
__device__ __forceinline__ void xcd_barrier_complete(unsigned* bar, unsigned x, unsigned& nloc, unsigned& nx) {
    const unsigned G = gridDim.x * gridDim.y * gridDim.z;
    unsigned sum, cnt, mine, sp = 0u;
    for (;;) {
        sum = 0u; cnt = 0u; mine = 0u;
#pragma unroll
        for (unsigned j = 0; j < 16; ++j) { const unsigned c = xb_ld(&bar[XB_XCNT(j)]); sum += c; cnt += (c > 0u) ? 1u : 0u; mine = (j == x) ? c : mine; }
        if (sum == G) break;
        __builtin_amdgcn_s_sleep(1);
        if ((++sp & 255u) == 0u) { if (xb_ld(&bar[XB_TMO])) break; if (sp > XB_SPIN_CAP) { atomicAdd(&bar[XB_TMO], 1u); break; } }
    }
    nloc = mine > 0u ? mine : 1u; nx = cnt > 0u ? cnt : 1u;
}
__device__ __forceinline__ void xcd_barrier(const XcdBarrier& b) {
    asm volatile("s_waitcnt vmcnt(0)" ::: "memory");
    __syncthreads();
    if (threadIdx.x == 0) {
        unsigned* bar = b.bar;
        __builtin_amdgcn_s_waitcnt(0);
        unsigned nloc = b.st[0], nx = b.st[1];
        if (nloc == 0u) { xcd_barrier_complete(bar, b.x, nloc, nx); b.st[0] = nloc; b.st[1] = nx; }
        const unsigned old = xb_add(&bar[XB_XSUB(b.x)], 1u);
        const unsigned gen = old / nloc;
        if (old + 1u == (gen + 1u) * nloc) {
            __builtin_amdgcn_fence(__ATOMIC_RELEASE, "agent");
            asm volatile("s_waitcnt vmcnt(0)" ::: "memory");
            const unsigned og = xb_add(&bar[XB_TOP], 1u);
            const unsigned tg = og / nx;
            if (og + 1u == (tg + 1u) * nx) xb_add(&bar[XB_TOPGEN], 1u);
            else XB_SPIN(xb_ld(&bar[XB_TOPGEN]) == tg, bar);
            __builtin_amdgcn_fence(__ATOMIC_ACQUIRE, "agent");
            xb_add(&bar[XB_XGEN(b.x)], 1u);
            asm volatile("s_waitcnt vmcnt(0)" ::: "memory");
        } else {
            XB_SPIN(xb_ld(&bar[XB_XGEN(b.x)]) == gen, bar);
            __builtin_amdgcn_fence(__ATOMIC_ACQUIRE, "agent");
            asm volatile("s_waitcnt vmcnt(0)" ::: "memory");
        }
    }
    __syncthreads();
}

struct Args {
    const float* in[24]; float* out; unsigned char* ws; int ph_lo, ph_hi;
};
typedef __attribute__((address_space(4))) const Args* KArgs;
struct Frame {
    LAS unsigned char* lds;
    int tid, lane, wave, vcu, G;
    unsigned char* ws;
};

__device__ __forceinline__ int fresh_bx() { int bx = blockIdx.x; asm volatile("" : "+s"(bx)); return bx; }
__device__ __forceinline__ float wave_sum(float v) {
#pragma unroll
    for (int o = 1; o < 64; o <<= 1) v += __shfl_xor(v, o);
    return v;
}

__device__ const float INV32[32] = {
    1.0f, 0.74989420933f, 0.56234132519f, 0.42169650343f, 0.31622776602f, 0.23713737057f, 0.17782794100f, 0.13335214322f,
    0.1f, 0.074989420933f, 0.056234132519f, 0.042169650343f, 0.031622776602f, 0.023713737057f, 0.017782794100f, 0.013335214322f,
    0.01f, 0.0074989420933f, 0.0056234132519f, 0.0042169650343f, 0.0031622776602f, 0.0023713737057f, 0.0017782794100f, 0.0013335214322f,
    0.001f, 0.00074989420933f, 0.00056234132519f, 0.00042169650343f, 0.00031622776602f, 0.00023713737057f, 0.00017782794100f, 0.00013335214322f };
__device__ const float INV16[16] = {
    1.0f, 0.56234132519f, 0.31622776602f, 0.17782794100f, 0.1f, 0.056234132519f, 0.031622776602f, 0.017782794100f,
    0.01f, 0.0056234132519f, 0.0031622776602f, 0.0017782794100f, 0.001f, 0.00056234132519f, 0.00031622776602f, 0.00017782794100f };

__device__ __forceinline__ void sincos_acc(float af, float& c, float& s) {
    const double a = (double)af; const double kd = __builtin_rint(a * 0.63661977236758134308); const int k = (int)kd;
    const double r = (a - kd * 1.57079632679489655800) - kd * 6.12323399573676603587e-17; const double r2 = r * r;
    const double sn = r * (1.0 + r2 * (-1.0 / 6 + r2 * (1.0 / 120 + r2 * (-1.0 / 5040 + r2 * (1.0 / 362880 + r2 * (-1.0 / 39916800 + r2 * (1.0 / 6227020800.0)))))));
    const double cs = 1.0 + r2 * (-0.5 + r2 * (1.0 / 24 + r2 * (-1.0 / 720 + r2 * (1.0 / 40320 + r2 * (-1.0 / 3628800 + r2 * (1.0 / 479001600.0 + r2 * (-1.0 / 87178291200.0)))))));
    double cc, ss;
    switch (k & 3) { case 0: cc = cs; ss = sn; break; case 1: cc = -sn; ss = cs; break; case 2: cc = -cs; ss = -sn; break; default: cc = sn; ss = -cs; break; }
    c = (float)cc; s = (float)ss;
}

__device__ __forceinline__ unsigned cvtpk_bf16(float lo, float hi) { unsigned r; asm volatile("v_cvt_pk_bf16_f32 %0, %1, %2" : "=v"(r) : "v"(lo), "v"(hi)); return r; }
__device__ __forceinline__ void p0_transpose_item(const float* W, int K, int N, bf16* WT, int item, int lane, bool gv) {
    const int nblk = N / 64, kb = item / nblk, nb = item % nblk, k0 = 64 * kb, n0 = 64 * nb;
    const int v0 = !gv ? n0 : (n0 < DFF ? (n0 >> 7) * 256 + (n0 & 127) : ((n0 - DFF) >> 7) * 256 + 128 + ((n0 - DFF) & 127));
    const int kr = lane >> 4, c4 = lane & 15;
    const GAS float* src = (const GAS float*)W + (size_t)(k0 + 16 * kr) * N + n0 + 4 * c4;
    f32x4 v[16];
#pragma unroll
    for (int i = 0; i < 16; ++i) v[i] = __builtin_nontemporal_load((const GAS f32x4*)(src + (size_t)i * N));
    GAS bf16* dst = (GAS bf16*)WT + (size_t)(v0 + 4 * c4) * K + k0 + 16 * kr;
#pragma unroll
    for (int e = 0; e < 4; ++e) {
        v4u o0, o1;
        o0.x = cvtpk_bf16(v[0][e], v[1][e]); o0.y = cvtpk_bf16(v[2][e], v[3][e]); o0.z = cvtpk_bf16(v[4][e], v[5][e]); o0.w = cvtpk_bf16(v[6][e], v[7][e]);
        o1.x = cvtpk_bf16(v[8][e], v[9][e]); o1.y = cvtpk_bf16(v[10][e], v[11][e]); o1.z = cvtpk_bf16(v[12][e], v[13][e]); o1.w = cvtpk_bf16(v[14][e], v[15][e]);
        *(GAS v4u*)(dst + (size_t)e * K) = o0; *(GAS v4u*)(dst + (size_t)e * K + 8) = o1;
    }
}

__device__ __forceinline__ void convert_matrix(Frame& F, KArgs a, int mat, int l, int gw, int ngw, int part = 0) {
    const float* W; bf16* WT; int K, N;
    if (mat == 0) { W = a->in[10] + (size_t)l * DM * NIN; WT = (bf16*)(F.ws + WS_WIN + (size_t)l * 72 * MiB); K = DM; N = NIN; }
    else if (mat == 1) { W = a->in[11] + (size_t)l * DM * DM; WT = (bf16*)(F.ws + WS_WOUT + (size_t)l * 32 * MiB); K = DM; N = DM; }
    else if (mat == 2) { W = a->in[21] + (size_t)l * DM * NUP; WT = (bf16*)(F.ws + WS_WUP + (size_t)l * 172 * MiB); K = DM; N = NUP; }
    else { W = a->in[23] + (size_t)l * DFF * DM; WT = (bf16*)(F.ws + WS_WDN + (size_t)l * 86 * MiB); K = DFF; N = DM; }
    const int nitems = (K / 64) * (N / 64); const int lo = part == 2 ? nitems / 2 : 0, hi = part == 1 ? nitems / 2 : nitems;
    for (int it = lo + gw; it < hi; it += ngw) p0_transpose_item(W, K, N, WT, it, F.lane, mat == 2);
}
__device__ __forceinline__ void tail_convert(Frame& F, KArgs a, int nbusy, int mat0, int l0, int part0, int mat1, int l1, int part1) {
    const int bx = fresh_bx(); if (bx < nbusy || nbusy >= F.G) return;
    const int gw = (bx - nbusy) * NWAVES + F.wave, ngw = (F.G - nbusy) * NWAVES;
    convert_matrix(F, a, mat0, l0, gw, ngw, part0);
    if (mat1 >= 0) convert_matrix(F, a, mat1, l1, gw, ngw, part1);
}
__device__ __forceinline__ float silu_f(float x) { return x / (1.f + __expf(-x)); }

__device__ __forceinline__ void phase_prologue(Frame& F, KArgs a) {
    const float* c_in = a->in[1]; const float* cctx = a->in[3]; const float* w_ada = a->in[4]; const float* b_ada = a->in[5];
    float* mod = (float*)(F.ws + WS_MOD);
    if (F.vcu == 0) {
        f32x2* thd = (f32x2*)(F.ws + WS_TAB);
        for (int e = F.tid; e < 64 * 32; e += NWAVES * 64) { const int pos = e >> 5, i = e & 31; float c, s; sincos_acc((float)pos * INV32[i], c, s); thd[e] = (f32x2){c, s}; }
        f32x2* tdh = (f32x2*)(F.ws + WS_TAB + 16384);
        for (int e = F.tid; e < 64 * 16; e += NWAVES * 64) { const int pos = e >> 4, i = e & 15; float c, s; sincos_acc((float)pos * INV16[i], c, s); tdh[e] = (f32x2){c, s}; }
        if (F.tid < 2) { const int l = F.tid; float s1 = 0.f, s2 = 0.f;
            for (int i = 0; i < 64; ++i) { s1 += a->in[14][l * 64 + i] * a->in[15][l * 64 + i]; s2 += a->in[16][l * 64 + i] * a->in[17][l * 64 + i]; }
            const float lam_init = 0.8f - 0.6f * expf(-0.3f * (float)l);
            float* lam = (float*)(F.ws + WS_TAB + 32768); lam[l * 2 + 0] = expf(s1) - expf(s2) + lam_init; lam[l * 2 + 1] = 1.f - lam_init; }
    }
    {
        LAS float* sv = (LAS float*)(F.lds + RING_OFF);
        LAS float* red = (LAS float*)(F.lds + RING_OFF + 49152);
        for (int e = F.tid; e < 3 * DM; e += NWAVES * 64) { const int v = e / DM, k = e % DM; const float x = v < 2 ? c_in[v * DM + k] : cctx[k]; sv[e] = silu_f(x); }
        __syncthreads();
        const int cg = F.lane & 15, kq = F.lane >> 4;
        for (int it = F.vcu; it < 2 * (NADA / 64); it += F.G) {
            const int l = it / (NADA / 64), ch = it % (NADA / 64);
            const float* W = w_ada + (size_t)l * DM * NADA + ch * 64 + cg * 4;
            f32x4 a0 = {0.f, 0.f, 0.f, 0.f}, a1 = a0, a2 = a0;
#pragma unroll 8
            for (int s = 0; s < DM / 32; ++s) { const int k = s * 32 + F.wave * 4 + kq; const f32x4 w = __builtin_nontemporal_load((const GAS f32x4*)(W + (size_t)k * NADA));
                a0 += w * sv[k]; a1 += w * sv[DM + k]; a2 += w * sv[2 * DM + k]; }
#pragma unroll
            for (int e = 0; e < 4; ++e) { a0[e] += __shfl_xor(a0[e], 16); a0[e] += __shfl_xor(a0[e], 32); a1[e] += __shfl_xor(a1[e], 16); a1[e] += __shfl_xor(a1[e], 32); a2[e] += __shfl_xor(a2[e], 16); a2[e] += __shfl_xor(a2[e], 32); }
            if (kq == 0) {
#pragma unroll
                for (int e = 0; e < 4; ++e) { red[(F.wave * 3 + 0) * 64 + cg * 4 + e] = a0[e]; red[(F.wave * 3 + 1) * 64 + cg * 4 + e] = a1[e]; red[(F.wave * 3 + 2) * 64 + cg * 4 + e] = a2[e]; } }
            __syncthreads();
            if (F.tid < 192) { const int v = F.tid / 64, cidx = F.tid % 64; float s = 0.f;
#pragma unroll
                for (int w = 0; w < 8; ++w) s += red[(w * 3 + v) * 64 + cidx];
                const int col = ch * 64 + cidx; mod[((size_t)l * 3 + v) * NADA + col] = s + b_ada[(size_t)l * NADA + col]; }
            __syncthreads();
        }
    }
    {
        const int gw = F.vcu * NWAVES + F.wave, NGW = F.G * NWAVES;
        convert_matrix(F, a, 0, 0, gw, NGW); convert_matrix(F, a, 2, 0, gw, NGW); convert_matrix(F, a, 2, 1, gw, NGW);
        if (F.G != 256) { convert_matrix(F, a, 1, 0, gw, NGW); convert_matrix(F, a, 3, 0, gw, NGW); convert_matrix(F, a, 0, 1, gw, NGW); convert_matrix(F, a, 1, 1, gw, NGW); convert_matrix(F, a, 3, 1, gw, NGW); }
    }
}

struct RowRegs { f32x4 v[16]; };
__device__ __forceinline__ float row_sumsq(const RowRegs& r) {
    float s = 0.f;
#pragma unroll
    for (int j = 0; j < 16; ++j) s += (r.v[j].x * r.v[j].x + r.v[j].y * r.v[j].y) + (r.v[j].z * r.v[j].z + r.v[j].w * r.v[j].w);
    return wave_sum(s);
}
__device__ __forceinline__ void row_load_f32(RowRegs& r, const float* p, int lane) {
    const GAS f32x4* q = (const GAS f32x4*)p + lane;
#pragma unroll
    for (int j = 0; j < 16; ++j) r.v[j] = __builtin_nontemporal_load(q + 64 * j);
}
__device__ __forceinline__ void row_load_bf16(RowRegs& r, const bf16* p, int lane) {
    const GAS v2u* q = (const GAS v2u*)p + lane;
#pragma unroll
    for (int j = 0; j < 16; ++j) { const v2u w = __builtin_nontemporal_load(q + 64 * j); r.v[j] = (f32x4){bf_lo(w.x), bf_hi(w.x), bf_lo(w.y), bf_hi(w.y)}; }
}
__device__ __forceinline__ void row_store_f32(const RowRegs& r, float* p, int lane) {
    GAS f32x4* q = (GAS f32x4*)p + lane;
#pragma unroll
    for (int j = 0; j < 16; ++j) __builtin_nontemporal_store(r.v[j], q + 64 * j);
}
__device__ __forceinline__ void row_store_bf16(const RowRegs& r, bf16* p, int lane) {
    GAS v2u* q = (GAS v2u*)p + lane;
#pragma unroll
    for (int j = 0; j < 16; ++j) { v2u w; w.x = pk2(r.v[j].x, r.v[j].y); w.y = pk2(r.v[j].z, r.v[j].w); __builtin_nontemporal_store(w, q + 64 * j); }
}
__device__ __forceinline__ void row_modnorm_store(const RowRegs& x, float rstd, const float* g, const float* sc, const float* sh, bf16* out, int lane) {
    GAS v2u* q = (GAS v2u*)out + lane;
#pragma unroll
    for (int j = 0; j < 16; ++j) { const int c = 4 * lane + 256 * j;
        const f32x4 gv = *(const GAS f32x4*)(g + c), sv = *(const GAS f32x4*)(sc + c), hv = *(const GAS f32x4*)(sh + c);
        const f32x4 y = (x.v[j] * rstd) * gv * (sv + 1.f) + hv;
        v2u w; w.x = pk2(y.x, y.y); w.y = pk2(y.z, y.w); q[64 * j] = w; }
}
__device__ __forceinline__ void row_residual(RowRegs& x, const RowRegs& y, float rstd, const float* g, const float* gate, int lane) {
#pragma unroll
    for (int j = 0; j < 16; ++j) { const int c = 4 * lane + 256 * j;
        const f32x4 gv = *(const GAS f32x4*)(g + c), tv = *(const GAS f32x4*)(gate + c);
        x.v[j] = x.v[j] + tv * ((y.v[j] * rstd) * gv); }
}

__device__ __forceinline__ void row_load_part(RowRegs& r, const float* part, int lrow, int lane) {
#pragma unroll
    for (int j = 0; j < 16; ++j) r.v[j] = (f32x4){0.f, 0.f, 0.f, 0.f};
#pragma unroll 2
    for (int c = 0; c < 8; ++c) { const GAS f32x4* q = (const GAS f32x4*)(part + ((size_t)c * 512 + lrow) * DM) + lane;
#pragma unroll
        for (int j = 0; j < 16; ++j) r.v[j] += q[64 * j]; }
}

__device__ __forceinline__ void phase_r0(Frame& F, KArgs a) {
    const float* mod = (const float*)(F.ws + WS_MOD); bf16* hx = (bf16*)(F.ws + WS_HX);
    const int gw = F.vcu * NWAVES + F.wave, NGW = F.G * NWAVES;
    for (int m = gw; m < MROWS; m += NGW) {
        const int b = m / TPB, t = m % TPB; const bool lat = t < SEQ;
        const float* src = lat ? a->in[0] + ((size_t)b * SEQ + t) * DM : a->in[2] + ((size_t)b * CTXL + (t - SEQ)) * DM;
        RowRegs x; row_load_f32(x, src, F.lane);
        const float rstd = 1.f / sqrtf(row_sumsq(x) * (1.f / DM) + EPS);
        const float* mv = mod + (size_t)(0 * 3 + (lat ? b : 2)) * NADA;
        row_modnorm_store(x, rstd, a->in[6]  , mv + DM, mv, hx + (size_t)m * DM, F.lane);
    }
}
__device__ __forceinline__ int r_row_balanced(int vcu, int wave, int k) {
    int id;
    if (wave < 2) { if (k == 0) { const int j = 2 * vcu + wave; return (j >> 8) * TPB + SEQ + (j & 255); } if (k > 1) return -1; id = 32 * vcu + wave; }
    else { if (k > 4) return -1; id = 32 * vcu + 2 + (wave - 2) * 5 + k; }
    return id + (id >= SEQ ? CTXL : 0);
}
__device__ __forceinline__ void phase_r1(Frame& F, KArgs a, int l, bool last) {
    const float* mod = (const float*)(F.ws + WS_MOD); bf16* xs = (bf16*)(F.ws + WS_XS); bf16* hx = (bf16*)(F.ws + WS_HX); const bf16* yb = (const bf16*)(F.ws + WS_Y);
    const int gw = F.vcu * NWAVES + F.wave, NGW = F.G * NWAVES; const bool bal = !last && F.G == 256;
    for (int k = 0;; ++k) {
        int m; if (bal) { m = r_row_balanced(F.vcu, F.wave, k); if (m < 0) break; } else { m = gw + k * NGW; if (m >= MROWS) break; }
        const int b = m / TPB, t = m % TPB; const bool lat = t < SEQ;
        if (last && !lat) continue;
        const float* mv = mod + (size_t)(l * 3 + (lat ? b : 2)) * NADA;
        RowRegs x, y;
        if (l == 0) row_load_f32(x, lat ? a->in[0] + ((size_t)b * SEQ + t) * DM : a->in[2] + ((size_t)b * CTXL + (t - SEQ)) * DM, F.lane);
        else row_load_bf16(x, xs + (size_t)m * DM, F.lane);
        if (lat) row_load_bf16(y, yb + (size_t)m * DM, F.lane); else row_load_part(y, (const float*)(F.ws + WS_PART), b * 256 + (t - SEQ), F.lane);
        const float rstd_y = 1.f / sqrtf(row_sumsq(y) * (1.f / DM) + EPS);
        row_residual(x, y, rstd_y, a->in[7] + (size_t)l * DM, mv + 2 * DM, F.lane);
        row_store_bf16(x, xs + (size_t)m * DM, F.lane);
        const float rstd = 1.f / sqrtf(row_sumsq(x) * (1.f / DM) + EPS);
        row_modnorm_store(x, rstd, a->in[8] + (size_t)l * DM, mv + 4 * DM, mv + 3 * DM, hx + (size_t)m * DM, F.lane);
    }
}
__device__ __forceinline__ void phase_r2(Frame& F, KArgs a, int l, bool last) {
    const float* mod = (const float*)(F.ws + WS_MOD); bf16* xs = (bf16*)(F.ws + WS_XS); bf16* hx = (bf16*)(F.ws + WS_HX); const bf16* yb = (const bf16*)(F.ws + WS_Y);
    const int gw = F.vcu * NWAVES + F.wave, NGW = F.G * NWAVES; const bool bal = !last && F.G == 256;
    for (int k = 0;; ++k) {
        int m; if (bal) { m = r_row_balanced(F.vcu, F.wave, k); if (m < 0) break; } else { m = gw + k * NGW; if (m >= MROWS) break; }
        const int b = m / TPB, t = m % TPB; const bool lat = t < SEQ;
        if (last && !lat) continue;
        const float* mv = mod + (size_t)(l * 3 + (lat ? b : 2)) * NADA;
        RowRegs x, y; row_load_bf16(x, xs + (size_t)m * DM, F.lane);
        if (lat) row_load_bf16(y, yb + (size_t)m * DM, F.lane); else row_load_part(y, (const float*)(F.ws + WS_PART), b * 256 + (t - SEQ), F.lane);
        const float rstd_y = 1.f / sqrtf(row_sumsq(y) * (1.f / DM) + EPS);
        row_residual(x, y, rstd_y, a->in[9] + (size_t)l * DM, mv + 5 * DM, F.lane);
        if (last) { row_store_f32(x, a->out + ((size_t)b * SEQ + t) * DM, F.lane); continue; }
        row_store_bf16(x, xs + (size_t)m * DM, F.lane);
        const float rstd = 1.f / sqrtf(row_sumsq(x) * (1.f / DM) + EPS);
        const float* mn = mod + (size_t)((l + 1) * 3 + (lat ? b : 2)) * NADA;
        row_modnorm_store(x, rstd, a->in[6] + (size_t)(l + 1) * DM, mn + DM, mn, hx + (size_t)m * DM, F.lane);
    }
}

__device__ __forceinline__ void phase_fixup(Frame& F, KArgs a, int l, bool last) {
    const float* side = (const float*)(F.ws + WS_U); bf16* ACT = (bf16*)(F.ws + WS_ACT);
    const float* cw = a->in[22] + (size_t)l * 3 * NUP;
    constexpr int CG = DFF / 4;
    const int ntile = last ? 32 : 34;
    for (int idx = F.vcu * NWAVES * 64 + F.tid; idx < ntile * 2 * CG; idx += F.G * NWAVES * 64) {
        const int cg = idx % CG, e = (idx / CG) & 1, pmi = idx / (2 * CG); const int pm = (last && pmi >= 16) ? pmi + 1 : pmi; const int pmb = pm % 17;
        const int col = cg * 4, vg = (col >> 7) * 256 + (col & 127);
        const float* sb = side + (size_t)pm * 4 * NUP;
        const f32x4 zero4 = {0.f, 0.f, 0.f, 0.f};
        f32x4 pg, pv, cg_, cv, ng, nv;
        if (e == 0) {
            cg_ = *(const GAS f32x4*)(sb + vg); cv = *(const GAS f32x4*)(sb + vg + 128); ng = *(const GAS f32x4*)(sb + NUP + vg); nv = *(const GAS f32x4*)(sb + NUP + vg + 128);
            if (pmb == 0 || pmb == 16) { pg = zero4; pv = zero4; } else { pg = *(const GAS f32x4*)(sb - NUP + vg); pv = *(const GAS f32x4*)(sb - NUP + vg + 128); }
        } else {
            cg_ = *(const GAS f32x4*)(sb + 3 * (size_t)NUP + vg); cv = *(const GAS f32x4*)(sb + 3 * (size_t)NUP + vg + 128); pg = *(const GAS f32x4*)(sb + 2 * (size_t)NUP + vg); pv = *(const GAS f32x4*)(sb + 2 * (size_t)NUP + vg + 128);
            if (pmb >= 15) { ng = zero4; nv = zero4; } else { ng = *(const GAS f32x4*)(sb + 4 * (size_t)NUP + vg); nv = *(const GAS f32x4*)(sb + 4 * (size_t)NUP + vg + 128); }
        }
        const f32x4 g = pg * *(const GAS f32x4*)(cw + col) + cg_ * *(const GAS f32x4*)(cw + NUP + col) + ng * *(const GAS f32x4*)(cw + 2 * NUP + col);
        const f32x4 v = pv * *(const GAS f32x4*)(cw + DFF + col) + cv * *(const GAS f32x4*)(cw + NUP + DFF + col) + nv * *(const GAS f32x4*)(cw + 2 * NUP + DFF + col);
        f32x4 o;
#pragma unroll
        for (int k = 0; k < 4; ++k) o[k] = g[k] / (1.f + __expf(-g[k])) * v[k];
        v2u w; w.x = pk2(o.x, o.y); w.y = pk2(o.z, o.w);
        *(GAS v2u*)(ACT + (size_t)(pm * 256 + (e ? 255 : 0)) * DFF + col) = w;
    }
}

template <int MASK>
__device__ __forceinline__ void attn_std_unit(Frame& F, const bf16* P, bf16* O, int b, int qrow0  , int qcol, int kcol, int vcol, int ocol,
                                              int nloc, int loc0, float sink, bool has_sink) {
    using namespace att;
    int lane_ = F.lane; asm volatile("" : "+v"(lane_));
    int lane = lane_, wid = F.wave, r32 = lane & 31, hi = lane >> 5;
    constexpr float SCALE = 0.088388347648318440f; constexpr float C = SCALE * 1.4426950408889634f;
    const size_t base = (size_t)b * TPB;
    const bf16* Qw = P + (base + qrow0 + wid * 32 + r32) * LDP + qcol + hi * 8;
    f32x16 o[4]; float m_reg, l_reg;
    attn_core<MASK, 0, 8>(o, m_reg, l_reg, Qw, P + base * LDP + kcol, P + base * LDP + vcol, nloc, loc0, qrow0 + wid * 32 + r32, C, 8.f / SCALE, (ALAS char*)F.lds);
    if (has_sink) l_reg += __builtin_amdgcn_exp2f(sink * 1.4426950408889634f - m_reg * C);
    asm volatile("" : "+v"(lane_)); lane = lane_; r32 = lane & 31; hi = lane >> 5;
    ALAS float* li_l = (ALAS float*)((ALAS char*)F.lds + WSCR_OFF) + wid * 64;
    if (hi == 0) li_l[r32] = l_reg; asm volatile("s_waitcnt lgkmcnt(0)" ::: "memory");
    bf16* Ow = O + (base + qrow0 + wid * 32) * LDO + ocol;
#pragma unroll
    for (int r = 0; r < 16; ++r) { const int orow = crow(r, hi); const float rl = __builtin_amdgcn_rcpf(li_l[orow]);
#pragma unroll
        for (int d0 = 0; d0 < 4; ++d0) Ow[(size_t)orow * LDO + d0 * 32 + r32] = (bf16)f2bf(o[d0][r] * rl); }
}
__device__ __forceinline__ void attn_diff_unit(Frame& F, const bf16* P, bf16* O, int b, int qrow0, int h, int nloc, int loc0, float lam, float omli, const float* gsub) {
    using namespace att;
    int lane_ = F.lane; asm volatile("" : "+v"(lane_));
    int lane = lane_, wid = F.wave, r32 = lane & 31, hi = lane >> 5;
    constexpr float SCALE = 0.125f; constexpr float C = SCALE * 1.4426950408889634f;
    const size_t base = (size_t)b * TPB;
    const bf16* Qw = P + (base + qrow0 + wid * 32 + r32) * LDP + QB_ + h * 128 + hi * 8;
    const bf16* Kb = P + base * LDP + KB_ + h * 128; const bf16* Vb = P + base * LDP + VB_ + h * 128;
    ALAS float* li_l = (ALAS float*)((ALAS char*)F.lds + WSCR_OFF) + wid * 64;
    f32x16 o[4]; float m_reg, l_reg;
    attn_core<0, 4, 4>(o, m_reg, l_reg, Qw, Kb, Vb, nloc, loc0, 0, C, 8.f / SCALE, (ALAS char*)F.lds);
    asm volatile("" : "+v"(lane_)); lane = lane_; r32 = lane & 31; hi = lane >> 5;
    if (hi == 0) li_l[r32] = l_reg; asm volatile("s_waitcnt lgkmcnt(0)" ::: "memory");
    { float* stash = (float*)(F.ws + WS_STASH) + ((size_t)blockIdx.x * 8 + wid) * 4096 + lane;
#pragma unroll
    for (int d0 = 0; d0 < 4; ++d0) { float* sp = stash + d0 * 1024; asm volatile("" : "+v"(sp));
#pragma unroll
        for (int r = 0; r < 16; ++r) sp[r * 64] = o[d0][r] * __builtin_amdgcn_rcpf(li_l[crow(r, hi)]); } }
    __syncthreads();
    attn_core<0, 0, 4>(o, m_reg, l_reg, Qw, Kb, Vb, nloc, loc0, 0, C, 8.f / SCALE, (ALAS char*)F.lds);
    asm volatile("" : "+v"(lane_)); lane = lane_; r32 = lane & 31; hi = lane >> 5;
    if (hi == 0) li_l[r32] = l_reg; asm volatile("s_waitcnt lgkmcnt(0)" ::: "memory");
    float* stash = (float*)(F.ws + WS_STASH) + ((size_t)blockIdx.x * 8 + wid) * 4096 + lane;
    float g4[4];
#pragma unroll
    for (int d0 = 0; d0 < 4; ++d0) g4[d0] = gsub[d0 * 32 + r32] * omli;
    bf16* Ow = O + (base + qrow0 + wid * 32) * LDO + QB_ + h * 128;
#pragma unroll
    for (int r = 0; r < 16; ++r) { const int orow = crow(r, hi); const float rl = __builtin_amdgcn_rcpf(li_l[orow]);
        float v[4]; float ss = 0.f;
#pragma unroll
        for (int d0 = 0; d0 < 4; ++d0) { v[d0] = o[d0][r] * rl - lam * stash[(d0 * 16 + r) * 64]; ss += v[d0] * v[d0]; }
        ss += __shfl_xor(ss, 1); ss += __shfl_xor(ss, 2); ss += __shfl_xor(ss, 4); ss += __shfl_xor(ss, 8); ss += __shfl_xor(ss, 16);
        const float rstd = 1.f / sqrtf(ss * (1.f / 128.f) + EPS);
#pragma unroll
        for (int d0 = 0; d0 < 4; ++d0) Ow[(size_t)orow * LDO + d0 * 32 + r32] = (bf16)f2bf(v[d0] * rstd * g4[d0]); }
}

__device__ __forceinline__ void phase_attention(Frame& F, KArgs a, int l, bool last) {
    const bf16* P = (const bf16*)(F.ws + WS_P); bf16* O = (bf16*)(F.ws + WS_O);
    const float* lamv = (const float*)(F.ws + WS_TAB + 32768); const float lam = lamv[l * 2], omli = lamv[l * 2 + 1];
    const float* sinkv = a->in[19] + l * 8; const float* gsub = a->in[18] + l * 128; const float* nab = a->in[20] + (size_t)l * 8 * 15 * 31;
#ifndef ATT_MASK
#define ATT_MASK 15
#endif
    if (ATT_MASK & 1) for (int it = 0;; ++it) { int u;
        if (F.G == 256) { if (it == 0) u = F.vcu; else if (it == 1 && !last && F.vcu >= 192 && F.vcu < 208) u = 256 + (F.vcu - 192); else break; }
        else { u = F.vcu + it * F.G; if (u >= (last ? 256 : 272)) break; }
        int b, h, qrow0, nloc;
        if (u < 256) { b = u >> 7; h = (u >> 4) & 7; qrow0 = (u & 15) * 256; nloc = 64; } else { const int e = u - 256; b = e >> 3; h = e & 7; qrow0 = SEQ; nloc = 0; }
        __syncthreads(); attn_diff_unit(F, P, O, b, qrow0, h, nloc, 0, lam, omli, gsub);
    }
    if (ATT_MASK & 2) for (int it = 0;; ++it) { int u;
        if (F.G == 256) { if (it == 0) u = F.vcu; else if (it == 1 && !last && F.vcu >= 208) u = 256 + (F.vcu - 208); else break; }
        else { u = F.vcu + it * F.G; if (u >= (last ? 256 : 304)) break; }
        int b, qrow0, qcol, kcol, vcol, nloc; float sink = 0.f; bool has_sink = false;
        if (u < 256) { const int h = (u >> 4) & 7, qb = u & 15; b = u >> 7; qrow0 = qb * 256; qcol = QA + h * 128; kcol = KA + (h >> 2) * 128; vcol = VA + (h >> 2) * 128; nloc = 64; }
        else { const int e = u - 256, g = e >> 4, h = e & 7; b = (e >> 3) & 1; qrow0 = SEQ; nloc = 0;
            if (g == 0) { qcol = QA + h * 128; kcol = KA + (h >> 2) * 128; vcol = VA + (h >> 2) * 128; }
            else if (g == 1) { qcol = QC + h * 128; kcol = KC + (h >> 2) * 128; vcol = VC + (h >> 2) * 128; sink = sinkv[h]; has_sink = true; }
            else { qcol = QD + h * 128; kcol = KD + h * 128; vcol = VD + h * 128; } }
        __syncthreads(); attn_std_unit<0>(F, P, O, b, qrow0, qcol, kcol, vcol, qcol, nloc, 0, sink, has_sink);
    }
    if (ATT_MASK & 4) for (int u = F.vcu; u < 256; u += F.G) { const int b = u >> 7, h = (u >> 4) & 7, qb = u & 15;
        const int lo = max(qb * 256 - 128, 0), hiK = min(qb * 256 + 384, SEQ);
        __syncthreads(); attn_std_unit<2>(F, P, O, b, qb * 256, QC + h * 128, KC + (h >> 2) * 128, VC + (h >> 2) * 128, QC + h * 128, (hiK - lo) / 64, lo, sinkv[h], true); }
    if (ATT_MASK & 8) for (int u = F.vcu; u < 256; u += F.G) { const int b = u >> 7, h = (u >> 4) & 7, qb = u & 15;
        const int r0 = qb * 4; int rlo, nrow;
        if (r0 == 0) { rlo = 0; nrow = 8; } else if (r0 == 60) { rlo = 56; nrow = 8; } else { rlo = min(r0 - 4, 52); nrow = 12; }
        __syncthreads();
        { LAS float* bl = (LAS float*)(F.lds + att::BIAS_OFF); for (int e = F.tid; e < 15 * 31; e += NWAVES * 64) bl[e] = nab[h * 465 + e] * 11.313708498984761f; }
        attn_std_unit<3>(F, P, O, b, qb * 256, QD + h * 128, KD + h * 128, VD + h * 128, QD + h * 128, nrow, rlo * 64, 0.f, false); }
    __syncthreads();
}

__global__ void __launch_bounds__(NWAVES * 64, 2) fwd_kernel(Args args) {
    extern __shared__ __attribute__((aligned(16))) unsigned char lds[];
    Frame F;
    F.lds = (LAS unsigned char*)lds;
    volatile LAS unsigned* MISC = (volatile LAS unsigned*)(F.lds + MISC_OFF);
    F.tid = threadIdx.x; F.lane = F.tid & 63; F.wave = __builtin_amdgcn_readfirstlane(F.tid >> 6);
    F.G = gridDim.x; { const int bx = blockIdx.x; F.vcu = (F.G % 8 == 0) ? (bx % 8) * (F.G / 8) + bx / 8 : bx; }
    KArgs ap = (KArgs)__builtin_amdgcn_kernarg_segment_ptr();
    F.ws = ap->ws;
    gu32* ctl = (gu32*)(F.ws + WS_CTL);
    for (int u = F.tid; u < (LDS_BYTES - LDSCTL_OFF) / 4; u += NWAVES * 64) ((LAS unsigned*)(F.lds + LDSCTL_OFF))[u] = 0u;
    __syncthreads();
    const int lo = ap->ph_lo, hi = ap->ph_hi;
    XcdBarrier bar; bar.bar = (unsigned*)(ctl + CW_BAR); bar.x = 0; bar.st = nullptr;
    if (hi - lo > 1) bar = xcd_barrier_post((unsigned*)(ctl + CW_BAR), MISC + 8);
#ifndef PH_MASK
#define PH_MASK 0x7ff
#endif
#ifndef REP_PRO
#define REP_PRO 1
#endif
#ifndef REP_ATT
#define REP_ATT 1
#endif
#ifndef REP_GEMM
#define REP_GEMM 1
#endif
#ifndef REP_CONV
#define REP_CONV 1
#endif
#define IN(k) (lo <= (k) && (k) < hi)
#define FRESH() asm volatile("" : "+v"(F.tid), "+v"(F.lane), "+s"(ap))
#define EN(j) (((PH_MASK) >> (j)) & 1)
#define SEAM(k) do { if (IN(k) && IN((k) + 1)) xcd_barrier(bar); } while (0)

    if (EN(0) && IN(0)) { for (int rep = 0; rep < REP_PRO; ++rep) { FRESH(); phase_prologue(F, ap); __syncthreads(); } } SEAM(0);
    if (EN(1) && IN(1)) { FRESH(); phase_r0(F, ap); } SEAM(1);
    for (int l = 0; l < 2; ++l) {
        const bool last = (l == 1); const int pb = 2 + 8 * l;
        const pg8::bf16_t* HX = (const pg8::bf16_t*)(F.ws + WS_HX);
        if (EN(2) && IN(pb + 0)) {
            pg8::Gemm g{HX, (const pg8::bf16_t*)(F.ws + WS_WIN + (size_t)l * 72 * MiB), MROWS, NIN, DM};
            pg8::StaticOrder S; S.init(MROWS / 256, NIN, DM, F.G, fresh_bx(), 0);
            { FRESH(); const f32x4* tg = (const f32x4*)(F.ws + WS_TAB); LAS f32x4* tl = (LAS f32x4*)(F.lds + THD_OFF);
              for (int e = F.tid; e < 1024; e += NWAVES * 64) tl[e] = tg[e];
              LAS float* gl = (LAS float*)(F.lds + GAINS_OFF); if (F.tid < 256) gl[F.tid] = (F.tid < 128 ? ap->in[12] + l * 128 : ap->in[13] + l * 128 - 128)[F.tid];
              __syncthreads(); }
            pg8::EpiInProj E{(pg8::bf16_t*)(F.ws + WS_P), NIN, (const LAS float*)(F.lds + THD_OFF), (const LAS float*)(F.lds + GAINS_OFF), (LAS float*)(F.lds + XCH_OFF)};
            pg8::gemm_phase<pg8::EpiInProj, pg8::StaticOrder, true>(F.lds + RING_OFF, g, S, E);
            if (F.G == 256) { if (!last) tail_convert(F, ap, (34 * 36) % 256, 1, 0, 0, -1, 0, 0); else tail_convert(F, ap, (34 * 36) % 256, 1, 1, 0, 3, 1, 1); }
        } SEAM(pb + 0);
        if (EN(4) && IN(pb + 1)) { for (int rep = 0; rep < REP_ATT; ++rep) { FRESH(); phase_attention(F, ap, l, last); } } SEAM(pb + 1);
        if (EN(5) && IN(pb + 2)) {
            pg8::Gemm g{(const pg8::bf16_t*)(F.ws + WS_O), (const pg8::bf16_t*)(F.ws + WS_WOUT + (size_t)l * 32 * MiB), MROWS, DM, DM};
            pg8::SplitOrder S; S.init(DM, DM, F.G, fresh_bx()); if (last) S.ca = 0;
            pg8::EpiSplit E{(pg8::bf16_t*)(F.ws + WS_Y), (float*)(F.ws + WS_PART), DM};
            pg8::gemm_phase<pg8::EpiSplit, pg8::SplitOrder, true>(F.lds + RING_OFF, g, S, E);
        } SEAM(pb + 2);
        if (EN(6) && IN(pb + 3)) { FRESH(); phase_r1(F, ap, l, last); } SEAM(pb + 3);
        if (EN(7) && IN(pb + 4)) {
            pg8::Gemm g{HX, (const pg8::bf16_t*)(F.ws + WS_WUP + (size_t)l * 172 * MiB), MROWS, NUP, DM};
            pg8::StaticOrder S; S.init(last ? 32 : 34, NUP, DM, F.G, fresh_bx(), last ? 1 : 0);
            pg8::EpiUpConv E{(pg8::bf16_t*)(F.ws + WS_ACT), (float*)(F.ws + WS_U), ap->in[22] + (size_t)l * 3 * NUP, (LAS float*)(F.lds + XCH_OFF), DFF, (LAS float*)(F.lds + WL_OFF), (LAS float*)(F.lds + GAINS_OFF), 0};
            pg8::gemm_phase<pg8::EpiUpConv, pg8::StaticOrder, true>(F.lds + RING_OFF, g, S, E);
            if (F.G == 256) { if (!last) tail_convert(F, ap, (34 * 86) % 256, 3, 0, 0, 0, 1, 0); else tail_convert(F, ap, (32 * 86) % 256, 3, 1, 2, -1, 0, 0); }
        } SEAM(pb + 4);
        if (EN(8) && IN(pb + 5)) { for (int rep = 0; rep < REP_CONV; ++rep) { FRESH(); phase_fixup(F, ap, l, last); } } SEAM(pb + 5);
        if (EN(9) && IN(pb + 6)) {
            pg8::Gemm g{(const pg8::bf16_t*)(F.ws + WS_ACT), (const pg8::bf16_t*)(F.ws + WS_WDN + (size_t)l * 86 * MiB), MROWS, DM, DFF};
            pg8::SplitOrder S; S.init(DM, DFF, F.G, fresh_bx()); if (last) S.ca = 0;
            pg8::EpiSplit E{(pg8::bf16_t*)(F.ws + WS_Y), (float*)(F.ws + WS_PART), DM};
            pg8::gemm_phase<pg8::EpiSplit, pg8::SplitOrder, true>(F.lds + RING_OFF, g, S, E);
        } SEAM(pb + 6);
        if (EN(10) && IN(pb + 7)) { FRESH(); phase_r2(F, ap, l, last); } SEAM(pb + 7);
    }
#undef IN
#undef SEAM
}

extern "C" void kernel_launch(void* const* d_in, const int* in_sizes, int n_in, void* d_out, int out_size, void* d_ws, size_t ws_size, hipStream_t stream) {
    static int grid = 0;
    if (grid == 0) {
        if (n_in != 24 || in_sizes[0] != NB * SEQ * DM || out_size != NB * SEQ * DM || ws_size < WS_END) {
            fprintf(stderr, "kernel_launch: unexpected shapes: n_in %d in0 %d out %d ws %zu (need %zu); nothing launched\n", n_in, n_in > 0 ? in_sizes[0] : -1, out_size, ws_size, (size_t)WS_END); grid = -1; return; }
        int dev = 0, cus = 0, per_cu = 0;
        if (hipGetDevice(&dev) != hipSuccess || hipDeviceGetAttribute(&cus, hipDeviceAttributeMultiprocessorCount, dev) != hipSuccess) { grid = -1; return; }
        if (hipFuncSetAttribute((const void*)fwd_kernel, hipFuncAttributeMaxDynamicSharedMemorySize, LDS_BYTES) != hipSuccess) { fprintf(stderr, "kernel_launch: hipFuncSetAttribute failed\n"); grid = -1; return; }
        if (hipOccupancyMaxActiveBlocksPerMultiprocessor(&per_cu, (const void*)fwd_kernel, NWAVES * 64, LDS_BYTES) != hipSuccess || per_cu < 1)
            fprintf(stderr, "kernel_launch: note: occupancy query reports %d workgroups per CU\n", per_cu);
        (void)hipGetLastError();
        grid = cus;
    }
    if (grid < 0) return;
    if (hipMemsetAsync((char*)d_ws + WS_CTL, 0, CTL_ZERO_BYTES, stream) != hipSuccess) return;
    Args a{};
    for (int i = 0; i < 24; ++i) a.in[i] = (const float*)d_in[i];
    a.out = (float*)d_out; a.ws = (unsigned char*)d_ws;
#if MK_SINGLE
    a.ph_lo = 0; a.ph_hi = NPHASE;
    hipLaunchKernelGGL(fwd_kernel, dim3(grid), dim3(NWAVES * 64), LDS_BYTES, stream, a);
#else
    for (int p = 0; p < NPHASE; ++p) { a.ph_lo = p; a.ph_hi = p + 1; hipLaunchKernelGGL(fwd_kernel, dim3(grid), dim3(NWAVES * 64), LDS_BYTES, stream, a); }
#endif
    const hipError_t le = hipPeekAtLastError();
    if (le != hipSuccess) fprintf(stderr, "kernel_launch: launch failed: %s\n", hipGetErrorName(le));
}
```

```cpp
#include <hip/hip_runtime.h>
#include <cstdio>
#include <cstdint>

#ifndef MK_SINGLE
#define MK_SINGLE 1
#endif

namespace pg8 {
#define PG8_LAS __attribute__((address_space(3)))
typedef unsigned short bf16_t;
typedef short bf16x8 __attribute__((ext_vector_type(8)));
typedef float f32x4 __attribute__((ext_vector_type(4)));
typedef unsigned u32x4 __attribute__((ext_vector_type(4)));
constexpr int BM = 256, BK = 64, HALF = 128, HTB = HALF * BK * 2, STAGE_BYTES = 8 * HTB, NXCD = 8, WGM = 8;

__host__ __device__ __forceinline__ int lds_byte(int r, int c) { const int st = (r >> 4) * 2 + (c >> 5), rr = r & 15, cc = c & 31, ob = rr * 64 + cc * 2; return st * 1024 + (ob ^ (((ob >> 9) & 1) << 5)); }
__host__ __device__ __forceinline__ void stage_rc(int b, int& R, int& C) { const int st = b / 1024, sb = b % 1024, swz = sb ^ (((sb >> 9) & 1) << 5); R = (st >> 1) * 16 + swz / 64; C = (st & 1) * 32 + (swz % 64) / 2; }
__host__ __device__ __forceinline__ int perm32(int rho) { const int n = rho >> 4, i = rho & 15; return 8 * (i >> 2) + 4 * n + (i & 3); }

struct Unit { int pm, pn, kt0, nt, slab; };
struct Gemm { const bf16_t* A; const bf16_t* Bt; int M, N, K; };

struct StaticOrder {
    int nM, nN, nwg, G, c, skip, ntk;
    __host__ __device__ __forceinline__ void init(int nM_, int N, int K, int G_, int c_, int skip_) { nM = nM_; nN = N / BM; nwg = nM * nN; G = G_; c = c_; skip = skip_; ntk = K / BK; }
    __host__ __device__ __forceinline__ bool at(long L, Unit& u) const {
        if (L >= nwg) return false;
        int wgid = (int)L; { const int q = nwg / NXCD, r = nwg % NXCD, xcd = wgid % NXCD, off = wgid / NXCD; wgid = (xcd < r ? xcd * (q + 1) : r * (q + 1) + (xcd - r) * q) + off; }
        const int nig = WGM * nN, gid = wgid / nig, fm = gid * WGM, gsz = (nM - fm) < WGM ? (nM - fm) : WGM;
        u.pm = fm + ((wgid % nig) % gsz); u.pn = (wgid % nig) / gsz; u.kt0 = 0; u.nt = ntk; u.slab = -1;
        if (skip && u.pm >= 16) u.pm += 1;
        return true;
    }
    int extra = 0, xpn0 = 0;
    __host__ __device__ __forceinline__ bool next(int i, Unit& u) const {
        const long L = (long)i * G + c;
        if (L < nwg || extra == 0) return at(L, u);
        const int e = (int)(L - nwg); if (e >= extra) return false;
        const int per = extra / 2; u.pm = e < per ? 16 : 33; u.pn = xpn0 + (e < per ? e : e - per); u.kt0 = 0; u.nt = ntk; u.slab = -1; return true;
    }
    __device__ __forceinline__ void a_ready(const Unit&) const {}
    __device__ __forceinline__ void done(const Unit&) const {}
};
struct SplitOrder {
    StaticOrder so; int ca, cb;
    __host__ __device__ __forceinline__ void init(int N, int K, int G_, int c_) { so.init(32, N, K, G_, c_, 1); const int ntk = K / BK; ca = ((ntk / 8 + 1) / 2) * 2; cb = (ntk - 6 * ca) / 2; if (6 * ca + 2 * cb != ntk || (cb & 1) || cb <= 0) { ca = ntk / 8; cb = ca; } }
    __host__ __device__ __forceinline__ bool next(int i, Unit& u) const {
        const long L = (long)i * so.G + so.c;
        if (L < so.nwg) return so.at(L, u);
        const int q = (int)(L - so.nwg); if (ca == 0 || q >= 256) return false;
        const int ch = q & 7, pn = (q >> 3) & 15, pp = q >> 7;
        u.pm = pp ? 33 : 16; u.pn = pn; u.slab = ch; u.kt0 = ch < 6 ? ca * ch : 6 * ca + cb * (ch - 6); u.nt = ch < 6 ? ca : cb;
        return true;
    }
    __device__ __forceinline__ void a_ready(const Unit&) const {}
    __device__ __forceinline__ void done(const Unit&) const {}
};

__device__ __forceinline__ unsigned cvt_pk_bf16(float lo, float hi) { unsigned r; asm volatile("v_cvt_pk_bf16_f32 %0, %1, %2" : "=v"(r) : "v"(lo), "v"(hi)); return r; }

struct EpiBf16 {
    static constexpr bool PERM = true, AFTER_DRAIN = false, PREFETCH = false;
    bf16_t* O; int ldc;
    __device__ __forceinline__ void operator()(const f32x4 (&acc)[2][2][4][2], const Unit& u, int wr, int wc, int fr, int fq) const {
        const int row0 = u.pm * BM + wr * 64 + fr; const int col0 = u.pn * BM + wc * 32 + 8 * fq;
#pragma unroll
        for (int ai = 0; ai < 2; ++ai)
#pragma unroll
            for (int m = 0; m < 4; ++m) { bf16_t* rowp = O + (size_t)(row0 + ai * HALF + m * 16) * ldc + col0;
#pragma unroll
                for (int bj = 0; bj < 2; ++bj) { const f32x4 v0 = acc[ai][bj][m][0], v1 = acc[ai][bj][m][1];
                    u32x4 w; w.x = cvt_pk_bf16(v0[0], v0[1]); w.y = cvt_pk_bf16(v0[2], v0[3]); w.z = cvt_pk_bf16(v1[0], v1[1]); w.w = cvt_pk_bf16(v1[2], v1[3]);
                    *(u32x4*)(rowp + bj * HALF) = w; } }
    }
};

struct EpiSplit {
    static constexpr bool PERM = true, AFTER_DRAIN = false, PREFETCH = false;
    bf16_t* O; float* part; int ldc;
    __device__ __forceinline__ void operator()(const f32x4 (&acc)[2][2][4][2], const Unit& u, int wr, int wc, int fr, int fq) const {
        const int col0 = u.pn * BM + wc * 32 + 8 * fq;
        if (u.slab < 0) {
            const int row0 = u.pm * BM + wr * 64 + fr;
#pragma unroll
            for (int ai = 0; ai < 2; ++ai)
#pragma unroll
                for (int m = 0; m < 4; ++m) { bf16_t* rowp = O + (size_t)(row0 + ai * HALF + m * 16) * ldc + col0;
#pragma unroll
                    for (int bj = 0; bj < 2; ++bj) { const f32x4 v0 = acc[ai][bj][m][0], v1 = acc[ai][bj][m][1];
                        u32x4 w; w.x = cvt_pk_bf16(v0[0], v0[1]); w.y = cvt_pk_bf16(v0[2], v0[3]); w.z = cvt_pk_bf16(v1[0], v1[1]); w.w = cvt_pk_bf16(v1[2], v1[3]);
                        *(u32x4*)(rowp + bj * HALF) = w; } }
        } else {
            const int row0 = (u.pm == 16 ? 0 : 256) + wr * 64 + fr; float* pb = part + (size_t)u.slab * 512 * ldc;
#pragma unroll
            for (int ai = 0; ai < 2; ++ai)
#pragma unroll
                for (int m = 0; m < 4; ++m) { float* rowp = pb + (size_t)(row0 + ai * HALF + m * 16) * ldc + col0;
#pragma unroll
                    for (int bj = 0; bj < 2; ++bj) { *(f32x4*)(rowp + bj * HALF) = acc[ai][bj][m][0]; *(f32x4*)(rowp + bj * HALF + 4) = acc[ai][bj][m][1]; } }
        }
    }
};

struct EpiInProj {
    static constexpr bool PERM = true, AFTER_DRAIN = false, PREFETCH = false;
    bf16_t* O; int ldc; const PG8_LAS float* thd; const PG8_LAS float* gains; PG8_LAS float* xch;
    __device__ __forceinline__ void operator()(f32x4 (&acc)[2][2][4][2], const Unit& u, int wr, int wc, int fr, int fq) const {
        const int pmb = u.pm % 17; const bool ctx = (pmb == 16); const int pn = u.pn;
        const int kind = pn < 4 ? 1 : pn < 8 ? 2 : pn < 12 ? 3 : pn < 16 ? 0 : pn == 16 ? 4 : pn < 18 ? 0 : pn < 22 ? 2 : pn == 26 ? 3 : 0;
        if (kind == 1 || kind == 4) {
            const PG8_LAS float* g = gains + (kind == 1 ? 0 : 128) + wc * 32 + 8 * fq;
            const f32x4 g0 = *(const PG8_LAS f32x4*)g, g1 = *(const PG8_LAS f32x4*)(g + 4);
#pragma unroll
            for (int ai = 0; ai < 2; ++ai)
#pragma unroll
                for (int m = 0; m < 4; ++m)
#pragma unroll
                    for (int bj = 0; bj < 2; ++bj) { const f32x4 a = acc[ai][bj][m][0], b = acc[ai][bj][m][1];
                        float s = (a[0] * a[0] + a[1] * a[1]) + (a[2] * a[2] + a[3] * a[3]) + (b[0] * b[0] + b[1] * b[1]) + (b[2] * b[2] + b[3] * b[3]);
                        s += __shfl_xor(s, 16); s += __shfl_xor(s, 32);
                        if (fq == 0) xch[((ai * HALF + wr * 64 + m * 16 + fr) * 2 + bj) * 4 + wc] = s; }
            asm volatile("s_waitcnt lgkmcnt(0)" ::: "memory"); __builtin_amdgcn_s_barrier(); asm volatile("" ::: "memory");
#pragma unroll
            for (int ai = 0; ai < 2; ++ai)
#pragma unroll
                for (int m = 0; m < 4; ++m)
#pragma unroll
                    for (int bj = 0; bj < 2; ++bj) { const f32x4 p = *(const PG8_LAS f32x4*)(xch + ((ai * HALF + wr * 64 + m * 16 + fr) * 2 + bj) * 4);
                        const float rstd = __builtin_amdgcn_rsqf(((p[0] + p[1]) + (p[2] + p[3])) * (1.f / 128.f) + 1e-6f);
                        acc[ai][bj][m][0] = acc[ai][bj][m][0] * rstd * g0; acc[ai][bj][m][1] = acc[ai][bj][m][1] * rstd * g1; }
        }
        if (kind != 0 && !ctx) {
            const bool dh = (kind == 2);
#pragma unroll
            for (int ai = 0; ai < 2; ++ai)
#pragma unroll
                for (int m = 0; m < 4; ++m) { const int t = pmb * 256 + ai * HALF + wr * 64 + m * 16 + fr; const int grow = t >> 6, gcol = t & 63;
                    f32x4 c01, c23;
                    if (!dh) { const PG8_LAS float* tp = thd + (((wc < 2) ? grow : gcol) * 32 + 16 * (wc & 1) + 4 * fq) * 2; c01 = *(const PG8_LAS f32x4*)tp; c23 = *(const PG8_LAS f32x4*)(tp + 4); }
                    else { typedef float f32x2_ __attribute__((ext_vector_type(2))); const PG8_LAS float* tp = thd + ((((wc & 1) == 0) ? grow : gcol) * 32 + 8 * fq) * 2;
                        const f32x2_ e0 = *(const PG8_LAS f32x2_*)tp, e1 = *(const PG8_LAS f32x2_*)(tp + 4), e2 = *(const PG8_LAS f32x2_*)(tp + 8), e3 = *(const PG8_LAS f32x2_*)(tp + 12);
                        c01 = (f32x4){e0.x, e0.y, e1.x, e1.y}; c23 = (f32x4){e2.x, e2.y, e3.x, e3.y}; }
#pragma unroll
                    for (int bj = 0; bj < 2; ++bj) { f32x4 a = acc[ai][bj][m][0], b = acc[ai][bj][m][1];
                        acc[ai][bj][m][0] = (f32x4){a[0] * c01[0] - a[1] * c01[1], a[0] * c01[1] + a[1] * c01[0], a[2] * c01[2] - a[3] * c01[3], a[2] * c01[3] + a[3] * c01[2]};
                        acc[ai][bj][m][1] = (f32x4){b[0] * c23[0] - b[1] * c23[1], b[0] * c23[1] + b[1] * c23[0], b[2] * c23[2] - b[3] * c23[3], b[2] * c23[3] + b[3] * c23[2]}; } }
        }
        const int row0 = u.pm * BM + wr * 64 + fr; const int col0 = u.pn * BM + wc * 32 + 8 * fq;
#pragma unroll
        for (int ai = 0; ai < 2; ++ai)
#pragma unroll
            for (int m = 0; m < 4; ++m) { bf16_t* rowp = O + (size_t)(row0 + ai * HALF + m * 16) * ldc + col0;
#pragma unroll
                for (int bj = 0; bj < 2; ++bj) { const f32x4 v0 = acc[ai][bj][m][0], v1 = acc[ai][bj][m][1];
                    u32x4 w; w.x = cvt_pk_bf16(v0[0], v0[1]); w.y = cvt_pk_bf16(v0[2], v0[3]); w.z = cvt_pk_bf16(v1[0], v1[1]); w.w = cvt_pk_bf16(v1[2], v1[3]);
                    *(u32x4*)(rowp + bj * HALF) = w; } }
    }
};

struct EpiUpConv {
    static constexpr bool PERM = true, AFTER_DRAIN = false, PREFETCH = true;
    bf16_t* ACT; float* side; const float* cw; PG8_LAS float* xb; int dff; PG8_LAS float* wl0; PG8_LAS float* wl1; mutable int par;
    __device__ __forceinline__ void prefetch(const Unit& u, int parity, int wid, int lane) const {
        if (wid == 0) { PG8_LAS float* wl = parity ? wl1 : wl0;
#pragma unroll
            for (int i = 0; i < 3; ++i) { const int q = 64 * i + lane, bt = q >> 5, c4 = q & 31, bj = bt / 3, tap = bt - 3 * bj;
                __builtin_amdgcn_global_load_lds((const unsigned*)(cw + (size_t)tap * 2 * dff + bj * dff + u.pn * 128 + 4 * c4), (PG8_LAS unsigned*)(wl + 256 * i), 16, 0, 0); } }
    }
    static __device__ __forceinline__ float dppf(float old, float src, const int ctrl_sel) {
        const int o = __float_as_int(old), s = __float_as_int(src); int r;
        if (ctrl_sel == 0) r = __builtin_amdgcn_update_dpp(o, s, 0x111, 0xF, 0xF, false);
        else if (ctrl_sel == 1) r = __builtin_amdgcn_update_dpp(o, s, 0x101, 0xF, 0xF, false);
        else if (ctrl_sel == 2) r = __builtin_amdgcn_update_dpp(o, s, 0x121, 0xF, 0xF, false);
        else r = __builtin_amdgcn_update_dpp(o, s, 0x12F, 0xF, 0xF, false);
        return __int_as_float(r);
    }
    static __device__ __forceinline__ f32x4 dpp4(const f32x4 old, const f32x4 src, const int c) { return (f32x4){dppf(old[0], src[0], c), dppf(old[1], src[1], c), dppf(old[2], src[2], c), dppf(old[3], src[3], c)}; }
    static __device__ __forceinline__ int xidx(int ai, int wr, int wc, int which, int bj, int fq, int n) { return ((((((ai * 2 + wr) * 4 + wc) * 2 + which) * 2 + bj) * 4 + fq) * 2 + n) * 4; }
    __device__ __forceinline__ void operator()(const f32x4 (&acc)[2][2][4][2], const Unit& u, int wr, int wc, int fr, int fq) const {
        const int cbase = wc * 32 + 8 * fq;
        f32x4 wts[2][2][3];
#pragma unroll
        for (int bj = 0; bj < 2; ++bj)
#pragma unroll
            for (int n = 0; n < 2; ++n)
#pragma unroll
                for (int j = 0; j < 3; ++j) wts[bj][n][j] = *(const PG8_LAS f32x4*)((par ? wl1 : wl0) + (bj * 3 + j) * 128 + cbase + 4 * n);
#pragma unroll
        for (int ai = 0; ai < 2; ++ai)
#pragma unroll
            for (int bj = 0; bj < 2; ++bj)
#pragma unroll
                for (int n = 0; n < 2; ++n) {
                    if (fr == 0) *(PG8_LAS f32x4*)(xb + xidx(ai, wr, wc, 0, bj, fq, n)) = acc[ai][bj][0][n];
                    if (fr == 15) *(PG8_LAS f32x4*)(xb + xidx(ai, wr, wc, 1, bj, fq, n)) = acc[ai][bj][3][n]; }
        { float* sp = side + (size_t)u.pm * 4 * (2 * dff) + (size_t)u.pn * 256 + cbase;
          if (wr == 0 && fr < 2) {
#pragma unroll
              for (int bj = 0; bj < 2; ++bj)
#pragma unroll
                  for (int n = 0; n < 2; ++n) *(f32x4*)(sp + (size_t)fr * (2 * dff) + bj * 128 + 4 * n) = acc[0][bj][0][n]; }
          if (wr == 1 && fr >= 14) {
#pragma unroll
              for (int bj = 0; bj < 2; ++bj)
#pragma unroll
                  for (int n = 0; n < 2; ++n) *(f32x4*)(sp + (size_t)(fr - 12) * (2 * dff) + bj * 128 + 4 * n) = acc[1][bj][3][n]; } }
        asm volatile("s_waitcnt lgkmcnt(0)" ::: "memory"); __builtin_amdgcn_s_barrier(); asm volatile("" ::: "memory");
        const f32x4 zero4 = {0.f, 0.f, 0.f, 0.f};
#pragma unroll
        for (int ai = 0; ai < 2; ++ai)
#pragma unroll
            for (int m = 0; m < 4; ++m) {
                const int beta = 2 * ai + wr;
                u32x4 w;
#pragma unroll
                for (int n = 0; n < 2; ++n) {
                    f32x4 res[2];
#pragma unroll
                    for (int bj = 0; bj < 2; ++bj) {
                        const f32x4 cur = acc[ai][bj][m][n];
                        f32x4 oldp, oldn;
                        if (m > 0) oldp = dpp4(zero4, acc[ai][bj][m - 1][n], 2);
                        else if (beta > 0) oldp = *(const PG8_LAS f32x4*)(xb + xidx((beta - 1) >> 1, (beta - 1) & 1, wc, 1, bj, fq, n));
                        else oldp = zero4;
                        if (m < 3) oldn = dpp4(zero4, acc[ai][bj][m + 1][n], 3);
                        else if (beta < 3) oldn = *(const PG8_LAS f32x4*)(xb + xidx((beta + 1) >> 1, (beta + 1) & 1, wc, 0, bj, fq, n));
                        else oldn = zero4;
                        const f32x4 prev = dpp4(oldp, cur, 0), next = dpp4(oldn, cur, 1);
                        res[bj] = prev * wts[bj][n][0] + cur * wts[bj][n][1] + next * wts[bj][n][2];
                    }
                    f32x4 o;
#pragma unroll
                    for (int e = 0; e < 4; ++e) o[e] = res[0][e] * __builtin_amdgcn_rcpf(1.f + __expf(-res[0][e])) * res[1][e];
                    if (n == 0) { w.x = cvt_pk_bf16(o[0], o[1]); w.y = cvt_pk_bf16(o[2], o[3]); } else { w.z = cvt_pk_bf16(o[0], o[1]); w.w = cvt_pk_bf16(o[2], o[3]); }
                }
                *(u32x4*)(ACT + (size_t)(u.pm * BM + ai * HALF + wr * 64 + m * 16 + fr) * dff + u.pn * 128 + cbase) = w;
            }
    }
};

template <class Epi, class Sched, bool ALIGN_EPI = false>
__device__ __forceinline__ void gemm_phase(PG8_LAS unsigned char* lds, const Gemm g, const Sched& S, const Epi& E) {
    int tid_ = threadIdx.x; asm volatile("" : "+v"(tid_));
    const int tid = tid_, wid = __builtin_amdgcn_readfirstlane(tid >> 6), lane = tid & 63, wr = wid >> 2, wc = wid & 3, fr = lane & 15, fq = lane >> 4;
    const int K = g.K;
    unsigned voffA[2], voffB[2];
#pragma unroll
    for (int i = 0; i < 2; ++i) { int R, C; stage_rc(tid * 16 + i * 8192, R, C); const int Rb = Epi::PERM ? ((R & ~31) + perm32(R & 31)) : R;
        voffA[i] = (unsigned)(R * K + C) * 2u; voffB[i] = (unsigned)(Rb * K + C) * 2u; }
    const size_t kstep = (size_t)(BK * 2);
    const size_t hstep = (size_t)HALF * K * 2;
    const size_t tstep = 2 * hstep;
    const unsigned ldsw = (unsigned)wid * 1024u;
    const int aoff = lds_byte(wr * 64 + fr, fq * 8), boff = lds_byte(wc * 32 + fr, fq * 8);
#define PG8_SA(b, h) (((b) * 2 + (h)) * HTB)
#define PG8_SB(b, h) ((4 + (b) * 2 + (h)) * HTB)
#define PG8_STAGE(bufoff, gbase, voff) do { _Pragma("unroll") for (int _i = 0; _i < 2; ++_i) \
        __builtin_amdgcn_global_load_lds((const unsigned*)((const char*)(gbase) + (voff)[_i]), (PG8_LAS unsigned*)(lds + (bufoff) + ldsw + _i * 8192), 16, 0, 0); } while (0)
#define PG8_LDA(dst, b, h) do { _Pragma("unroll") for (int m = 0; m < 4; ++m) _Pragma("unroll") for (int k = 0; k < 2; ++k) dst[m][k] = *(const PG8_LAS bf16x8*)(lds + PG8_SA(b, h) + aoff + m * 2048 + k * 1024); } while (0)
#define PG8_LDB(dst, b, h) do { _Pragma("unroll") for (int n = 0; n < 2; ++n) _Pragma("unroll") for (int k = 0; k < 2; ++k) dst[n][k] = *(const PG8_LAS bf16x8*)(lds + PG8_SB(b, h) + boff + n * 2048 + k * 1024); } while (0)
#define PG8_MMA(ai, bj, At, Bt) do { __builtin_amdgcn_s_setprio(1); _Pragma("unroll") for (int m = 0; m < 4; ++m) _Pragma("unroll") for (int n = 0; n < 2; ++n) _Pragma("unroll") for (int k = 0; k < 2; ++k) \
        acc[ai][bj][m][n] = __builtin_amdgcn_mfma_f32_16x16x32_bf16(Bt[n][k], At[m][k], acc[ai][bj][m][n], 0, 0, 0); __builtin_amdgcn_s_setprio(0); } while (0)
#define PG8_WAIT_V(n) asm volatile("s_waitcnt vmcnt(" #n ")" ::: "memory")
#define PG8_WAIT_L(n) asm volatile("s_waitcnt lgkmcnt(" #n ")" ::: "memory")
#define PG8_BAR __builtin_amdgcn_s_barrier()
#define PG8_SCHED __builtin_amdgcn_sched_barrier(0)
    Unit cur, nxt; int ui = 0;
    if (!S.next(0, cur)) return;
    f32x4 acc[2][2][4][2];
#pragma unroll
    for (int a = 0; a < 2; ++a)
#pragma unroll
        for (int b = 0; b < 2; ++b)
#pragma unroll
            for (int m = 0; m < 4; ++m)
#pragma unroll
                for (int n = 0; n < 2; ++n) acc[a][b][m][n] = (f32x4){0.f, 0.f, 0.f, 0.f};
    bf16x8 At[4][2], B0[2][2], B1[2][2];
    const char* cA = (const char*)g.A + (size_t)cur.pm * tstep + (size_t)cur.kt0 * kstep; const char* cB = (const char*)g.Bt + (size_t)cur.pn * tstep + (size_t)cur.kt0 * kstep;
    S.a_ready(cur);
    if constexpr (Epi::PREFETCH) E.prefetch(cur, 0, wid, lane);
    PG8_STAGE(PG8_SB(0, 0), cB, voffB); PG8_STAGE(PG8_SB(0, 1), cB + hstep, voffB); PG8_STAGE(PG8_SA(0, 0), cA, voffA); PG8_STAGE(PG8_SA(0, 1), cA + hstep, voffA);
    if (wr == 1) PG8_BAR;
    PG8_WAIT_V(2); PG8_BAR;
    PG8_STAGE(PG8_SB(1, 0), cB + kstep, voffB); PG8_STAGE(PG8_SA(1, 0), cA + kstep, voffA); PG8_STAGE(PG8_SB(1, 1), cB + hstep + kstep, voffB);
    PG8_WAIT_V(6); PG8_BAR;
    for (;;) {
        const bool has_next = S.next(ui + 1, nxt);
        const char* nA = has_next ? (const char*)g.A + (size_t)nxt.pm * tstep + (size_t)nxt.kt0 * kstep : cA; const char* nB = has_next ? (const char*)g.Bt + (size_t)nxt.pn * tstep + (size_t)nxt.kt0 * kstep : cB;
        const int nt = cur.nt;
        for (int t = 0; t < nt; t += 2) {
            const bool last = (t == nt - 2);
            const char* a1 = cA + (size_t)(t + 1) * kstep;
            const char* a2 = last ? nA : cA + (size_t)(t + 2) * kstep; const char* b2 = last ? nB : cB + (size_t)(t + 2) * kstep;
            const char* a3 = a2 + kstep; const char* b3 = b2 + kstep;
            if (last && has_next) S.a_ready(nxt);
            PG8_LDB(B0, 0, 0); PG8_LDB(B1, 0, 1); PG8_SCHED; PG8_LDA(At, 0, 0); PG8_STAGE(PG8_SA(1, 1), a1 + hstep, voffA);
            PG8_WAIT_V(8); PG8_WAIT_L(0); PG8_BAR; PG8_MMA(0, 0, At, B0); PG8_MMA(0, 1, At, B1); PG8_BAR; PG8_SCHED;
            PG8_LDA(At, 0, 1); PG8_STAGE(PG8_SB(0, 0), b2, voffB); PG8_STAGE(PG8_SB(0, 1), b2 + hstep, voffB); PG8_STAGE(PG8_SA(0, 0), a2, voffA);
            PG8_WAIT_V(8); PG8_WAIT_L(0); PG8_BAR; PG8_MMA(1, 0, At, B0); PG8_MMA(1, 1, At, B1); PG8_BAR; PG8_SCHED;
            PG8_LDB(B0, 1, 0); PG8_LDB(B1, 1, 1); PG8_SCHED; PG8_LDA(At, 1, 0); PG8_STAGE(PG8_SA(0, 1), a2 + hstep, voffA);
            PG8_WAIT_V(8); PG8_WAIT_L(0); PG8_BAR; PG8_MMA(0, 0, At, B0); PG8_MMA(0, 1, At, B1); PG8_BAR; PG8_SCHED;
            PG8_LDA(At, 1, 1); PG8_STAGE(PG8_SB(1, 0), b3, voffB); PG8_STAGE(PG8_SB(1, 1), b3 + hstep, voffB); PG8_STAGE(PG8_SA(1, 0), a3, voffA);
            PG8_WAIT_V(8); PG8_WAIT_L(0); PG8_BAR; PG8_MMA(1, 0, At, B0); PG8_MMA(1, 1, At, B1); PG8_BAR; PG8_SCHED;
        }
        if constexpr (ALIGN_EPI) { if (wr == 0) PG8_BAR; }
        if constexpr (Epi::PREFETCH) { if (has_next) E.prefetch(nxt, (ui + 1) & 1, wid, lane); }
        if constexpr (!Epi::AFTER_DRAIN) { if constexpr (Epi::PREFETCH) E.par = ui & 1; E(acc, cur, wr, wc, fr, fq); S.done(cur); }
        if (!has_next) break;
#pragma unroll
        for (int a = 0; a < 2; ++a)
#pragma unroll
            for (int b = 0; b < 2; ++b)
#pragma unroll
                for (int m = 0; m < 4; ++m)
#pragma unroll
                    for (int n = 0; n < 2; ++n) acc[a][b][m][n] = (f32x4){0.f, 0.f, 0.f, 0.f};
        cur = nxt; cA = nA; cB = nB; ++ui;
        if constexpr (ALIGN_EPI) { if (wr == 1) PG8_BAR; }
    }
    PG8_WAIT_V(0);
    if constexpr (!ALIGN_EPI) { if (wr == 0) PG8_BAR; }
    PG8_BAR;
#undef PG8_SA
#undef PG8_SB
#undef PG8_STAGE
#undef PG8_LDA
#undef PG8_LDB
#undef PG8_MMA
#undef PG8_WAIT_V
#undef PG8_WAIT_L
#undef PG8_BAR
#undef PG8_SCHED
}
}

namespace att {
#define ALAS __attribute__((address_space(3)))
typedef unsigned short bf16;
typedef short bf16x8 __attribute__((ext_vector_type(8)));
typedef short s16x4 __attribute__((ext_vector_type(4)));
typedef float f32x16 __attribute__((ext_vector_type(16)));
typedef unsigned u32x4 __attribute__((ext_vector_type(4)));
constexpr int LDP = 9216, LDO = 4096;
constexpr int SLOT = 32768;
constexpr int WSCR_OFF = 131072 + 1024, BIAS_OFF = WSCR_OFF + 2048, SHM_END = BIAS_OFF + 2048;
constexpr int NCTX_T = 4;
#define KSWZ(row, colB) ((row) * 256 + ((colB) ^ (((row) & 7) << 4)))
#define SBAR() __builtin_amdgcn_sched_barrier(0)
__device__ __forceinline__ int crow(int r, int hi) { return (r & 3) + 8 * (r >> 2) + 4 * hi; }
__device__ __forceinline__ unsigned cvtpk(float lo, float hi) { unsigned r; asm volatile("v_cvt_pk_bf16_f32 %0, %1, %2" : "=v"(r) : "v"(lo), "v"(hi)); return r; }

__device__ __forceinline__ void partialSM(f32x16& p0, f32x16& p1, float& m_reg, float& mn, float& alpha, const float C, const float thr_raw) {
    float pmax = p0[0];
#pragma unroll
    for (int r = 1; r < 16; ++r) pmax = fmaxf(pmax, p0[r]);
#pragma unroll
    for (int r = 0; r < 16; ++r) pmax = fmaxf(pmax, p1[r]);
    { auto rr = __builtin_amdgcn_permlane32_swap(__float_as_uint(pmax), __float_as_uint(pmax), false, false);
      pmax = fmaxf(__uint_as_float(rr[0]), __uint_as_float(rr[1])); }
    if (__builtin_expect(__all(pmax - m_reg <= thr_raw), 1)) { mn = m_reg; alpha = 1.f; }
    else { mn = fmaxf(m_reg, pmax); alpha = __builtin_amdgcn_exp2f((m_reg - mn) * C); m_reg = mn; }
    const float mnC = -mn * C;
#pragma unroll
    for (int r = 0; r < 16; ++r) p0[r] = fmaf(p0[r], C, mnC);
#pragma unroll
    for (int r = 0; r < 16; ++r) p1[r] = fmaf(p1[r], C, mnC);
#pragma unroll
    for (int r = 0; r < 16; ++r) p0[r] = __builtin_amdgcn_exp2f(p0[r]);
}
__device__ __forceinline__ void finishSM(f32x16& p0, f32x16& p1, float alpha, float& l_reg, bf16x8& pa0, bf16x8& pa1, bf16x8& pa2, bf16x8& pa3) {
#pragma unroll
    for (int r = 0; r < 16; ++r) p1[r] = __builtin_amdgcn_exp2f(p1[r]);
    float ps = 0;
#pragma unroll
    for (int r = 0; r < 16; ++r) ps += p0[r];
#pragma unroll
    for (int r = 0; r < 16; ++r) ps += p1[r];
    { auto rr = __builtin_amdgcn_permlane32_swap(__float_as_uint(ps), __float_as_uint(ps), false, false);
      ps = __uint_as_float(rr[0]) + __uint_as_float(rr[1]); }
    l_reg = l_reg * alpha + ps;
#define PK4(P, BASE, OUT) do { unsigned a0 = cvtpk(P[BASE + 0], P[BASE + 1]), a1 = cvtpk(P[BASE + 2], P[BASE + 3]);   \
    unsigned b0 = cvtpk(P[BASE + 4], P[BASE + 5]), b1 = cvtpk(P[BASE + 6], P[BASE + 7]);                              \
    auto r0 = __builtin_amdgcn_permlane32_swap(a0, b0, false, false); auto r1 = __builtin_amdgcn_permlane32_swap(a1, b1, false, false); \
    u32x4 w = {r0[0], r1[0], r0[1], r1[1]}; OUT = __builtin_bit_cast(bf16x8, w); } while (0)
    PK4(p0, 0, pa0); PK4(p0, 8, pa1); PK4(p1, 0, pa2); PK4(p1, 8, pa3);
#undef PK4
}
template <int D0LO, int D0N>
__device__ __forceinline__ void qkt(f32x16& p0, f32x16& p1, const ALAS char* Ks, const bf16x8* qr, int r32, int hi) {
    p0 = f32x16{}; p1 = f32x16{};
    __builtin_amdgcn_s_setprio(1);
#pragma unroll
    for (int d0 = D0LO; d0 < D0LO + D0N; ++d0) { const int cb = (d0 * 16 + hi * 8) * 2;
        const bf16x8 b0 = *(const ALAS bf16x8*)(Ks + KSWZ(r32, cb));
        const bf16x8 b1 = *(const ALAS bf16x8*)(Ks + KSWZ(32 + r32, cb));
        p0 = __builtin_amdgcn_mfma_f32_32x32x16_bf16(b0, qr[d0], p0, 0, 0, 0);
        p1 = __builtin_amdgcn_mfma_f32_32x32x16_bf16(b1, qr[d0], p1, 0, 0, 0); }
    __builtin_amdgcn_s_setprio(0);
}
__device__ __forceinline__ int v_st(int k, int c) { const int kk = (k & ~0xC) | ((k & 4) << 1) | ((k & 8) >> 1); return ((kk >> 3) * 4 + (c >> 5)) * 512 + ((kk & 7) * 32 + (c & 31)) * 2; }
__device__ __forceinline__ int v_rd_base(int lane) { return ((lane & 3) << 3) | (((lane >> 2) & 3) << 6) | (((lane >> 4) & 1) << 5) | (((lane >> 5) & 1) << 8); }
constexpr int v_rd_off(int d0, int ks, int half) { return d0 * 512 + ks * 4096 + half * 2048; }
template <int OFF> __device__ __forceinline__ s16x4 tr_read(int vb) {
    s16x4 r; asm volatile("ds_read_b64_tr_b16 %0, %1 offset:%2" : "=&v"(r) : "v"(vb), "i"(OFF) : "memory"); return r;
}
template <int D0> __device__ __forceinline__ void pv_one(f32x16& od, int vb, bf16x8 pa0, bf16x8 pa1, bf16x8 pa2, bf16x8 pa3) {
    const s16x4 l0 = tr_read<v_rd_off(D0, 0, 0)>(vb), h0 = tr_read<v_rd_off(D0, 0, 1)>(vb), l1 = tr_read<v_rd_off(D0, 1, 0)>(vb), h1 = tr_read<v_rd_off(D0, 1, 1)>(vb);
    const s16x4 l2 = tr_read<v_rd_off(D0, 2, 0)>(vb), h2 = tr_read<v_rd_off(D0, 2, 1)>(vb), l3 = tr_read<v_rd_off(D0, 3, 0)>(vb), h3 = tr_read<v_rd_off(D0, 3, 1)>(vb);
    asm volatile("s_waitcnt lgkmcnt(0)" ::: "memory"); SBAR();
#define PK(L, H) (bf16x8){L[0], L[1], L[2], L[3], H[0], H[1], H[2], H[3]}
    od = __builtin_amdgcn_mfma_f32_32x32x16_bf16(pa0, PK(l0, h0), od, 0, 0, 0);
    od = __builtin_amdgcn_mfma_f32_32x32x16_bf16(pa1, PK(l1, h1), od, 0, 0, 0);
    od = __builtin_amdgcn_mfma_f32_32x32x16_bf16(pa2, PK(l2, h2), od, 0, 0, 0);
    od = __builtin_amdgcn_mfma_f32_32x32x16_bf16(pa3, PK(l3, h3), od, 0, 0, 0);
#undef PK
}
__device__ __forceinline__ void pv_d0(f32x16* o, int vb, bf16x8 pa0, bf16x8 pa1, bf16x8 pa2, bf16x8 pa3) {
    __builtin_amdgcn_s_setprio(1);
    pv_one<0>(o[0], vb, pa0, pa1, pa2, pa3); pv_one<1>(o[1], vb, pa0, pa1, pa2, pa3); pv_one<2>(o[2], vb, pa0, pa1, pa2, pa3); pv_one<3>(o[3], vb, pa0, pa1, pa2, pa3);
    __builtin_amdgcn_s_setprio(0);
}

template <int MASK>
__device__ __forceinline__ void apply_mask(f32x16& p0, f32x16& p1, int j, int loc0, int qp, int hi, const ALAS float* bias) {
    if constexpr (MASK == 2) {
        if (j >= NCTX_T) { const int kbase = loc0 + 64 * (j - NCTX_T);
#pragma unroll
            for (int r = 0; r < 16; ++r) { const int d0 = qp - (kbase + crow(r, hi)); const int d1 = d0 - 32;
                if (d0 > 128 || d0 < -128) p0[r] = -1e30f;
                if (d1 > 128 || d1 < -128) p1[r] = -1e30f; } }
    } else if constexpr (MASK == 3) {
        if (j >= NCTX_T) { const int kbase = loc0 + 64 * (j - NCTX_T);
            const int qrow = qp >> 6, qcol = qp & 63; const int rs = min(max(qrow - 4, 0), 56), cs = min(max(qcol - 8, 0), 48);
            const int kr = kbase >> 6; const int dr = kr - rs;
            if (dr < 0 || dr >= 8) {
#pragma unroll
                for (int r = 0; r < 16; ++r) { p0[r] = -1e30f; p1[r] = -1e30f; }
            } else {
                const ALAS float* brow = bias + (kr - qrow + 7) * 31 + 15 - qcol;
#pragma unroll
                for (int r = 0; r < 16; ++r) { const int kc0 = crow(r, hi), kc1 = kc0 + 32;
                    const bool ok0 = (unsigned)(kc0 - cs) < 16u, ok1 = (unsigned)(kc1 - cs) < 16u;
                    const float b0 = brow[ok0 ? kc0 : qcol], b1 = brow[ok1 ? kc1 : qcol];
                    p0[r] = ok0 ? p0[r] + b0 : -1e30f; p1[r] = ok1 ? p1[r] + b1 : -1e30f;
                    if ((r & 3) == 3) asm volatile("" ::: "memory"); }
            }
        }
    }
}

template <int MASK, int D0LO, int D0N>
__device__ __forceinline__ void attn_core(f32x16 (&o)[4], float& m_reg, float& l_reg, const bf16* __restrict__ Qw, const bf16* __restrict__ Kb, const bf16* __restrict__ Vb,
                                          const int nloc, const int loc0, const int qp, const float C, const float thr_raw, ALAS char* lds) {
    int tid_ = threadIdx.x; asm volatile("" : "+v"(tid_));
    const int tid = tid_, wid = __builtin_amdgcn_readfirstlane(tid >> 6), lane = tid & 63, r32 = lane & 31, hi = lane >> 5;
    ALAS float* ws = (ALAS float*)(lds + WSCR_OFF) + wid * 64; ALAS float* al_l = ws + 32;
    const ALAS float* bias = (const ALAS float*)(lds + BIAS_OFF);
    unsigned voffK[2], voffV[2];
#pragma unroll
    for (int i = 0; i < 2; ++i) { const int q = (wid + 8 * i) * 64 + lane;
        { const int row = q >> 4, cc = (q & 15) ^ (row & 7); voffK[i] = (unsigned)(row * (LDP * 2) + cc * 16); }
        { const int kk = (q >> 7) * 8 + ((q & 31) >> 2), c = ((q >> 5) & 3) * 32 + (q & 3) * 8; const int k = (kk & ~0xC) | ((kk & 4) << 1) | ((kk & 8) >> 1); voffV[i] = (unsigned)(k * (LDP * 2) + c * 2); } }
    const int NT = NCTX_T + nloc;
#define KOFF(j) ((j) < NCTX_T ? 4096 + 64 * (j) : loc0 + 64 * ((j) - NCTX_T))
#define ISSUE(j) do { const size_t _ro = (size_t)KOFF(j) * (LDP * 2); const char* _gk = (const char*)Kb + _ro; const char* _gv = (const char*)Vb + _ro; ALAS char* _sl = lds + ((j) & 3) * SLOT + wid * 1024; \
    _Pragma("unroll") for (int _i = 0; _i < 2; ++_i) __builtin_amdgcn_global_load_lds((const unsigned*)(_gk + voffK[_i]), (ALAS unsigned*)(_sl + _i * 8192), 16, 0, 0); \
    _Pragma("unroll") for (int _i = 0; _i < 2; ++_i) __builtin_amdgcn_global_load_lds((const unsigned*)(_gv + voffV[_i]), (ALAS unsigned*)(_sl + 16384 + _i * 8192), 16, 0, 0); } while (0)
#define WAITBAR(n) do { asm volatile("s_waitcnt vmcnt(" #n ") lgkmcnt(0)" ::: "memory"); __builtin_amdgcn_s_barrier(); asm volatile("" ::: "memory"); } while (0)
#define RESC(a) do { if (__any((a) < 1.f)) { if (hi == 0) al_l[r32] = (a); asm volatile("s_waitcnt lgkmcnt(0)" ::: "memory"); \
    _Pragma("unroll") for (int d = 0; d < 4; ++d) _Pragma("unroll") for (int r = 0; r < 16; ++r) o[d][r] *= al_l[crow(r, hi)]; } } while (0)
    asm volatile("s_waitcnt vmcnt(0)" ::: "memory");
    m_reg = -1e30f; l_reg = 0.f;
#pragma unroll
    for (int d = 0; d < 4; ++d) o[d] = f32x16{};
    bf16x8 qr[8];
#pragma unroll
    for (int d0 = 0; d0 < 8; ++d0) qr[d0] = *(const bf16x8*)(Qw + d0 * 16);
    ISSUE(0); ISSUE(1); ISSUE(2);
    const int vb0 = (int)(uintptr_t)lds + 16384 + v_rd_base(lane);
    f32x16 pA0, pA1, pB0, pB1; float mnA, mnB, alA, alB; bf16x8 pa0, pa1, pa2, pa3;
    WAITBAR(8);
    qkt<D0LO, D0N>(pA0, pA1, lds, qr, r32, hi); apply_mask<MASK>(pA0, pA1, 0, loc0, qp, hi, bias); partialSM(pA0, pA1, m_reg, mnA, alA, C, thr_raw);
    WAITBAR(4);
    ISSUE(3);
    for (int j = 1; j + 1 < NT; j += 2) {
        SBAR(); qkt<D0LO, D0N>(pB0, pB1, lds + (j & 3) * SLOT, qr, r32, hi);
        finishSM(pA0, pA1, alA, l_reg, pa0, pa1, pa2, pa3); SBAR();
        pv_d0(o, vb0 + ((j - 1) & 3) * SLOT, pa0, pa1, pa2, pa3); apply_mask<MASK>(pB0, pB1, j, loc0, qp, hi, bias); partialSM(pB0, pB1, m_reg, mnB, alB, C, thr_raw);
        if (j + 2 < NT) { WAITBAR(4); } else { WAITBAR(0); }
        if (j + 3 < NT) ISSUE(j + 3);
        RESC(alB);
        SBAR(); qkt<D0LO, D0N>(pA0, pA1, lds + ((j + 1) & 3) * SLOT, qr, r32, hi);
        finishSM(pB0, pB1, alB, l_reg, pa0, pa1, pa2, pa3); SBAR();
        pv_d0(o, vb0 + (j & 3) * SLOT, pa0, pa1, pa2, pa3); apply_mask<MASK>(pA0, pA1, j + 1, loc0, qp, hi, bias); partialSM(pA0, pA1, m_reg, mnA, alA, C, thr_raw);
        if (j + 3 < NT) { WAITBAR(4); } else { WAITBAR(0); }
        if (j + 4 < NT) ISSUE(j + 4);
        RESC(alA);
    }
    SBAR(); qkt<D0LO, D0N>(pB0, pB1, lds + ((NT - 1) & 3) * SLOT, qr, r32, hi);
    finishSM(pA0, pA1, alA, l_reg, pa0, pa1, pa2, pa3); SBAR();
    pv_d0(o, vb0 + ((NT - 2) & 3) * SLOT, pa0, pa1, pa2, pa3); apply_mask<MASK>(pB0, pB1, NT - 1, loc0, qp, hi, bias); partialSM(pB0, pB1, m_reg, mnB, alB, C, thr_raw);
    RESC(alB);
    finishSM(pB0, pB1, alB, l_reg, pa0, pa1, pa2, pa3); SBAR();
    pv_d0(o, vb0 + ((NT - 1) & 3) * SLOT, pa0, pa1, pa2, pa3);
#undef KOFF
#undef ISSUE
#undef WAITBAR
#undef RESC
}
}

constexpr int NWAVES = 8;
constexpr int DM = 4096, NB = 2, SEQ = 4096, CTXL = 256, TPB = SEQ + CTXL  , MROWS = NB * TPB  ;
constexpr int NIN = 9216, DFF = 11008, NUP = 2 * DFF, NADA = 6 * DM;
constexpr int QA = 0, QB_ = 1024, QC = 2048, QD = 3072, KA = 4096, VA = 4352, KB_ = 4608, VB_ = 5632, KC = 6656, VC = 6912, KD = 7168, VD = 8192;
constexpr float EPS = 1e-6f;
constexpr int NPHASE = 18;

constexpr size_t MiB = 1u << 20;
constexpr size_t WS_CTL = 0, CTL_ZERO_BYTES = 1 * MiB;
constexpr size_t WS_MOD = 1 * MiB;
constexpr size_t WS_TAB = 2 * MiB;
constexpr size_t WS_WIN = 4 * MiB;
constexpr size_t WS_WOUT = WS_WIN + 2 * 72 * MiB;
constexpr size_t WS_WUP = WS_WOUT + 2 * 32 * MiB;
constexpr size_t WS_WDN = WS_WUP + 2 * 172 * MiB;
constexpr size_t WS_XS = WS_WDN + 2 * 86 * MiB;
constexpr size_t WS_HX = WS_XS + 136 * MiB;
constexpr size_t WS_P = WS_HX + 68 * MiB;
constexpr size_t WS_O = WS_P + 153 * MiB;
constexpr size_t WS_Y = WS_O + 68 * MiB;
constexpr size_t WS_U = WS_Y + 68 * MiB;
constexpr size_t WS_ACT = WS_U + 366 * MiB;
constexpr size_t WS_STASH = WS_ACT + 183 * MiB;
constexpr size_t WS_PART = WS_STASH + 32 * MiB;
constexpr size_t WS_END = WS_PART + 64 * MiB;
static_assert((size_t)MROWS * NUP * 2 <= 366 * MiB && (size_t)MROWS * DFF * 2 <= 183 * MiB && (size_t)MROWS * NIN * 2 <= 153 * MiB, "ws map");
constexpr int CW_BAR = 4096;

constexpr int RING_OFF = 0, RING_BYTES = 131072;
constexpr int LDSCTL_OFF = RING_BYTES, MISC_OFF = LDSCTL_OFF + 320;
constexpr int LDS_BYTES = 163840;
constexpr int WL_OFF = att::SHM_END + 8192, THD_OFF = WL_OFF + 3072, GAINS_OFF = att::WSCR_OFF;
static_assert(THD_OFF + 16384 <= LDS_BYTES, "LDS map");
constexpr int XCH_OFF = att::SHM_END;
static_assert(XCH_OFF + 8192 <= LDS_BYTES && att::WSCR_OFF >= MISC_OFF + 128, "LDS map");

#define GAS __attribute__((address_space(1)))
#define LAS __attribute__((address_space(3)))
typedef unsigned short bf16;
typedef unsigned v4u __attribute__((ext_vector_type(4)));
typedef unsigned v2u __attribute__((ext_vector_type(2)));
typedef float f32x4 __attribute__((ext_vector_type(4)));
typedef float f32x2 __attribute__((ext_vector_type(2)));
typedef GAS unsigned gu32;
#define RLX_AGENT __ATOMIC_RELAXED, __HIP_MEMORY_SCOPE_AGENT
#define LDS_WAIT() asm volatile("s_waitcnt lgkmcnt(0)" ::: "memory")
#define VM_WAIT() asm volatile("s_waitcnt vmcnt(0)" ::: "memory")
__device__ __forceinline__ unsigned f2bf(float f) { unsigned u = __builtin_bit_cast(unsigned, f); return (u + 0x7fffu + ((u >> 16) & 1u)) >> 16; }
__device__ __forceinline__ unsigned pk2(float lo, float hi) { return f2bf(lo) | (f2bf(hi) << 16); }
__device__ __forceinline__ float bf_lo(unsigned w) { return __uint_as_float(w << 16); }
__device__ __forceinline__ float bf_hi(unsigned w) { return __uint_as_float(w & 0xffff0000u); }

#define XB_TMO      128
#define XB_XCNT(j)  (256  + 64 * (j))
#define XB_XSUB(j)  (1280 + 64 * (j))
#define XB_XGEN(j)  (2304 + 64 * (j))
#define XB_TOP      3328
#define XB_TOPGEN   3392
#define XCD_BAR_WORDS 3456
#define XB_SPIN_CAP (1u << 24)

__device__ __forceinline__ unsigned xb_ld(unsigned* p)              { return __hip_atomic_load(p, __ATOMIC_RELAXED, __HIP_MEMORY_SCOPE_AGENT); }
__device__ __forceinline__ unsigned xb_add(unsigned* p, unsigned v) { return __hip_atomic_fetch_add(p, v, __ATOMIC_RELAXED, __HIP_MEMORY_SCOPE_AGENT); }
__device__ __forceinline__ unsigned xb_xcc_id() { return (unsigned)__builtin_amdgcn_s_getreg((3 << 11) | 20) & 0xFu; }
#define XB_SPIN(cond, bar) do { unsigned _sp = 0; while (cond) { __builtin_amdgcn_s_sleep(1); \
    if ((++_sp & 255u) == 0u) { if (xb_ld(&(bar)[XB_TMO])) break; if (_sp > XB_SPIN_CAP) { atomicAdd(&(bar)[XB_TMO], 1u); break; } } } } while (0)

struct XcdBarrier { unsigned* bar; unsigned x; volatile LAS unsigned* st; };

__device__ __forceinline__ XcdBarrier xcd_barrier_post(unsigned* bar, volatile LAS unsigned* st) {
    XcdBarrier b; b.bar = bar; b.x = xb_xcc_id(); b.st = st;
    if (threadIdx.x == 0) (void)xb_add(&bar[XB_XCNT(b.x)], 1u);
    return b;
}
__device__ __forceinline__ void xcd_barrier_complete(unsigned* bar, unsigned x, unsigned& nloc, unsigned& nx) {
    const unsigned G = gridDim.x * gridDim.y * gridDim.z;
    unsigned sum, cnt, mine, sp = 0u;
    for (;;) {
        sum = 0u; cnt = 0u; mine = 0u;
#pragma unroll
        for (unsigned j = 0; j < 16; ++j) { const unsigned c = xb_ld(&bar[XB_XCNT(j)]); sum += c; cnt += (c > 0u) ? 1u : 0u; mine = (j == x) ? c : mine; }
        if (sum == G) break;
        __builtin_amdgcn_s_sleep(1);
        if ((++sp & 255u) == 0u) { if (xb_ld(&bar[XB_TMO])) break; if (sp > XB_SPIN_CAP) { atomicAdd(&bar[XB_TMO], 1u); break; } }
    }
    nloc = mine > 0u ? mine : 1u; nx = cnt > 0u ? cnt : 1u;
}
__device__ __forceinline__ void xcd_barrier(const XcdBarrier& b) {
    asm volatile("s_waitcnt vmcnt(0)" ::: "memory");
    __syncthreads();
    if (threadIdx.x == 0) {
        unsigned* bar = b.bar;
        __builtin_amdgcn_s_waitcnt(0);
        unsigned nloc = b.st[0], nx = b.st[1];
        if (nloc == 0u) { xcd_barrier_complete(bar, b.x, nloc, nx); b.st[0] = nloc; b.st[1] = nx; }
        const unsigned old = xb_add(&bar[XB_XSUB(b.x)], 1u);
        const unsigned gen = old / nloc;
        if (old + 1u == (gen + 1u) * nloc) {
            __builtin_amdgcn_fence(__ATOMIC_RELEASE, "agent");
            asm volatile("s_waitcnt vmcnt(0)" ::: "memory");
            const unsigned og = xb_add(&bar[XB_TOP], 1u);
            const unsigned tg = og / nx;
            if (og + 1u == (tg + 1u) * nx) xb_add(&bar[XB_TOPGEN], 1u);
            else XB_SPIN(xb_ld(&bar[XB_TOPGEN]) == tg, bar);
            __builtin_amdgcn_fence(__ATOMIC_ACQUIRE, "agent");
            xb_add(&bar[XB_XGEN(b.x)], 1u);
            asm volatile("s_waitcnt vmcnt(0)" ::: "memory");
        } else {
            XB_SPIN(xb_ld(&bar[XB_XGEN(b.x)]) == gen, bar);
            __builtin_amdgcn_fence(__ATOMIC_ACQUIRE, "agent");
            asm volatile("s_waitcnt vmcnt(0)" ::: "memory");
        }
    }
    __syncthreads();
}

struct Args {
    const float* in[24]; float* out; unsigned char* ws; int ph_lo, ph_hi;
};
typedef __attribute__((address_space(4))) const Args* KArgs;
struct Frame {
    LAS unsigned char* lds;
    int tid, lane, wave, vcu, G;
    unsigned char* ws;
};

__device__ __forceinline__ int fresh_bx() { int bx = blockIdx.x; asm volatile("" : "+s"(bx)); return bx; }
__device__ __forceinline__ float wave_sum(float v) {
#pragma unroll
    for (int o = 1; o < 64; o <<= 1) v += __shfl_xor(v, o);
    return v;
}

__device__ const float INV32[32] = {
    1.0f, 0.74989420933f, 0.56234132519f, 0.42169650343f, 0.31622776602f, 0.23713737057f, 0.17782794100f, 0.13335214322f,
    0.1f, 0.074989420933f, 0.056234132519f, 0.042169650343f, 0.031622776602f, 0.023713737057f, 0.017782794100f, 0.013335214322f,
    0.01f, 0.0074989420933f, 0.0056234132519f, 0.0042169650343f, 0.0031622776602f, 0.0023713737057f, 0.0017782794100f, 0.0013335214322f,
    0.001f, 0.00074989420933f, 0.00056234132519f, 0.00042169650343f, 0.00031622776602f, 0.00023713737057f, 0.00017782794100f, 0.00013335214322f };
__device__ const float INV16[16] = {
    1.0f, 0.56234132519f, 0.31622776602f, 0.17782794100f, 0.1f, 0.056234132519f, 0.031622776602f, 0.017782794100f,
    0.01f, 0.0056234132519f, 0.0031622776602f, 0.0017782794100f, 0.001f, 0.00056234132519f, 0.00031622776602f, 0.00017782794100f };

__device__ __forceinline__ void sincos_acc(float af, float& c, float& s) {
    const double a = (double)af; const double kd = __builtin_rint(a * 0.63661977236758134308); const int k = (int)kd;
    const double r = (a - kd * 1.57079632679489655800) - kd * 6.12323399573676603587e-17; const double r2 = r * r;
    const double sn = r * (1.0 + r2 * (-1.0 / 6 + r2 * (1.0 / 120 + r2 * (-1.0 / 5040 + r2 * (1.0 / 362880 + r2 * (-1.0 / 39916800 + r2 * (1.0 / 6227020800.0)))))));
    const double cs = 1.0 + r2 * (-0.5 + r2 * (1.0 / 24 + r2 * (-1.0 / 720 + r2 * (1.0 / 40320 + r2 * (-1.0 / 3628800 + r2 * (1.0 / 479001600.0 + r2 * (-1.0 / 87178291200.0)))))));
    double cc, ss;
    switch (k & 3) { case 0: cc = cs; ss = sn; break; case 1: cc = -sn; ss = cs; break; case 2: cc = -cs; ss = -sn; break; default: cc = sn; ss = -cs; break; }
    c = (float)cc; s = (float)ss;
}

__device__ __forceinline__ unsigned cvtpk_bf16(float lo, float hi) { unsigned r; asm volatile("v_cvt_pk_bf16_f32 %0, %1, %2" : "=v"(r) : "v"(lo), "v"(hi)); return r; }
struct TItem { f32x4 v[16]; };
__device__ __forceinline__ void p0_item_load(TItem& t, const float* W, int K, int N, int item, int lane) {
    const int nblk = N / 64, kb = item / nblk, nb = item % nblk, k0 = 64 * kb, n0 = 64 * nb;
    const int kr = lane >> 4, c4 = lane & 15;
    const GAS float* src = (const GAS float*)W + (size_t)(k0 + 16 * kr) * N + n0 + 4 * c4;
#pragma unroll
    for (int i = 0; i < 16; ++i) t.v[i] = __builtin_nontemporal_load((const GAS f32x4*)(src + (size_t)i * N));
}
__device__ __forceinline__ void p0_item_store(const TItem& t, int K, int N, bf16* WT, int item, int lane, bool gv) {
    const int nblk = N / 64, kb = item / nblk, nb = item % nblk, k0 = 64 * kb, n0 = 64 * nb;
    const int v0 = !gv ? n0 : (n0 < DFF ? (n0 >> 7) * 256 + (n0 & 127) : ((n0 - DFF) >> 7) * 256 + 128 + ((n0 - DFF) & 127));
    const int kr = lane >> 4, c4 = lane & 15;
    GAS bf16* dst = (GAS bf16*)WT + (size_t)(v0 + 4 * c4) * K + k0 + 16 * kr;
#pragma unroll
    for (int e = 0; e < 4; ++e) {
        v4u o0, o1;
        o0.x = cvtpk_bf16(t.v[0][e], t.v[1][e]); o0.y = cvtpk_bf16(t.v[2][e], t.v[3][e]); o0.z = cvtpk_bf16(t.v[4][e], t.v[5][e]); o0.w = cvtpk_bf16(t.v[6][e], t.v[7][e]);
        o1.x = cvtpk_bf16(t.v[8][e], t.v[9][e]); o1.y = cvtpk_bf16(t.v[10][e], t.v[11][e]); o1.z = cvtpk_bf16(t.v[12][e], t.v[13][e]); o1.w = cvtpk_bf16(t.v[14][e], t.v[15][e]);
        *(GAS v4u*)(dst + (size_t)e * K) = o0; *(GAS v4u*)(dst + (size_t)e * K + 8) = o1;
    }
}

__device__ __forceinline__ void convert_matrix(Frame& F, KArgs a, int mat, int l, int gw, int ngw, int part = 0) {
    const float* W; bf16* WT; int K, N;
    if (mat == 0) { W = a->in[10] + (size_t)l * DM * NIN; WT = (bf16*)(F.ws + WS_WIN + (size_t)l * 72 * MiB); K = DM; N = NIN; }
    else if (mat == 1) { W = a->in[11] + (size_t)l * DM * DM; WT = (bf16*)(F.ws + WS_WOUT + (size_t)l * 32 * MiB); K = DM; N = DM; }
    else if (mat == 2) { W = a->in[21] + (size_t)l * DM * NUP; WT = (bf16*)(F.ws + WS_WUP + (size_t)l * 172 * MiB); K = DM; N = NUP; }
    else { W = a->in[23] + (size_t)l * DFF * DM; WT = (bf16*)(F.ws + WS_WDN + (size_t)l * 86 * MiB); K = DFF; N = DM; }
    const int nitems = (K / 64) * (N / 64); const int lo = part == 2 ? nitems / 2 : 0, hi = part == 1 ? nitems / 2 : nitems;
    int it = lo + gw; if (it >= hi) return;
    TItem ta, tb; p0_item_load(ta, W, K, N, it, F.lane);
    for (;;) {
        const int it1 = it + ngw; if (it1 < hi) p0_item_load(tb, W, K, N, it1, F.lane);
        p0_item_store(ta, K, N, WT, it, F.lane, mat == 2); if (it1 >= hi) break;
        const int it2 = it1 + ngw; if (it2 < hi) p0_item_load(ta, W, K, N, it2, F.lane);
        p0_item_store(tb, K, N, WT, it1, F.lane, mat == 2); if (it2 >= hi) break;
        it = it2;
    }
}
__device__ __forceinline__ void tail_convert(Frame& F, KArgs a, int nbusy, int mat0, int l0, int part0, int mat1, int l1, int part1) {
    const int bx = fresh_bx(); if (bx < nbusy || nbusy >= F.G) return;
    const int gw = (bx - nbusy) * NWAVES + F.wave, ngw = (F.G - nbusy) * NWAVES;
    convert_matrix(F, a, mat0, l0, gw, ngw, part0);
    if (mat1 >= 0) convert_matrix(F, a, mat1, l1, gw, ngw, part1);
}
__device__ __forceinline__ float silu_f(float x) { return x / (1.f + __expf(-x)); }

__device__ __forceinline__ void phase_prologue(Frame& F, KArgs a) {
    const float* c_in = a->in[1]; const float* cctx = a->in[3]; const float* w_ada = a->in[4]; const float* b_ada = a->in[5];
    float* mod = (float*)(F.ws + WS_MOD);
    if (F.vcu == 0) {
        f32x2* thd = (f32x2*)(F.ws + WS_TAB);
        for (int e = F.tid; e < 64 * 32; e += NWAVES * 64) { const int pos = e >> 5, i = e & 31; float c, s; sincos_acc((float)pos * INV32[i], c, s); thd[e] = (f32x2){c, s}; }
        f32x2* tdh = (f32x2*)(F.ws + WS_TAB + 16384);
        for (int e = F.tid; e < 64 * 16; e += NWAVES * 64) { const int pos = e >> 4, i = e & 15; float c, s; sincos_acc((float)pos * INV16[i], c, s); tdh[e] = (f32x2){c, s}; }
        if (F.tid < 2) { const int l = F.tid; float s1 = 0.f, s2 = 0.f;
            for (int i = 0; i < 64; ++i) { s1 += a->in[14][l * 64 + i] * a->in[15][l * 64 + i]; s2 += a->in[16][l * 64 + i] * a->in[17][l * 64 + i]; }
            const float lam_init = 0.8f - 0.6f * expf(-0.3f * (float)l);
            float* lam = (float*)(F.ws + WS_TAB + 32768); lam[l * 2 + 0] = expf(s1) - expf(s2) + lam_init; lam[l * 2 + 1] = 1.f - lam_init; }
    }
    {
        LAS float* sv = (LAS float*)(F.lds + RING_OFF);
        LAS float* red = (LAS float*)(F.lds + RING_OFF + 49152);
        for (int e = F.tid; e < 3 * DM; e += NWAVES * 64) { const int v = e / DM, k = e % DM; const float x = v < 2 ? c_in[v * DM + k] : cctx[k]; sv[e] = silu_f(x); }
        __syncthreads();
        const int cg = F.lane & 15, kq = F.lane >> 4;
        for (int it = F.vcu; it < 2 * (NADA / 64); it += F.G) {
            const int l = it / (NADA / 64), ch = it % (NADA / 64);
            const float* W = w_ada + (size_t)l * DM * NADA + ch * 64 + cg * 4;
            f32x4 a0 = {0.f, 0.f, 0.f, 0.f}, a1 = a0, a2 = a0;
#pragma unroll 8
            for (int s = 0; s < DM / 32; ++s) { const int k = s * 32 + F.wave * 4 + kq; const f32x4 w = __builtin_nontemporal_load((const GAS f32x4*)(W + (size_t)k * NADA));
                a0 += w * sv[k]; a1 += w * sv[DM + k]; a2 += w * sv[2 * DM + k]; }
#pragma unroll
            for (int e = 0; e < 4; ++e) { a0[e] += __shfl_xor(a0[e], 16); a0[e] += __shfl_xor(a0[e], 32); a1[e] += __shfl_xor(a1[e], 16); a1[e] += __shfl_xor(a1[e], 32); a2[e] += __shfl_xor(a2[e], 16); a2[e] += __shfl_xor(a2[e], 32); }
            if (kq == 0) {
#pragma unroll
                for (int e = 0; e < 4; ++e) { red[(F.wave * 3 + 0) * 64 + cg * 4 + e] = a0[e]; red[(F.wave * 3 + 1) * 64 + cg * 4 + e] = a1[e]; red[(F.wave * 3 + 2) * 64 + cg * 4 + e] = a2[e]; } }
            __syncthreads();
            if (F.tid < 192) { const int v = F.tid / 64, cidx = F.tid % 64; float s = 0.f;
#pragma unroll
                for (int w = 0; w < 8; ++w) s += red[(w * 3 + v) * 64 + cidx];
                const int col = ch * 64 + cidx; mod[((size_t)l * 3 + v) * NADA + col] = s + b_ada[(size_t)l * NADA + col]; }
            __syncthreads();
        }
    }
    {
        const int gw = F.vcu * NWAVES + F.wave, NGW = F.G * NWAVES;
        convert_matrix(F, a, 0, 0, gw, NGW); convert_matrix(F, a, 2, 0, gw, NGW); convert_matrix(F, a, 2, 1, gw, NGW);
        if (F.G != 256) { convert_matrix(F, a, 1, 0, gw, NGW); convert_matrix(F, a, 3, 0, gw, NGW); convert_matrix(F, a, 0, 1, gw, NGW); convert_matrix(F, a, 1, 1, gw, NGW); convert_matrix(F, a, 3, 1, gw, NGW); }
    }
}

struct RowRegs { f32x4 v[16]; };
__device__ __forceinline__ float row_sumsq(const RowRegs& r) {
    float s = 0.f;
#pragma unroll
    for (int j = 0; j < 16; ++j) s += (r.v[j].x * r.v[j].x + r.v[j].y * r.v[j].y) + (r.v[j].z * r.v[j].z + r.v[j].w * r.v[j].w);
    return wave_sum(s);
}
__device__ __forceinline__ void row_load_f32(RowRegs& r, const float* p, int lane) {
    const GAS f32x4* q = (const GAS f32x4*)p + lane;
#pragma unroll
    for (int j = 0; j < 16; ++j) r.v[j] = __builtin_nontemporal_load(q + 64 * j);
}
__device__ __forceinline__ void row_load_bf16(RowRegs& r, const bf16* p, int lane) {
    const GAS v2u* q = (const GAS v2u*)p + lane;
#pragma unroll
    for (int j = 0; j < 16; ++j) { const v2u w = __builtin_nontemporal_load(q + 64 * j); r.v[j] = (f32x4){bf_lo(w.x), bf_hi(w.x), bf_lo(w.y), bf_hi(w.y)}; }
}
__device__ __forceinline__ void row_store_f32(const RowRegs& r, float* p, int lane) {
    GAS f32x4* q = (GAS f32x4*)p + lane;
#pragma unroll
    for (int j = 0; j < 16; ++j) __builtin_nontemporal_store(r.v[j], q + 64 * j);
}
__device__ __forceinline__ void row_store_bf16(const RowRegs& r, bf16* p, int lane) {
    GAS v2u* q = (GAS v2u*)p + lane;
#pragma unroll
    for (int j = 0; j < 16; ++j) { v2u w; w.x = pk2(r.v[j].x, r.v[j].y); w.y = pk2(r.v[j].z, r.v[j].w); __builtin_nontemporal_store(w, q + 64 * j); }
}
__device__ __forceinline__ void row_modnorm_store(const RowRegs& x, float rstd, const float* g, const float* sc, const float* sh, bf16* out, int lane) {
    GAS v2u* q = (GAS v2u*)out + lane;
#pragma unroll
    for (int j = 0; j < 16; ++j) { const int c = 4 * lane + 256 * j;
        const f32x4 gv = *(const GAS f32x4*)(g + c), sv = *(const GAS f32x4*)(sc + c), hv = *(const GAS f32x4*)(sh + c);
        const f32x4 y = (x.v[j] * rstd) * gv * (sv + 1.f) + hv;
        v2u w; w.x = pk2(y.x, y.y); w.y = pk2(y.z, y.w); q[64 * j] = w; }
}
__device__ __forceinline__ void row_residual(RowRegs& x, const RowRegs& y, float rstd, const float* g, const float* gate, int lane) {
#pragma unroll
    for (int j = 0; j < 16; ++j) { const int c = 4 * lane + 256 * j;
        const f32x4 gv = *(const GAS f32x4*)(g + c), tv = *(const GAS f32x4*)(gate + c);
        x.v[j] = x.v[j] + tv * ((y.v[j] * rstd) * gv); }
}

__device__ __forceinline__ void row_load_part(RowRegs& r, const float* part, int lrow, int lane) {
#pragma unroll
    for (int j = 0; j < 16; ++j) r.v[j] = (f32x4){0.f, 0.f, 0.f, 0.f};
#pragma unroll 2
    for (int c = 0; c < 8; ++c) { const GAS f32x4* q = (const GAS f32x4*)(part + ((size_t)c * 512 + lrow) * DM) + lane;
#pragma unroll
        for (int j = 0; j < 16; ++j) r.v[j] += q[64 * j]; }
}

__device__ __forceinline__ void phase_r0(Frame& F, KArgs a) {
    const float* mod = (const float*)(F.ws + WS_MOD); bf16* hx = (bf16*)(F.ws + WS_HX);
    const int gw = F.vcu * NWAVES + F.wave, NGW = F.G * NWAVES;
    for (int m = gw; m < MROWS; m += NGW) {
        const int b = m / TPB, t = m % TPB; const bool lat = t < SEQ;
        const float* src = lat ? a->in[0] + ((size_t)b * SEQ + t) * DM : a->in[2] + ((size_t)b * CTXL + (t - SEQ)) * DM;
        RowRegs x; row_load_f32(x, src, F.lane);
        const float rstd = 1.f / sqrtf(row_sumsq(x) * (1.f / DM) + EPS);
        const float* mv = mod + (size_t)(0 * 3 + (lat ? b : 2)) * NADA;
        row_modnorm_store(x, rstd, a->in[6]  , mv + DM, mv, hx + (size_t)m * DM, F.lane);
    }
}
__device__ __forceinline__ int r_row_balanced(int vcu, int wave, int k) {
    int id;
    if (wave < 2) { if (k == 0) { const int j = 2 * vcu + wave; return (j >> 8) * TPB + SEQ + (j & 255); } if (k > 1) return -1; id = 32 * vcu + wave; }
    else { if (k > 4) return -1; id = 32 * vcu + 2 + (wave - 2) * 5 + k; }
    return id + (id >= SEQ ? CTXL : 0);
}
__device__ __forceinline__ void phase_r1(Frame& F, KArgs a, int l, bool last) {
    const float* mod = (const float*)(F.ws + WS_MOD); bf16* xs = (bf16*)(F.ws + WS_XS); bf16* hx = (bf16*)(F.ws + WS_HX); const bf16* yb = (const bf16*)(F.ws + WS_Y);
    const int gw = F.vcu * NWAVES + F.wave, NGW = F.G * NWAVES; const bool bal = !last && F.G == 256;
    for (int k = 0;; ++k) {
        int m; if (bal) { m = r_row_balanced(F.vcu, F.wave, k); if (m < 0) break; } else { m = gw + k * NGW; if (m >= MROWS) break; }
        const int b = m / TPB, t = m % TPB; const bool lat = t < SEQ;
        if (last && !lat) continue;
        const float* mv = mod + (size_t)(l * 3 + (lat ? b : 2)) * NADA;
        RowRegs x, y;
        if (l == 0) row_load_f32(x, lat ? a->in[0] + ((size_t)b * SEQ + t) * DM : a->in[2] + ((size_t)b * CTXL + (t - SEQ)) * DM, F.lane);
        else row_load_bf16(x, xs + (size_t)m * DM, F.lane);
        if (lat) row_load_bf16(y, yb + (size_t)m * DM, F.lane); else row_load_part(y, (const float*)(F.ws + WS_PART), b * 256 + (t - SEQ), F.lane);
        const float rstd_y = 1.f / sqrtf(row_sumsq(y) * (1.f / DM) + EPS);
        row_residual(x, y, rstd_y, a->in[7] + (size_t)l * DM, mv + 2 * DM, F.lane);
        row_store_bf16(x, xs + (size_t)m * DM, F.lane);
        const float rstd = 1.f / sqrtf(row_sumsq(x) * (1.f / DM) + EPS);
        row_modnorm_store(x, rstd, a->in[8] + (size_t)l * DM, mv + 4 * DM, mv + 3 * DM, hx + (size_t)m * DM, F.lane);
    }
}
__device__ __forceinline__ void phase_r2(Frame& F, KArgs a, int l, bool last) {
    const float* mod = (const float*)(F.ws + WS_MOD); bf16* xs = (bf16*)(F.ws + WS_XS); bf16* hx = (bf16*)(F.ws + WS_HX); const bf16* yb = (const bf16*)(F.ws + WS_Y);
    const int gw = F.vcu * NWAVES + F.wave, NGW = F.G * NWAVES; const bool bal = !last && F.G == 256;
    for (int k = 0;; ++k) {
        int m; if (bal) { m = r_row_balanced(F.vcu, F.wave, k); if (m < 0) break; } else { m = gw + k * NGW; if (m >= MROWS) break; }
        const int b = m / TPB, t = m % TPB; const bool lat = t < SEQ;
        if (last && !lat) continue;
        const float* mv = mod + (size_t)(l * 3 + (lat ? b : 2)) * NADA;
        RowRegs x, y; row_load_bf16(x, xs + (size_t)m * DM, F.lane);
        if (lat) row_load_bf16(y, yb + (size_t)m * DM, F.lane); else row_load_part(y, (const float*)(F.ws + WS_PART), b * 256 + (t - SEQ), F.lane);
        const float rstd_y = 1.f / sqrtf(row_sumsq(y) * (1.f / DM) + EPS);
        row_residual(x, y, rstd_y, a->in[9] + (size_t)l * DM, mv + 5 * DM, F.lane);
        if (last) { row_store_f32(x, a->out + ((size_t)b * SEQ + t) * DM, F.lane); continue; }
        row_store_bf16(x, xs + (size_t)m * DM, F.lane);
        const float rstd = 1.f / sqrtf(row_sumsq(x) * (1.f / DM) + EPS);
        const float* mn = mod + (size_t)((l + 1) * 3 + (lat ? b : 2)) * NADA;
        row_modnorm_store(x, rstd, a->in[6] + (size_t)(l + 1) * DM, mn + DM, mn, hx + (size_t)m * DM, F.lane);
    }
}

__device__ __forceinline__ void phase_fixup(Frame& F, KArgs a, int l, bool last) {
    const float* side = (const float*)(F.ws + WS_U); bf16* ACT = (bf16*)(F.ws + WS_ACT);
    const float* cw = a->in[22] + (size_t)l * 3 * NUP;
    constexpr int CG = DFF / 4;
    const int ntile = last ? 32 : 34;
    for (int idx = F.vcu * NWAVES * 64 + F.tid; idx < ntile * 2 * CG; idx += F.G * NWAVES * 64) {
        const int cg = idx % CG, e = (idx / CG) & 1, pmi = idx / (2 * CG); const int pm = (last && pmi >= 16) ? pmi + 1 : pmi; const int pmb = pm % 17;
        const int col = cg * 4, vg = (col >> 7) * 256 + (col & 127);
        const float* sb = side + (size_t)pm * 4 * NUP;
        const f32x4 zero4 = {0.f, 0.f, 0.f, 0.f};
        f32x4 pg, pv, cg_, cv, ng, nv;
        if (e == 0) {
            cg_ = *(const GAS f32x4*)(sb + vg); cv = *(const GAS f32x4*)(sb + vg + 128); ng = *(const GAS f32x4*)(sb + NUP + vg); nv = *(const GAS f32x4*)(sb + NUP + vg + 128);
            if (pmb == 0 || pmb == 16) { pg = zero4; pv = zero4; } else { pg = *(const GAS f32x4*)(sb - NUP + vg); pv = *(const GAS f32x4*)(sb - NUP + vg + 128); }
        } else {
            cg_ = *(const GAS f32x4*)(sb + 3 * (size_t)NUP + vg); cv = *(const GAS f32x4*)(sb + 3 * (size_t)NUP + vg + 128); pg = *(const GAS f32x4*)(sb + 2 * (size_t)NUP + vg); pv = *(const GAS f32x4*)(sb + 2 * (size_t)NUP + vg + 128);
            if (pmb >= 15) { ng = zero4; nv = zero4; } else { ng = *(const GAS f32x4*)(sb + 4 * (size_t)NUP + vg); nv = *(const GAS f32x4*)(sb + 4 * (size_t)NUP + vg + 128); }
        }
        const f32x4 g = pg * *(const GAS f32x4*)(cw + col) + cg_ * *(const GAS f32x4*)(cw + NUP + col) + ng * *(const GAS f32x4*)(cw + 2 * NUP + col);
        const f32x4 v = pv * *(const GAS f32x4*)(cw + DFF + col) + cv * *(const GAS f32x4*)(cw + NUP + DFF + col) + nv * *(const GAS f32x4*)(cw + 2 * NUP + DFF + col);
        f32x4 o;
#pragma unroll
        for (int k = 0; k < 4; ++k) o[k] = g[k] / (1.f + __expf(-g[k])) * v[k];
        v2u w; w.x = pk2(o.x, o.y); w.y = pk2(o.z, o.w);
        *(GAS v2u*)(ACT + (size_t)(pm * 256 + (e ? 255 : 0)) * DFF + col) = w;
    }
}

template <int MASK>
__device__ __forceinline__ void attn_std_unit(Frame& F, const bf16* P, bf16* O, int b, int qrow0  , int qcol, int kcol, int vcol, int ocol,
                                              int nloc, int loc0, float sink, bool has_sink) {
    using namespace att;
    int lane_ = F.lane; asm volatile("" : "+v"(lane_));
    int lane = lane_, wid = F.wave, r32 = lane & 31, hi = lane >> 5;
    constexpr float SCALE = 0.088388347648318440f; constexpr float C = SCALE * 1.4426950408889634f;
    const size_t base = (size_t)b * TPB;
    const bf16* Qw = P + (base + qrow0 + wid * 32 + r32) * LDP + qcol + hi * 8;
    f32x16 o[4]; float m_reg, l_reg;
    attn_core<MASK, 0, 8>(o, m_reg, l_reg, Qw, P + base * LDP + kcol, P + base * LDP + vcol, nloc, loc0, qrow0 + wid * 32 + r32, C, 8.f / SCALE, (ALAS char*)F.lds);
    if (has_sink) l_reg += __builtin_amdgcn_exp2f(sink * 1.4426950408889634f - m_reg * C);
    asm volatile("" : "+v"(lane_)); lane = lane_; r32 = lane & 31; hi = lane >> 5;
    ALAS float* li_l = (ALAS float*)((ALAS char*)F.lds + WSCR_OFF) + wid * 64;
    if (hi == 0) li_l[r32] = l_reg; asm volatile("s_waitcnt lgkmcnt(0)" ::: "memory");
    bf16* Ow = O + (base + qrow0 + wid * 32) * LDO + ocol;
#pragma unroll
    for (int r = 0; r < 16; ++r) { const int orow = crow(r, hi); const float rl = __builtin_amdgcn_rcpf(li_l[orow]);
#pragma unroll
        for (int d0 = 0; d0 < 4; ++d0) Ow[(size_t)orow * LDO + d0 * 32 + r32] = (bf16)f2bf(o[d0][r] * rl); }
}
__device__ __forceinline__ void attn_diff_unit(Frame& F, const bf16* P, bf16* O, int b, int qrow0, int h, int nloc, int loc0, float lam, float omli, const float* gsub) {
    using namespace att;
    int lane_ = F.lane; asm volatile("" : "+v"(lane_));
    int lane = lane_, wid = F.wave, r32 = lane & 31, hi = lane >> 5;
    constexpr float SCALE = 0.125f; constexpr float C = SCALE * 1.4426950408889634f;
    const size_t base = (size_t)b * TPB;
    const bf16* Qw = P + (base + qrow0 + wid * 32 + r32) * LDP + QB_ + h * 128 + hi * 8;
    const bf16* Kb = P + base * LDP + KB_ + h * 128; const bf16* Vb = P + base * LDP + VB_ + h * 128;
    ALAS float* li_l = (ALAS float*)((ALAS char*)F.lds + WSCR_OFF) + wid * 64;
    f32x16 o[4]; float m_reg, l_reg;
    attn_core<0, 4, 4>(o, m_reg, l_reg, Qw, Kb, Vb, nloc, loc0, 0, C, 8.f / SCALE, (ALAS char*)F.lds);
    asm volatile("" : "+v"(lane_)); lane = lane_; r32 = lane & 31; hi = lane >> 5;
    if (hi == 0) li_l[r32] = l_reg; asm volatile("s_waitcnt lgkmcnt(0)" ::: "memory");
    { float* stash = (float*)(F.ws + WS_STASH) + ((size_t)blockIdx.x * 8 + wid) * 4096 + lane;
#pragma unroll
    for (int d0 = 0; d0 < 4; ++d0) { float* sp = stash + d0 * 1024; asm volatile("" : "+v"(sp));
#pragma unroll
        for (int r = 0; r < 16; ++r) sp[r * 64] = o[d0][r] * __builtin_amdgcn_rcpf(li_l[crow(r, hi)]); } }
    __syncthreads();
    attn_core<0, 0, 4>(o, m_reg, l_reg, Qw, Kb, Vb, nloc, loc0, 0, C, 8.f / SCALE, (ALAS char*)F.lds);
    asm volatile("" : "+v"(lane_)); lane = lane_; r32 = lane & 31; hi = lane >> 5;
    if (hi == 0) li_l[r32] = l_reg; asm volatile("s_waitcnt lgkmcnt(0)" ::: "memory");
    float* stash = (float*)(F.ws + WS_STASH) + ((size_t)blockIdx.x * 8 + wid) * 4096 + lane;
    float g4[4];
#pragma unroll
    for (int d0 = 0; d0 < 4; ++d0) g4[d0] = gsub[d0 * 32 + r32] * omli;
    bf16* Ow = O + (base + qrow0 + wid * 32) * LDO + QB_ + h * 128;
#pragma unroll
    for (int r = 0; r < 16; ++r) { const int orow = crow(r, hi); const float rl = __builtin_amdgcn_rcpf(li_l[orow]);
        float v[4]; float ss = 0.f;
#pragma unroll
        for (int d0 = 0; d0 < 4; ++d0) { v[d0] = o[d0][r] * rl - lam * stash[(d0 * 16 + r) * 64]; ss += v[d0] * v[d0]; }
        ss += __shfl_xor(ss, 1); ss += __shfl_xor(ss, 2); ss += __shfl_xor(ss, 4); ss += __shfl_xor(ss, 8); ss += __shfl_xor(ss, 16);
        const float rstd = 1.f / sqrtf(ss * (1.f / 128.f) + EPS);
#pragma unroll
        for (int d0 = 0; d0 < 4; ++d0) Ow[(size_t)orow * LDO + d0 * 32 + r32] = (bf16)f2bf(v[d0] * rstd * g4[d0]); }
}

__device__ __forceinline__ void phase_attention(Frame& F, KArgs a, int l, bool last) {
    const bf16* P = (const bf16*)(F.ws + WS_P); bf16* O = (bf16*)(F.ws + WS_O);
    const float* lamv = (const float*)(F.ws + WS_TAB + 32768); const float lam = lamv[l * 2], omli = lamv[l * 2 + 1];
    const float* sinkv = a->in[19] + l * 8; const float* gsub = a->in[18] + l * 128; const float* nab = a->in[20] + (size_t)l * 8 * 15 * 31;
#ifndef ATT_MASK
#define ATT_MASK 15
#endif
    if (ATT_MASK & 1) for (int it = 0;; ++it) { int u;
        if (F.G == 256) { if (it == 0) u = F.vcu; else if (it == 1 && !last && F.vcu >= 192 && F.vcu < 208) u = 256 + (F.vcu - 192); else break; }
        else { u = F.vcu + it * F.G; if (u >= (last ? 256 : 272)) break; }
        int b, h, qrow0, nloc;
        if (u < 256) { b = u >> 7; h = (u >> 4) & 7; qrow0 = (u & 15) * 256; nloc = 64; } else { const int e = u - 256; b = e >> 3; h = e & 7; qrow0 = SEQ; nloc = 0; }
        __syncthreads(); attn_diff_unit(F, P, O, b, qrow0, h, nloc, 0, lam, omli, gsub);
    }
    if (ATT_MASK & 2) for (int it = 0;; ++it) { int u;
        if (F.G == 256) { if (it == 0) u = F.vcu; else if (it == 1 && !last && F.vcu >= 208) u = 256 + (F.vcu - 208); else break; }
        else { u = F.vcu + it * F.G; if (u >= (last ? 256 : 304)) break; }
        int b, qrow0, qcol, kcol, vcol, nloc; float sink = 0.f; bool has_sink = false;
        if (u < 256) { const int h = (u >> 4) & 7, qb = u & 15; b = u >> 7; qrow0 = qb * 256; qcol = QA + h * 128; kcol = KA + (h >> 2) * 128; vcol = VA + (h >> 2) * 128; nloc = 64; }
        else { const int e = u - 256, g = e >> 4, h = e & 7; b = (e >> 3) & 1; qrow0 = SEQ; nloc = 0;
            if (g == 0) { qcol = QA + h * 128; kcol = KA + (h >> 2) * 128; vcol = VA + (h >> 2) * 128; }
            else if (g == 1) { qcol = QC + h * 128; kcol = KC + (h >> 2) * 128; vcol = VC + (h >> 2) * 128; sink = sinkv[h]; has_sink = true; }
            else { qcol = QD + h * 128; kcol = KD + h * 128; vcol = VD + h * 128; } }
        __syncthreads(); attn_std_unit<0>(F, P, O, b, qrow0, qcol, kcol, vcol, qcol, nloc, 0, sink, has_sink);
    }
    if (ATT_MASK & 4) for (int u = F.vcu; u < 256; u += F.G) { const int b = u >> 7, h = (u >> 4) & 7, qb = u & 15;
        const int lo = max(qb * 256 - 128, 0), hiK = min(qb * 256 + 384, SEQ);
        __syncthreads(); attn_std_unit<2>(F, P, O, b, qb * 256, QC + h * 128, KC + (h >> 2) * 128, VC + (h >> 2) * 128, QC + h * 128, (hiK - lo) / 64, lo, sinkv[h], true); }
    if (ATT_MASK & 8) for (int u = F.vcu; u < 256; u += F.G) { const int b = u >> 7, h = (u >> 4) & 7, qb = u & 15;
        const int r0 = qb * 4; int rlo, nrow;
        if (r0 == 0) { rlo = 0; nrow = 8; } else if (r0 == 60) { rlo = 56; nrow = 8; } else { rlo = min(r0 - 4, 52); nrow = 12; }
        __syncthreads();
        { LAS float* bl = (LAS float*)(F.lds + att::BIAS_OFF); for (int e = F.tid; e < 15 * 31; e += NWAVES * 64) bl[e] = nab[h * 465 + e] * 11.313708498984761f; }
        attn_std_unit<3>(F, P, O, b, qb * 256, QD + h * 128, KD + h * 128, VD + h * 128, QD + h * 128, nrow, rlo * 64, 0.f, false); }
    __syncthreads();
}

__global__ void __launch_bounds__(NWAVES * 64, 2) fwd_kernel(Args args) {
    extern __shared__ __attribute__((aligned(16))) unsigned char lds[];
    Frame F;
    F.lds = (LAS unsigned char*)lds;
    volatile LAS unsigned* MISC = (volatile LAS unsigned*)(F.lds + MISC_OFF);
    F.tid = threadIdx.x; F.lane = F.tid & 63; F.wave = __builtin_amdgcn_readfirstlane(F.tid >> 6);
    F.G = gridDim.x; { const int bx = blockIdx.x; F.vcu = (F.G % 8 == 0) ? (bx % 8) * (F.G / 8) + bx / 8 : bx; }
    KArgs ap = (KArgs)__builtin_amdgcn_kernarg_segment_ptr();
    F.ws = ap->ws;
    gu32* ctl = (gu32*)(F.ws + WS_CTL);
    for (int u = F.tid; u < (LDS_BYTES - LDSCTL_OFF) / 4; u += NWAVES * 64) ((LAS unsigned*)(F.lds + LDSCTL_OFF))[u] = 0u;
    __syncthreads();
    const int lo = ap->ph_lo, hi = ap->ph_hi;
    XcdBarrier bar; bar.bar = (unsigned*)(ctl + CW_BAR); bar.x = 0; bar.st = nullptr;
    if (hi - lo > 1) bar = xcd_barrier_post((unsigned*)(ctl + CW_BAR), MISC + 8);
#ifndef PH_MASK
#define PH_MASK 0x7ff
#endif
#ifndef REP_PRO
#define REP_PRO 1
#endif
#ifndef REP_ATT
#define REP_ATT 1
#endif
#ifndef REP_GEMM
#define REP_GEMM 1
#endif
#ifndef REP_CONV
#define REP_CONV 1
#endif
#define IN(k) (lo <= (k) && (k) < hi)
#define FRESH() asm volatile("" : "+v"(F.tid), "+v"(F.lane), "+s"(ap))
#define EN(j) (((PH_MASK) >> (j)) & 1)
#define SEAM(k) do { if (IN(k) && IN((k) + 1)) xcd_barrier(bar); } while (0)

    if (EN(0) && IN(0)) { for (int rep = 0; rep < REP_PRO; ++rep) { FRESH(); phase_prologue(F, ap); __syncthreads(); } } SEAM(0);
    if (EN(1) && IN(1)) { FRESH(); phase_r0(F, ap); } SEAM(1);
    for (int l = 0; l < 2; ++l) {
        const bool last = (l == 1); const int pb = 2 + 8 * l;
        const pg8::bf16_t* HX = (const pg8::bf16_t*)(F.ws + WS_HX);
        if (EN(2) && IN(pb + 0)) {
            pg8::Gemm g{HX, (const pg8::bf16_t*)(F.ws + WS_WIN + (size_t)l * 72 * MiB), MROWS, NIN, DM};
            pg8::StaticOrder S; if (!last) S.init(MROWS / 256, NIN, DM, F.G, fresh_bx(), 0); else { S.init(32, NIN, DM, F.G, fresh_bx(), 1); S.extra = 40; S.xpn0 = 16; }
            { FRESH(); const f32x4* tg = (const f32x4*)(F.ws + WS_TAB); LAS f32x4* tl = (LAS f32x4*)(F.lds + THD_OFF);
              for (int e = F.tid; e < 1024; e += NWAVES * 64) tl[e] = tg[e];
              LAS float* gl = (LAS float*)(F.lds + GAINS_OFF); if (F.tid < 256) gl[F.tid] = (F.tid < 128 ? ap->in[12] + l * 128 : ap->in[13] + l * 128 - 128)[F.tid];
              __syncthreads(); }
            pg8::EpiInProj E{(pg8::bf16_t*)(F.ws + WS_P), NIN, (const LAS float*)(F.lds + THD_OFF), (const LAS float*)(F.lds + GAINS_OFF), (LAS float*)(F.lds + XCH_OFF)};
            pg8::gemm_phase<pg8::EpiInProj, pg8::StaticOrder, true>(F.lds + RING_OFF, g, S, E);
            if (F.G == 256) { if (!last) tail_convert(F, ap, (34 * 36) % 256, 1, 0, 0, -1, 0, 0); else tail_convert(F, ap, (32 * 36 + 40) % 256, 1, 1, 0, 3, 1, 1); }
        } SEAM(pb + 0);
        if (EN(4) && IN(pb + 1)) { for (int rep = 0; rep < REP_ATT; ++rep) { FRESH(); phase_attention(F, ap, l, last); } } SEAM(pb + 1);
        if (EN(5) && IN(pb + 2)) {
            pg8::Gemm g{(const pg8::bf16_t*)(F.ws + WS_O), (const pg8::bf16_t*)(F.ws + WS_WOUT + (size_t)l * 32 * MiB), MROWS, DM, DM};
            pg8::SplitOrder S; S.init(DM, DM, F.G, fresh_bx()); if (last) S.ca = 0;
            pg8::EpiSplit E{(pg8::bf16_t*)(F.ws + WS_Y), (float*)(F.ws + WS_PART), DM};
            pg8::gemm_phase<pg8::EpiSplit, pg8::SplitOrder, true>(F.lds + RING_OFF, g, S, E);
        } SEAM(pb + 2);
        if (EN(6) && IN(pb + 3)) { FRESH(); phase_r1(F, ap, l, last); } SEAM(pb + 3);
        if (EN(7) && IN(pb + 4)) {
            pg8::Gemm g{HX, (const pg8::bf16_t*)(F.ws + WS_WUP + (size_t)l * 172 * MiB), MROWS, NUP, DM};
            pg8::StaticOrder S; S.init(last ? 32 : 34, NUP, DM, F.G, fresh_bx(), last ? 1 : 0);
            pg8::EpiUpConv E{(pg8::bf16_t*)(F.ws + WS_ACT), (float*)(F.ws + WS_U), ap->in[22] + (size_t)l * 3 * NUP, (LAS float*)(F.lds + XCH_OFF), DFF, (LAS float*)(F.lds + WL_OFF), (LAS float*)(F.lds + GAINS_OFF), 0};
            pg8::gemm_phase<pg8::EpiUpConv, pg8::StaticOrder, true>(F.lds + RING_OFF, g, S, E);
            if (F.G == 256) { if (!last) tail_convert(F, ap, (34 * 86) % 256, 3, 0, 0, 0, 1, 0); else tail_convert(F, ap, (32 * 86) % 256, 3, 1, 2, -1, 0, 0); }
        } SEAM(pb + 4);
        if (EN(8) && IN(pb + 5)) { for (int rep = 0; rep < REP_CONV; ++rep) { FRESH(); phase_fixup(F, ap, l, last); } } SEAM(pb + 5);
        if (EN(9) && IN(pb + 6)) {
            pg8::Gemm g{(const pg8::bf16_t*)(F.ws + WS_ACT), (const pg8::bf16_t*)(F.ws + WS_WDN + (size_t)l * 86 * MiB), MROWS, DM, DFF};
            pg8::SplitOrder S; S.init(DM, DFF, F.G, fresh_bx()); if (last) S.ca = 0;
            pg8::EpiSplit E{(pg8::bf16_t*)(F.ws + WS_Y), (float*)(F.ws + WS_PART), DM};
            pg8::gemm_phase<pg8::EpiSplit, pg8::SplitOrder, true>(F.lds + RING_OFF, g, S, E);
        } SEAM(pb + 6);
        if (EN(10) && IN(pb + 7)) { FRESH(); phase_r2(F, ap, l, last); } SEAM(pb + 7);
    }
#undef IN
#undef SEAM
}

extern "C" void kernel_launch(void* const* d_in, const int* in_sizes, int n_in, void* d_out, int out_size, void* d_ws, size_t ws_size, hipStream_t stream) {
    static int grid = 0;
    if (grid == 0) {
        if (n_in != 24 || in_sizes[0] != NB * SEQ * DM || out_size != NB * SEQ * DM || ws_size < WS_END) {
            fprintf(stderr, "kernel_launch: unexpected shapes: n_in %d in0 %d out %d ws %zu (need %zu); nothing launched\n", n_in, n_in > 0 ? in_sizes[0] : -1, out_size, ws_size, (size_t)WS_END); grid = -1; return; }
        int dev = 0, cus = 0, per_cu = 0;
        if (hipGetDevice(&dev) != hipSuccess || hipDeviceGetAttribute(&cus, hipDeviceAttributeMultiprocessorCount, dev) != hipSuccess) { grid = -1; return; }
        if (hipFuncSetAttribute((const void*)fwd_kernel, hipFuncAttributeMaxDynamicSharedMemorySize, LDS_BYTES) != hipSuccess) { fprintf(stderr, "kernel_launch: hipFuncSetAttribute failed\n"); grid = -1; return; }
        if (hipOccupancyMaxActiveBlocksPerMultiprocessor(&per_cu, (const void*)fwd_kernel, NWAVES * 64, LDS_BYTES) != hipSuccess || per_cu < 1)
            fprintf(stderr, "kernel_launch: note: occupancy query reports %d workgroups per CU\n", per_cu);
        (void)hipGetLastError();
        grid = cus;
    }
    if (grid < 0) return;
    if (hipMemsetAsync((char*)d_ws + WS_CTL, 0, CTL_ZERO_BYTES, stream) != hipSuccess) return;
    Args a{};
    for (int i = 0; i < 24; ++i) a.in[i] = (const float*)d_in[i];
    a.out = (float*)d_out; a.ws = (unsigned char*)d_ws;
#if MK_SINGLE
    a.ph_lo = 0; a.ph_hi = NPHASE;
    hipLaunchKernelGGL(fwd_kernel, dim3(grid), dim3(NWAVES * 64), LDS_BYTES, stream, a);
#else
    for (int p = 0; p < NPHASE; ++p) { a.ph_lo = p; a.ph_hi = p + 1; hipLaunchKernelGGL(fwd_kernel, dim3(grid), dim3(NWAVES * 64), LDS_BYTES, stream, a); }
#endif
    const hipError_t le = hipPeekAtLastError();
    if (le != hipSuccess) fprintf(stderr, "kernel_launch: launch failed: %s\n", hipGetErrorName(le));
}
```
